# Optimizing an MI355X kernel written in HIP

```python
import jax, jax.numpy as jnp
from jax import lax
import numpy as np

D_MODEL = 2048
BATCH = 4
SEQ = 4096
DEPTH = 2

CTX_LEN = 256
GRID_W = 64
EPS = 1e-6
HEAD_DIM = 128
ROT_AXIS = HEAD_DIM // 2
ROPE_THETA = 10000.0
Q_BLOCK = 128
ATTN_WIDTH = D_MODEL // 2
N_Q_HEADS = ATTN_WIDTH // HEAD_DIM
N_KV_HEADS = N_Q_HEADS // 4
KV_WIDTH = N_KV_HEADS * HEAD_DIM
SCONV_WIDTH = D_MODEL // 2
SCONV_K = 3
SCONV_PAD = 1
EVEN_SIZES = (ATTN_WIDTH, KV_WIDTH, KV_WIDTH, SCONV_WIDTH, SCONV_WIDTH, SCONV_WIDTH)
EVEN_IN = sum(EVEN_SIZES)
EVEN_OUT = ATTN_WIDTH + SCONV_WIDTH
LRU_WIDTH = 5 * D_MODEL // 4
LRU_BLOCK = 256
N_LRU_BLOCKS = LRU_WIDTH // LRU_BLOCK
LRU_CONV_K = 4
LRU_CONV_PAD = 1
LRU_C = 8.0
N_EXPERTS = 16
EXPERT_FF = D_MODEL
EC_FACTOR = 2
N_EVEN = (DEPTH + 1) // 2
N_ODD = DEPTH // 2

kernel_name = "hybrid_attn_conv_rglru_ecmoe_dit"


def rmsnorm(x, g):
    xf = x.astype(jnp.float32)
    y = xf * lax.rsqrt(jnp.mean(xf * xf, axis=-1, keepdims=True) + EPS)
    return (y * g.astype(jnp.float32)).astype(x.dtype)


def adaln(cvec, w, b):
    m = jax.nn.silu(cvec) @ w + b
    return jnp.split(m, 6, axis=-1)


def modulate(h, shift, scale):
    return h * (1 + scale) + shift


def split_cols(p, sizes):
    idx = np.cumsum(np.array(sizes))[:-1].tolist()
    return jnp.split(p, idx, axis=-1)


def heads(t, nh):
    return t.reshape(t.shape[:2] + (nh, HEAD_DIM))


def headnorm(t, g):
    tf = t.astype(jnp.float32)
    y = tf * lax.rsqrt(jnp.mean(tf * tf, axis=-1, keepdims=True) + EPS)
    return (y * g.astype(jnp.float32)).astype(t.dtype)


def rope_tables(pos):
    freqs = ROPE_THETA ** (-jnp.arange(0, ROT_AXIS, 2, dtype=jnp.float32) / ROT_AXIS)
    ang = pos.astype(jnp.float32)[:, None] * freqs[None, :]
    return jnp.cos(ang)[None, :, None, :], jnp.sin(ang)[None, :, None, :]


def rotate(u, cos, sin):
    u1, u2 = jnp.split(u, 2, axis=-1)
    return jnp.concatenate([u1 * cos - u2 * sin, u1 * sin + u2 * cos], axis=-1)


def rope2d(t, rope):
    cos_r, sin_r, cos_c, sin_c = rope
    tf = t.astype(jnp.float32)
    out = jnp.concatenate([rotate(tf[..., :ROT_AXIS], cos_r, sin_r),
                           rotate(tf[..., ROT_AXIS:], cos_c, sin_c)], axis=-1)
    return out.astype(t.dtype)


def block_attention(q, k, v):
    bsz, n = q.shape[0], q.shape[1]
    grp = N_Q_HEADS // N_KV_HEADS
    qb = q.reshape(bsz, n // Q_BLOCK, Q_BLOCK, N_KV_HEADS, grp, HEAD_DIM).transpose(1, 0, 2, 3, 4, 5)
    scale = HEAD_DIM ** -0.5

    def one(qblk):
        s = jnp.einsum('bqkgd,bskd->bkgqs', qblk, k).astype(jnp.float32) * scale
        p = jax.nn.softmax(s, axis=-1).astype(v.dtype)
        return jnp.einsum('bkgqs,bskd->bqkgd', p, v)

    o = lax.map(one, qb)
    return o.transpose(1, 0, 2, 3, 4, 5).reshape(bsz, n, N_Q_HEADS * HEAD_DIM)


def dwconv(u, w, b, pad_left):
    k_w = w.shape[0]
    n = u.shape[1]
    up = jnp.pad(u, ((0, 0), (pad_left, k_w - 1 - pad_left), (0, 0)))
    acc = up[:, 0:n] * w[0]
    for j in range(1, k_w):
        acc = acc + up[:, j:j + n] * w[j]
    return acc + b


def even_mixer(a_lat, a_ctx, w_in, q_g, k_g, conv_w, conv_b, w_out, rope, need_ctx):
    ql, kl, vl, bl, cl, ul = split_cols(a_lat @ w_in, EVEN_SIZES)
    ql = rope2d(headnorm(heads(ql, N_Q_HEADS), q_g), rope)
    kl = rope2d(headnorm(heads(kl, N_KV_HEADS), k_g), rope)
    vl = heads(vl, N_KV_HEADS)
    if need_ctx:
        qc, kc, vc, bc, cc, uc = split_cols(a_ctx @ w_in, EVEN_SIZES)
    else:
        kc, vc = split_cols(a_ctx @ w_in[:, ATTN_WIDTH:ATTN_WIDTH + 2 * KV_WIDTH], (KV_WIDTH, KV_WIDTH))
    kc = headnorm(heads(kc, N_KV_HEADS), k_g)
    vc = heads(vc, N_KV_HEADS)
    k_all = jnp.concatenate([kc, kl], axis=1)
    v_all = jnp.concatenate([vc, vl], axis=1)
    att_lat = block_attention(ql, k_all, v_all)
    conv_lat = bl * dwconv(cl * ul, conv_w, conv_b, SCONV_PAD)
    y_lat = jnp.concatenate([att_lat, conv_lat], axis=-1) @ w_out
    if not need_ctx:
        return y_lat, None
    qc = headnorm(heads(qc, N_Q_HEADS), q_g)
    att_ctx = block_attention(qc, kc, vc)
    conv_ctx = bc * dwconv(cc * uc, conv_w, conv_b, SCONV_PAD)
    y_ctx = jnp.concatenate([att_ctx, conv_ctx], axis=-1) @ w_out
    return y_lat, y_ctx


def blockdiag(u, w):
    bsz, n, width = u.shape
    ub = u.reshape(bsz, n, N_LRU_BLOCKS, LRU_BLOCK)
    return jnp.einsum('bnhi,hij->bnhj', ub, w).reshape(bsz, n, width)


def rglru_coeffs(u, wa, ba, wx, bx, lam):
    r = jax.nn.sigmoid((blockdiag(u, wa) + ba).astype(jnp.float32))
    ig = jax.nn.sigmoid((blockdiag(u, wx) + bx).astype(jnp.float32))
    log_a = -LRU_C * r * jax.nn.softplus(-lam.astype(jnp.float32))
    a = jnp.exp(log_a)
    bterm = jnp.sqrt(-jnp.expm1(2.0 * log_a)) * ig * u.astype(jnp.float32)
    return a, bterm


def linear_scan(a, b, h0, reverse):
    def step(h, ab):
        a_t, b_t = ab
        h = a_t * h + b_t
        return h, h
    h_fin, ys = lax.scan(step, h0, (a.swapaxes(0, 1), b.swapaxes(0, 1)), reverse=reverse)
    return ys.swapaxes(0, 1), h_fin


def odd_mixer(a_lat, a_ctx, w_in, conv_w, conv_b, wa, ba, wx, bx, lam, w_out, need_ctx):
    xl, gl = split_cols(a_lat @ w_in, (LRU_WIDTH, LRU_WIDTH))
    if need_ctx:
        xc, gc = split_cols(a_ctx @ w_in, (LRU_WIDTH, LRU_WIDTH))
    else:
        xc = a_ctx @ w_in[:, :LRU_WIDTH]
    ul = dwconv(xl, conv_w, conv_b, LRU_CONV_PAD)
    uc = dwconv(xc, conv_w, conv_b, LRU_CONV_PAD)
    h0 = jnp.zeros((a_ctx.shape[0], LRU_WIDTH), jnp.float32)
    y_lat = jnp.zeros(ul.shape, jnp.float32)
    y_ctx = jnp.zeros(uc.shape, jnp.float32)
    for d, rev in ((0, False), (1, True)):
        ac, bc = rglru_coeffs(uc, wa[d], ba[d], wx[d], bx[d], lam[d])
        hc, hc_fin = linear_scan(ac, bc, h0, rev)
        al, bl = rglru_coeffs(ul, wa[d], ba[d], wx[d], bx[d], lam[d])
        hl, _ = linear_scan(al, bl, hc_fin, rev)
        y_lat = y_lat + hl
        y_ctx = y_ctx + hc
    out_lat = (y_lat.astype(a_lat.dtype) * jax.nn.gelu(gl)) @ w_out
    if not need_ctx:
        return out_lat, None
    out_ctx = (y_ctx.astype(a_ctx.dtype) * jax.nn.gelu(gc)) @ w_out
    return out_lat, out_ctx


def ec_moe(h, w_router, w_gate, w_up, w_down):
    n = h.shape[1]
    cap = max(1, EC_FACTOR * n // N_EXPERTS)
    logits = jnp.einsum('bnd,de->bne', h, w_router).astype(jnp.float32)
    aff = jax.nn.softmax(logits, axis=-1)
    g, idx = lax.top_k(aff.transpose(0, 2, 1), cap)
    xs = jax.vmap(lambda hb, ib: hb[ib])(h, idx)
    hid = jax.nn.silu(jnp.einsum('becd,edf->becf', xs, w_gate)) * jnp.einsum('becd,edf->becf', xs, w_up)
    out = jnp.einsum('becf,efd->becd', hid, w_down) * g[..., None].astype(h.dtype)
    d = h.shape[-1]
    return jax.vmap(lambda ob, ib: jnp.zeros((n, d), ob.dtype).at[ib.reshape(-1)].add(ob.reshape(-1, d)))(out, idx)


def setup_inputs(seed: int = 0) -> dict:
    key = jax.random.key(seed)
    ks = jax.random.split(key, 32)
    f32 = jnp.float32
    D = D_MODEL

    def nrm(k, shape, scale):
        return jax.random.normal(k, shape, f32) * scale

    u = jax.random.uniform(ks[20], (N_ODD, 2, LRU_WIDTH), f32, 0.9, 0.999)
    a_base = u ** (1.0 / LRU_C)
    od_lam = jnp.log(a_base) - jnp.log1p(-a_base)
    return {
        "x": nrm(ks[0], (BATCH, SEQ, D), 1.0),
        "c": nrm(ks[1], (BATCH, D), 1.0),
        "ctx": nrm(ks[2], (BATCH, CTX_LEN, D), 1.0),
        "c_ctx": nrm(ks[3], (D,), 1.0),
        "mod_w": nrm(ks[4], (DEPTH, D, 6 * D), D ** -0.5),
        "mod_b": nrm(ks[5], (DEPTH, 6 * D), 0.01),
        "norm1_g": 1.0 + nrm(ks[6], (DEPTH, D), 0.02),
        "norm2_g": 1.0 + nrm(ks[7], (DEPTH, D), 0.02),
        "ev_w_in": nrm(ks[8], (N_EVEN, D, EVEN_IN), D ** -0.5),
        "ev_q_norm": 1.0 + nrm(ks[9], (N_EVEN, HEAD_DIM), 0.02),
        "ev_k_norm": 1.0 + nrm(ks[10], (N_EVEN, HEAD_DIM), 0.02),
        "ev_conv_w": nrm(ks[11], (N_EVEN, SCONV_K, SCONV_WIDTH), SCONV_K ** -0.5),
        "ev_conv_b": nrm(ks[12], (N_EVEN, SCONV_WIDTH), 0.01),
        "ev_w_out": nrm(ks[13], (N_EVEN, EVEN_OUT, D), EVEN_OUT ** -0.5),
        "od_w_in": nrm(ks[14], (N_ODD, D, 2 * LRU_WIDTH), D ** -0.5),
        "od_conv_w": nrm(ks[15], (N_ODD, LRU_CONV_K, LRU_WIDTH), LRU_CONV_K ** -0.5),
        "od_conv_b": nrm(ks[16], (N_ODD, LRU_WIDTH), 0.01),
        "od_wa": nrm(ks[17], (N_ODD, 2, N_LRU_BLOCKS, LRU_BLOCK, LRU_BLOCK), LRU_BLOCK ** -0.5),
        "od_ba": nrm(ks[18], (N_ODD, 2, LRU_WIDTH), 0.01),
        "od_wx": nrm(ks[19], (N_ODD, 2, N_LRU_BLOCKS, LRU_BLOCK, LRU_BLOCK), LRU_BLOCK ** -0.5),
        "od_bx": nrm(ks[21], (N_ODD, 2, LRU_WIDTH), 0.01),
        "od_lam": od_lam,
        "od_w_out": nrm(ks[22], (N_ODD, LRU_WIDTH, D), LRU_WIDTH ** -0.5),
        "moe_router": nrm(ks[23], (DEPTH, D, N_EXPERTS), D ** -0.5),
        "moe_w_gate": nrm(ks[24], (DEPTH, N_EXPERTS, D, EXPERT_FF), D ** -0.5),
        "moe_w_up": nrm(ks[25], (DEPTH, N_EXPERTS, D, EXPERT_FF), D ** -0.5),
        "moe_w_down": nrm(ks[26], (DEPTH, N_EXPERTS, EXPERT_FF, D), EXPERT_FF ** -0.5),
        "final_norm_g": 1.0 + nrm(ks[27], (D,), 0.02),
    }


def reference(x, c, ctx, c_ctx, mod_w, mod_b, norm1_g, norm2_g, ev_w_in, ev_q_norm, ev_k_norm,
              ev_conv_w, ev_conv_b, ev_w_out, od_w_in, od_conv_w, od_conv_b, od_wa, od_ba, od_wx,
              od_bx, od_lam, od_w_out, moe_router, moe_w_gate, moe_w_up, moe_w_down, final_norm_g):
    n = x.shape[1]
    rows = n // GRID_W
    row = jnp.repeat(jnp.arange(rows), GRID_W)
    col = jnp.tile(jnp.arange(GRID_W), rows)
    cos_r, sin_r = rope_tables(row)
    cos_c, sin_c = rope_tables(col)
    rope = (cos_r, sin_r, cos_c, sin_c)

    h_lat = x
    h_ctx = ctx
    for i in range(DEPTH):
        need_ctx = i < DEPTH - 1
        ml = [m[:, None, :] for m in adaln(c, mod_w[i], mod_b[i])]
        mc = adaln(c_ctx, mod_w[i], mod_b[i])
        a_lat = modulate(rmsnorm(h_lat, norm1_g[i]), ml[0], ml[1])
        a_ctx = modulate(rmsnorm(h_ctx, norm1_g[i]), mc[0], mc[1])
        if i % 2 == 0:
            j = i // 2
            y_lat, y_ctx = even_mixer(a_lat, a_ctx, ev_w_in[j], ev_q_norm[j], ev_k_norm[j],
                                      ev_conv_w[j], ev_conv_b[j], ev_w_out[j], rope, need_ctx)
        else:
            j = i // 2
            y_lat, y_ctx = odd_mixer(a_lat, a_ctx, od_w_in[j], od_conv_w[j], od_conv_b[j], od_wa[j],
                                     od_ba[j], od_wx[j], od_bx[j], od_lam[j], od_w_out[j], need_ctx)
        h_lat = h_lat + ml[2] * y_lat
        b_lat = modulate(rmsnorm(h_lat, norm2_g[i]), ml[3], ml[4])
        h_lat = h_lat + ml[5] * ec_moe(b_lat, moe_router[i], moe_w_gate[i], moe_w_up[i], moe_w_down[i])
        if need_ctx:
            h_ctx = h_ctx + mc[2] * y_ctx
            b_ctx = modulate(rmsnorm(h_ctx, norm2_g[i]), mc[3], mc[4])
            h_ctx = h_ctx + mc[5] * ec_moe(b_ctx, moe_router[i], moe_w_gate[i], moe_w_up[i], moe_w_down[i])
    return rmsnorm(h_lat, final_norm_g)
```

```cpp
#include <hip/hip_runtime.h>
#include <cstdio>
#include <cstdint>

#ifndef MK_PER_PHASE
#define MK_PER_PHASE 0
#endif

#define LAS __attribute__((address_space(3)))
typedef unsigned short bf16_t;
typedef short bf16x8 __attribute__((ext_vector_type(8)));
typedef short s16x4 __attribute__((ext_vector_type(4)));
typedef float f32x4 __attribute__((ext_vector_type(4)));
typedef float f32x2 __attribute__((ext_vector_type(2)));
typedef float f32x16 __attribute__((ext_vector_type(16)));
typedef unsigned u32x4 __attribute__((ext_vector_type(4)));
typedef unsigned u32x2 __attribute__((ext_vector_type(2)));
typedef int i32x8 __attribute__((ext_vector_type(8)));
typedef int i32x8a __attribute__((ext_vector_type(8), aligned(16)));
typedef int i32x4a __attribute__((ext_vector_type(4), aligned(16)));

#define XB_TMO      128
#define XB_XCNT(j)  (256  + 64 * (j))
#define XB_XSUB(j)  (1280 + 64 * (j))
#define XB_XGEN(j)  (2304 + 64 * (j))
#define XB_TOP      3328
#define XB_TOPGEN   3392
#define XCD_BAR_WORDS 3456
#define XB_SPIN_CAP (1u << 18)

__device__ __forceinline__ unsigned xb_ld(unsigned* p)              { return __hip_atomic_load(p, __ATOMIC_RELAXED, __HIP_MEMORY_SCOPE_AGENT); }
__device__ __forceinline__ unsigned xb_add(unsigned* p, unsigned v) { return __hip_atomic_fetch_add(p, v, __ATOMIC_RELAXED, __HIP_MEMORY_SCOPE_AGENT); }
__device__ __forceinline__ unsigned xb_xcc_id() { return (unsigned)__builtin_amdgcn_s_getreg((3 << 11) | 20) & 0xFu; }
#define XB_SPIN(cond, bar) do { unsigned _sp = 0; while (cond) { __builtin_amdgcn_s_sleep(1); \
    if ((++_sp & 255u) == 0u) { if (xb_ld(&(bar)[XB_TMO])) break; if (_sp > XB_SPIN_CAP) { atomicAdd(&(bar)[XB_TMO], 1u); break; } } } } while (0)

struct XcdBarrier { unsigned* bar; unsigned x; volatile LAS unsigned* st; int wid; };

__device__ __forceinline__ int xb_lane() { int l; asm volatile("v_mbcnt_lo_u32_b32 %0, -1, 0\n\tv_mbcnt_hi_u32_b32 %0, -1, %0" : "=v"(l)); return l; }
__device__ __forceinline__ XcdBarrier xcd_barrier_post(unsigned* bar, volatile LAS unsigned* st, int wid) {
    XcdBarrier b; b.bar = bar; b.x = xb_xcc_id(); b.st = st; b.wid = wid;
    if (wid == 0 && xb_lane() == 0) (void)xb_add(&bar[XB_XCNT(b.x)], 1u);
    return b;
}
__device__ __forceinline__ void xcd_barrier_complete(unsigned* bar, unsigned x, unsigned& nloc, unsigned& nx) {
    const unsigned G = gridDim.x * gridDim.y * gridDim.z;
    unsigned sum, cnt, mine, sp = 0u;
    for (;;) {
        sum = 0u; cnt = 0u; mine = 0u;
#pragma unroll
        for (unsigned j = 0; j < 16; ++j) { const unsigned c = xb_ld(&bar[XB_XCNT(j)]); sum += c; cnt += (c > 0u) ? 1u : 0u; mine = (j == x) ? c : mine; }
        if (sum == G) break;
        __builtin_amdgcn_s_sleep(1);
        if ((++sp & 255u) == 0u) { if (xb_ld(&bar[XB_TMO])) break; if (sp > XB_SPIN_CAP) { atomicAdd(&bar[XB_TMO], 1u); break; } }
    }
    nloc = mine > 0u ? mine : 1u; nx = cnt > 0u ? cnt : 1u;
}
__device__ __forceinline__ void xcd_barrier(const XcdBarrier& b) {
    asm volatile("s_waitcnt vmcnt(0)" ::: "memory");
    __syncthreads();
    if (b.wid == 0 && xb_lane() == 0) {
        unsigned* bar = b.bar;
        __builtin_amdgcn_s_waitcnt(0);
        unsigned nloc = b.st[0], nx = b.st[1];
        if (nloc == 0u) { xcd_barrier_complete(bar, b.x, nloc, nx); b.st[0] = nloc; b.st[1] = nx; }
        const unsigned old = xb_add(&bar[XB_XSUB(b.x)], 1u);
        const unsigned gen = old / nloc;
        if (old + 1u == (gen + 1u) * nloc) {
            __builtin_amdgcn_fence(__ATOMIC_RELEASE, "agent");
            asm volatile("s_waitcnt vmcnt(0)" ::: "memory");
            const unsigned og = xb_add(&bar[XB_TOP], 1u);
            const unsigned tg = og / nx;
            if (og + 1u == (tg + 1u) * nx) xb_add(&bar[XB_TOPGEN], 1u);
            else XB_SPIN(xb_ld(&bar[XB_TOPGEN]) == tg, bar);
            __builtin_amdgcn_fence(__ATOMIC_ACQUIRE, "agent");
            xb_add(&bar[XB_XGEN(b.x)], 1u);
            asm volatile("s_waitcnt vmcnt(0)" ::: "memory");
        } else {
            XB_SPIN(xb_ld(&bar[XB_XGEN(b.x)]) == gen, bar);
            __builtin_amdgcn_fence(__ATOMIC_ACQUIRE, "agent");
            asm volatile("s_waitcnt vmcnt(0)" ::: "memory");
        }
    }
    __syncthreads();
}

constexpr int DM = 2048, NB = 4, SEQ = 4096, CTXL = 256, TPB = SEQ + CTXL  , MROWS = NB * TPB  ;
constexpr int NMT = MROWS / 256;
constexpr int EV_IN = 4608, OD_IN = 5120, LRUW = 2560, PRJ_LD = 5120, YLD = 2560, MODN = 12288;
constexpr int NEXP = 16, FF = 2048;
constexpr float EPS = 1e-6f;
constexpr float W8_SCALE = 32.0f, W8_INV = 1.0f / 32.0f;

constexpr size_t al256(size_t x) { return (x + 255) / 256 * 256; }
constexpr size_t WS_CTL   = 0;
constexpr size_t WS_MOD   = 65536;
constexpr size_t WS_WEVIN = WS_MOD   + al256((size_t)2 * 5 * MODN * 4);
constexpr size_t WS_WEVOUT= WS_WEVIN + (size_t)EV_IN * DM * 2;
constexpr size_t WS_WODIN = WS_WEVOUT+ (size_t)DM * DM * 2;
constexpr size_t WS_WLRU  = WS_WODIN + (size_t)OD_IN * DM * 2;
constexpr size_t WS_WODOUT= WS_WLRU  + (size_t)2 * 10 * 512 * 256 * 2;
constexpr size_t WS_WGU   = WS_WODOUT+ (size_t)DM * LRUW * 2;
constexpr size_t WS_WDN   = WS_WGU   + (size_t)2 * NEXP * 4096 * DM;
constexpr size_t WS_H     = WS_WDN   + (size_t)2 * NEXP * DM * DM;
constexpr size_t WS_ACT   = WS_H     + (size_t)MROWS * DM * 4;
constexpr size_t WS_PRJ   = WS_ACT   + (size_t)MROWS * DM * 2;
constexpr size_t WS_U     = WS_PRJ   + (size_t)MROWS * PRJ_LD * 2;
constexpr size_t WS_YIN   = WS_U     + (size_t)MROWS * LRUW * 2;
constexpr size_t WS_AFF   = WS_YIN   + (size_t)MROWS * YLD * 2;
constexpr size_t WS_SLOT  = WS_AFF   + (size_t)MROWS * 16 * 4;
constexpr size_t WS_GVAL  = WS_SLOT  + (size_t)MROWS * 16 * 4;
constexpr size_t WS_OFFT  = WS_GVAL  + al256((size_t)NEXP * 2304 * 4);
constexpr size_t WS_AGG   = WS_OFFT  + al256((size_t)NEXP * 2304 * 4);
constexpr size_t WS_XS    = WS_AGG   + (size_t)2 * NB * 68 * LRUW * 8;
constexpr size_t WS_HID   = WS_XS    + (size_t)NEXP * 2304 * DM * 2;
constexpr size_t WS_EO    = WS_HID   + (size_t)NEXP * 2304 * DM * 2;
constexpr size_t WS_KC    = WS_EO    + (size_t)NEXP * 2304 * DM * 2;
constexpr size_t WS_VC    = WS_KC    + (size_t)NB * 2 * TPB * 128 * 2;
constexpr size_t WS_CARRY = WS_VC    + (size_t)NB * 2 * TPB * 128 * 2;
constexpr size_t WS_END   = WS_CARRY + (size_t)2 * NB * 68 * LRUW * 4;
constexpr size_t WS_SCNT  = WS_CTL + 16384;
constexpr size_t WS_LAGI  = WS_XS;
static_assert((size_t)2 * MROWS * LRUW * 4 <= WS_KC - WS_XS, "LAGI alias");

struct Params { const float* in[28]; float* out; unsigned char* ws; int ph_lo, ph_hi; };
enum { I_X = 0, I_C, I_CTX, I_CCTX, I_MODW, I_MODB, I_N1G, I_N2G, I_EVWIN, I_EVQN, I_EVKN, I_EVCW, I_EVCB, I_EVWOUT, I_ODWIN, I_ODCW, I_ODCB, I_ODWA, I_ODBA, I_ODWX, I_ODBX,
       I_ODLAM, I_ODWOUT, I_ROUTER, I_WGATE, I_WUP, I_WDOWN, I_FNG };

__device__ __forceinline__ unsigned cvt_pk_bf16(float lo, float hi) { unsigned r; asm volatile("v_cvt_pk_bf16_f32 %0, %1, %2" : "=v"(r) : "v"(lo), "v"(hi)); return r; }
__device__ __forceinline__ unsigned pk4_fp8(float a, float b, float c, float d) { int w = 0; w = __builtin_amdgcn_cvt_pk_fp8_f32(a, b, w, false); w = __builtin_amdgcn_cvt_pk_fp8_f32(c, d, w, true); return (unsigned)w; }
#define GAS __attribute__((address_space(1)))
__device__ __forceinline__ f32x4 ld_nt(const float* p) { return __builtin_nontemporal_load((const GAS f32x4*)(const GAS float*)p); }
__device__ __forceinline__ void st_nt(float* p, f32x4 v) { __builtin_nontemporal_store(v, (GAS f32x4*)(GAS float*)p); }
__device__ __forceinline__ void st_wt16(float* p, f32x4 v) { asm volatile("global_store_dwordx4 %0, %1, off sc1\n\ts_nop 1" :: "v"(p), "v"(v) : "memory"); }
__device__ __forceinline__ float bf_lo(unsigned w) { return __uint_as_float(w << 16); }
__device__ __forceinline__ float bf_hi(unsigned w) { return __uint_as_float(w & 0xffff0000u); }
__device__ __forceinline__ int lane_fresh() { int l; asm volatile("v_mbcnt_lo_u32_b32 %0, -1, 0\n\tv_mbcnt_hi_u32_b32 %0, -1, %0" : "=v"(l)); return l; }
__device__ __forceinline__ float wave_sum(float v) {
#pragma unroll
    for (int o = 32; o >= 1; o >>= 1) v += __shfl_xor(v, o);
    return v;
}
__device__ __forceinline__ float fast_sigmoid(float x) { return __builtin_amdgcn_rcpf(1.0f + __builtin_amdgcn_exp2f(-1.4426950408889634f * x)); }
__device__ __forceinline__ float gelu_tanh(float x) { const float t = 0.7978845608028654f * (x + 0.044715f * x * x * x); return x * fast_sigmoid(2.0f * t); }
__device__ __forceinline__ int xcd_remap(int L, int nwg) { const int q = nwg >> 3, r = nwg & 7, xcd = L & 7, off = L >> 3; return (xcd < r ? xcd * (q + 1) : r * (q + 1) + (xcd - r) * q) + off; }

namespace pg8 {
constexpr int BM = 256, BK = 64, HALF = 128, HTB = HALF * BK * 2, STAGE_BYTES = 8 * HTB;
__device__ __forceinline__ int lds_byte(int r, int c) { const int st = (r >> 4) * 2 + (c >> 5), rr = r & 15, cc = c & 31, ob = rr * 64 + cc * 2; return st * 1024 + (ob ^ (((ob >> 9) & 1) << 5)); }
__device__ __forceinline__ void stage_rc(int b, int& R, int& C) { const int st = b / 1024, sb = b % 1024, swz = sb ^ (((sb >> 9) & 1) << 5); R = (st >> 1) * 16 + swz / 64; C = (st & 1) * 32 + (swz % 64) / 2; }
__device__ __forceinline__ int perm32(int rho) { const int n = rho >> 4, i = rho & 15; return 8 * (i >> 2) + 4 * n + (i & 3); }
struct Unit { int pm, pn, e; };
__device__ __forceinline__ void glds16_s(const void* base_uniform, unsigned voff, unsigned lds_dst) {
    unsigned keep;
    asm volatile("s_mov_b32 %0, m0\n\ts_mov_b32 m0, %3\n\ts_nop 0\n\tglobal_load_lds_dwordx4 %1, %2\n\ts_mov_b32 m0, %0" : "=&s"(keep) : "v"(voff), "s"(base_uniform), "s"(lds_dst) : "memory");
}
struct Shape { int K, lda; };

template <bool FP8, bool GATHER, class Epi, class Sched>
__device__ __forceinline__ void gemm_phase(LAS unsigned char* lds, int wid_in, const Shape g, const Sched& S, const Epi& E) {
    const int lane = lane_fresh(), wid = wid_in, tid = wid * 64 + lane, wr = wid >> 2, wc = wid & 3, fr = lane & 15, fq = lane >> 4;
    const int K = g.K, nt = K / BK;
    unsigned voffA[2], voffB[2]; int gR[2]; unsigned gC[2];
#pragma unroll
    for (int i = 0; i < 2; ++i) { int R, C; stage_rc(tid * 16 + i * 8192, R, C); const int Rb = Epi::PERM ? ((R & ~31) + perm32(R & 31)) : R;
        voffA[i] = (unsigned)(R * g.lda + C) * 2u; voffB[i] = (unsigned)(Rb * K + C) * 2u; gR[i] = R; gC[i] = (unsigned)C * 2u; }
    unsigned coff[2][2], noff[2][2], nnoff[2][2];
#define PG8_LOADOFF(dst, un) do { const unsigned* tb_ = S.offtab() + S.slotbase(un); _Pragma("unroll") for (int h_ = 0; h_ < 2; ++h_) _Pragma("unroll") for (int i_ = 0; i_ < 2; ++i_) dst[h_][i_] = tb_[h_ * 128 + gR[i_]] + gC[i_]; } while (0)
#define PG8_STAGE_A(bufoff, kb, h, nx) do { if constexpr (GATHER) { _Pragma("unroll") for (int _i = 0; _i < 2; ++_i) glds16_s(S.gbase() + (kb), (nx) ? noff[h][_i] : coff[h][_i], ldsb + (unsigned)((bufoff) + _i * 8192)); } \
        else { PG8_STAGE(bufoff, ((nx) ? nA : cA) + (kb) + (h) * hstepA, voffA); } } while (0)
    const size_t kstep = (size_t)(BK * 2);
    const size_t hstepA = (size_t)HALF * g.lda * 2, hstepB = (size_t)HALF * K * 2;
    const unsigned ldsb = (unsigned)(uintptr_t)lds + (unsigned)wid * 1024u;
    const int aoff = lds_byte(wr * 64 + fr, fq * 8), boff = lds_byte(wc * 32 + fr, fq * 8);
#define PG8_SA(b, h) (((b) * 2 + (h)) * HTB)
#define PG8_SB(b, h) ((4 + (b) * 2 + (h)) * HTB)
#define PG8_STAGE(bufoff, gbase, voff) do { _Pragma("unroll") for (int _i = 0; _i < 2; ++_i) glds16_s((gbase), (voff)[_i], ldsb + (unsigned)((bufoff) + _i * 8192)); } while (0)
#define PG8_LD32(p) __builtin_shufflevector(*(const LAS i32x4a*)(p), *(const LAS i32x4a*)((p) + 1024), 0, 1, 2, 3, 4, 5, 6, 7)
#define PG8_LDA(dst, b, h) do { if constexpr (FP8) { _Pragma("unroll") for (int m = 0; m < 4; ++m) dst##8[m] = PG8_LD32(lds + PG8_SA(b, h) + aoff + m * 2048); } \
        else { _Pragma("unroll") for (int m = 0; m < 4; ++m) _Pragma("unroll") for (int k = 0; k < 2; ++k) dst[m][k] = *(const LAS bf16x8*)(lds + PG8_SA(b, h) + aoff + m * 2048 + k * 1024); } } while (0)
#define PG8_LDB(dst, b, h) do { if constexpr (FP8) { _Pragma("unroll") for (int n = 0; n < 2; ++n) dst##8[n] = PG8_LD32(lds + PG8_SB(b, h) + boff + n * 2048); } \
        else { _Pragma("unroll") for (int n = 0; n < 2; ++n) _Pragma("unroll") for (int k = 0; k < 2; ++k) dst[n][k] = *(const LAS bf16x8*)(lds + PG8_SB(b, h) + boff + n * 2048 + k * 1024); } } while (0)
#define PG8_MMA(ai, bj, At, Bt) do { __builtin_amdgcn_s_setprio(1); _Pragma("unroll") for (int m = 0; m < 4; ++m) _Pragma("unroll") for (int n = 0; n < 2; ++n) { \
        f32x16& av_ = accv[ai][bj][m >> 1]; constexpr int dummy_ = 0; (void)dummy_; const int g_ = ((m & 1) * 2 + n) * 4; f32x4 c_ = (f32x4){av_[g_], av_[g_ + 1], av_[g_ + 2], av_[g_ + 3]}; \
        if constexpr (FP8) c_ = __builtin_amdgcn_mfma_scale_f32_16x16x128_f8f6f4(Bt##8[n], At##8[m], c_, 0, 0, 0, 127, 0, 127); \
        else { _Pragma("unroll") for (int k = 0; k < 2; ++k) c_ = __builtin_amdgcn_mfma_f32_16x16x32_bf16(Bt[n][k], At[m][k], c_, 0, 0, 0); } \
        av_[g_] = c_[0]; av_[g_ + 1] = c_[1]; av_[g_ + 2] = c_[2]; av_[g_ + 3] = c_[3]; } __builtin_amdgcn_s_setprio(0); } while (0)
#define PG8_WAIT_V(n) asm volatile("s_waitcnt vmcnt(" #n ")" ::: "memory")
#define PG8_WAIT_L(n) asm volatile("s_waitcnt lgkmcnt(" #n ")" ::: "memory")
#define PG8_BAR __builtin_amdgcn_s_barrier()
#define PG8_SCHED __builtin_amdgcn_sched_barrier(0)
    Unit cur, nxt; int ui = 0;
    if (!S.next(0, cur)) return;
    f32x16 accv[2][2][2];
#pragma unroll
    for (int a = 0; a < 2; ++a)
#pragma unroll
        for (int b = 0; b < 2; ++b)
#pragma unroll
            for (int m = 0; m < 2; ++m)
#pragma unroll
                for (int j = 0; j < 16; ++j) accv[a][b][m][j] = 0.f;
    bf16x8 At[4][2], B0[2][2], B1[2][2]; i32x8 At8[4], B08[2], B18[2];
    const char* cA = S.abase(cur); const char* cB = S.bbase(cur); const char* nA = cA;
    if constexpr (GATHER) { PG8_LOADOFF(coff, cur); Unit n1; if (S.next(1, n1)) PG8_LOADOFF(noff, n1); else PG8_LOADOFF(noff, cur); }
    PG8_STAGE(PG8_SB(0, 0), cB, voffB); PG8_STAGE_A(PG8_SA(0, 0), 0, 0, false); PG8_STAGE(PG8_SB(0, 1), cB + hstepB, voffB); PG8_STAGE_A(PG8_SA(0, 1), 0, 1, false);
    if (wr == 1) PG8_BAR;
    PG8_WAIT_V(4); PG8_BAR;
    PG8_STAGE(PG8_SB(1, 0), cB + kstep, voffB); PG8_STAGE_A(PG8_SA(1, 0), kstep, 0, false); PG8_STAGE(PG8_SB(1, 1), cB + hstepB + kstep, voffB);
    PG8_WAIT_V(6); PG8_BAR;
    for (;;) {
        const bool has_next = S.next(ui + 1, nxt);
        nA = has_next ? S.abase(nxt) : cA; const char* nB = has_next ? S.bbase(nxt) : cB;
        bool has_nn = false;
        if constexpr (GATHER) { Unit nn; has_nn = S.next(ui + 2, nn);
            if (has_nn) { const unsigned* tb_ = S.offtab() + S.slotbase(nn); _Pragma("unroll") for (int h_ = 0; h_ < 2; ++h_) _Pragma("unroll") for (int i_ = 0; i_ < 2; ++i_) nnoff[h_][i_] = tb_[h_ * 128 + gR[i_]]; } }
        for (int t = 0; t < nt; t += 2) {
            const bool last = (t == nt - 2);
            const size_t k1 = (size_t)(t + 1) * kstep, k2 = last ? 0 : (size_t)(t + 2) * kstep, k3 = k2 + kstep;
            const char* b2 = last ? nB : cB + (size_t)(t + 2) * kstep; const char* b3 = b2 + kstep;
            PG8_LDB(B0, 0, 0); PG8_SCHED; PG8_LDA(At, 0, 0); PG8_STAGE_A(PG8_SA(1, 1), k1, 1, false);
            PG8_WAIT_L(8); PG8_BAR; PG8_WAIT_L(0); PG8_MMA(0, 0, At, B0); PG8_BAR; PG8_SCHED;
            PG8_LDB(B1, 0, 1); PG8_STAGE(PG8_SB(0, 0), b2, voffB);
            PG8_BAR; PG8_WAIT_L(0); PG8_MMA(0, 1, At, B1); PG8_BAR;
            PG8_LDA(At, 0, 1); PG8_STAGE_A(PG8_SA(0, 0), k2, 0, last);
            PG8_BAR; PG8_WAIT_L(0); PG8_MMA(1, 0, At, B0); PG8_BAR; PG8_SCHED;
            PG8_STAGE(PG8_SB(0, 1), b2 + hstepB, voffB);
            PG8_WAIT_V(6); PG8_BAR; PG8_MMA(1, 1, At, B1); PG8_BAR;
            PG8_LDB(B0, 1, 0); PG8_SCHED; PG8_LDA(At, 1, 0); PG8_STAGE_A(PG8_SA(0, 1), k2, 1, last);
            PG8_WAIT_L(8); PG8_BAR; PG8_WAIT_L(0); PG8_MMA(0, 0, At, B0); PG8_BAR; PG8_SCHED;
            PG8_LDB(B1, 1, 1); PG8_STAGE(PG8_SB(1, 0), b3, voffB);
            PG8_BAR; PG8_WAIT_L(0); PG8_MMA(0, 1, At, B1); PG8_BAR;
            PG8_LDA(At, 1, 1); PG8_STAGE_A(PG8_SA(1, 0), k3, 0, last);
            PG8_BAR; PG8_WAIT_L(0); PG8_MMA(1, 0, At, B0); PG8_BAR; PG8_SCHED;
            PG8_STAGE(PG8_SB(1, 1), b3 + hstepB, voffB);
            PG8_WAIT_V(6); PG8_BAR; PG8_MMA(1, 1, At, B1); PG8_BAR;
        }
        { f32x4 acc[2][2][4][2];
#pragma unroll
          for (int a = 0; a < 2; ++a)
#pragma unroll
            for (int b = 0; b < 2; ++b)
#pragma unroll
              for (int m = 0; m < 4; ++m)
#pragma unroll
                for (int n = 0; n < 2; ++n) { const int g_ = ((m & 1) * 2 + n) * 4; acc[a][b][m][n] = (f32x4){accv[a][b][m >> 1][g_], accv[a][b][m >> 1][g_ + 1], accv[a][b][m >> 1][g_ + 2], accv[a][b][m >> 1][g_ + 3]}; }
          const int le_ = lane_fresh(); E(acc, cur, wr, wc, le_ & 15, le_ >> 4); }
        if (!has_next) break;
#pragma unroll
        for (int a = 0; a < 2; ++a)
#pragma unroll
            for (int b = 0; b < 2; ++b)
#pragma unroll
                for (int m = 0; m < 2; ++m)
#pragma unroll
                    for (int j = 0; j < 16; ++j) accv[a][b][m][j] = 0.f;
        cur = nxt; cA = nA; cB = nB; ++ui;
        if constexpr (GATHER) {
#pragma unroll
            for (int h_ = 0; h_ < 2; ++h_)
#pragma unroll
                for (int i_ = 0; i_ < 2; ++i_) { coff[h_][i_] = noff[h_][i_]; if (has_nn) noff[h_][i_] = nnoff[h_][i_] + gC[i_]; } }
    }
    PG8_WAIT_V(0);
    if (wr == 0) PG8_BAR;
    PG8_BAR;
#undef PG8_SA
#undef PG8_SB
#undef PG8_STAGE
#undef PG8_STAGE_A
#undef PG8_LOADOFF
#undef PG8_LDA
#undef PG8_LD32
#undef PG8_LDB
#undef PG8_MMA
#undef PG8_WAIT_V
#undef PG8_WAIT_L
#undef PG8_BAR
#undef PG8_SCHED
}
}
using pg8::Unit;

struct SchedDense {
    __device__ __forceinline__ const unsigned* offtab() const { return nullptr; }
    __device__ __forceinline__ int slotbase(const Unit&) const { return 0; }
    __device__ __forceinline__ const char* gbase() const { return nullptr; }
    const char* A; const char* Bt; int nM, nN, G, c, lda, K, lat_only;
    __device__ __forceinline__ bool next(int i, Unit& u) const {
        const int nwg = nM * nN; const int L = i * G + c; if (L >= nwg) return false;
        const int w = xcd_remap(L, nwg);
        const int nig = 8 * nN, gid = w / nig, fm = gid * 8, gsz = (nM - fm) < 8 ? (nM - fm) : 8;
        const int lm = fm + ((w % nig) % gsz); u.pn = (w % nig) / gsz; u.pm = lat_only ? (lm + (lm >> 4) + 1) : lm; u.e = 0; return true;
    }
    __device__ __forceinline__ const char* abase(const Unit& u) const { return A + (size_t)u.pm * 256 * lda * 2; }
    __device__ __forceinline__ const char* bbase(const Unit& u) const { return Bt + (size_t)u.pn * 256 * K * 2; }
};
struct SchedOdIn {
    __device__ __forceinline__ const unsigned* offtab() const { return nullptr; }
    __device__ __forceinline__ int slotbase(const Unit&) const { return 0; }
    __device__ __forceinline__ const char* gbase() const { return nullptr; }
    const char* A; const char* Bt; int G, c;
    __device__ __forceinline__ bool next(int i, Unit& u) const {
        const int L = i * G + c; if (L >= 1320) return false;
        if (L < 1280) { const int w = xcd_remap(L, 1280); const int nig = 8 * 20, gid = w / nig, fm = gid * 8; const int lm = fm + ((w % nig) % 8); u.pn = (w % nig) / 8; u.pm = lm + (lm >> 4) + 1; }
        else { const int q = L - 1280; u.pm = 17 * (q & 3); u.pn = q >> 2; }
        u.e = 0; return true;
    }
    __device__ __forceinline__ const char* abase(const Unit& u) const { return A + (size_t)u.pm * 256 * DM * 2; }
    __device__ __forceinline__ const char* bbase(const Unit& u) const { return Bt + (size_t)u.pn * 256 * DM * 2; }
};
struct SchedLru {
    __device__ __forceinline__ const unsigned* offtab() const { return nullptr; }
    __device__ __forceinline__ int slotbase(const Unit&) const { return 0; }
    __device__ __forceinline__ const char* gbase() const { return nullptr; }
    const char* A; const char* Bt; int G, c;
    __device__ __forceinline__ bool next(int i, Unit& u) const {
        const int L = i * G + c; if (L >= NMT * 40) return false;
        const int w = xcd_remap(L, NMT * 40); const int q = w % 40; u.pm = w / 40; u.e = q >> 1; u.pn = q & 1; return true;
    }
    __device__ __forceinline__ const char* abase(const Unit& u) const { return A + ((size_t)u.pm * 256 * LRUW + (u.e % 10) * 256) * 2; }
    __device__ __forceinline__ const char* bbase(const Unit& u) const { return Bt + ((size_t)u.e * 512 + u.pn * 256) * 256 * 2; }
};
struct SchedMoe {
    const char* A; const char* Bt; int nMe, nN, estr, brows, G, c; const unsigned* otab;
    __device__ __forceinline__ const unsigned* offtab() const { return otab; }
    __device__ __forceinline__ int slotbase(const Unit& u) const { return u.e * estr + u.pm * 256; }
    __device__ __forceinline__ const char* gbase() const { return A; }
    __device__ __forceinline__ bool next(int i, Unit& u) const {
        const int per = nMe * nN, nwg = NEXP * per; const int L = i * G + c; if (L >= nwg) return false;
        const int w = xcd_remap(L, nwg); u.e = w / per; const int r = w % per; u.pm = r % nMe; u.pn = r / nMe; return true;
    }
    __device__ __forceinline__ const char* abase(const Unit& u) const { return A + ((size_t)u.e * estr + u.pm * 256) * DM; }
    __device__ __forceinline__ const char* bbase(const Unit& u) const { return Bt + ((size_t)u.e * brows + u.pn * 256) * DM; }
};

struct EpiPlainBf16 {
    static constexpr bool PERM = true;
    bf16_t* O; int ldc; int gelu_from;
    __device__ __forceinline__ void operator()(const f32x4 (&acc)[2][2][4][2], const Unit& u, int wr, int wc, int fr, int fq) const {
        const int row0 = u.pm * 256 + wr * 64 + fr, col0 = u.pn * 256 + wc * 32 + 8 * fq; const bool gl = u.pn >= gelu_from;
#pragma unroll
        for (int ai = 0; ai < 2; ++ai)
#pragma unroll
            for (int m = 0; m < 4; ++m) { bf16_t* rowp = O + (size_t)(row0 + ai * 128 + m * 16) * ldc + col0;
#pragma unroll
                for (int bj = 0; bj < 2; ++bj) { f32x4 v0 = acc[ai][bj][m][0], v1 = acc[ai][bj][m][1];
                    if (gl) {
#pragma unroll
                        for (int j = 0; j < 4; ++j) { v0[j] = gelu_tanh(v0[j]); v1[j] = gelu_tanh(v1[j]); } }
                    u32x4 w; w.x = cvt_pk_bf16(v0[0], v0[1]); w.y = cvt_pk_bf16(v0[2], v0[3]); w.z = cvt_pk_bf16(v1[0], v1[1]); w.w = cvt_pk_bf16(v1[2], v1[3]);
                    *(u32x4*)(rowp + bj * 128) = w; } }
    }
};
struct EpiEvIn {
    static constexpr bool PERM = true;
    bf16_t* O; int ldc;
    __device__ __forceinline__ void operator()(const f32x4 (&acc)[2][2][4][2], const Unit& u, int wr, int wc, int fr, int fq) const {
        const int row0 = u.pm * 256 + wr * 64 + fr;
        if (u.pn < 10) { const int col0 = u.pn * 256 + wc * 32 + 8 * fq;
#pragma unroll
            for (int ai = 0; ai < 2; ++ai)
#pragma unroll
                for (int m = 0; m < 4; ++m) { bf16_t* rowp = O + (size_t)(row0 + ai * 128 + m * 16) * ldc + col0;
#pragma unroll
                    for (int bj = 0; bj < 2; ++bj) { const f32x4 v0 = acc[ai][bj][m][0], v1 = acc[ai][bj][m][1];
                        u32x4 w; w.x = cvt_pk_bf16(v0[0], v0[1]); w.y = cvt_pk_bf16(v0[2], v0[3]); w.z = cvt_pk_bf16(v1[0], v1[1]); w.w = cvt_pk_bf16(v1[2], v1[3]);
                        *(u32x4*)(rowp + bj * 128) = w; } }
        } else { const int col0 = 2560 + (u.pn - 10) * 128 + wc * 32 + 8 * fq;
#pragma unroll
            for (int ai = 0; ai < 2; ++ai)
#pragma unroll
                for (int m = 0; m < 4; ++m) { const f32x4 v0 = acc[ai][0][m][0] * acc[ai][1][m][0], v1 = acc[ai][0][m][1] * acc[ai][1][m][1];
                    u32x4 w; w.x = cvt_pk_bf16(v0[0], v0[1]); w.y = cvt_pk_bf16(v0[2], v0[3]); w.z = cvt_pk_bf16(v1[0], v1[1]); w.w = cvt_pk_bf16(v1[2], v1[3]);
                    *(u32x4*)(O + (size_t)(row0 + ai * 128 + m * 16) * ldc + col0) = w; }
        }
    }
};
struct EpiResid {
    static constexpr bool PERM = true;
    const float* x; const float* ctx; bf16_t* h; const float* mod; int layer0;
    __device__ __forceinline__ void operator()(const f32x4 (&acc)[2][2][4][2], const Unit& u, int wr, int wc, int fr, int fq) const {
        const int b = u.pm / 17, pt = u.pm - b * 17;
        const float* hold = pt == 0 ? ctx + (size_t)b * CTXL * DM : x + ((size_t)b * SEQ + (pt - 1) * 256) * DM;
        bf16_t* ho = h + (size_t)u.pm * 256 * DM;
        const float* gate = mod + (size_t)(pt == 0 ? 4 : b) * MODN + 4096;
        const int r0 = wr * 64 + fr, col0 = u.pn * 256 + wc * 32 + 8 * fq;
        f32x4 gv[2][2];
#pragma unroll
        for (int bj = 0; bj < 2; ++bj)
#pragma unroll
            for (int n = 0; n < 2; ++n) gv[bj][n] = *(const f32x4*)(gate + col0 + bj * 128 + n * 4);
#pragma unroll
        for (int ai = 0; ai < 2; ++ai) {
            if (layer0) { f32x4 hv[4][2][2];
#pragma unroll
                for (int m = 0; m < 4; ++m) { const size_t off = (size_t)(r0 + ai * 128 + m * 16) * DM + col0;
#pragma unroll
                    for (int bj = 0; bj < 2; ++bj)
#pragma unroll
                        for (int n = 0; n < 2; ++n) hv[m][bj][n] = *(const f32x4*)(hold + off + bj * 128 + n * 4); }
#pragma unroll
                for (int m = 0; m < 4; ++m) { const size_t off = (size_t)(r0 + ai * 128 + m * 16) * DM + col0;
#pragma unroll
                    for (int bj = 0; bj < 2; ++bj) { const f32x4 v0 = hv[m][bj][0] + gv[bj][0] * acc[ai][bj][m][0], v1 = hv[m][bj][1] + gv[bj][1] * acc[ai][bj][m][1];
                        u32x4 w; w.x = cvt_pk_bf16(v0[0], v0[1]); w.y = cvt_pk_bf16(v0[2], v0[3]); w.z = cvt_pk_bf16(v1[0], v1[1]); w.w = cvt_pk_bf16(v1[2], v1[3]); *(u32x4*)(ho + off + bj * 128) = w; } }
            } else { u32x4 hw[4][2];
#pragma unroll
                for (int m = 0; m < 4; ++m) { const size_t off = (size_t)(r0 + ai * 128 + m * 16) * DM + col0;
#pragma unroll
                    for (int bj = 0; bj < 2; ++bj) hw[m][bj] = *(const u32x4*)(ho + off + bj * 128); }
#pragma unroll
                for (int m = 0; m < 4; ++m) { const size_t off = (size_t)(r0 + ai * 128 + m * 16) * DM + col0;
#pragma unroll
                    for (int bj = 0; bj < 2; ++bj) { const u32x4 q = hw[m][bj];
                        const f32x4 v0 = (f32x4){bf_lo(q.x), bf_hi(q.x), bf_lo(q.y), bf_hi(q.y)} + gv[bj][0] * acc[ai][bj][m][0], v1 = (f32x4){bf_lo(q.z), bf_hi(q.z), bf_lo(q.w), bf_hi(q.w)} + gv[bj][1] * acc[ai][bj][m][1];
                        u32x4 w; w.x = cvt_pk_bf16(v0[0], v0[1]); w.y = cvt_pk_bf16(v0[2], v0[3]); w.z = cvt_pk_bf16(v1[0], v1[1]); w.w = cvt_pk_bf16(v1[2], v1[3]); *(u32x4*)(ho + off + bj * 128) = w; } } }
        }
    }
};
struct EpiSwiglu {
    static constexpr bool PERM = true;
    unsigned char* O; int estr;
    __device__ __forceinline__ void operator()(const f32x4 (&acc)[2][2][4][2], const Unit& u, int wr, int wc, int fr, int fq) const {
        const unsigned row0 = (unsigned)(u.e * estr + u.pm * 256 + wr * 64 + fr); const unsigned col0 = (unsigned)(u.pn * 128 + wc * 32 + 8 * fq);
#pragma unroll
        for (int ai = 0; ai < 2; ++ai)
#pragma unroll
            for (int m = 0; m < 4; ++m) { float o[8];
#pragma unroll
                for (int n = 0; n < 2; ++n)
#pragma unroll
                    for (int j = 0; j < 4; ++j) { const float gt = acc[ai][0][m][n][j] * W8_INV, up = acc[ai][1][m][n][j] * W8_INV; o[n * 4 + j] = gt * fast_sigmoid(gt) * up; }
                u32x2 w; w.x = pk4_fp8(o[0], o[1], o[2], o[3]); w.y = pk4_fp8(o[4], o[5], o[6], o[7]);
                *(u32x2*)(O + (unsigned)((row0 + ai * 128 + m * 16) * DM + col0)) = w; __builtin_amdgcn_sched_barrier(0); }
    }
};
struct EpiDown {
    static constexpr bool PERM = true;
    unsigned char* O; const float* gval; int estr;
    __device__ __forceinline__ void operator()(const f32x4 (&acc)[2][2][4][2], const Unit& u, int wr, int wc, int fr, int fq) const {
        const unsigned row0 = (unsigned)(u.e * estr + u.pm * 256 + wr * 64 + fr); const unsigned col0 = (unsigned)(u.pn * 256 + wc * 32 + 8 * fq);
#pragma unroll
        for (int ai = 0; ai < 2; ++ai) { float gvv[4];
#pragma unroll
            for (int m = 0; m < 4; ++m) gvv[m] = gval[row0 + ai * 128 + m * 16] * W8_INV;
            __builtin_amdgcn_sched_barrier(0);
#pragma unroll
            for (int m = 0; m < 4; ++m) { const unsigned slot = row0 + ai * 128 + m * 16; const float gv = gvv[m];
#pragma unroll
                for (int bj = 0; bj < 2; ++bj) { const f32x4 v0 = acc[ai][bj][m][0] * gv, v1 = acc[ai][bj][m][1] * gv;
                    u32x2 w; w.x = pk4_fp8(v0[0], v0[1], v0[2], v0[3]); w.y = pk4_fp8(v1[0], v1[1], v1[2], v1[3]);
                    *(u32x2*)(O + (slot * DM + col0 + bj * 128)) = w; }
                __builtin_amdgcn_sched_barrier(0); } }
    }
};
struct EpiLru {
    static constexpr bool PERM = true;
    const bf16_t* U; unsigned* lagi; const float* ba; const float* bx; const float* lam;
    __device__ __forceinline__ void operator()(const f32x4 (&acc)[2][2][4][2], const Unit& u, int wr, int wc, int fr, int fq) const {
        const int d = u.e / 10, hb = u.e - d * 10; const int ch0 = hb * 256 + u.pn * 128 + wc * 32 + 8 * fq; const int row0 = u.pm * 256 + wr * 64 + fr;
        unsigned short* outp = (unsigned short*)lagi + (size_t)d * MROWS * LRUW;
        constexpr float NL2E = -1.4426950408889634f;
#pragma unroll
        for (int n = 0; n < 2; ++n) { const int chn = ch0 + 4 * n; f32x2 vba[2], vbx[2], sp[2], csp[2];
#pragma unroll
            for (int j = 0; j < 4; ++j) { const float lm = lam[d * LRUW + chn + j]; const float spl = fmaxf(-lm, 0.f) + __logf(1.0f + __expf(-fabsf(lm)));
                vba[j >> 1][j & 1] = NL2E * ba[d * LRUW + chn + j]; vbx[j >> 1][j & 1] = NL2E * bx[d * LRUW + chn + j]; sp[j >> 1][j & 1] = -8.0f * spl; csp[j >> 1][j & 1] = 4.0f * __builtin_amdgcn_sqrtf(spl); }
            u32x2 uws[2][4];
#pragma unroll
            for (int ai = 0; ai < 2; ++ai)
#pragma unroll
                for (int m = 0; m < 4; ++m) uws[ai][m] = *(const u32x2*)(U + (size_t)(row0 + ai * 128 + m * 16) * LRUW + chn);
#pragma unroll
            for (int ai = 0; ai < 2; ++ai)
#pragma unroll
                for (int m = 0; m < 4; ++m) { const size_t row = (size_t)(row0 + ai * 128 + m * 16); const u32x2 uw = uws[ai][m]; unsigned o[2];
#pragma unroll
                    for (int h = 0; h < 2; ++h) { const unsigned uwh = h ? uw.y : uw.x; const f32x2 uv = {bf_lo(uwh), bf_hi(uwh)};
                        f32x2 ta = (f32x2){acc[ai][0][m][n][2 * h], acc[ai][0][m][n][2 * h + 1]} * NL2E + vba[h], tx = (f32x2){acc[ai][1][m][n][2 * h], acc[ai][1][m][n][2 * h + 1]} * NL2E + vbx[h];
                        f32x2 ea, ex; ea.x = __builtin_amdgcn_exp2f(fminf(ta.x, 40.f)); ea.y = __builtin_amdgcn_exp2f(fminf(ta.y, 40.f)); ex.x = __builtin_amdgcn_exp2f(fminf(tx.x, 40.f)); ex.y = __builtin_amdgcn_exp2f(fminf(tx.y, 40.f));
                        ea = ea + 1.0f; ex = ex + 1.0f;
                        const f32x2 dd = (ea * ex) * ex; f32x2 g; g.x = __builtin_amdgcn_rsqf(dd.x); g.y = __builtin_amdgcn_rsqf(dd.y);
                        const f32x2 q = g * ex, r = q * q, la = r * sp[h], y = la + la;
                        f32x2 t = y * 0.041666668f + 0.16666667f; t = t * y + 0.5f; t = t * y;
                        f32x2 s1 = t * (-0.125f) + 0.5f; s1 = s1 * t + 1.0f;
                        const f32x2 bt = ((csp[h] * uv) * g) * s1;
                        (void)la; const int bb = __builtin_amdgcn_cvt_pk_fp8_f32(bt.x, bt.y, 0, false);
                        const unsigned c0 = (unsigned)(q.x * 255.0f + 0.5f), c1 = (unsigned)(q.y * 255.0f + 0.5f);
                        o[h] = c0 | (((unsigned)bb & 0xffu) << 8) | (c1 << 16) | (((unsigned)bb & 0xff00u) << 16); }
                    *(u32x2*)(outp + row * LRUW + chn) = (u32x2){o[0], o[1]}; } }
    }
};

namespace att {
constexpr int D = 128, NW = 8, QBLK = 32, KVBLK = 64;
constexpr float SCALE = 0.088388347648318440f;
constexpr float THR = 8.f;
constexpr int LDQ = PRJ_LD, LDK = 128, LDO = YLD;
constexpr size_t SHM_V = KVBLK * D * 2, SHM_K = KVBLK * D * 2, SHM_ATTN = 2 * SHM_V + 2 * SHM_K + NW * 64 * 4;
#define KSWZ(row, colB) ((row) * 256 + ((colB) ^ (((row) & 7) << 4)))
#define SBAR() __builtin_amdgcn_sched_barrier(0)
__device__ __forceinline__ int crow(int r, int hi) { return (r & 3) + 8 * (r >> 2) + 4 * hi; }
__device__ __forceinline__ void partialSM(f32x16& p0, f32x16& p1, float& m_reg, float& mn, float& alpha) {
  constexpr float C = SCALE * 1.4426950408889634f;
  float pmax = p0[0]; for (int r = 1; r < 16; ++r) pmax = fmaxf(pmax, p0[r]); for (int r = 0; r < 16; ++r) pmax = fmaxf(pmax, p1[r]);
  { auto rr = __builtin_amdgcn_permlane32_swap(__float_as_uint(pmax), __float_as_uint(pmax), false, false);
    pmax = fmaxf(__uint_as_float(rr[0]), __uint_as_float(rr[1])); }
  if (__builtin_expect(__all(pmax - m_reg <= THR / SCALE), 1)) { mn = m_reg; alpha = 1.f; }
  else { mn = fmaxf(m_reg, pmax); alpha = __builtin_amdgcn_exp2f((m_reg - mn) * C); m_reg = mn; }
  float mnC = -mn * C;
  for (int r = 0; r < 16; ++r) p0[r] = fmaf(p0[r], C, mnC); for (int r = 0; r < 16; ++r) p1[r] = fmaf(p1[r], C, mnC);
  for (int r = 0; r < 16; ++r) p0[r] = __builtin_amdgcn_exp2f(p0[r]);
}
__device__ __forceinline__ void finishSM(f32x16& p0, f32x16& p1, float alpha, float& l_reg, bf16x8& pa0, bf16x8& pa1, bf16x8& pa2, bf16x8& pa3) {
  for (int r = 0; r < 16; ++r) p1[r] = __builtin_amdgcn_exp2f(p1[r]);
  float ps = 0; for (int r = 0; r < 16; ++r) ps += p0[r]; for (int r = 0; r < 16; ++r) ps += p1[r];
  { auto rr = __builtin_amdgcn_permlane32_swap(__float_as_uint(ps), __float_as_uint(ps), false, false);
    ps = __uint_as_float(rr[0]) + __uint_as_float(rr[1]); }
  l_reg = l_reg * alpha + ps;
#define PK4(P, BASE, OUT) do { unsigned a0 = cvt_pk_bf16(P[BASE + 0], P[BASE + 1]), a1 = cvt_pk_bf16(P[BASE + 2], P[BASE + 3]);   \
    unsigned b0 = cvt_pk_bf16(P[BASE + 4], P[BASE + 5]), b1 = cvt_pk_bf16(P[BASE + 6], P[BASE + 7]);                              \
    auto r0 = __builtin_amdgcn_permlane32_swap(a0, b0, false, false); auto r1 = __builtin_amdgcn_permlane32_swap(a1, b1, false, false); \
    u32x4 w = {r0[0], r1[0], r0[1], r1[1]}; OUT = *reinterpret_cast<bf16x8*>(&w); } while (0)
  PK4(p0, 0, pa0); PK4(p0, 8, pa1); PK4(p1, 0, pa2); PK4(p1, 8, pa3);
#undef PK4
}
__device__ __forceinline__ void qkt(f32x16& p0, f32x16& p1, const bf16_t* Ks, const bf16x8* qr, int r32, int hi) {
  p0 = f32x16{}; p1 = f32x16{};
  for (int d0 = 0; d0 < 8; ++d0) { int cb = (d0 * 16 + hi * 8) * 2;
    bf16x8 b0 = *reinterpret_cast<const bf16x8*>((const char*)Ks + KSWZ(r32, cb));
    bf16x8 b1 = *reinterpret_cast<const bf16x8*>((const char*)Ks + KSWZ(32 + r32, cb));
    p0 = __builtin_amdgcn_mfma_f32_32x32x16_bf16(b0, qr[d0], p0, 0, 0, 0);
    p1 = __builtin_amdgcn_mfma_f32_32x32x16_bf16(b1, qr[d0], p1, 0, 0, 0); }
}
__device__ __forceinline__ int v_st(int k, int c) { const int kk = (k & ~0xC) | ((k & 4) << 1) | ((k & 8) >> 1); return ((kk >> 3) * 4 + (c >> 5)) * 512 + ((kk & 7) * 32 + (c & 31)) * 2; }
__device__ __forceinline__ int v_rd_base(int lane) { return ((lane & 3) << 3) | (((lane >> 2) & 3) << 6) | (((lane >> 4) & 1) << 5) | (((lane >> 5) & 1) << 8); }
constexpr int v_rd_off(int d0, int ks, int half) { return d0 * 512 + ks * 4096 + half * 2048; }
template <int OFF> __device__ __forceinline__ s16x4 tr_read(int vb) {
  s16x4 r; asm volatile("ds_read_b64_tr_b16 %0, %1 offset:%2" : "=&v"(r) : "v"(vb), "i"(OFF) : "memory"); return r;
}
template <int D0> __device__ __forceinline__ void pv_one(f32x16& od, int vb, bf16x8 pa0, bf16x8 pa1, bf16x8 pa2, bf16x8 pa3) {
  const s16x4 l0 = tr_read<v_rd_off(D0, 0, 0)>(vb), h0 = tr_read<v_rd_off(D0, 0, 1)>(vb), l1 = tr_read<v_rd_off(D0, 1, 0)>(vb), h1 = tr_read<v_rd_off(D0, 1, 1)>(vb);
  const s16x4 l2 = tr_read<v_rd_off(D0, 2, 0)>(vb), h2 = tr_read<v_rd_off(D0, 2, 1)>(vb), l3 = tr_read<v_rd_off(D0, 3, 0)>(vb), h3 = tr_read<v_rd_off(D0, 3, 1)>(vb);
  asm volatile("s_waitcnt lgkmcnt(0)" ::: "memory"); SBAR();
#define PK(L, H) (bf16x8){L[0], L[1], L[2], L[3], H[0], H[1], H[2], H[3]}
  od = __builtin_amdgcn_mfma_f32_32x32x16_bf16(pa0, PK(l0, h0), od, 0, 0, 0);
  od = __builtin_amdgcn_mfma_f32_32x32x16_bf16(pa1, PK(l1, h1), od, 0, 0, 0);
  od = __builtin_amdgcn_mfma_f32_32x32x16_bf16(pa2, PK(l2, h2), od, 0, 0, 0);
  od = __builtin_amdgcn_mfma_f32_32x32x16_bf16(pa3, PK(l3, h3), od, 0, 0, 0);
#undef PK
}
__device__ __forceinline__ void pv_d0(f32x16* o, int vb, bf16x8 pa0, bf16x8 pa1, bf16x8 pa2, bf16x8 pa3) {
  pv_one<0>(o[0], vb, pa0, pa1, pa2, pa3); pv_one<1>(o[1], vb, pa0, pa1, pa2, pa3); pv_one<2>(o[2], vb, pa0, pa1, pa2, pa3); pv_one<3>(o[3], vb, pa0, pa1, pa2, pa3);
}
__device__ __forceinline__ void attn_dense_body(const bf16_t* __restrict__ Qb, const bf16_t* __restrict__ Kh, const bf16_t* __restrict__ Vh, bf16_t* __restrict__ Ob, int seq, char* lds, int wid_in) {
  const int lane = lane_fresh();
  const int wid = wid_in, tid = wid * 64 + lane, r32 = lane & 31, hi = lane >> 5;
  bf16_t* V_lds = (bf16_t*)lds; bf16_t* K_lds = (bf16_t*)(lds + 2 * SHM_V);
  float* ws = (float*)(lds + 2 * SHM_V + 2 * SHM_K) + wid * 64; float* li_l = ws; float* al_l = ws + 32;
  float m_reg = -1e30f, l_reg = 0; f32x16 o[4] = {}; bf16x8 qr[8];
  const bf16_t* Qw = Qb + (long)(wid * QBLK + r32) * LDQ + hi * 8;
#pragma unroll
  for (int d0 = 0; d0 < 8; ++d0) qr[d0] = *reinterpret_cast<const bf16x8*>(Qw + d0 * 16);
  const int sr = tid >> 4, sc = (tid & 15) * 8, vst0 = v_st(sr, sc), vst1 = v_st(32 + sr, sc);
  const int vb0 = (int)(uintptr_t)V_lds + v_rd_base(lane);
  const unsigned toff = (unsigned)(sr * LDK + sc) * 2u;
  struct { bf16x8 vs0, vs1, ks0, ks1; } sr_[2];
#define SLOAD(i, k0) do { const char* vp_ = (const char*)(Vh + (long)(k0) * LDK); const char* kp_ = (const char*)(Kh + (long)(k0) * LDK); \
    sr_[i].vs0 = *reinterpret_cast<const bf16x8*>(vp_ + toff); sr_[i].vs1 = *reinterpret_cast<const bf16x8*>(vp_ + 32 * LDK * 2 + toff); \
    sr_[i].ks0 = *reinterpret_cast<const bf16x8*>(kp_ + toff); sr_[i].ks1 = *reinterpret_cast<const bf16x8*>(kp_ + 32 * LDK * 2 + toff); } while (0)
#define SWRITE(b, i) do { *(bf16x8*)((char*)V_lds + (b) * SHM_V + vst0) = sr_[i].vs0;          \
    *(bf16x8*)((char*)V_lds + (b) * SHM_V + vst1) = sr_[i].vs1; int kc = sc * 2;               \
    *(bf16x8*)((char*)K_lds + (b) * SHM_K + KSWZ(sr, kc)) = sr_[i].ks0;                       \
    *(bf16x8*)((char*)K_lds + (b) * SHM_K + KSWZ(32 + sr, kc)) = sr_[i].ks1; } while (0)
#define SWAIT() asm volatile("s_waitcnt vmcnt(4)" ::: "memory")
#define RESC(a) do { if (__any((a) < 1.f)) { if (hi == 0) al_l[r32] = (a); asm volatile("s_waitcnt lgkmcnt(0)" ::: "memory"); \
    for (int d = 0; d < 4; ++d) for (int r = 0; r < 16; ++r) o[d][r] *= al_l[crow(r, hi)]; } } while (0)
  f32x16 pA0, pA1, pB0, pB1; float mnA, mnB, alA, alB; bf16x8 pa0, pa1, pa2, pa3; const int NT = seq / KVBLK;
  constexpr int SE = 0, SO = 1;
  SLOAD(SE, 0); asm volatile("s_waitcnt vmcnt(0)" ::: "memory"); SWRITE(0, SE); __syncthreads();
  qkt(pA0, pA1, K_lds, qr, r32, hi); partialSM(pA0, pA1, m_reg, mnA, alA);
  SLOAD(SO, KVBLK); if (2 < NT) SLOAD(SE, 2 * KVBLK);
  SWAIT(); SWRITE(1, SO); __syncthreads();
  for (int j = 1; j + 1 < NT; j += 2) {
    SBAR(); qkt(pB0, pB1, (bf16_t*)((char*)K_lds + SHM_K), qr, r32, hi);
    finishSM(pA0, pA1, alA, l_reg, pa0, pa1, pa2, pa3); SBAR();
    SLOAD(SO, (j + 2) * KVBLK); SBAR();
    pv_d0(o, vb0, pa0, pa1, pa2, pa3); partialSM(pB0, pB1, m_reg, mnB, alB);
    __syncthreads(); SWAIT(); SWRITE(0, SE);
    RESC(alB); __syncthreads();
    SBAR(); qkt(pA0, pA1, K_lds, qr, r32, hi);
    finishSM(pB0, pB1, alB, l_reg, pa0, pa1, pa2, pa3); SBAR();
    if (j + 3 < NT) SLOAD(SE, (j + 3) * KVBLK); SBAR();
    pv_d0(o, vb0 + (int)SHM_V, pa0, pa1, pa2, pa3); partialSM(pA0, pA1, m_reg, mnA, alA);
    __syncthreads(); SWAIT(); SWRITE(1, SO);
    RESC(alA); __syncthreads();
  }
  SBAR(); qkt(pB0, pB1, (bf16_t*)((char*)K_lds + SHM_K), qr, r32, hi);
  finishSM(pA0, pA1, alA, l_reg, pa0, pa1, pa2, pa3); SBAR();
  pv_d0(o, vb0, pa0, pa1, pa2, pa3); partialSM(pB0, pB1, m_reg, mnB, alB);
  __syncthreads(); RESC(alB);
  finishSM(pB0, pB1, alB, l_reg, pa0, pa1, pa2, pa3); SBAR();
  pv_d0(o, vb0 + (int)SHM_V, pa0, pa1, pa2, pa3);
  if (hi == 0) li_l[r32] = l_reg; asm volatile("s_waitcnt lgkmcnt(0)" ::: "memory");
  float rli[16];
#pragma unroll
  for (int r = 0; r < 16; ++r) rli[r] = __builtin_amdgcn_rcpf(li_l[crow(r, hi)]);
  bf16_t* Ow = Ob + (long)(wid * QBLK) * LDO;
#pragma unroll
  for (int r = 0; r < 16; ++r) { int orow = crow(r, hi);
    for (int d0 = 0; d0 < 4; ++d0) Ow[(long)orow * LDO + d0 * 32 + r32] = (bf16_t)(cvt_pk_bf16(o[d0][r] * rli[r], 0.f) & 0xffffu); }
  __syncthreads();
#undef SLOAD
#undef SWRITE
#undef SWAIT
#undef RESC
}
}

struct Ctx {
    Params P; unsigned char* ws; int wid, G, c;
    LAS unsigned char* lds; char* ldsg;
};

constexpr int N_MOD_UNITS = 192;
constexpr int CV_A = 576, CV_B = CV_A + 256, CV_C = CV_B + 640, CV_D = CV_C + 320, CV_E = CV_D + 160, CV_F = CV_E + 880 + 2 * 3 * 16 * 128 - 11000  ;
__device__ __noinline__ void cvt_tile(const float* __restrict__ src, int ld, bf16_t* __restrict__ dst, int ldd, int tid) {
    const int c4 = ((tid >> 6) & 3) * 8 + (tid & 7), kq = (tid >> 8) * 8 + ((tid >> 3) & 7);
    const float* s = src + (size_t)(kq * 8) * ld + c4 * 4;
    f32x4 v[8];
#pragma unroll
    for (int i = 0; i < 8; ++i) v[i] = ld_nt(s + (size_t)i * ld);
#pragma unroll
    for (int j = 0; j < 4; ++j) { u32x4 w; w.x = cvt_pk_bf16(v[0][j], v[1][j]); w.y = cvt_pk_bf16(v[2][j], v[3][j]); w.z = cvt_pk_bf16(v[4][j], v[5][j]); w.w = cvt_pk_bf16(v[6][j], v[7][j]);
        __builtin_nontemporal_store(w, (GAS u32x4*)(GAS bf16_t*)(dst + (size_t)(c4 * 4 + j) * ldd + kq * 8)); }
}
__device__ __noinline__ void cvt_tile8(const float* __restrict__ src, int ld, unsigned char* __restrict__ dst, int ldd, int split, int tid) {
    const int c4 = (tid >> 6) * 8 + (tid & 7), kq = (tid >> 3) & 7;
    const float* s = src + (size_t)(kq * 16) * ld + c4 * 4;
    f32x4 v[16];
#pragma unroll
    for (int i = 0; i < 16; ++i) v[i] = ld_nt(s + (size_t)i * ld);
    const int rbase = split ? ((c4 >> 5) * 256 + (c4 & 31) * 4) : c4 * 4;
#pragma unroll
    for (int j = 0; j < 4; ++j) { u32x4 w;
        w.x = pk4_fp8(v[0][j] * W8_SCALE, v[1][j] * W8_SCALE, v[2][j] * W8_SCALE, v[3][j] * W8_SCALE); w.y = pk4_fp8(v[4][j] * W8_SCALE, v[5][j] * W8_SCALE, v[6][j] * W8_SCALE, v[7][j] * W8_SCALE);
        w.z = pk4_fp8(v[8][j] * W8_SCALE, v[9][j] * W8_SCALE, v[10][j] * W8_SCALE, v[11][j] * W8_SCALE); w.w = pk4_fp8(v[12][j] * W8_SCALE, v[13][j] * W8_SCALE, v[14][j] * W8_SCALE, v[15][j] * W8_SCALE);
        __builtin_nontemporal_store(w, (GAS u32x4*)(GAS unsigned char*)(dst + (size_t)(rbase + j) * ldd + kq * 16)); }
}
constexpr int MOE_TILES = 3 * 16 * 128;
__device__ __forceinline__ void moe_cvt_tile(const Ctx& F, int layer, int q, int tid) {
    const Params& P = F.P; const int m = q / 2048, r = q % 2048, le = layer * 16 + (r >> 7), kt = (r >> 3) & 15, nt = r & 7;
    const size_t so = (size_t)le * DM * DM + (size_t)kt * 128 * DM + nt * 256;
    if (m == 0)      cvt_tile8(P.in[I_WGATE] + so, DM, F.ws + WS_WGU + ((size_t)le * 4096 + nt * 512) * DM + kt * 128, DM, 1, tid);
    else if (m == 1) cvt_tile8(P.in[I_WUP]   + so, DM, F.ws + WS_WGU + ((size_t)le * 4096 + nt * 512 + 128) * DM + kt * 128, DM, 1, tid);
    else             cvt_tile8(P.in[I_WDOWN] + so, DM, F.ws + WS_WDN + ((size_t)le * DM + nt * 256) * DM + kt * 128, DM, 0, tid);
}
struct CvtJob { const float* src; unsigned char* dst; int split; };
__device__ __forceinline__ CvtJob moe_job(const Ctx& F, int g) {
    const Params& P = F.P; const int layer = g / MOE_TILES, q = g - layer * MOE_TILES, m = q >> 11, r = q & 2047, le = layer * 16 + (r >> 7), kt = (r >> 3) & 15, nt = r & 7;
    const float* pg = P.in[I_WGATE]; const float* pu = P.in[I_WUP]; const float* pd = P.in[I_WDOWN];
    asm volatile("" : "+s"(pg), "+s"(pu), "+s"(pd));
    const size_t so = (size_t)le * DM * DM + (size_t)kt * 128 * DM + nt * 256;
    CvtJob j; j.src = (m == 0 ? pg : (m == 1 ? pu : pd)) + so; j.split = m < 2 ? 1 : 0;
    j.dst = m < 2 ? F.ws + WS_WGU + ((size_t)le * 4096 + nt * 512 + (m == 1 ? 128 : 0)) * DM + kt * 128 : F.ws + WS_WDN + ((size_t)le * DM + nt * 256) * DM + kt * 128;
    return j;
}
__device__ __forceinline__ void conv_range(const Ctx& F, int g0, int g1, int first_cu) {
    const int tid = F.wid * 64 + lane_fresh(); const int c4 = (tid >> 6) * 8 + (tid & 7), kq = (tid >> 3) & 7; constexpr int n = 1;
    const int cnt = (g1 - g0 + (F.G - first_cu) - 1) / (F.G - first_cu);
    int g = g0 + (F.c - first_cu) * cnt; g1 = g + cnt < g1 ? g + cnt : g1; if (g >= g1) return;
#define CV8_LOAD(v_, src_) { const GAS float* s_ = (const GAS float*)(src_) + (size_t)(kq * 16) * DM + c4 * 4; _Pragma("unroll") for (int i = 0; i < 16; ++i) v_[i] = __builtin_nontemporal_load((const GAS f32x4*)(s_ + (size_t)i * DM)); }
#define CV8_STORE(v_, job_) { const int rbase = (job_).split ? ((c4 >> 5) * 256 + (c4 & 31) * 4) : c4 * 4; \
        _Pragma("unroll") for (int j = 0; j < 4; ++j) { u32x4 w; \
            w.x = pk4_fp8(v_[0][j] * W8_SCALE, v_[1][j] * W8_SCALE, v_[2][j] * W8_SCALE, v_[3][j] * W8_SCALE); w.y = pk4_fp8(v_[4][j] * W8_SCALE, v_[5][j] * W8_SCALE, v_[6][j] * W8_SCALE, v_[7][j] * W8_SCALE); \
            w.z = pk4_fp8(v_[8][j] * W8_SCALE, v_[9][j] * W8_SCALE, v_[10][j] * W8_SCALE, v_[11][j] * W8_SCALE); w.w = pk4_fp8(v_[12][j] * W8_SCALE, v_[13][j] * W8_SCALE, v_[14][j] * W8_SCALE, v_[15][j] * W8_SCALE); \
            __builtin_nontemporal_store(w, (GAS u32x4*)(GAS unsigned char*)((job_).dst + (size_t)(rbase + j) * DM + kq * 16)); } }
    f32x4 va[16], vb[16]; CvtJob ja = moe_job(F, g), jb = ja; CV8_LOAD(va, ja.src)
    for (;;) {
        if (g + n >= g1) { CV8_STORE(va, ja) break; }
        jb = moe_job(F, g + n); CV8_LOAD(vb, jb.src)
        CV8_STORE(va, ja)
        g += n;
        if (g + n >= g1) { CV8_STORE(vb, jb) break; }
        ja = moe_job(F, g + n); CV8_LOAD(va, ja.src)
        CV8_STORE(vb, jb)
        g += n;
    }
#undef CV8_STORE
#undef CV8_LOAD
}
constexpr int NCV2 = 48, NCV5 = 72, NCV9 = 64, NCV11 = 32, NCV13 = 8;
constexpr int GT0 = 880, GT2 = 3890, GT5 = 6144, GT9 = 8794, GT11 = 10800, GT13 = 11000;
static_assert(GT5 >= MOE_TILES, "layer 0's expert weights must be complete before P8");
__device__ __forceinline__ void p0_prologue(const Ctx& F) {
    const Params& P = F.P; const int tid = F.wid * 64 + lane_fresh();
    LAS float* sil = (LAS float*)F.lds;
    LAS float* red = (LAS float*)(F.lds + 40960);
    for (int u = F.c; u < N_MOD_UNITS + CV_F; u += F.G) {
        if (u < N_MOD_UNITS) {
            const int l = u / 96, j0 = (u % 96) * 128;
            for (int i = tid; i < 5 * DM; i += 512) { const int v = i >> 11, k = i & 2047; const float cv = v < 4 ? P.in[I_C][v * DM + k] : P.in[I_CCTX][k]; sil[i] = cv * fast_sigmoid(cv); }
            __syncthreads();
            const int hw = tid >> 5, l32 = tid & 31;
            f32x4 a0 = {0, 0, 0, 0}, a1 = a0, a2 = a0, a3 = a0, a4 = a0;
            const float* wp = P.in[I_MODW] + ((size_t)(l * DM + hw * 128)) * MODN + j0 + l32 * 4;
#pragma unroll 8
            for (int kk = 0; kk < 128; ++kk) { const f32x4 w = ld_nt(wp + (size_t)kk * MODN); const int k = hw * 128 + kk;
                a0 += sil[k] * w; a1 += sil[DM + k] * w; a2 += sil[2 * DM + k] * w; a3 += sil[3 * DM + k] * w; a4 += sil[4 * DM + k] * w; }
            *(LAS f32x4*)(red + (hw * 5 + 0) * 128 + l32 * 4) = a0; *(LAS f32x4*)(red + (hw * 5 + 1) * 128 + l32 * 4) = a1; *(LAS f32x4*)(red + (hw * 5 + 2) * 128 + l32 * 4) = a2;
            *(LAS f32x4*)(red + (hw * 5 + 3) * 128 + l32 * 4) = a3; *(LAS f32x4*)(red + (hw * 5 + 4) * 128 + l32 * 4) = a4;
            __syncthreads();
            float* mod = (float*)(F.ws + WS_MOD);
            for (int o = tid; o < 640; o += 512) { const int v = o >> 7, col = o & 127; float s = 0.f;
#pragma unroll
                for (int h = 0; h < 16; ++h) s += red[(h * 5 + v) * 128 + col];
                mod[(size_t)(l * 5 + v) * MODN + j0 + col] = s + P.in[I_MODB][l * MODN + j0 + col]; }
            __syncthreads();
        } else {
            const int t = u - N_MOD_UNITS;
            if (t < CV_A)      { const int q = t;        const int kt = q / 36, nt = q % 36; const int drow = nt < 20 ? nt * 128 : (nt < 28 ? 2560 + (nt - 20) * 256 : 2560 + (nt - 28) * 256 + 128);
                cvt_tile(P.in[I_EVWIN]  + (size_t)kt * 128 * EV_IN + nt * 128, EV_IN, (bf16_t*)(F.ws + WS_WEVIN)  + (size_t)drow * DM + kt * 128, DM, tid); }
            else if (t < CV_B) { const int q = t - CV_A; const int kt = q / 16, nt = q % 16; cvt_tile(P.in[I_EVWOUT] + (size_t)kt * 128 * DM + nt * 128, DM, (bf16_t*)(F.ws + WS_WEVOUT) + (size_t)nt * 128 * DM + kt * 128, DM, tid); }
            else if (t < CV_C) { const int q = t - CV_B; const int kt = q / 40, nt = q % 40; cvt_tile(P.in[I_ODWIN]  + (size_t)kt * 128 * OD_IN + nt * 128, OD_IN, (bf16_t*)(F.ws + WS_WODIN)  + (size_t)nt * 128 * DM + kt * 128, DM, tid); }
            else if (t < CV_D) { const int q = t - CV_C; const int kt = q / 16, nt = q % 16; cvt_tile(P.in[I_ODWOUT] + (size_t)kt * 128 * DM + nt * 128, DM, (bf16_t*)(F.ws + WS_WODOUT) + (size_t)nt * 128 * LRUW + kt * 128, LRUW, tid); }
            else if (t < CV_E) { const int q = t - CV_D; const int m = q / 80, r = q % 80, dh = r >> 2, kt = (r >> 1) & 1, nt = r & 1;
                bf16_t* dst = (bf16_t*)(F.ws + WS_WLRU) + ((size_t)dh * 512 + nt * 256 + m * 128) * 256 + kt * 128; const size_t so = (size_t)dh * 65536 + (size_t)kt * 128 * 256 + nt * 128;
                if (m == 0) cvt_tile(P.in[I_ODWA] + so, 256, dst, 256, tid); else cvt_tile(P.in[I_ODWX] + so, 256, dst, 256, tid); }
            else { const int q = t - CV_E; const int g = q < GT0 ? q : GT13 + (q - GT0); moe_cvt_tile(F, g / MOE_TILES, g % MOE_TILES, tid); }
        }
    }
}

template <int MODE> __device__ __forceinline__ void norm_pair(const Ctx& F, const LAS float* lm, int lane, int row, const f32x4 (&nx)[2][8], const u32x2 (&nw)[2][8], int sm0, int sm1) {
    const Params& P = F.P; bf16_t* h = (bf16_t*)(F.ws + WS_H); bf16_t* act = (bf16_t*)(F.ws + WS_ACT); const unsigned char* eo = F.ws + WS_EO;
    const int b = row / TPB, p = row - b * TPB; const bool isctx = p < CTXL; const int mv = isctx ? 4 : b;
    f32x4 v[2][8];
#pragma unroll
    for (int q = 0; q < 2; ++q)
#pragma unroll
        for (int i = 0; i < 8; ++i) v[q][i] = MODE == 0 ? nx[q][i] : (f32x4){bf_lo(nw[q][i].x), bf_hi(nw[q][i].x), bf_lo(nw[q][i].y), bf_hi(nw[q][i].y)};
    if (MODE >= 1) {
        f32x4 a[2][8];
#pragma unroll
        for (int q = 0; q < 2; ++q)
#pragma unroll
            for (int i = 0; i < 8; ++i) a[q][i] = (f32x4){0.f, 0.f, 0.f, 0.f};
        unsigned sel0 = (unsigned)__ballot(sm0 >= 0) & 0xffffu, sel1 = (unsigned)__ballot(sm1 >= 0) & 0xffffu;
        while (sel0 | sel1) {
            int sl[4]; bool on[4];
            { on[0] = sel0 != 0u; const int e = on[0] ? __builtin_ctz(sel0) : 0; if (on[0]) sel0 &= sel0 - 1u; sl[0] = on[0] ? __builtin_amdgcn_readlane(sm0, e) : 0; }
            { on[1] = sel0 != 0u; const int e = on[1] ? __builtin_ctz(sel0) : 0; if (on[1]) sel0 &= sel0 - 1u; sl[1] = on[1] ? __builtin_amdgcn_readlane(sm0, e) : sl[0]; }
            { on[2] = sel1 != 0u; const int e = on[2] ? __builtin_ctz(sel1) : 0; if (on[2]) sel1 &= sel1 - 1u; sl[2] = on[2] ? __builtin_amdgcn_readlane(sm1, e) : 0; }
            { on[3] = sel1 != 0u; const int e = on[3] ? __builtin_ctz(sel1) : 0; if (on[3]) sel1 &= sel1 - 1u; sl[3] = on[3] ? __builtin_amdgcn_readlane(sm1, e) : sl[2]; }
            unsigned w[4][8];
#pragma unroll
            for (int t = 0; t < 4; ++t)
#pragma unroll
                for (int i = 0; i < 8; ++i) w[t][i] = *(const unsigned*)(eo + (size_t)sl[t] * DM + lane * 4 + 256 * i);
#pragma unroll
            for (int t = 0; t < 4; ++t) { if (on[t]) {
#pragma unroll
                for (int i = 0; i < 8; ++i) a[t >> 1][i] += (f32x4){__builtin_amdgcn_cvt_f32_fp8((int)w[t][i], 0), __builtin_amdgcn_cvt_f32_fp8((int)w[t][i], 1), __builtin_amdgcn_cvt_f32_fp8((int)w[t][i], 2), __builtin_amdgcn_cvt_f32_fp8((int)w[t][i], 3)}; } }
        }
        const LAS float* g2 = lm + 10 * DM + mv * DM + lane * 4;
#pragma unroll
        for (int i = 0; i < 8; ++i) { const f32x4 gv = *(const LAS f32x4*)(g2 + 256 * i); v[0][i] += gv * a[0][i]; v[1][i] += gv * a[1][i]; }
        if (MODE == 1) {
#pragma unroll
            for (int q = 0; q < 2; ++q)
#pragma unroll
                for (int i = 0; i < 8; ++i) { u32x2 w2; w2.x = cvt_pk_bf16(v[q][i][0], v[q][i][1]); w2.y = cvt_pk_bf16(v[q][i][2], v[q][i][3]); *(u32x2*)(h + (size_t)(row + q) * DM + lane * 4 + 256 * i) = w2; } }
    }
    float rinv[2];
#pragma unroll
    for (int q = 0; q < 2; ++q) { float ss = 0.f;
#pragma unroll
        for (int i = 0; i < 8; ++i) ss += v[q][i][0] * v[q][i][0] + v[q][i][1] * v[q][i][1] + v[q][i][2] * v[q][i][2] + v[q][i][3] * v[q][i][3];
        ss = wave_sum(ss); rinv[q] = __builtin_amdgcn_rsqf(ss * (1.0f / DM) + EPS); }
    if (MODE == 2) {
        float* op = P.out + ((size_t)b * SEQ + (p - CTXL)) * DM + lane * 4; const LAS float* gf = lm + lane * 4;
#pragma unroll
        for (int i = 0; i < 8; ++i) { const f32x4 gv = *(const LAS f32x4*)(gf + 256 * i); st_nt(op + 256 * i, v[0][i] * rinv[0] * gv); st_nt(op + DM + 256 * i, v[1][i] * rinv[1] * gv); }
    } else {
        const LAS float* gsp = lm + mv * DM + lane * 4;
#pragma unroll
        for (int i = 0; i < 8; ++i) { const f32x4 gs = *(const LAS f32x4*)(gsp + 256 * i), sv = *(const LAS f32x4*)(gsp + 5 * DM + 256 * i);
#pragma unroll
            for (int q = 0; q < 2; ++q) { const f32x4 y = v[q][i] * rinv[q] * gs + sv;
                u32x2 w2; w2.x = cvt_pk_bf16(y[0], y[1]); w2.y = cvt_pk_bf16(y[2], y[3]); *(u32x2*)(act + (size_t)(row + q) * DM + lane * 4 + 256 * i) = w2; } }
    }
}
template <int MODE> __device__ __forceinline__ void phase_norm(const Ctx& F) {
    const Params& P = F.P; const int lane = lane_fresh();
    const float* mod = (const float*)(F.ws + WS_MOD); const bf16_t* h = (const bf16_t*)(F.ws + WS_H); const int* slotmap = (const int*)(F.ws + WS_SLOT);
    const int lprev = MODE == 2 ? 1 : 0, lnext = MODE == 0 ? 0 : 1;
    LAS float* lm = (LAS float*)F.lds;
    { const int tid = F.wid * 64 + lane;
      for (int i = tid; i < 5 * DM; i += 512) { const int mvv = i >> 11, k = i & 2047;
          if (MODE != 2) { const float* sh_ = mod + (size_t)(lnext * 5 + mvv) * MODN; lm[i] = P.in[I_N1G][lnext * DM + k] * (1.0f + sh_[2048 + k]); lm[5 * DM + i] = sh_[k]; }
          if (MODE >= 1) lm[10 * DM + i] = mod[(size_t)(lprev * 5 + mvv) * MODN + 10240 + k]; }
      if (MODE == 2) for (int i = tid; i < DM; i += 512) lm[i] = P.in[I_FNG][i];
      __syncthreads(); }
    const int npair = MODE == 2 ? NB * SEQ / 2 : MROWS / 2; const int pstep = F.G * 8;
#define NM_ROW(j) (MODE == 2 ? ((j) / (SEQ / 2)) * TPB + CTXL + ((j) % (SEQ / 2)) * 2 : (j) * 2)
#define NM_LOAD(j, nx, nw, nsm0, nsm1) { const int r_ = NM_ROW(j); \
        if (MODE == 0) { const int b_ = r_ / TPB, p_ = r_ - b_ * TPB; const float* src = p_ < CTXL ? P.in[I_CTX] + ((size_t)b_ * CTXL + p_) * DM : P.in[I_X] + ((size_t)b_ * SEQ + (p_ - CTXL)) * DM; \
            _Pragma("unroll") for (int q = 0; q < 2; ++q) _Pragma("unroll") for (int i = 0; i < 8; ++i) nx[q][i] = ld_nt(src + (size_t)q * DM + lane * 4 + 256 * i); \
        } else { \
            _Pragma("unroll") for (int q = 0; q < 2; ++q) _Pragma("unroll") for (int i = 0; i < 8; ++i) nw[q][i] = *(const u32x2*)(h + (size_t)(r_ + q) * DM + lane * 4 + 256 * i); \
            nsm0 = lane < 16 ? slotmap[(size_t)r_ * 16 + lane] : -1; nsm1 = lane < 16 ? slotmap[(size_t)(r_ + 1) * 16 + lane] : -1; } }
    f32x4 ax[2][8], bx[2][8]; u32x2 aw[2][8], bw[2][8]; int as0 = -1, as1 = -1, bs0 = -1, bs1 = -1; int jp = F.c * 8 + F.wid;
    if (jp < npair) {
        NM_LOAD(jp, ax, aw, as0, as1)
        for (;;) {
            if (jp + pstep >= npair) { norm_pair<MODE>(F, lm, lane, NM_ROW(jp), ax, aw, as0, as1); break; }
            NM_LOAD(jp + pstep, bx, bw, bs0, bs1)
            norm_pair<MODE>(F, lm, lane, NM_ROW(jp), ax, aw, as0, as1);
            jp += pstep;
            if (jp + pstep >= npair) { norm_pair<MODE>(F, lm, lane, NM_ROW(jp), bx, bw, bs0, bs1); break; }
            NM_LOAD(jp + pstep, ax, aw, as0, as1)
            norm_pair<MODE>(F, lm, lane, NM_ROW(jp), bx, bw, bs0, bs1);
            jp += pstep;
        }
    }
#undef NM_LOAD
#undef NM_ROW
}

__device__ __forceinline__ void phase_router(const Ctx& F, int layer) {
    const Params& P = F.P; const int lane = lane_fresh(), tid = F.wid * 64 + lane;
    const float* mod = (const float*)(F.ws + WS_MOD); const bf16_t* h = (const bf16_t*)(F.ws + WS_H); unsigned char* act8 = F.ws + WS_ACT; float* aff = (float*)(F.ws + WS_AFF);
    LAS float* Wt = (LAS float*)F.lds;
    const float* wr = P.in[I_ROUTER] + (size_t)layer * DM * 16;
    for (int i = tid; i < DM * 16; i += 512) Wt[(i & 15) * DM + (i >> 4)] = wr[i];
    __syncthreads();
    const int npair = layer == 0 ? MROWS / 2 : NB * SEQ / 2; const int pstep = F.G * 8;
#define RT_ROW(j) (layer == 0 ? (j) * 2 : ((j) / (SEQ / 2)) * TPB + CTXL + ((j) % (SEQ / 2)) * 2)
    u32x2 nw[2][8]; int jp = F.c * 8 + F.wid;
    if (jp < npair) { const int r_ = RT_ROW(jp);
#pragma unroll
        for (int q = 0; q < 2; ++q)
#pragma unroll
            for (int i = 0; i < 8; ++i) nw[q][i] = *(const u32x2*)(h + (size_t)(r_ + q) * DM + lane * 4 + 256 * i); }
    for (; jp < npair; jp += pstep) {
        const int row = RT_ROW(jp); const int b = row / TPB, p = row - b * TPB; const bool isctx = p < CTXL; const int mv = isctx ? 4 : b;
        f32x4 v[2][8];
#pragma unroll
        for (int q = 0; q < 2; ++q)
#pragma unroll
            for (int i = 0; i < 8; ++i) v[q][i] = (f32x4){bf_lo(nw[q][i].x), bf_hi(nw[q][i].x), bf_lo(nw[q][i].y), bf_hi(nw[q][i].y)};
        if (jp + pstep < npair) { const int r_ = RT_ROW(jp + pstep);
#pragma unroll
            for (int q = 0; q < 2; ++q)
#pragma unroll
                for (int i = 0; i < 8; ++i) nw[q][i] = *(const u32x2*)(h + (size_t)(r_ + q) * DM + lane * 4 + 256 * i); }
        float rinv[2];
#pragma unroll
        for (int q = 0; q < 2; ++q) { float ss = 0.f;
#pragma unroll
            for (int i = 0; i < 8; ++i) ss += v[q][i][0] * v[q][i][0] + v[q][i][1] * v[q][i][1] + v[q][i][2] * v[q][i][2] + v[q][i][3] * v[q][i][3];
            ss = wave_sum(ss); rinv[q] = __builtin_amdgcn_rsqf(ss * (1.0f / DM) + EPS); }
        const float* g = P.in[I_N2G] + layer * DM + lane * 4; const float* sh = mod + (size_t)(layer * 5 + mv) * MODN + 6144 + lane * 4; const float* sc = sh + 2048;
#pragma unroll
        for (int i = 0; i < 8; ++i) { const f32x4 gs = *(const f32x4*)(g + 256 * i) * (1.0f + *(const f32x4*)(sc + 256 * i)), sv = *(const f32x4*)(sh + 256 * i);
#pragma unroll
            for (int q = 0; q < 2; ++q) { v[q][i] = v[q][i] * rinv[q] * gs + sv;
                *(unsigned*)(act8 + (size_t)(row + q) * DM + lane * 4 + 256 * i) = pk4_fp8(v[q][i][0], v[q][i][1], v[q][i][2], v[q][i][3]); } }
        float lg[2][16];
#pragma unroll
        for (int e = 0; e < 16; ++e) { float s0 = 0.f, s1 = 0.f;
#pragma unroll
            for (int i = 0; i < 8; ++i) { const f32x4 w = *(const LAS f32x4*)(Wt + e * DM + lane * 4 + 256 * i);
                s0 += v[0][i][0] * w[0] + v[0][i][1] * w[1] + v[0][i][2] * w[2] + v[0][i][3] * w[3]; s1 += v[1][i][0] * w[0] + v[1][i][1] * w[1] + v[1][i][2] * w[2] + v[1][i][3] * w[3]; }
            lg[0][e] = wave_sum(s0); lg[1][e] = wave_sum(s1); __builtin_amdgcn_sched_barrier(0); }
#pragma unroll
        for (int q = 0; q < 2; ++q) { float mx = lg[q][0];
#pragma unroll
            for (int e = 1; e < 16; ++e) mx = fmaxf(mx, lg[q][e]);
            float sum = 0.f;
#pragma unroll
            for (int e = 0; e < 16; ++e) { lg[q][e] = __expf(lg[q][e] - mx); sum += lg[q][e]; }
            float mine = lg[q][0];
#pragma unroll
            for (int e = 1; e < 16; ++e) mine = (lane == e) ? lg[q][e] : mine;
            if (lane < 16) aff[(size_t)(row + q) * 16 + lane] = mine / sum; }
    }
#undef RT_ROW
    __syncthreads();
}

__device__ __forceinline__ unsigned block_excl_scan(unsigned x, LAS unsigned* wsum, int lane, int wid) {
    unsigned s = x;
#pragma unroll
    for (int o = 1; o < 64; o <<= 1) { const unsigned t = __shfl_up(s, o); if (lane >= o) s += t; }
    if (lane == 63) wsum[wid] = s;
    __syncthreads();
    unsigned below = 0;
#pragma unroll
    for (int w = 0; w < 8; ++w) below += (w < wid) ? wsum[w] : 0u;
    __syncthreads();
    return below + s - x;
}
__device__ __forceinline__ void phase_topk(const Ctx& F, int layer) {
    const int lane = lane_fresh(), tid = F.wid * 64 + lane; const int estr = layer == 0 ? 2304 : 2048;
    const float* aff = (const float*)(F.ws + WS_AFF); int* slotmap = (int*)(F.ws + WS_SLOT); float* gval = (float*)(F.ws + WS_GVAL);
    unsigned* offt = (unsigned*)(F.ws + WS_OFFT);
    LAS unsigned* key = (LAS unsigned*)F.lds;
    LAS unsigned* hist = key + 4096;
    LAS unsigned* wsum = hist + 256;
    LAS unsigned* bc = wsum + 16;
    LAS unsigned* list = bc + 16;
    const int nunits = layer == 0 ? 320 : 256;
    for (int u = F.c; u < nunits; u += F.G) {
        const bool lat = u < 256; const int be = lat ? (u >> 2) : (u - 256), q = lat ? (u & 3) : 0; const int b = be >> 4, e = be & 15;
        const int n = lat ? SEQ : CTXL, cap = n >> 3, row0 = b * TPB + (lat ? CTXL : 0);
        for (int i = tid; i < n; i += 512) key[i] = __float_as_uint(aff[(size_t)(row0 + i) * 16 + e]);
        unsigned prefix = 0u, mask = 0u, krem = (unsigned)cap;
#pragma unroll 1
        for (int pass = 0; pass < 4; ++pass) { const int shift = 24 - 8 * pass;
            if (tid < 256) hist[tid] = 0u;
            __syncthreads();
            for (int i = tid; i < n; i += 512) { const unsigned k = key[i]; if ((k & mask) == prefix) __hip_atomic_fetch_add(hist + ((k >> shift) & 255u), 1u, __ATOMIC_RELAXED, __HIP_MEMORY_SCOPE_WORKGROUP); }
            __syncthreads();
            unsigned sfx = 0u;
            if (tid < 256) { sfx = hist[tid];
#pragma unroll
                for (int o = 1; o < 64; o <<= 1) { const unsigned t = __shfl_down(sfx, o); if (lane + o < 64) sfx += t; }
                if (lane == 0) wsum[F.wid] = sfx; }
            __syncthreads();
            if (tid < 256) { unsigned above = 0u;
#pragma unroll
                for (int w = 1; w < 4; ++w) above += (w > F.wid) ? wsum[w] : 0u;
                const unsigned ge = sfx + above; unsigned gt = __shfl_down(sfx, 1); gt = (lane == 63) ? above : gt + above;
                if (ge >= krem && gt < krem) { bc[0] = (unsigned)tid; bc[1] = krem - gt; } }
            __syncthreads();
            prefix |= bc[0] << shift; mask |= 255u << shift; krem = bc[1];
        }
        const int per = lat ? 8 : 1; const bool own = tid * per < n; const int i0 = tid * per;
        unsigned eqc = 0u;
        if (own) for (int j = 0; j < per; ++j) eqc += (key[i0 + j] == prefix) ? 1u : 0u;
        unsigned eqb = block_excl_scan(eqc, wsum, lane, F.wid);
        unsigned selm = 0u, selc = 0u;
        if (own) for (int j = 0; j < per; ++j) { const unsigned k = key[i0 + j]; bool sl = k > prefix; if (k == prefix) { sl = eqb < krem; ++eqb; } if (sl) { selm |= 1u << j; ++selc; } }
        unsigned sb = block_excl_scan(selc, wsum, lane, F.wid);
        const int slot0 = e * estr + (lat ? b * 512 : 2048 + b * 32);
        const bool mine = lat ? ((tid >> 7) == q) : true;
        if (own) for (int j = 0; j < per; ++j) { const bool sl = (selm >> j) & 1u; if (sl) list[sb] = (unsigned)(i0 + j);
            if (mine) slotmap[(size_t)(row0 + i0 + j) * 16 + e] = sl ? slot0 + (int)sb : -1; if (sl) ++sb; }
        __syncthreads();
        const int r_lo = lat ? q * 128 : 0, r_hi = lat ? r_lo + 128 : 32;
        for (int r = r_lo + tid; r < r_hi; r += 512) { const unsigned t = list[r]; gval[slot0 + r] = __uint_as_float(key[t]); offt[slot0 + r] = (unsigned)(row0 + t) * (unsigned)DM; }
        if (layer == 0 && !lat && b == 0 && tid < 128) offt[e * estr + 2176 + tid] = 0u;
        __syncthreads();
    }
}

__device__ __forceinline__ void unpack8(const u32x4 v, float (&o)[8]) { o[0] = bf_lo(v.x); o[1] = bf_hi(v.x); o[2] = bf_lo(v.y); o[3] = bf_hi(v.y); o[4] = bf_lo(v.z); o[5] = bf_hi(v.z); o[6] = bf_lo(v.w); o[7] = bf_hi(v.w); }
__device__ __forceinline__ void load_cu(const bf16_t* prj, int row, int ch, float (&o)[8]) {
    const u32x4 cv = *(const u32x4*)(prj + (size_t)row * PRJ_LD + 2560 + ch), uv = *(const u32x4*)(prj + (size_t)row * PRJ_LD + 3584 + ch);
    o[0] = bf_lo(cv.x) * bf_lo(uv.x); o[1] = bf_hi(cv.x) * bf_hi(uv.x); o[2] = bf_lo(cv.y) * bf_lo(uv.y); o[3] = bf_hi(cv.y) * bf_hi(uv.y);
    o[4] = bf_lo(cv.z) * bf_lo(uv.z); o[5] = bf_hi(cv.z) * bf_hi(uv.z); o[6] = bf_lo(cv.w) * bf_lo(uv.w); o[7] = bf_hi(cv.w) * bf_hi(uv.w);
}
__device__ __forceinline__ void load_x8(const bf16_t* prj, int row, int ch, int seg_lo, int seg_hi, float (&o)[8]) {
    if (row < seg_lo || row >= seg_hi) {
#pragma unroll
        for (int j = 0; j < 8; ++j) o[j] = 0.f; }
    else { const u32x4 v = *(const u32x4*)(prj + (size_t)row * PRJ_LD + ch); o[0] = bf_lo(v.x); o[1] = bf_hi(v.x); o[2] = bf_lo(v.y); o[3] = bf_hi(v.y); o[4] = bf_lo(v.z); o[5] = bf_hi(v.z); o[6] = bf_lo(v.w); o[7] = bf_hi(v.w); }
}
__device__ __forceinline__ int rope_unit(int c, int k, int G) {
    constexpr int NROPE = MROWS / 16;
    if (G != 256) { const int u = c + k * G; return u < NROPE ? u : -1; }
    if (k < 3) return k * 256 + c;
    if (k == 3) return c >= 32 ? 768 + (c - 32) : -1;
    if (k == 4) return (c >= 32 && c < 128) ? 992 + (c - 32) : -1;
    return -1;
}
__device__ __forceinline__ void phase_rope_conv(const Ctx& F) {
    const Params& P = F.P; const int tid = F.wid * 64 + lane_fresh();
    bf16_t* prj = (bf16_t*)(F.ws + WS_PRJ); bf16_t* yin = (bf16_t*)(F.ws + WS_YIN);
    constexpr int NCONV = MROWS / 32, NROPE = MROWS / 16;
    {
        const int ch = (tid & 127) * 8;
        const float* cw = P.in[I_EVCW]; float w0[8], w1[8], w2[8], cb[8];
#pragma unroll
        for (int j = 0; j < 8; ++j) { w0[j] = cw[ch + j]; w1[j] = cw[1024 + ch + j]; w2[j] = cw[2048 + ch + j]; cb[j] = P.in[I_EVCB][ch + j]; }
        u32x4 ncin[10], nbin[8];
#define RC_LOAD(un) { const int r0_ = (un) * 32 + (tid >> 7) * 8; const int b_ = r0_ / TPB, p_ = r0_ - b_ * TPB; const int lo_ = b_ * TPB + (p_ < CTXL ? 0 : CTXL), hi_ = b_ * TPB + (p_ < CTXL ? CTXL : TPB); \
            _Pragma("unroll") for (int k = 0; k < 10; ++k) { const int row = r0_ - 1 + k; const int rc = row < lo_ ? lo_ : (row >= hi_ ? hi_ - 1 : row); \
                ncin[k] = *(const u32x4*)((const char*)prj + (unsigned)(rc * PRJ_LD + 2560 + ch) * 2u); if (row < lo_ || row >= hi_) ncin[k] = (u32x4){0u, 0u, 0u, 0u}; }         \
            _Pragma("unroll") for (int k = 0; k < 8; ++k) nbin[k] = *(const u32x4*)((const char*)prj + (unsigned)((r0_ + k) * PRJ_LD + 1536 + ch) * 2u); }
        int u = F.c; if (u < NCONV) RC_LOAD(u)
        for (; u < NCONV; u += F.G) {
            const int r0 = u * 32 + (tid >> 7) * 8;
            u32x4 cin[10], bin[8];
#pragma unroll
            for (int k = 0; k < 10; ++k) cin[k] = ncin[k];
#pragma unroll
            for (int k = 0; k < 8; ++k) bin[k] = nbin[k];
            if (u + F.G < NCONV) RC_LOAD(u + F.G)
            const unsigned so0 = (unsigned)(r0 * YLD + 1024 + ch) * 2u; __builtin_amdgcn_sched_barrier(0);
            float prev[8], cur[8], nxt[8];
            unpack8(cin[0], prev); unpack8(cin[1], cur);
#pragma unroll
            for (int rr = 0; rr < 8; ++rr) { float bb[8]; unpack8(cin[rr + 2], nxt); unpack8(bin[rr], bb);
                float o[8];
#pragma unroll
                for (int j = 0; j < 8; ++j) { o[j] = bb[j] * (w0[j] * prev[j] + w1[j] * cur[j] + w2[j] * nxt[j] + cb[j]); prev[j] = cur[j]; cur[j] = nxt[j]; }
                u32x4 w; w.x = cvt_pk_bf16(o[0], o[1]); w.y = cvt_pk_bf16(o[2], o[3]); w.z = cvt_pk_bf16(o[4], o[5]); w.w = cvt_pk_bf16(o[6], o[7]);
                *(u32x4*)((char*)yin + (so0 + (unsigned)(rr * YLD * 2))) = w; __builtin_amdgcn_sched_barrier(0); }
        }
#undef RC_LOAD
    }
    {
        const int i = tid & 31; const bool second = ((i >> 3) & 1) != 0;
        float gq[4], gk[4], fr[4];
#pragma unroll
        for (int j = 0; j < 4; ++j) { gq[j] = P.in[I_EVQN][4 * i + j]; gk[j] = P.in[I_EVKN][4 * i + j]; const int fi = 4 * (i & 7) + j; fr[j] = __powf(10000.0f, -(float)(2 * fi) * (1.0f / 64.0f)); }
        u32x2 nwv[10], nv0, nv1;
#define RR_LOAD(un) { const bf16_t* rp_ = prj + (size_t)((un) * 16 + (tid >> 5)) * PRJ_LD + 4 * i; \
            _Pragma("unroll") for (int hh = 0; hh < 10; ++hh) nwv[hh] = *(const u32x2*)(rp_ + hh * 128); nv0 = *(const u32x2*)(rp_ + 1280); nv1 = *(const u32x2*)(rp_ + 1408); }
        int k = 0, u = rope_unit(F.c, 0, F.G); if (u >= 0) RR_LOAD(u)
        for (; u >= 0; ++k) {
            const int un = rope_unit(F.c, k + 1, F.G);
            const int row = u * 16 + (tid >> 5);
            const int b = row / TPB, p = row - b * TPB; const bool lat = p >= CTXL; const int t = p - CTXL;
            u32x2 wv[10];
#pragma unroll
            for (int hh = 0; hh < 10; ++hh) wv[hh] = nwv[hh];
            const u32x2 vv0 = nv0, vv1 = nv1;
            if (un >= 0) RR_LOAD(un)
            float cs[4], sn[4];
            { const int blk = i >> 4; const float pos = lat ? (float)(blk == 0 ? (t >> 6) : (t & 63)) : 0.f;
#pragma unroll
              for (int j = 0; j < 4; ++j) { float s_, c_; sincosf(pos * fr[j], &s_, &c_); cs[j] = c_; sn[j] = s_; } }
            bf16_t* rowp = prj + (size_t)row * PRJ_LD + 4 * i;
#pragma unroll
            for (int hh = 0; hh < 10; ++hh) {
                const u32x2 w = wv[hh]; float x[4] = {bf_lo(w.x), bf_hi(w.x), bf_lo(w.y), bf_hi(w.y)};
                float ss = x[0] * x[0] + x[1] * x[1] + x[2] * x[2] + x[3] * x[3];
#pragma unroll
                for (int o = 16; o >= 1; o >>= 1) ss += __shfl_xor(ss, o);
                const float rinv = __builtin_amdgcn_rsqf(ss * (1.0f / 128.0f) + EPS);
                float y[4];
#pragma unroll
                for (int j = 0; j < 4; ++j) y[j] = x[j] * rinv * (hh < 8 ? gq[j] : gk[j]);
                float o4[4];
#pragma unroll
                for (int j = 0; j < 4; ++j) { const float pr = __shfl_xor(y[j], 8); o4[j] = second ? (pr * sn[j] + y[j] * cs[j]) : (y[j] * cs[j] - pr * sn[j]); }
                wv[hh].x = cvt_pk_bf16(o4[0], o4[1]); wv[hh].y = cvt_pk_bf16(o4[2], o4[3]);
            }
#pragma unroll
            for (int hh = 0; hh < 8; ++hh) *(u32x2*)(rowp + hh * 128) = wv[hh];
            bf16_t* kc = (bf16_t*)(F.ws + WS_KC) + ((size_t)(b * 2) * TPB + p) * 128 + 4 * i; bf16_t* vc = (bf16_t*)(F.ws + WS_VC) + ((size_t)(b * 2) * TPB + p) * 128 + 4 * i;
            *(u32x2*)kc = wv[8]; *(u32x2*)(kc + (size_t)TPB * 128) = wv[9]; *(u32x2*)vc = vv0; *(u32x2*)(vc + (size_t)TPB * 128) = vv1;
            u = un;
        }
#undef RR_LOAD
    }
}

__device__ __forceinline__ void phase_attn(const Ctx& F) {
    const bf16_t* prj = (const bf16_t*)(F.ws + WS_PRJ); bf16_t* yin = (bf16_t*)(F.ws + WS_YIN);
    const int combo = F.c & 7, b = combo >> 1, kvh = combo & 1;
    const bf16_t* Kh = (const bf16_t*)(F.ws + WS_KC) + (size_t)(b * 2 + kvh) * TPB * 128; const bf16_t* Vh = (const bf16_t*)(F.ws + WS_VC) + (size_t)(b * 2 + kvh) * TPB * 128;
#define ATT_UNIT(i) do { const int w = (F.c >> 3) + 32 * (i); const int hq = kvh * 4 + ((i) < 2 ? (w >> 4) : (F.c >> 3)), qb = w & 15; \
        const size_t qrow = (size_t)b * TPB + ((i) < 2 ? CTXL + qb * 256 : 0); \
        att::attn_dense_body(prj + qrow * PRJ_LD + hq * 128, Kh, Vh, yin + qrow * YLD + hq * 128, (i) < 2 ? TPB : CTXL, F.ldsg, F.wid); } while (0)
    ATT_UNIT(0);
    ATT_UNIT(1);
    if (F.c < 32) ATT_UNIT(2);
#undef ATT_UNIT
}

__device__ __forceinline__ void phase_lru_conv(const Ctx& F) {
    const Params& P = F.P; const int tid = F.wid * 64 + lane_fresh();
    const bf16_t* prj = (const bf16_t*)(F.ws + WS_PRJ); bf16_t* U = (bf16_t*)(F.ws + WS_U);
    constexpr int RG = 8, NRG = MROWS / RG;
    const int gt = F.c * 512 + tid, nth = (F.G * 512) / 320;
    if (gt < nth * 320) {
        const int ch = (gt % 320) * 8; int rg = gt / 320;
        const float* cw = P.in[I_ODCW]; float w0[8], w1[8], w2[8], w3[8], cb[8];
#pragma unroll
        for (int j = 0; j < 8; ++j) { w0[j] = cw[ch + j]; w1[j] = cw[LRUW + ch + j]; w2[j] = cw[2 * LRUW + ch + j]; w3[j] = cw[3 * LRUW + ch + j]; cb[j] = P.in[I_ODCB][ch + j]; }
        u32x4 nin[RG + 3];
#define LC_LOAD(g) { const int r0_ = (g) * RG; const int b_ = r0_ / TPB, p_ = r0_ - b_ * TPB; const int lo_ = b_ * TPB + (p_ < CTXL ? 0 : CTXL), hi_ = b_ * TPB + (p_ < CTXL ? CTXL : TPB); \
            _Pragma("unroll") for (int k = 0; k < RG + 3; ++k) { const int row = r0_ - 1 + k; const int rc = row < lo_ ? lo_ : (row >= hi_ ? hi_ - 1 : row); \
                nin[k] = *(const u32x4*)((const char*)prj + (unsigned)(rc * PRJ_LD + ch) * 2u); if (row < lo_ || row >= hi_) nin[k] = (u32x4){0u, 0u, 0u, 0u}; } }
        if (rg < NRG) LC_LOAD(rg)
        for (; rg < NRG; rg += nth) {
            u32x4 xin[RG + 3];
#pragma unroll
            for (int k = 0; k < RG + 3; ++k) xin[k] = nin[k];
            if (rg + nth < NRG) LC_LOAD(rg + nth)
            const unsigned so0 = (unsigned)(rg * RG * LRUW + ch) * 2u; __builtin_amdgcn_sched_barrier(0);
#pragma unroll
            for (int rr = 0; rr < RG; ++rr) { float xm[8], x0[8], x1[8], x2[8]; unpack8(xin[rr], xm); unpack8(xin[rr + 1], x0); unpack8(xin[rr + 2], x1); unpack8(xin[rr + 3], x2);
                float o[8];
#pragma unroll
                for (int j = 0; j < 8; ++j) o[j] = w0[j] * xm[j] + w1[j] * x0[j] + w2[j] * x1[j] + w3[j] * x2[j] + cb[j];
                u32x4 w; w.x = cvt_pk_bf16(o[0], o[1]); w.y = cvt_pk_bf16(o[2], o[3]); w.z = cvt_pk_bf16(o[4], o[5]); w.w = cvt_pk_bf16(o[6], o[7]);
                *(u32x4*)((char*)U + (so0 + (unsigned)(rr * LRUW * 2))) = w; __builtin_amdgcn_sched_barrier(0); }
        }
#undef LC_LOAD
    }
}

__device__ __forceinline__ int scan_chunk_at(int d, int k) { return d == 0 ? k : (k < 4 ? 3 - k : 71 - k); }
__device__ __forceinline__ int scan_order_of(int d, int c) { return d == 0 ? c : (c < 4 ? 3 - c : 71 - c); }
__device__ __forceinline__ void scan_dec(unsigned w, float sp0, float sp1, float& a0, float& b0, float& a1, float& b1) {
    const float q0 = (float)(w & 0xffu) * (1.0f / 255.0f), q1 = (float)((w >> 16) & 0xffu) * (1.0f / 255.0f);
    a0 = __expf(q0 * q0 * sp0); a1 = __expf(q1 * q1 * sp1); b0 = __builtin_amdgcn_cvt_f32_fp8((int)w, 1); b1 = __builtin_amdgcn_cvt_f32_fp8((int)w, 3);
}
__device__ __forceinline__ float lru_sp(const float* lam, int d, int ch) { const float lm = lam[d * LRUW + ch]; return -8.0f * (fmaxf(-lm, 0.f) + __logf(1.0f + __expf(-fabsf(lm)))); }
__device__ __forceinline__ void phase_scan1(const Ctx& F) {
    const unsigned short* lav = (const unsigned short*)(F.ws + WS_LAGI); float* agg = (float*)(F.ws + WS_AGG); const int lane = lane_fresh(); const float* lam = F.P.in[I_ODLAM];
    float* carry = (float*)(F.ws + WS_CARRY); unsigned* scnt = (unsigned*)(F.ws + WS_SCNT);
    constexpr int NU = 2 * NB * 68 * 10;
    const int half = lane >> 5, sub = lane & 31;
    for (int u = F.c * 8 + F.wid; u < NU; u += F.G * 8) {
        const int cg = u % 10, c = (u / 10) % 68, b = (u / (10 * 68)) % NB, d = u / (10 * 68 * NB);
        const int ch = cg * 256 + sub * 8;
        const int r0 = d == 0 ? half * 32 : 63 - half * 32; const int rstep = d == 0 ? LRUW * 2 : -LRUW * 2;
        unsigned off = (unsigned)((((size_t)d * MROWS + (size_t)b * TPB + c * 64 + r0) * LRUW + ch) * 2);
        float hh[8], ss[8], sp[8];
#pragma unroll
        for (int j = 0; j < 8; ++j) { hh[j] = 0.f; ss[j] = 0.f; sp[j] = lru_sp(lam, d, ch + j); asm volatile("" : "+v"(sp[j])); }
#pragma unroll
        for (int blk = 0; blk < 2; ++blk) { u32x4 w[16];
#pragma unroll
            for (int kk = 0; kk < 16; ++kk) { w[kk] = *(const u32x4*)((const char*)lav + off); off += (unsigned)rstep; }
#pragma unroll
            for (int kk = 0; kk < 16; ++kk) {
#pragma unroll
                for (int p = 0; p < 4; ++p) { const unsigned x = p == 0 ? w[kk].x : (p == 1 ? w[kk].y : (p == 2 ? w[kk].z : w[kk].w));
                    const float q0 = (float)(x & 0xffu) * (1.0f / 255.0f), q1 = (float)((x >> 16) & 0xffu) * (1.0f / 255.0f); const float la0 = q0 * q0 * sp[2 * p], la1 = q1 * q1 * sp[2 * p + 1];
                    hh[2 * p] = __expf(la0) * hh[2 * p] + __builtin_amdgcn_cvt_f32_fp8((int)x, 1); hh[2 * p + 1] = __expf(la1) * hh[2 * p + 1] + __builtin_amdgcn_cvt_f32_fp8((int)x, 3); ss[2 * p] += la0; ss[2 * p + 1] += la1;
                    asm volatile("" : "+v"(hh[2 * p]), "+v"(hh[2 * p + 1]), "+v"(ss[2 * p]), "+v"(ss[2 * p + 1])); }
                __builtin_amdgcn_sched_barrier(0); }
        }
        float so[8], ho[8];
#pragma unroll
        for (int j = 0; j < 8; ++j) { so[j] = __shfl_xor(ss[j], 32); ho[j] = __shfl_xor(hh[j], 32); }
        if (half == 1) { float* ap = agg + ((((size_t)d * NB + b) * 68 + c) * LRUW + ch) * 2;
#pragma unroll
            for (int p = 0; p < 4; ++p) { const float h0 = __expf(ss[2 * p]) * ho[2 * p] + hh[2 * p], h1 = __expf(ss[2 * p + 1]) * ho[2 * p + 1] + hh[2 * p + 1];
                st_wt16(ap + 4 * p, (f32x4){ss[2 * p] + so[2 * p], h0, ss[2 * p + 1] + so[2 * p + 1], h1}); } }
        asm volatile("s_waitcnt vmcnt(0)" ::: "memory");
        unsigned old_ = 0u;
        if (lane == 0) old_ = __hip_atomic_fetch_add(scnt + (((d * NB + b) * 10 + cg) * 16), 1u, __ATOMIC_RELAXED, __HIP_MEMORY_SCOPE_AGENT);
        old_ = (unsigned)__builtin_amdgcn_readfirstlane((int)old_);
        if (old_ == 67u) {
            __builtin_amdgcn_fence(__ATOMIC_ACQUIRE, "agent");
            const int pch = cg * 256 + lane * 4; float st[4] = {0.f, 0.f, 0.f, 0.f};
            const float* ab = agg + (((size_t)d * NB + b) * 68 * LRUW + pch) * 2; float* cb = carry + ((size_t)d * NB + b) * 68 * LRUW + pch;
#pragma unroll 1
            for (int k0 = 0; k0 < 68; k0 += 17) { f32x4 a0[17], a1[17];
#pragma unroll
                for (int j = 0; j < 17; ++j) { const int cc = scan_chunk_at(d, k0 + j); a0[j] = *(const f32x4*)(ab + (size_t)cc * LRUW * 2); a1[j] = *(const f32x4*)(ab + (size_t)cc * LRUW * 2 + 4); }
#pragma unroll
                for (int j = 0; j < 17; ++j) { const int cc = scan_chunk_at(d, k0 + j);
                    *(f32x4*)(cb + (size_t)cc * LRUW) = (f32x4){st[0], st[1], st[2], st[3]};
                    st[0] = __expf(a0[j][0]) * st[0] + a0[j][1]; st[1] = __expf(a0[j][2]) * st[1] + a0[j][3]; st[2] = __expf(a1[j][0]) * st[2] + a1[j][1]; st[3] = __expf(a1[j][2]) * st[3] + a1[j][3]; } }
        }
    }
}
__device__ __forceinline__ void scan_carry(const float* agg, int d, int b, int c, int ch, float& h0, float& h1) {
    h0 = 0.f; h1 = 0.f; const int ord = scan_order_of(d, c);
    for (int k0 = 0; k0 < ord; k0 += 16) { f32x4 a[16];
#pragma unroll
        for (int j = 0; j < 16; ++j) { const int cc = scan_chunk_at(d, (k0 + j < ord) ? k0 + j : 0); a[j] = *(const f32x4*)(agg + ((((size_t)d * NB + b) * 68 + cc) * LRUW + ch) * 2);
            if (k0 + j >= ord) a[j] = (f32x4){0.f, 0.f, 0.f, 0.f}; }
#pragma unroll
        for (int j = 0; j < 16; ++j) { h0 = __expf(a[j][0]) * h0 + a[j][1]; h1 = __expf(a[j][2]) * h1 + a[j][3]; } }
}
__device__ __forceinline__ void phase_scan2(const Ctx& F) {
    const unsigned short* lav = (const unsigned short*)(F.ws + WS_LAGI); const float* carry = (const float*)(F.ws + WS_CARRY); const float* lam = F.P.in[I_ODLAM];
    const bf16_t* prj = (const bf16_t*)(F.ws + WS_PRJ); bf16_t* yin = (bf16_t*)(F.ws + WS_YIN); const int lane = lane_fresh();
    constexpr int NU = NB * 64 * 20;
    for (int u = F.c * 8 + F.wid; u < NU; u += F.G * 8) {
        const int cg = u % 20, c = 4 + (u / 20) % 64, b = u / (20 * 64);
        const int ch = cg * 128 + lane * 2; const size_t row0 = (size_t)b * TPB + c * 64;
        unsigned yf[64]; float h0, h1;
        { const f32x2 cv = *(const f32x2*)(carry + (((size_t)0 * NB + b) * 68 + c) * LRUW + ch); h0 = cv.x; h1 = cv.y; }
        { const size_t base = row0 * LRUW + ch;
          const float sp0 = lru_sp(lam, 0, ch), sp1 = lru_sp(lam, 0, ch + 1);
#pragma unroll
          for (int blk = 0; blk < 4; ++blk) { unsigned w[16];
#pragma unroll
            for (int r = 0; r < 16; ++r) w[r] = *(const unsigned*)(lav + base + (size_t)(blk * 16 + r) * LRUW);
#pragma unroll
            for (int r = 0; r < 16; ++r) { float a0, b0, a1, b1; scan_dec(w[r], sp0, sp1, a0, b0, a1, b1); h0 = a0 * h0 + b0; h1 = a1 * h1 + b1; yf[blk * 16 + r] = cvt_pk_bf16(h0, h1); } } }
        { const f32x2 cv = *(const f32x2*)(carry + (((size_t)1 * NB + b) * 68 + c) * LRUW + ch); h0 = cv.x; h1 = cv.y; }
        { const size_t base = (size_t)MROWS * LRUW + row0 * LRUW + ch;
          const float sp0 = lru_sp(lam, 1, ch), sp1 = lru_sp(lam, 1, ch + 1);
#pragma unroll
          for (int blk = 3; blk >= 0; --blk) { unsigned w[16]; unsigned gw[16];
#pragma unroll
            for (int r = 0; r < 16; ++r) { w[r] = *(const unsigned*)(lav + base + (size_t)(blk * 16 + r) * LRUW); gw[r] = *(const unsigned*)(prj + (row0 + blk * 16 + r) * PRJ_LD + LRUW + ch); }
#pragma unroll
            for (int r = 15; r >= 0; --r) { float a0, b0, a1, b1; scan_dec(w[r], sp0, sp1, a0, b0, a1, b1); h0 = a0 * h0 + b0; h1 = a1 * h1 + b1;
                const unsigned f = yf[blk * 16 + r]; gw[r] = cvt_pk_bf16((h0 + bf_lo(f)) * bf_lo(gw[r]), (h1 + bf_hi(f)) * bf_hi(gw[r])); }
#pragma unroll
            for (int r = 0; r < 16; ++r) *(unsigned*)(yin + (row0 + blk * 16 + r) * YLD + ch) = gw[r]; } }
    }
}

constexpr int NPHASE = 22;
constexpr int LDS_BYTES = 147456;
constexpr int LDS_MISC = 135168;
__global__ void __launch_bounds__(512, 2) mk_fwd(Params prm) {
    extern __shared__ __attribute__((aligned(16))) unsigned char lds_raw[];
    Ctx F; F.P = prm; F.ws = prm.ws; F.wid = __builtin_amdgcn_readfirstlane((int)threadIdx.x >> 6); F.G = gridDim.x; F.c = blockIdx.x;
    F.lds = (LAS unsigned char*)lds_raw; F.ldsg = (char*)lds_raw;
    volatile LAS unsigned* misc = (volatile LAS unsigned*)(F.lds + LDS_MISC);
    if (threadIdx.x < 4) misc[threadIdx.x] = 0u;
    __syncthreads();
    XcdBarrier bar; bar.bar = (unsigned*)(F.ws + WS_CTL); bar.x = 0; bar.st = misc; bar.wid = F.wid;
    const int lo = prm.ph_lo, hi = prm.ph_hi;
    if (hi - lo > 1) bar = xcd_barrier_post((unsigned*)(F.ws + WS_CTL), misc, F.wid);
#ifndef PH_MASK
#define PH_MASK 0xffffffffu
#endif
#define IN(k) ((((unsigned)PH_MASK >> (k)) & 1u) && lo <= (k) && (k) < hi)
#define SEAM(k) do { if (IN((k) + 1)) xcd_barrier(bar); } while (0)
#ifndef REP_MASK
#define REP_MASK 0u
#endif
#define NREP(k) ((((unsigned)REP_MASK >> (k)) & 1u) ? 2 : 1)
#define PHASE(k, ...) if (IN(k)) { for (int rep_ = 0; rep_ < NREP(k); ++rep_) { __VA_ARGS__ if (rep_ + 1 < NREP(k)) xcd_barrier(bar); } SEAM(k); }
    const float* mod = (const float*)(F.ws + WS_MOD);
    PHASE(0, p0_prologue(F);)
    PHASE(1, phase_norm<0>(F);)
    PHASE(2, if (F.c < F.G - NCV2) { SchedDense S{(const char*)(F.ws + WS_ACT), (const char*)(F.ws + WS_WEVIN), NMT, EV_IN / 256, F.G - NCV2, F.c, DM, DM, 0};
        EpiEvIn E{(bf16_t*)(F.ws + WS_PRJ), PRJ_LD}; pg8::gemm_phase<false, false>(F.lds, F.wid, pg8::Shape{DM, DM}, S, E); } else conv_range(F, GT0, GT2, F.G - NCV2);)
    PHASE(3, phase_rope_conv(F);)
    PHASE(4, phase_attn(F);)
    PHASE(5, if (F.c < F.G - NCV5) { SchedDense S{(const char*)(F.ws + WS_YIN), (const char*)(F.ws + WS_WEVOUT), NMT, DM / 256, F.G - NCV5, F.c, YLD, DM, 0};
        EpiResid E{prm.in[I_X], prm.in[I_CTX], (bf16_t*)(F.ws + WS_H), mod, 1}; pg8::gemm_phase<false, false>(F.lds, F.wid, pg8::Shape{DM, YLD}, S, E); } else conv_range(F, GT2, GT5, F.G - NCV5);)
    PHASE(6, phase_router(F, 0);)
    PHASE(7, phase_topk(F, 0);)
    PHASE(8, SchedMoe S{(const char*)(F.ws + WS_ACT), (const char*)(F.ws + WS_WGU), 9, 16, 2304, 4096, F.G, F.c, (const unsigned*)(F.ws + WS_OFFT)};
        EpiSwiglu E{F.ws + WS_HID, 2304}; pg8::gemm_phase<true, true>(F.lds, F.wid, pg8::Shape{DM / 2, DM / 2}, S, E);)
    PHASE(9, if (F.c < F.G - NCV9) { SchedMoe S{(const char*)(F.ws + WS_HID), (const char*)(F.ws + WS_WDN), 9, 8, 2304, 2048, F.G - NCV9, F.c, nullptr};
        EpiDown E{F.ws + WS_EO, (const float*)(F.ws + WS_GVAL), 2304}; pg8::gemm_phase<true, false>(F.lds, F.wid, pg8::Shape{DM / 2, DM / 2}, S, E); } else conv_range(F, GT5, GT9, F.G - NCV9);)
    PHASE(10, phase_norm<1>(F);)
    PHASE(11, if (F.c < F.G - NCV11) { SchedOdIn S{(const char*)(F.ws + WS_ACT), (const char*)(F.ws + WS_WODIN), F.G - NCV11, F.c};
        EpiPlainBf16 E{(bf16_t*)(F.ws + WS_PRJ), PRJ_LD, 10}; pg8::gemm_phase<false, false>(F.lds, F.wid, pg8::Shape{DM, DM}, S, E); } else conv_range(F, GT9, GT11, F.G - NCV11);)
    PHASE(12, phase_lru_conv(F);)
    PHASE(13, if (F.c < F.G - NCV13) { SchedLru S{(const char*)(F.ws + WS_U), (const char*)(F.ws + WS_WLRU), F.G - NCV13, F.c};
        EpiLru E{(const bf16_t*)(F.ws + WS_U), (unsigned*)(F.ws + WS_LAGI), prm.in[I_ODBA], prm.in[I_ODBX], prm.in[I_ODLAM]}; pg8::gemm_phase<false, false>(F.lds, F.wid, pg8::Shape{256, LRUW}, S, E); } else conv_range(F, GT11, GT13, F.G - NCV13);)
    PHASE(14, phase_scan1(F);)
    PHASE(15, phase_scan2(F);)
    PHASE(16, SchedDense S{(const char*)(F.ws + WS_YIN), (const char*)(F.ws + WS_WODOUT), 64, DM / 256, F.G, F.c, YLD, LRUW, 1};
        EpiResid E{prm.in[I_X], prm.in[I_CTX], (bf16_t*)(F.ws + WS_H), mod + 5 * MODN, 0}; pg8::gemm_phase<false, false>(F.lds, F.wid, pg8::Shape{LRUW, YLD}, S, E);)
    PHASE(17, phase_router(F, 1);)
    PHASE(18, phase_topk(F, 1);)
    PHASE(19, SchedMoe S{(const char*)(F.ws + WS_ACT), (const char*)(F.ws + WS_WGU) + (size_t)NEXP * 4096 * DM, 8, 16, 2048, 4096, F.G, F.c, (const unsigned*)(F.ws + WS_OFFT)};
        EpiSwiglu E{F.ws + WS_HID, 2048}; pg8::gemm_phase<true, true>(F.lds, F.wid, pg8::Shape{DM / 2, DM / 2}, S, E);)
    PHASE(20, SchedMoe S{(const char*)(F.ws + WS_HID), (const char*)(F.ws + WS_WDN) + (size_t)NEXP * DM * DM, 8, 8, 2048, 2048, F.G, F.c, nullptr};
        EpiDown E{F.ws + WS_EO, (const float*)(F.ws + WS_GVAL), 2048}; pg8::gemm_phase<true, false>(F.lds, F.wid, pg8::Shape{DM / 2, DM / 2}, S, E);)
    PHASE(21, phase_norm<2>(F);)
#undef IN
#undef SEAM
}

extern "C" void kernel_launch(void* const* d_in, const int* in_sizes, int n_in, void* d_out, int out_size, void* d_ws, size_t ws_size, hipStream_t stream) {
    static int grid = 0;
    if (grid == 0) {
        if (n_in != 28 || out_size != NB * SEQ * DM || ws_size < WS_END) { fprintf(stderr, "kernel_launch: bad shapes: n_in %d out %d ws %zu (need %zu)\n", n_in, out_size, ws_size, (size_t)WS_END); grid = -1; return; }
        int dev = 0, cus = 0, per_cu = 0;
        if (hipGetDevice(&dev) != hipSuccess || hipDeviceGetAttribute(&cus, hipDeviceAttributeMultiprocessorCount, dev) != hipSuccess) { grid = -1; return; }
        if (hipFuncSetAttribute((const void*)mk_fwd, hipFuncAttributeMaxDynamicSharedMemorySize, LDS_BYTES) != hipSuccess) { fprintf(stderr, "kernel_launch: hipFuncSetAttribute failed\n"); grid = -1; return; }
        if (hipOccupancyMaxActiveBlocksPerMultiprocessor(&per_cu, (const void*)mk_fwd, 512, LDS_BYTES) != hipSuccess || per_cu < 1) fprintf(stderr, "kernel_launch: occupancy query says %d\n", per_cu);
        (void)hipGetLastError();
        grid = cus;
    }
    if (grid < 0) return;
    (void)in_sizes;
    (void)hipMemsetAsync((char*)d_ws + WS_CTL, 0, 65536, stream);
    Params p{};
    for (int i = 0; i < 28; ++i) p.in[i] = (const float*)d_in[i];
    p.out = (float*)d_out; p.ws = (unsigned char*)d_ws;
#if MK_PER_PHASE
    for (int ph = 0; ph < NPHASE; ++ph) { p.ph_lo = ph; p.ph_hi = ph + 1; hipLaunchKernelGGL(mk_fwd, dim3(grid), dim3(512), LDS_BYTES, stream, p); }
#else
    p.ph_lo = 0; p.ph_hi = NPHASE; hipLaunchKernelGGL(mk_fwd, dim3(grid), dim3(512), LDS_BYTES, stream, p);
#endif
    const hipError_t le = hipPeekAtLastError();
    if (le != hipSuccess) fprintf(stderr, "kernel_launch: launch failed: %s\n", hipGetErrorName(le));
}
```

```cpp
#include <hip/hip_runtime.h>
#include <cstdio>
#include <cstdint>

#ifndef MK_PER_PHASE
#define MK_PER_PHASE 0
#endif

#define LAS __attribute__((address_space(3)))
typedef unsigned short bf16_t;
typedef short bf16x8 __attribute__((ext_vector_type(8)));
typedef short s16x4 __attribute__((ext_vector_type(4)));
typedef float f32x4 __attribute__((ext_vector_type(4)));
typedef float f32x2 __attribute__((ext_vector_type(2)));
typedef float f32x16 __attribute__((ext_vector_type(16)));
typedef unsigned u32x4 __attribute__((ext_vector_type(4)));
typedef unsigned u32x2 __attribute__((ext_vector_type(2)));
typedef int i32x8 __attribute__((ext_vector_type(8)));
typedef int i32x8a __attribute__((ext_vector_type(8), aligned(16)));
typedef int i32x4a __attribute__((ext_vector_type(4), aligned(16)));

#define XB_TMO      128
#define XB_XCNT(j)  (256  + 64 * (j))
#define XB_XSUB(j)  (1280 + 64 * (j))
#define XB_XGEN(j)  (2304 + 64 * (j))
#define XB_TOP      3328
#define XB_TOPGEN   3392
#define XCD_BAR_WORDS 3456
#define XB_SPIN_CAP (1u << 18)

__device__ __forceinline__ unsigned xb_ld(unsigned* p)              { return __hip_atomic_load(p, __ATOMIC_RELAXED, __HIP_MEMORY_SCOPE_AGENT); }
__device__ __forceinline__ unsigned xb_add(unsigned* p, unsigned v) { return __hip_atomic_fetch_add(p, v, __ATOMIC_RELAXED, __HIP_MEMORY_SCOPE_AGENT); }
__device__ __forceinline__ unsigned xb_xcc_id() { return (unsigned)__builtin_amdgcn_s_getreg((3 << 11) | 20) & 0xFu; }
#define XB_SPIN(cond, bar) do { unsigned _sp = 0; while (cond) { __builtin_amdgcn_s_sleep(1); \
    if ((++_sp & 255u) == 0u) { if (xb_ld(&(bar)[XB_TMO])) break; if (_sp > XB_SPIN_CAP) { atomicAdd(&(bar)[XB_TMO], 1u); break; } } } } while (0)

struct XcdBarrier { unsigned* bar; unsigned x; volatile LAS unsigned* st; int wid; };

__device__ __forceinline__ int xb_lane() { int l; asm volatile("v_mbcnt_lo_u32_b32 %0, -1, 0\n\tv_mbcnt_hi_u32_b32 %0, -1, %0" : "=v"(l)); return l; }
__device__ __forceinline__ XcdBarrier xcd_barrier_post(unsigned* bar, volatile LAS unsigned* st, int wid) {
    XcdBarrier b; b.bar = bar; b.x = xb_xcc_id(); b.st = st; b.wid = wid;
    if (wid == 0 && xb_lane() == 0) (void)xb_add(&bar[XB_XCNT(b.x)], 1u);
    return b;
}
__device__ __forceinline__ void xcd_barrier_complete(unsigned* bar, unsigned x, unsigned& nloc, unsigned& nx) {
    const unsigned G = gridDim.x * gridDim.y * gridDim.z;
    unsigned sum, cnt, mine, sp = 0u;
    for (;;) {
        sum = 0u; cnt = 0u; mine = 0u;
#pragma unroll
        for (unsigned j = 0; j < 16; ++j) { const unsigned c = xb_ld(&bar[XB_XCNT(j)]); sum += c; cnt += (c > 0u) ? 1u : 0u; mine = (j == x) ? c : mine; }
        if (sum == G) break;
        __builtin_amdgcn_s_sleep(1);
        if ((++sp & 255u) == 0u) { if (xb_ld(&bar[XB_TMO])) break; if (sp > XB_SPIN_CAP) { atomicAdd(&bar[XB_TMO], 1u); break; } }
    }
    nloc = mine > 0u ? mine : 1u; nx = cnt > 0u ? cnt : 1u;
}
__device__ __forceinline__ void xcd_barrier(const XcdBarrier& b) {
    asm volatile("s_waitcnt vmcnt(0)" ::: "memory");
    __syncthreads();
    if (b.wid == 0 && xb_lane() == 0) {
        unsigned* bar = b.bar;
        __builtin_amdgcn_s_waitcnt(0);
        unsigned nloc = b.st[0], nx = b.st[1];
        if (nloc == 0u) { xcd_barrier_complete(bar, b.x, nloc, nx); b.st[0] = nloc; b.st[1] = nx; }
        const unsigned old = xb_add(&bar[XB_XSUB(b.x)], 1u);
        const unsigned gen = old / nloc;
        if (old + 1u == (gen + 1u) * nloc) {
            __builtin_amdgcn_fence(__ATOMIC_RELEASE, "agent");
            asm volatile("s_waitcnt vmcnt(0)" ::: "memory");
            const unsigned og = xb_add(&bar[XB_TOP], 1u);
            const unsigned tg = og / nx;
            if (og + 1u == (tg + 1u) * nx) xb_add(&bar[XB_TOPGEN], 1u);
            else XB_SPIN(xb_ld(&bar[XB_TOPGEN]) == tg, bar);
            __builtin_amdgcn_fence(__ATOMIC_ACQUIRE, "agent");
            xb_add(&bar[XB_XGEN(b.x)], 1u);
            asm volatile("s_waitcnt vmcnt(0)" ::: "memory");
        } else {
            XB_SPIN(xb_ld(&bar[XB_XGEN(b.x)]) == gen, bar);
            __builtin_amdgcn_fence(__ATOMIC_ACQUIRE, "agent");
            asm volatile("s_waitcnt vmcnt(0)" ::: "memory");
        }
    }
    __syncthreads();
}

constexpr int DM = 2048, NB = 4, SEQ = 4096, CTXL = 256, TPB = SEQ + CTXL  , MROWS = NB * TPB  ;
constexpr int NMT = MROWS / 256;
constexpr int EV_IN = 4608, OD_IN = 5120, LRUW = 2560, PRJ_LD = 5120, YLD = 2560, MODN = 12288;
constexpr int NEXP = 16, FF = 2048;
constexpr float EPS = 1e-6f;
constexpr float W8_SCALE = 32.0f, W8_INV = 1.0f / 32.0f;

constexpr size_t al256(size_t x) { return (x + 255) / 256 * 256; }
constexpr size_t WS_CTL   = 0;
constexpr size_t WS_MOD   = 65536;
constexpr size_t WS_WEVIN = WS_MOD   + al256((size_t)2 * 5 * MODN * 4);
constexpr size_t WS_WEVOUT= WS_WEVIN + (size_t)EV_IN * DM * 2;
constexpr size_t WS_WODIN = WS_WEVOUT+ (size_t)DM * DM * 2;
constexpr size_t WS_WLRU  = WS_WODIN + (size_t)OD_IN * DM * 2;
constexpr size_t WS_WODOUT= WS_WLRU  + (size_t)2 * 10 * 512 * 256 * 2;
constexpr size_t WS_WGU   = WS_WODOUT+ (size_t)DM * LRUW * 2;
constexpr size_t WS_WDN   = WS_WGU   + (size_t)2 * NEXP * 4096 * DM;
constexpr size_t WS_H     = WS_WDN   + (size_t)2 * NEXP * DM * DM;
constexpr size_t WS_ACT   = WS_H     + (size_t)MROWS * DM * 4;
constexpr size_t WS_PRJ   = WS_ACT   + (size_t)MROWS * DM * 2;
constexpr size_t WS_U     = WS_PRJ   + (size_t)MROWS * PRJ_LD * 2;
constexpr size_t WS_YIN   = WS_U     + (size_t)MROWS * LRUW * 2;
constexpr size_t WS_AFF   = WS_YIN   + (size_t)MROWS * YLD * 2;
constexpr size_t WS_SLOT  = WS_AFF   + (size_t)MROWS * 16 * 4;
constexpr size_t WS_GVAL  = WS_SLOT  + (size_t)MROWS * 16 * 4;
constexpr size_t WS_OFFT  = WS_GVAL  + al256((size_t)NEXP * 2304 * 4);
constexpr size_t WS_AGG   = WS_OFFT  + al256((size_t)NEXP * 2304 * 4);
constexpr size_t WS_XS    = WS_AGG   + (size_t)2 * NB * 68 * LRUW * 8;
constexpr size_t WS_HID   = WS_XS    + (size_t)NEXP * 2304 * DM * 2;
constexpr size_t WS_EO    = WS_HID   + (size_t)NEXP * 2304 * DM * 2;
constexpr size_t WS_KC    = WS_EO    + (size_t)NEXP * 2304 * DM * 2;
constexpr size_t WS_VC    = WS_KC    + (size_t)NB * 2 * TPB * 128 * 2;
constexpr size_t WS_CARRY = WS_VC    + (size_t)NB * 2 * TPB * 128 * 2;
constexpr size_t WS_END   = WS_CARRY + (size_t)2 * NB * 68 * LRUW * 4;
constexpr size_t WS_SCNT  = WS_CTL + 16384;
constexpr size_t WS_LAGI  = WS_XS;
static_assert((size_t)2 * MROWS * LRUW * 4 <= WS_KC - WS_XS, "LAGI alias");

struct Params { const float* in[28]; float* out; unsigned char* ws; int ph_lo, ph_hi; };
enum { I_X = 0, I_C, I_CTX, I_CCTX, I_MODW, I_MODB, I_N1G, I_N2G, I_EVWIN, I_EVQN, I_EVKN, I_EVCW, I_EVCB, I_EVWOUT, I_ODWIN, I_ODCW, I_ODCB, I_ODWA, I_ODBA, I_ODWX, I_ODBX,
       I_ODLAM, I_ODWOUT, I_ROUTER, I_WGATE, I_WUP, I_WDOWN, I_FNG };

__device__ __forceinline__ unsigned cvt_pk_bf16(float lo, float hi) { unsigned r; asm volatile("v_cvt_pk_bf16_f32 %0, %1, %2" : "=v"(r) : "v"(lo), "v"(hi)); return r; }
__device__ __forceinline__ unsigned pk4_fp8(float a, float b, float c, float d) { int w = 0; w = __builtin_amdgcn_cvt_pk_fp8_f32(a, b, w, false); w = __builtin_amdgcn_cvt_pk_fp8_f32(c, d, w, true); return (unsigned)w; }
#define GAS __attribute__((address_space(1)))
__device__ __forceinline__ f32x4 ld_nt(const float* p) { return __builtin_nontemporal_load((const GAS f32x4*)(const GAS float*)p); }
__device__ __forceinline__ void st_nt(float* p, f32x4 v) { __builtin_nontemporal_store(v, (GAS f32x4*)(GAS float*)p); }
__device__ __forceinline__ void st_wt16(float* p, f32x4 v) { asm volatile("global_store_dwordx4 %0, %1, off sc1\n\ts_nop 1" :: "v"(p), "v"(v) : "memory"); }
__device__ __forceinline__ float bf_lo(unsigned w) { return __uint_as_float(w << 16); }
__device__ __forceinline__ float bf_hi(unsigned w) { return __uint_as_float(w & 0xffff0000u); }
__device__ __forceinline__ int lane_fresh() { int l; asm volatile("v_mbcnt_lo_u32_b32 %0, -1, 0\n\tv_mbcnt_hi_u32_b32 %0, -1, %0" : "=v"(l)); return l; }
__device__ __forceinline__ float wave_sum(float v) {
#pragma unroll
    for (int o = 32; o >= 1; o >>= 1) v += __shfl_xor(v, o);
    return v;
}
__device__ __forceinline__ float fast_sigmoid(float x) { return __builtin_amdgcn_rcpf(1.0f + __builtin_amdgcn_exp2f(-1.4426950408889634f * x)); }
__device__ __forceinline__ float gelu_tanh(float x) { const float t = 0.7978845608028654f * (x + 0.044715f * x * x * x); return x * fast_sigmoid(2.0f * t); }
__device__ __forceinline__ int xcd_remap(int L, int nwg) { const int q = nwg >> 3, r = nwg & 7, xcd = L & 7, off = L >> 3; return (xcd < r ? xcd * (q + 1) : r * (q + 1) + (xcd - r) * q) + off; }

namespace pg8 {
constexpr int BM = 256, BK = 64, HALF = 128, HTB = HALF * BK * 2, STAGE_BYTES = 8 * HTB;
__device__ __forceinline__ int lds_byte(int r, int c) { const int st = (r >> 4) * 2 + (c >> 5), rr = r & 15, cc = c & 31, ob = rr * 64 + cc * 2; return st * 1024 + (ob ^ (((ob >> 9) & 1) << 5)); }
__device__ __forceinline__ void stage_rc(int b, int& R, int& C) { const int st = b / 1024, sb = b % 1024, swz = sb ^ (((sb >> 9) & 1) << 5); R = (st >> 1) * 16 + swz / 64; C = (st & 1) * 32 + (swz % 64) / 2; }
__device__ __forceinline__ int perm32(int rho) { const int n = rho >> 4, i = rho & 15; return 8 * (i >> 2) + 4 * n + (i & 3); }
struct Unit { int pm, pn, e; };
__device__ __forceinline__ void glds16_s(const void* base_uniform, unsigned voff, unsigned lds_dst) {
    unsigned keep;
    asm volatile("s_mov_b32 %0, m0\n\ts_mov_b32 m0, %3\n\ts_nop 0\n\tglobal_load_lds_dwordx4 %1, %2\n\ts_mov_b32 m0, %0" : "=&s"(keep) : "v"(voff), "s"(base_uniform), "s"(lds_dst) : "memory");
}
struct Shape { int K, lda; };

template <bool FP8, bool GATHER, class Epi, class Sched>
__device__ __forceinline__ void gemm_phase(LAS unsigned char* lds, int wid_in, const Shape g, const Sched& S, const Epi& E) {
    const int lane = lane_fresh(), wid = wid_in, tid = wid * 64 + lane, wr = wid >> 2, wc = wid & 3, fr = lane & 15, fq = lane >> 4;
    const int K = g.K, nt = K / BK;
    unsigned voffA[2], voffB[2]; int gR[2]; unsigned gC[2];
#pragma unroll
    for (int i = 0; i < 2; ++i) { int R, C; stage_rc(tid * 16 + i * 8192, R, C); const int Rb = Epi::PERM ? ((R & ~31) + perm32(R & 31)) : R;
        voffA[i] = (unsigned)(R * g.lda + C) * 2u; voffB[i] = (unsigned)(Rb * K + C) * 2u; gR[i] = R; gC[i] = (unsigned)C * 2u; }
    unsigned coff[2][2], noff[2][2], nnoff[2][2];
#define PG8_LOADOFF(dst, un) do { const unsigned* tb_ = S.offtab() + S.slotbase(un); _Pragma("unroll") for (int h_ = 0; h_ < 2; ++h_) _Pragma("unroll") for (int i_ = 0; i_ < 2; ++i_) dst[h_][i_] = tb_[h_ * 128 + gR[i_]] + gC[i_]; } while (0)
#define PG8_STAGE_A(bufoff, kb, h, nx) do { if constexpr (GATHER) { _Pragma("unroll") for (int _i = 0; _i < 2; ++_i) glds16_s(S.gbase() + (kb), (nx) ? noff[h][_i] : coff[h][_i], ldsb + (unsigned)((bufoff) + _i * 8192)); } \
        else { PG8_STAGE(bufoff, ((nx) ? nA : cA) + (kb) + (h) * hstepA, voffA); } } while (0)
    const size_t kstep = (size_t)(BK * 2);
    const size_t hstepA = (size_t)HALF * g.lda * 2, hstepB = (size_t)HALF * K * 2;
    const unsigned ldsb = (unsigned)(uintptr_t)lds + (unsigned)wid * 1024u;
    const int aoff = lds_byte(wr * 64 + fr, fq * 8), boff = lds_byte(wc * 32 + fr, fq * 8);
#define PG8_SA(b, h) (((b) * 2 + (h)) * HTB)
#define PG8_SB(b, h) ((4 + (b) * 2 + (h)) * HTB)
#define PG8_STAGE(bufoff, gbase, voff) do { _Pragma("unroll") for (int _i = 0; _i < 2; ++_i) glds16_s((gbase), (voff)[_i], ldsb + (unsigned)((bufoff) + _i * 8192)); } while (0)
#define PG8_LD32(p) __builtin_shufflevector(*(const LAS i32x4a*)(p), *(const LAS i32x4a*)((p) + 1024), 0, 1, 2, 3, 4, 5, 6, 7)
#define PG8_LDA(dst, b, h) do { if constexpr (FP8) { _Pragma("unroll") for (int m = 0; m < 4; ++m) dst##8[m] = PG8_LD32(lds + PG8_SA(b, h) + aoff + m * 2048); } \
        else { _Pragma("unroll") for (int m = 0; m < 4; ++m) _Pragma("unroll") for (int k = 0; k < 2; ++k) dst[m][k] = *(const LAS bf16x8*)(lds + PG8_SA(b, h) + aoff + m * 2048 + k * 1024); } } while (0)
#define PG8_LDB(dst, b, h) do { if constexpr (FP8) { _Pragma("unroll") for (int n = 0; n < 2; ++n) dst##8[n] = PG8_LD32(lds + PG8_SB(b, h) + boff + n * 2048); } \
        else { _Pragma("unroll") for (int n = 0; n < 2; ++n) _Pragma("unroll") for (int k = 0; k < 2; ++k) dst[n][k] = *(const LAS bf16x8*)(lds + PG8_SB(b, h) + boff + n * 2048 + k * 1024); } } while (0)
#define PG8_MMA(ai, bj, At, Bt) do { __builtin_amdgcn_s_setprio(1); _Pragma("unroll") for (int m = 0; m < 4; ++m) _Pragma("unroll") for (int n = 0; n < 2; ++n) { \
        f32x16& av_ = accv[ai][bj][m >> 1]; constexpr int dummy_ = 0; (void)dummy_; const int g_ = ((m & 1) * 2 + n) * 4; f32x4 c_ = (f32x4){av_[g_], av_[g_ + 1], av_[g_ + 2], av_[g_ + 3]}; \
        if constexpr (FP8) c_ = __builtin_amdgcn_mfma_scale_f32_16x16x128_f8f6f4(Bt##8[n], At##8[m], c_, 0, 0, 0, 127, 0, 127); \
        else { _Pragma("unroll") for (int k = 0; k < 2; ++k) c_ = __builtin_amdgcn_mfma_f32_16x16x32_bf16(Bt[n][k], At[m][k], c_, 0, 0, 0); } \
        av_[g_] = c_[0]; av_[g_ + 1] = c_[1]; av_[g_ + 2] = c_[2]; av_[g_ + 3] = c_[3]; } __builtin_amdgcn_s_setprio(0); } while (0)
#define PG8_WAIT_V(n) asm volatile("s_waitcnt vmcnt(" #n ")" ::: "memory")
#define PG8_WAIT_L(n) asm volatile("s_waitcnt lgkmcnt(" #n ")" ::: "memory")
#define PG8_BAR __builtin_amdgcn_s_barrier()
#define PG8_SCHED __builtin_amdgcn_sched_barrier(0)
    Unit cur, nxt; int ui = 0;
    if (!S.next(0, cur)) return;
    f32x16 accv[2][2][2];
#pragma unroll
    for (int a = 0; a < 2; ++a)
#pragma unroll
        for (int b = 0; b < 2; ++b)
#pragma unroll
            for (int m = 0; m < 2; ++m)
#pragma unroll
                for (int j = 0; j < 16; ++j) accv[a][b][m][j] = 0.f;
    bf16x8 At[4][2], B0[2][2], B1[2][2]; i32x8 At8[4], B08[2], B18[2];
    const char* cA = S.abase(cur); const char* cB = S.bbase(cur); const char* nA = cA;
    if constexpr (GATHER) { PG8_LOADOFF(coff, cur); Unit n1; if (S.next(1, n1)) PG8_LOADOFF(noff, n1); else PG8_LOADOFF(noff, cur); }
    PG8_STAGE(PG8_SB(0, 0), cB, voffB); PG8_STAGE_A(PG8_SA(0, 0), 0, 0, false); PG8_STAGE(PG8_SB(0, 1), cB + hstepB, voffB); PG8_STAGE_A(PG8_SA(0, 1), 0, 1, false);
    if (wr == 1) PG8_BAR;
    PG8_WAIT_V(4); PG8_BAR;
    PG8_STAGE(PG8_SB(1, 0), cB + kstep, voffB); PG8_STAGE_A(PG8_SA(1, 0), kstep, 0, false); PG8_STAGE(PG8_SB(1, 1), cB + hstepB + kstep, voffB);
    PG8_WAIT_V(6); PG8_BAR;
    for (;;) {
        const bool has_next = S.next(ui + 1, nxt);
        nA = has_next ? S.abase(nxt) : cA; const char* nB = has_next ? S.bbase(nxt) : cB;
        bool has_nn = false;
        if constexpr (GATHER) { Unit nn; has_nn = S.next(ui + 2, nn);
            if (has_nn) { const unsigned* tb_ = S.offtab() + S.slotbase(nn); _Pragma("unroll") for (int h_ = 0; h_ < 2; ++h_) _Pragma("unroll") for (int i_ = 0; i_ < 2; ++i_) nnoff[h_][i_] = tb_[h_ * 128 + gR[i_]]; } }
        for (int t = 0; t < nt; t += 2) {
            const bool last = (t == nt - 2);
            const size_t k1 = (size_t)(t + 1) * kstep, k2 = last ? 0 : (size_t)(t + 2) * kstep, k3 = k2 + kstep;
            const char* b2 = last ? nB : cB + (size_t)(t + 2) * kstep; const char* b3 = b2 + kstep;
            PG8_LDB(B0, 0, 0); PG8_SCHED; PG8_LDA(At, 0, 0); PG8_STAGE_A(PG8_SA(1, 1), k1, 1, false);
            PG8_WAIT_L(8); PG8_BAR; PG8_WAIT_L(0); PG8_MMA(0, 0, At, B0); PG8_BAR; PG8_SCHED;
            PG8_LDB(B1, 0, 1); PG8_STAGE(PG8_SB(0, 0), b2, voffB);
            PG8_BAR; PG8_WAIT_L(0); PG8_MMA(0, 1, At, B1); PG8_BAR;
            PG8_LDA(At, 0, 1); PG8_STAGE_A(PG8_SA(0, 0), k2, 0, last);
            PG8_BAR; PG8_WAIT_L(0); PG8_MMA(1, 0, At, B0); PG8_BAR; PG8_SCHED;
            PG8_STAGE(PG8_SB(0, 1), b2 + hstepB, voffB);
            PG8_WAIT_V(6); PG8_BAR; PG8_MMA(1, 1, At, B1); PG8_BAR;
            PG8_LDB(B0, 1, 0); PG8_SCHED; PG8_LDA(At, 1, 0); PG8_STAGE_A(PG8_SA(0, 1), k2, 1, last);
            PG8_WAIT_L(8); PG8_BAR; PG8_WAIT_L(0); PG8_MMA(0, 0, At, B0); PG8_BAR; PG8_SCHED;
            PG8_LDB(B1, 1, 1); PG8_STAGE(PG8_SB(1, 0), b3, voffB);
            PG8_BAR; PG8_WAIT_L(0); PG8_MMA(0, 1, At, B1); PG8_BAR;
            PG8_LDA(At, 1, 1); PG8_STAGE_A(PG8_SA(1, 0), k3, 0, last);
            PG8_BAR; PG8_WAIT_L(0); PG8_MMA(1, 0, At, B0); PG8_BAR; PG8_SCHED;
            PG8_STAGE(PG8_SB(1, 1), b3 + hstepB, voffB);
            PG8_WAIT_V(6); PG8_BAR; PG8_MMA(1, 1, At, B1); PG8_BAR;
        }
        { f32x4 acc[2][2][4][2];
#pragma unroll
          for (int a = 0; a < 2; ++a)
#pragma unroll
            for (int b = 0; b < 2; ++b)
#pragma unroll
              for (int m = 0; m < 4; ++m)
#pragma unroll
                for (int n = 0; n < 2; ++n) { const int g_ = ((m & 1) * 2 + n) * 4; acc[a][b][m][n] = (f32x4){accv[a][b][m >> 1][g_], accv[a][b][m >> 1][g_ + 1], accv[a][b][m >> 1][g_ + 2], accv[a][b][m >> 1][g_ + 3]}; }
          const int le_ = lane_fresh(); E(acc, cur, wr, wc, le_ & 15, le_ >> 4); }
        if (!has_next) break;
#pragma unroll
        for (int a = 0; a < 2; ++a)
#pragma unroll
            for (int b = 0; b < 2; ++b)
#pragma unroll
                for (int m = 0; m < 2; ++m)
#pragma unroll
                    for (int j = 0; j < 16; ++j) accv[a][b][m][j] = 0.f;
        cur = nxt; cA = nA; cB = nB; ++ui;
        if constexpr (GATHER) {
#pragma unroll
            for (int h_ = 0; h_ < 2; ++h_)
#pragma unroll
                for (int i_ = 0; i_ < 2; ++i_) { coff[h_][i_] = noff[h_][i_]; if (has_nn) noff[h_][i_] = nnoff[h_][i_] + gC[i_]; } }
    }
    PG8_WAIT_V(0);
    if (wr == 0) PG8_BAR;
    PG8_BAR;
#undef PG8_SA
#undef PG8_SB
#undef PG8_STAGE
#undef PG8_STAGE_A
#undef PG8_LOADOFF
#undef PG8_LDA
#undef PG8_LD32
#undef PG8_LDB
#undef PG8_MMA
#undef PG8_WAIT_V
#undef PG8_WAIT_L
#undef PG8_BAR
#undef PG8_SCHED
}
}
using pg8::Unit;

struct SchedDense {
    __device__ __forceinline__ const unsigned* offtab() const { return nullptr; }
    __device__ __forceinline__ int slotbase(const Unit&) const { return 0; }
    __device__ __forceinline__ const char* gbase() const { return nullptr; }
    const char* A; const char* Bt; int nM, nN, G, c, lda, K, lat_only;
    __device__ __forceinline__ bool next(int i, Unit& u) const {
        const int nwg = nM * nN; const int L = i * G + c; if (L >= nwg) return false;
        const int w = xcd_remap(L, nwg);
        const int nig = 8 * nN, gid = w / nig, fm = gid * 8, gsz = (nM - fm) < 8 ? (nM - fm) : 8;
        const int lm = fm + ((w % nig) % gsz); u.pn = (w % nig) / gsz; u.pm = lat_only ? (lm + (lm >> 4) + 1) : lm; u.e = 0; return true;
    }
    __device__ __forceinline__ const char* abase(const Unit& u) const { return A + (size_t)u.pm * 256 * lda * 2; }
    __device__ __forceinline__ const char* bbase(const Unit& u) const { return Bt + (size_t)u.pn * 256 * K * 2; }
};
struct SchedOdIn {
    __device__ __forceinline__ const unsigned* offtab() const { return nullptr; }
    __device__ __forceinline__ int slotbase(const Unit&) const { return 0; }
    __device__ __forceinline__ const char* gbase() const { return nullptr; }
    const char* A; const char* Bt; int G, c;
    __device__ __forceinline__ bool next(int i, Unit& u) const {
        const int L = i * G + c; if (L >= 1320) return false;
        if (L < 1280) { const int w = xcd_remap(L, 1280); const int nig = 8 * 20, gid = w / nig, fm = gid * 8; const int lm = fm + ((w % nig) % 8); u.pn = (w % nig) / 8; u.pm = lm + (lm >> 4) + 1; }
        else { const int q = L - 1280; u.pm = 17 * (q & 3); u.pn = q >> 2; }
        u.e = 0; return true;
    }
    __device__ __forceinline__ const char* abase(const Unit& u) const { return A + (size_t)u.pm * 256 * DM * 2; }
    __device__ __forceinline__ const char* bbase(const Unit& u) const { return Bt + (size_t)u.pn * 256 * DM * 2; }
};
struct SchedLru {
    __device__ __forceinline__ const unsigned* offtab() const { return nullptr; }
    __device__ __forceinline__ int slotbase(const Unit&) const { return 0; }
    __device__ __forceinline__ const char* gbase() const { return nullptr; }
    const char* A; const char* Bt; int G, c;
    __device__ __forceinline__ bool next(int i, Unit& u) const {
        const int L = i * G + c; if (L >= NMT * 40) return false;
        const int w = xcd_remap(L, NMT * 40); const int q = w % 40; u.pm = w / 40; u.e = q >> 1; u.pn = q & 1; return true;
    }
    __device__ __forceinline__ const char* abase(const Unit& u) const { return A + ((size_t)u.pm * 256 * LRUW + (u.e % 10) * 256) * 2; }
    __device__ __forceinline__ const char* bbase(const Unit& u) const { return Bt + ((size_t)u.e * 512 + u.pn * 256) * 256 * 2; }
};
struct SchedMoe {
    const char* A; const char* Bt; int nMe, nN, estr, brows, G, c; const unsigned* otab;
    __device__ __forceinline__ const unsigned* offtab() const { return otab; }
    __device__ __forceinline__ int slotbase(const Unit& u) const { return u.e * estr + u.pm * 256; }
    __device__ __forceinline__ const char* gbase() const { return A; }
    __device__ __forceinline__ bool next(int i, Unit& u) const {
        const int per = nMe * nN, nwg = NEXP * per; const int L = i * G + c; if (L >= nwg) return false;
        const int w = xcd_remap(L, nwg); u.e = w / per; const int r = w % per; u.pm = r % nMe; u.pn = r / nMe; return true;
    }
    __device__ __forceinline__ const char* abase(const Unit& u) const { return A + ((size_t)u.e * estr + u.pm * 256) * DM; }
    __device__ __forceinline__ const char* bbase(const Unit& u) const { return Bt + ((size_t)u.e * brows + u.pn * 256) * DM; }
};

struct EpiPlainBf16 {
    static constexpr bool PERM = true;
    bf16_t* O; int ldc; int gelu_from;
    __device__ __forceinline__ void operator()(const f32x4 (&acc)[2][2][4][2], const Unit& u, int wr, int wc, int fr, int fq) const {
        const int row0 = u.pm * 256 + wr * 64 + fr, col0 = u.pn * 256 + wc * 32 + 8 * fq; const bool gl = u.pn >= gelu_from;
#pragma unroll
        for (int ai = 0; ai < 2; ++ai)
#pragma unroll
            for (int m = 0; m < 4; ++m) { bf16_t* rowp = O + (size_t)(row0 + ai * 128 + m * 16) * ldc + col0;
#pragma unroll
                for (int bj = 0; bj < 2; ++bj) { f32x4 v0 = acc[ai][bj][m][0], v1 = acc[ai][bj][m][1];
                    if (gl) {
#pragma unroll
                        for (int j = 0; j < 4; ++j) { v0[j] = gelu_tanh(v0[j]); v1[j] = gelu_tanh(v1[j]); } }
                    u32x4 w; w.x = cvt_pk_bf16(v0[0], v0[1]); w.y = cvt_pk_bf16(v0[2], v0[3]); w.z = cvt_pk_bf16(v1[0], v1[1]); w.w = cvt_pk_bf16(v1[2], v1[3]);
                    *(u32x4*)(rowp + bj * 128) = w; } }
    }
};
struct EpiEvIn {
    static constexpr bool PERM = true;
    bf16_t* O; int ldc;
    __device__ __forceinline__ void operator()(const f32x4 (&acc)[2][2][4][2], const Unit& u, int wr, int wc, int fr, int fq) const {
        const int row0 = u.pm * 256 + wr * 64 + fr;
        if (u.pn < 10) { const int col0 = u.pn * 256 + wc * 32 + 8 * fq;
#pragma unroll
            for (int ai = 0; ai < 2; ++ai)
#pragma unroll
                for (int m = 0; m < 4; ++m) { bf16_t* rowp = O + (size_t)(row0 + ai * 128 + m * 16) * ldc + col0;
#pragma unroll
                    for (int bj = 0; bj < 2; ++bj) { const f32x4 v0 = acc[ai][bj][m][0], v1 = acc[ai][bj][m][1];
                        u32x4 w; w.x = cvt_pk_bf16(v0[0], v0[1]); w.y = cvt_pk_bf16(v0[2], v0[3]); w.z = cvt_pk_bf16(v1[0], v1[1]); w.w = cvt_pk_bf16(v1[2], v1[3]);
                        *(u32x4*)(rowp + bj * 128) = w; } }
        } else { const int col0 = 2560 + (u.pn - 10) * 128 + wc * 32 + 8 * fq;
#pragma unroll
            for (int ai = 0; ai < 2; ++ai)
#pragma unroll
                for (int m = 0; m < 4; ++m) { const f32x4 v0 = acc[ai][0][m][0] * acc[ai][1][m][0], v1 = acc[ai][0][m][1] * acc[ai][1][m][1];
                    u32x4 w; w.x = cvt_pk_bf16(v0[0], v0[1]); w.y = cvt_pk_bf16(v0[2], v0[3]); w.z = cvt_pk_bf16(v1[0], v1[1]); w.w = cvt_pk_bf16(v1[2], v1[3]);
                    *(u32x4*)(O + (size_t)(row0 + ai * 128 + m * 16) * ldc + col0) = w; }
        }
    }
};
struct EpiResid {
    static constexpr bool PERM = true;
    const float* x; const float* ctx; bf16_t* h; const float* mod; int layer0;
    __device__ __forceinline__ void operator()(const f32x4 (&acc)[2][2][4][2], const Unit& u, int wr, int wc, int fr, int fq) const {
        const int b = u.pm / 17, pt = u.pm - b * 17;
        const float* hold = pt == 0 ? ctx + (size_t)b * CTXL * DM : x + ((size_t)b * SEQ + (pt - 1) * 256) * DM;
        bf16_t* ho = h + (size_t)u.pm * 256 * DM;
        const float* gate = mod + (size_t)(pt == 0 ? 4 : b) * MODN + 4096;
        const int r0 = wr * 64 + fr, col0 = u.pn * 256 + wc * 32 + 8 * fq;
        f32x4 gv[2][2];
#pragma unroll
        for (int bj = 0; bj < 2; ++bj)
#pragma unroll
            for (int n = 0; n < 2; ++n) gv[bj][n] = *(const f32x4*)(gate + col0 + bj * 128 + n * 4);
#pragma unroll
        for (int ai = 0; ai < 2; ++ai) {
            if (layer0) { f32x4 hv[4][2][2];
#pragma unroll
                for (int m = 0; m < 4; ++m) { const size_t off = (size_t)(r0 + ai * 128 + m * 16) * DM + col0;
#pragma unroll
                    for (int bj = 0; bj < 2; ++bj)
#pragma unroll
                        for (int n = 0; n < 2; ++n) hv[m][bj][n] = *(const f32x4*)(hold + off + bj * 128 + n * 4); }
#pragma unroll
                for (int m = 0; m < 4; ++m) { const size_t off = (size_t)(r0 + ai * 128 + m * 16) * DM + col0;
#pragma unroll
                    for (int bj = 0; bj < 2; ++bj) { const f32x4 v0 = hv[m][bj][0] + gv[bj][0] * acc[ai][bj][m][0], v1 = hv[m][bj][1] + gv[bj][1] * acc[ai][bj][m][1];
                        u32x4 w; w.x = cvt_pk_bf16(v0[0], v0[1]); w.y = cvt_pk_bf16(v0[2], v0[3]); w.z = cvt_pk_bf16(v1[0], v1[1]); w.w = cvt_pk_bf16(v1[2], v1[3]); *(u32x4*)(ho + off + bj * 128) = w; } }
            } else { u32x4 hw[4][2];
#pragma unroll
                for (int m = 0; m < 4; ++m) { const size_t off = (size_t)(r0 + ai * 128 + m * 16) * DM + col0;
#pragma unroll
                    for (int bj = 0; bj < 2; ++bj) hw[m][bj] = *(const u32x4*)(ho + off + bj * 128); }
#pragma unroll
                for (int m = 0; m < 4; ++m) { const size_t off = (size_t)(r0 + ai * 128 + m * 16) * DM + col0;
#pragma unroll
                    for (int bj = 0; bj < 2; ++bj) { const u32x4 q = hw[m][bj];
                        const f32x4 v0 = (f32x4){bf_lo(q.x), bf_hi(q.x), bf_lo(q.y), bf_hi(q.y)} + gv[bj][0] * acc[ai][bj][m][0], v1 = (f32x4){bf_lo(q.z), bf_hi(q.z), bf_lo(q.w), bf_hi(q.w)} + gv[bj][1] * acc[ai][bj][m][1];
                        u32x4 w; w.x = cvt_pk_bf16(v0[0], v0[1]); w.y = cvt_pk_bf16(v0[2], v0[3]); w.z = cvt_pk_bf16(v1[0], v1[1]); w.w = cvt_pk_bf16(v1[2], v1[3]); *(u32x4*)(ho + off + bj * 128) = w; } } }
        }
    }
};
struct EpiSwiglu {
    static constexpr bool PERM = true;
    unsigned char* O; int estr;
    __device__ __forceinline__ void operator()(const f32x4 (&acc)[2][2][4][2], const Unit& u, int wr, int wc, int fr, int fq) const {
        const unsigned row0 = (unsigned)(u.e * estr + u.pm * 256 + wr * 64 + fr); const unsigned col0 = (unsigned)(u.pn * 128 + wc * 32 + 8 * fq);
#pragma unroll
        for (int ai = 0; ai < 2; ++ai)
#pragma unroll
            for (int m = 0; m < 4; ++m) { float o[8];
#pragma unroll
                for (int n = 0; n < 2; ++n)
#pragma unroll
                    for (int j = 0; j < 4; ++j) { const float gt = acc[ai][0][m][n][j] * W8_INV, up = acc[ai][1][m][n][j] * W8_INV; o[n * 4 + j] = gt * fast_sigmoid(gt) * up; }
                u32x2 w; w.x = pk4_fp8(o[0], o[1], o[2], o[3]); w.y = pk4_fp8(o[4], o[5], o[6], o[7]);
                *(u32x2*)(O + (unsigned)((row0 + ai * 128 + m * 16) * DM + col0)) = w; __builtin_amdgcn_sched_barrier(0); }
    }
};
struct EpiDown {
    static constexpr bool PERM = true;
    unsigned char* O; const float* gval; int estr;
    __device__ __forceinline__ void operator()(const f32x4 (&acc)[2][2][4][2], const Unit& u, int wr, int wc, int fr, int fq) const {
        const unsigned row0 = (unsigned)(u.e * estr + u.pm * 256 + wr * 64 + fr); const unsigned col0 = (unsigned)(u.pn * 256 + wc * 32 + 8 * fq);
#pragma unroll
        for (int ai = 0; ai < 2; ++ai) { float gvv[4];
#pragma unroll
            for (int m = 0; m < 4; ++m) gvv[m] = gval[row0 + ai * 128 + m * 16] * W8_INV;
            __builtin_amdgcn_sched_barrier(0);
#pragma unroll
            for (int m = 0; m < 4; ++m) { const unsigned slot = row0 + ai * 128 + m * 16; const float gv = gvv[m];
#pragma unroll
                for (int bj = 0; bj < 2; ++bj) { const f32x4 v0 = acc[ai][bj][m][0] * gv, v1 = acc[ai][bj][m][1] * gv;
                    u32x2 w; w.x = pk4_fp8(v0[0], v0[1], v0[2], v0[3]); w.y = pk4_fp8(v1[0], v1[1], v1[2], v1[3]);
                    *(u32x2*)(O + (slot * DM + col0 + bj * 128)) = w; }
                __builtin_amdgcn_sched_barrier(0); } }
    }
};
struct EpiLru {
    static constexpr bool PERM = true;
    const bf16_t* U; unsigned* lagi; const float* ba; const float* bx; const float* lam;
    __device__ __forceinline__ void operator()(const f32x4 (&acc)[2][2][4][2], const Unit& u, int wr, int wc, int fr, int fq) const {
        const int d = u.e / 10, hb = u.e - d * 10; const int ch0 = hb * 256 + u.pn * 128 + wc * 32 + 8 * fq; const int row0 = u.pm * 256 + wr * 64 + fr;
        unsigned short* outp = (unsigned short*)lagi + (size_t)d * MROWS * LRUW;
        constexpr float NL2E = -1.4426950408889634f;
#pragma unroll
        for (int n = 0; n < 2; ++n) { const int chn = ch0 + 4 * n; f32x2 vba[2], vbx[2], sp[2], csp[2];
#pragma unroll
            for (int j = 0; j < 4; ++j) { const float lm = lam[d * LRUW + chn + j]; const float spl = fmaxf(-lm, 0.f) + __logf(1.0f + __expf(-fabsf(lm)));
                vba[j >> 1][j & 1] = NL2E * ba[d * LRUW + chn + j]; vbx[j >> 1][j & 1] = NL2E * bx[d * LRUW + chn + j]; sp[j >> 1][j & 1] = -8.0f * spl; csp[j >> 1][j & 1] = 4.0f * __builtin_amdgcn_sqrtf(spl); }
            u32x2 uws[2][4];
#pragma unroll
            for (int ai = 0; ai < 2; ++ai)
#pragma unroll
                for (int m = 0; m < 4; ++m) uws[ai][m] = *(const u32x2*)(U + (size_t)(row0 + ai * 128 + m * 16) * LRUW + chn);
#pragma unroll
            for (int ai = 0; ai < 2; ++ai)
#pragma unroll
                for (int m = 0; m < 4; ++m) { const size_t row = (size_t)(row0 + ai * 128 + m * 16); const u32x2 uw = uws[ai][m]; unsigned o[2];
#pragma unroll
                    for (int h = 0; h < 2; ++h) { const unsigned uwh = h ? uw.y : uw.x; const f32x2 uv = {bf_lo(uwh), bf_hi(uwh)};
                        f32x2 ta = (f32x2){acc[ai][0][m][n][2 * h], acc[ai][0][m][n][2 * h + 1]} * NL2E + vba[h], tx = (f32x2){acc[ai][1][m][n][2 * h], acc[ai][1][m][n][2 * h + 1]} * NL2E + vbx[h];
                        f32x2 ea, ex; ea.x = __builtin_amdgcn_exp2f(fminf(ta.x, 40.f)); ea.y = __builtin_amdgcn_exp2f(fminf(ta.y, 40.f)); ex.x = __builtin_amdgcn_exp2f(fminf(tx.x, 40.f)); ex.y = __builtin_amdgcn_exp2f(fminf(tx.y, 40.f));
                        ea = ea + 1.0f; ex = ex + 1.0f;
                        const f32x2 dd = (ea * ex) * ex; f32x2 g; g.x = __builtin_amdgcn_rsqf(dd.x); g.y = __builtin_amdgcn_rsqf(dd.y);
                        const f32x2 q = g * ex, r = q * q, la = r * sp[h], y = la + la;
                        f32x2 t = y * 0.041666668f + 0.16666667f; t = t * y + 0.5f; t = t * y;
                        f32x2 s1 = t * (-0.125f) + 0.5f; s1 = s1 * t + 1.0f;
                        const f32x2 bt = ((csp[h] * uv) * g) * s1;
                        (void)la; const int bb = __builtin_amdgcn_cvt_pk_fp8_f32(bt.x, bt.y, 0, false);
                        const unsigned c0 = (unsigned)(q.x * 255.0f + 0.5f), c1 = (unsigned)(q.y * 255.0f + 0.5f);
                        o[h] = c0 | (((unsigned)bb & 0xffu) << 8) | (c1 << 16) | (((unsigned)bb & 0xff00u) << 16); }
                    *(u32x2*)(outp + row * LRUW + chn) = (u32x2){o[0], o[1]}; } }
    }
};

namespace att {
constexpr int D = 128, NW = 8, QBLK = 32, KVBLK = 64;
constexpr float SCALE = 0.088388347648318440f;
constexpr float THR = 8.f;
constexpr int LDQ = PRJ_LD, LDK = 128, LDO = YLD;
constexpr size_t SHM_V = KVBLK * D * 2, SHM_K = KVBLK * D * 2, SHM_ATTN = 2 * SHM_V + 2 * SHM_K + NW * 64 * 4;
#define KSWZ(row, colB) ((row) * 256 + ((colB) ^ (((row) & 7) << 4)))
#define SBAR() __builtin_amdgcn_sched_barrier(0)
__device__ __forceinline__ int crow(int r, int hi) { return (r & 3) + 8 * (r >> 2) + 4 * hi; }
__device__ __forceinline__ void partialSM(f32x16& p0, f32x16& p1, float& m_reg, float& mn, float& alpha) {
  constexpr float C = SCALE * 1.4426950408889634f;
  float pmax = p0[0]; for (int r = 1; r < 16; ++r) pmax = fmaxf(pmax, p0[r]); for (int r = 0; r < 16; ++r) pmax = fmaxf(pmax, p1[r]);
  { auto rr = __builtin_amdgcn_permlane32_swap(__float_as_uint(pmax), __float_as_uint(pmax), false, false);
    pmax = fmaxf(__uint_as_float(rr[0]), __uint_as_float(rr[1])); }
  if (__builtin_expect(__all(pmax - m_reg <= THR / SCALE), 1)) { mn = m_reg; alpha = 1.f; }
  else { mn = fmaxf(m_reg, pmax); alpha = __builtin_amdgcn_exp2f((m_reg - mn) * C); m_reg = mn; }
  float mnC = -mn * C;
  for (int r = 0; r < 16; ++r) p0[r] = fmaf(p0[r], C, mnC); for (int r = 0; r < 16; ++r) p1[r] = fmaf(p1[r], C, mnC);
  for (int r = 0; r < 16; ++r) p0[r] = __builtin_amdgcn_exp2f(p0[r]);
}
__device__ __forceinline__ void finishSM(f32x16& p0, f32x16& p1, float alpha, float& l_reg, bf16x8& pa0, bf16x8& pa1, bf16x8& pa2, bf16x8& pa3) {
  for (int r = 0; r < 16; ++r) p1[r] = __builtin_amdgcn_exp2f(p1[r]);
  float ps = 0; for (int r = 0; r < 16; ++r) ps += p0[r]; for (int r = 0; r < 16; ++r) ps += p1[r];
  { auto rr = __builtin_amdgcn_permlane32_swap(__float_as_uint(ps), __float_as_uint(ps), false, false);
    ps = __uint_as_float(rr[0]) + __uint_as_float(rr[1]); }
  l_reg = l_reg * alpha + ps;
#define PK4(P, BASE, OUT) do { unsigned a0 = cvt_pk_bf16(P[BASE + 0], P[BASE + 1]), a1 = cvt_pk_bf16(P[BASE + 2], P[BASE + 3]);   \
    unsigned b0 = cvt_pk_bf16(P[BASE + 4], P[BASE + 5]), b1 = cvt_pk_bf16(P[BASE + 6], P[BASE + 7]);                              \
    auto r0 = __builtin_amdgcn_permlane32_swap(a0, b0, false, false); auto r1 = __builtin_amdgcn_permlane32_swap(a1, b1, false, false); \
    u32x4 w = {r0[0], r1[0], r0[1], r1[1]}; OUT = *reinterpret_cast<bf16x8*>(&w); } while (0)
  PK4(p0, 0, pa0); PK4(p0, 8, pa1); PK4(p1, 0, pa2); PK4(p1, 8, pa3);
#undef PK4
}
__device__ __forceinline__ void qkt(f32x16& p0, f32x16& p1, const bf16_t* Ks, const bf16x8* qr, int r32, int hi) {
  p0 = f32x16{}; p1 = f32x16{};
  for (int d0 = 0; d0 < 8; ++d0) { int cb = (d0 * 16 + hi * 8) * 2;
    bf16x8 b0 = *reinterpret_cast<const bf16x8*>((const char*)Ks + KSWZ(r32, cb));
    bf16x8 b1 = *reinterpret_cast<const bf16x8*>((const char*)Ks + KSWZ(32 + r32, cb));
    p0 = __builtin_amdgcn_mfma_f32_32x32x16_bf16(b0, qr[d0], p0, 0, 0, 0);
    p1 = __builtin_amdgcn_mfma_f32_32x32x16_bf16(b1, qr[d0], p1, 0, 0, 0); }
}
__device__ __forceinline__ int v_st(int k, int c) { const int kk = (k & ~0xC) | ((k & 4) << 1) | ((k & 8) >> 1); return ((kk >> 3) * 4 + (c >> 5)) * 512 + ((kk & 7) * 32 + (c & 31)) * 2; }
__device__ __forceinline__ int v_rd_base(int lane) { return ((lane & 3) << 3) | (((lane >> 2) & 3) << 6) | (((lane >> 4) & 1) << 5) | (((lane >> 5) & 1) << 8); }
constexpr int v_rd_off(int d0, int ks, int half) { return d0 * 512 + ks * 4096 + half * 2048; }
template <int OFF> __device__ __forceinline__ s16x4 tr_read(int vb) {
  s16x4 r; asm volatile("ds_read_b64_tr_b16 %0, %1 offset:%2" : "=&v"(r) : "v"(vb), "i"(OFF) : "memory"); return r;
}
template <int D0> __device__ __forceinline__ void pv_one(f32x16& od, int vb, bf16x8 pa0, bf16x8 pa1, bf16x8 pa2, bf16x8 pa3) {
  const s16x4 l0 = tr_read<v_rd_off(D0, 0, 0)>(vb), h0 = tr_read<v_rd_off(D0, 0, 1)>(vb), l1 = tr_read<v_rd_off(D0, 1, 0)>(vb), h1 = tr_read<v_rd_off(D0, 1, 1)>(vb);
  const s16x4 l2 = tr_read<v_rd_off(D0, 2, 0)>(vb), h2 = tr_read<v_rd_off(D0, 2, 1)>(vb), l3 = tr_read<v_rd_off(D0, 3, 0)>(vb), h3 = tr_read<v_rd_off(D0, 3, 1)>(vb);
  asm volatile("s_waitcnt lgkmcnt(0)" ::: "memory"); SBAR();
#define PK(L, H) (bf16x8){L[0], L[1], L[2], L[3], H[0], H[1], H[2], H[3]}
  od = __builtin_amdgcn_mfma_f32_32x32x16_bf16(pa0, PK(l0, h0), od, 0, 0, 0);
  od = __builtin_amdgcn_mfma_f32_32x32x16_bf16(pa1, PK(l1, h1), od, 0, 0, 0);
  od = __builtin_amdgcn_mfma_f32_32x32x16_bf16(pa2, PK(l2, h2), od, 0, 0, 0);
  od = __builtin_amdgcn_mfma_f32_32x32x16_bf16(pa3, PK(l3, h3), od, 0, 0, 0);
#undef PK
}
__device__ __forceinline__ void pv_d0(f32x16* o, int vb, bf16x8 pa0, bf16x8 pa1, bf16x8 pa2, bf16x8 pa3) {
  pv_one<0>(o[0], vb, pa0, pa1, pa2, pa3); pv_one<1>(o[1], vb, pa0, pa1, pa2, pa3); pv_one<2>(o[2], vb, pa0, pa1, pa2, pa3); pv_one<3>(o[3], vb, pa0, pa1, pa2, pa3);
}
__device__ __forceinline__ void attn_dense_body(const bf16_t* __restrict__ Qb, const bf16_t* __restrict__ Kh, const bf16_t* __restrict__ Vh, bf16_t* __restrict__ Ob, int seq, char* lds, int wid_in) {
  const int lane = lane_fresh();
  const int wid = wid_in, tid = wid * 64 + lane, r32 = lane & 31, hi = lane >> 5;
  bf16_t* V_lds = (bf16_t*)lds; bf16_t* K_lds = (bf16_t*)(lds + 2 * SHM_V);
  float* ws = (float*)(lds + 2 * SHM_V + 2 * SHM_K) + wid * 64; float* li_l = ws; float* al_l = ws + 32;
  float m_reg = -1e30f, l_reg = 0; f32x16 o[4] = {}; bf16x8 qr[8];
  const bf16_t* Qw = Qb + (long)(wid * QBLK + r32) * LDQ + hi * 8;
#pragma unroll
  for (int d0 = 0; d0 < 8; ++d0) qr[d0] = *reinterpret_cast<const bf16x8*>(Qw + d0 * 16);
  const int sr = tid >> 4, sc = (tid & 15) * 8, vst0 = v_st(sr, sc), vst1 = v_st(32 + sr, sc);
  const int vb0 = (int)(uintptr_t)V_lds + v_rd_base(lane);
  const unsigned toff = (unsigned)(sr * LDK + sc) * 2u;
  struct { bf16x8 vs0, vs1, ks0, ks1; } sr_[2];
#define SLOAD(i, k0) do { const char* vp_ = (const char*)(Vh + (long)(k0) * LDK); const char* kp_ = (const char*)(Kh + (long)(k0) * LDK); \
    sr_[i].vs0 = *reinterpret_cast<const bf16x8*>(vp_ + toff); sr_[i].vs1 = *reinterpret_cast<const bf16x8*>(vp_ + 32 * LDK * 2 + toff); \
    sr_[i].ks0 = *reinterpret_cast<const bf16x8*>(kp_ + toff); sr_[i].ks1 = *reinterpret_cast<const bf16x8*>(kp_ + 32 * LDK * 2 + toff); } while (0)
#define SWRITE(b, i) do { *(bf16x8*)((char*)V_lds + (b) * SHM_V + vst0) = sr_[i].vs0;          \
    *(bf16x8*)((char*)V_lds + (b) * SHM_V + vst1) = sr_[i].vs1; int kc = sc * 2;               \
    *(bf16x8*)((char*)K_lds + (b) * SHM_K + KSWZ(sr, kc)) = sr_[i].ks0;                       \
    *(bf16x8*)((char*)K_lds + (b) * SHM_K + KSWZ(32 + sr, kc)) = sr_[i].ks1; } while (0)
#define SWAIT() asm volatile("s_waitcnt vmcnt(4)" ::: "memory")
#define RESC(a) do { if (__any((a) < 1.f)) { if (hi == 0) al_l[r32] = (a); asm volatile("s_waitcnt lgkmcnt(0)" ::: "memory"); \
    for (int d = 0; d < 4; ++d) for (int r = 0; r < 16; ++r) o[d][r] *= al_l[crow(r, hi)]; } } while (0)
  f32x16 pA0, pA1, pB0, pB1; float mnA, mnB, alA, alB; bf16x8 pa0, pa1, pa2, pa3; const int NT = seq / KVBLK;
  constexpr int SE = 0, SO = 1;
  SLOAD(SE, 0); asm volatile("s_waitcnt vmcnt(0)" ::: "memory"); SWRITE(0, SE); __syncthreads();
  qkt(pA0, pA1, K_lds, qr, r32, hi); partialSM(pA0, pA1, m_reg, mnA, alA);
  SLOAD(SO, KVBLK); if (2 < NT) SLOAD(SE, 2 * KVBLK);
  SWAIT(); SWRITE(1, SO); __syncthreads();
  for (int j = 1; j + 1 < NT; j += 2) {
    SBAR(); qkt(pB0, pB1, (bf16_t*)((char*)K_lds + SHM_K), qr, r32, hi);
    finishSM(pA0, pA1, alA, l_reg, pa0, pa1, pa2, pa3); SBAR();
    SLOAD(SO, (j + 2) * KVBLK); SBAR();
    pv_d0(o, vb0, pa0, pa1, pa2, pa3); partialSM(pB0, pB1, m_reg, mnB, alB);
    __syncthreads(); SWAIT(); SWRITE(0, SE);
    RESC(alB); __syncthreads();
    SBAR(); qkt(pA0, pA1, K_lds, qr, r32, hi);
    finishSM(pB0, pB1, alB, l_reg, pa0, pa1, pa2, pa3); SBAR();
    if (j + 3 < NT) SLOAD(SE, (j + 3) * KVBLK); SBAR();
    pv_d0(o, vb0 + (int)SHM_V, pa0, pa1, pa2, pa3); partialSM(pA0, pA1, m_reg, mnA, alA);
    __syncthreads(); SWAIT(); SWRITE(1, SO);
    RESC(alA); __syncthreads();
  }
  SBAR(); qkt(pB0, pB1, (bf16_t*)((char*)K_lds + SHM_K), qr, r32, hi);
  finishSM(pA0, pA1, alA, l_reg, pa0, pa1, pa2, pa3); SBAR();
  pv_d0(o, vb0, pa0, pa1, pa2, pa3); partialSM(pB0, pB1, m_reg, mnB, alB);
  __syncthreads(); RESC(alB);
  finishSM(pB0, pB1, alB, l_reg, pa0, pa1, pa2, pa3); SBAR();
  pv_d0(o, vb0 + (int)SHM_V, pa0, pa1, pa2, pa3);
  if (hi == 0) li_l[r32] = l_reg; asm volatile("s_waitcnt lgkmcnt(0)" ::: "memory");
  float rli[16];
#pragma unroll
  for (int r = 0; r < 16; ++r) rli[r] = __builtin_amdgcn_rcpf(li_l[crow(r, hi)]);
  bf16_t* Ow = Ob + (long)(wid * QBLK) * LDO;
#pragma unroll
  for (int r = 0; r < 16; ++r) { int orow = crow(r, hi);
    for (int d0 = 0; d0 < 4; ++d0) Ow[(long)orow * LDO + d0 * 32 + r32] = (bf16_t)(cvt_pk_bf16(o[d0][r] * rli[r], 0.f) & 0xffffu); }
  __syncthreads();
#undef SLOAD
#undef SWRITE
#undef SWAIT
#undef RESC
}
}

struct Ctx {
    Params P; unsigned char* ws; int wid, G, c;
    LAS unsigned char* lds; char* ldsg;
};

constexpr int N_MOD_UNITS = 192;
constexpr int CV_A = 576, CV_B = CV_A + 256, CV_C = CV_B + 640, CV_D = CV_C + 320, CV_E = CV_D + 160, CV_F = CV_E + 424 + 2 * 3 * 16 * 128 - 11424  ;
__device__ __noinline__ void cvt_tile(const float* __restrict__ src, int ld, bf16_t* __restrict__ dst, int ldd, int tid) {
    const int c4 = ((tid >> 6) & 3) * 8 + (tid & 7), kq = (tid >> 8) * 8 + ((tid >> 3) & 7);
    const float* s = src + (size_t)(kq * 8) * ld + c4 * 4;
    f32x4 v[8];
#pragma unroll
    for (int i = 0; i < 8; ++i) v[i] = ld_nt(s + (size_t)i * ld);
#pragma unroll
    for (int j = 0; j < 4; ++j) { u32x4 w; w.x = cvt_pk_bf16(v[0][j], v[1][j]); w.y = cvt_pk_bf16(v[2][j], v[3][j]); w.z = cvt_pk_bf16(v[4][j], v[5][j]); w.w = cvt_pk_bf16(v[6][j], v[7][j]);
        __builtin_nontemporal_store(w, (GAS u32x4*)(GAS bf16_t*)(dst + (size_t)(c4 * 4 + j) * ldd + kq * 8)); }
}
__device__ __noinline__ void cvt_tile8(const float* __restrict__ src, int ld, unsigned char* __restrict__ dst, int ldd, int split, int tid) {
    const int c4 = (tid >> 6) * 8 + (tid & 7), kq = (tid >> 3) & 7;
    const float* s = src + (size_t)(kq * 16) * ld + c4 * 4;
    f32x4 v[16];
#pragma unroll
    for (int i = 0; i < 16; ++i) v[i] = ld_nt(s + (size_t)i * ld);
    const int rbase = split ? ((c4 >> 5) * 256 + (c4 & 31) * 4) : c4 * 4;
#pragma unroll
    for (int j = 0; j < 4; ++j) { u32x4 w;
        w.x = pk4_fp8(v[0][j] * W8_SCALE, v[1][j] * W8_SCALE, v[2][j] * W8_SCALE, v[3][j] * W8_SCALE); w.y = pk4_fp8(v[4][j] * W8_SCALE, v[5][j] * W8_SCALE, v[6][j] * W8_SCALE, v[7][j] * W8_SCALE);
        w.z = pk4_fp8(v[8][j] * W8_SCALE, v[9][j] * W8_SCALE, v[10][j] * W8_SCALE, v[11][j] * W8_SCALE); w.w = pk4_fp8(v[12][j] * W8_SCALE, v[13][j] * W8_SCALE, v[14][j] * W8_SCALE, v[15][j] * W8_SCALE);
        __builtin_nontemporal_store(w, (GAS u32x4*)(GAS unsigned char*)(dst + (size_t)(rbase + j) * ldd + kq * 16)); }
}
constexpr int MOE_TILES = 3 * 16 * 128;
__device__ __forceinline__ void moe_cvt_tile(const Ctx& F, int layer, int q, int tid) {
    const Params& P = F.P; const int m = q / 2048, r = q % 2048, le = layer * 16 + (r >> 7), kt = (r >> 3) & 15, nt = r & 7;
    const size_t so = (size_t)le * DM * DM + (size_t)kt * 128 * DM + nt * 256;
    if (m == 0)      cvt_tile8(P.in[I_WGATE] + so, DM, F.ws + WS_WGU + ((size_t)le * 4096 + nt * 512) * DM + kt * 128, DM, 1, tid);
    else if (m == 1) cvt_tile8(P.in[I_WUP]   + so, DM, F.ws + WS_WGU + ((size_t)le * 4096 + nt * 512 + 128) * DM + kt * 128, DM, 1, tid);
    else             cvt_tile8(P.in[I_WDOWN] + so, DM, F.ws + WS_WDN + ((size_t)le * DM + nt * 256) * DM + kt * 128, DM, 0, tid);
}
struct CvtJob { const float* src; unsigned char* dst; int split; };
__device__ __forceinline__ CvtJob moe_job(const Ctx& F, int g) {
    const Params& P = F.P; const int layer = g / MOE_TILES, q = g - layer * MOE_TILES, m = q >> 11, r = q & 2047, le = layer * 16 + (r >> 7), kt = (r >> 3) & 15, nt = r & 7;
    const float* pg = P.in[I_WGATE]; const float* pu = P.in[I_WUP]; const float* pd = P.in[I_WDOWN];
    asm volatile("" : "+s"(pg), "+s"(pu), "+s"(pd));
    const size_t so = (size_t)le * DM * DM + (size_t)kt * 128 * DM + nt * 256;
    CvtJob j; j.src = (m == 0 ? pg : (m == 1 ? pu : pd)) + so; j.split = m < 2 ? 1 : 0;
    j.dst = m < 2 ? F.ws + WS_WGU + ((size_t)le * 4096 + nt * 512 + (m == 1 ? 128 : 0)) * DM + kt * 128 : F.ws + WS_WDN + ((size_t)le * DM + nt * 256) * DM + kt * 128;
    return j;
}
__device__ __forceinline__ void conv_range(const Ctx& F, int g0, int g1, int first_cu) {
    const int tid = F.wid * 64 + lane_fresh(); const int c4 = (tid >> 6) * 8 + (tid & 7), kq = (tid >> 3) & 7; constexpr int n = 1;
    const int cnt = (g1 - g0 + (F.G - first_cu) - 1) / (F.G - first_cu);
    int g = g0 + (F.c - first_cu) * cnt; g1 = g + cnt < g1 ? g + cnt : g1; if (g >= g1) return;
#define CV8_LOAD(v_, src_) { const GAS float* s_ = (const GAS float*)(src_) + (size_t)(kq * 16) * DM + c4 * 4; _Pragma("unroll") for (int i = 0; i < 16; ++i) v_[i] = __builtin_nontemporal_load((const GAS f32x4*)(s_ + (size_t)i * DM)); }
#define CV8_STORE(v_, job_) { const int rbase = (job_).split ? ((c4 >> 5) * 256 + (c4 & 31) * 4) : c4 * 4; \
        _Pragma("unroll") for (int j = 0; j < 4; ++j) { u32x4 w; \
            w.x = pk4_fp8(v_[0][j] * W8_SCALE, v_[1][j] * W8_SCALE, v_[2][j] * W8_SCALE, v_[3][j] * W8_SCALE); w.y = pk4_fp8(v_[4][j] * W8_SCALE, v_[5][j] * W8_SCALE, v_[6][j] * W8_SCALE, v_[7][j] * W8_SCALE); \
            w.z = pk4_fp8(v_[8][j] * W8_SCALE, v_[9][j] * W8_SCALE, v_[10][j] * W8_SCALE, v_[11][j] * W8_SCALE); w.w = pk4_fp8(v_[12][j] * W8_SCALE, v_[13][j] * W8_SCALE, v_[14][j] * W8_SCALE, v_[15][j] * W8_SCALE); \
            __builtin_nontemporal_store(w, (GAS u32x4*)(GAS unsigned char*)((job_).dst + (size_t)(rbase + j) * DM + kq * 16)); } }
    f32x4 va[16], vb[16]; CvtJob ja = moe_job(F, g), jb = ja; CV8_LOAD(va, ja.src)
    for (;;) {
        if (g + n >= g1) { CV8_STORE(va, ja) break; }
        jb = moe_job(F, g + n); CV8_LOAD(vb, jb.src)
        CV8_STORE(va, ja)
        g += n;
        if (g + n >= g1) { CV8_STORE(vb, jb) break; }
        ja = moe_job(F, g + n); CV8_LOAD(va, ja.src)
        CV8_STORE(vb, jb)
        g += n;
    }
#undef CV8_STORE
#undef CV8_LOAD
}
constexpr int NCV2 = 48, NCV5 = 72, NCV9 = 64, NCV11 = 32, NCV13 = 8;
constexpr int GT0 = 424, GT2 = 3694, GT5 = 6144, GT9 = 9024, GT11 = 11204, GT13 = 11424;
static_assert(GT5 >= MOE_TILES, "layer 0's expert weights must be complete before P8");
__device__ __forceinline__ void p0_prologue(const Ctx& F) {
    const Params& P = F.P; const int tid = F.wid * 64 + lane_fresh();
    LAS float* sil = (LAS float*)F.lds;
    LAS float* red = (LAS float*)(F.lds + 40960);
    for (int u = F.c; u < N_MOD_UNITS + CV_F; u += F.G) {
        if (u < N_MOD_UNITS) {
            const int l = u / 96, j0 = (u % 96) * 128;
            for (int i = tid; i < 5 * DM; i += 512) { const int v = i >> 11, k = i & 2047; const float cv = v < 4 ? P.in[I_C][v * DM + k] : P.in[I_CCTX][k]; sil[i] = cv * fast_sigmoid(cv); }
            __syncthreads();
            const int hw = tid >> 5, l32 = tid & 31;
            f32x4 a0 = {0, 0, 0, 0}, a1 = a0, a2 = a0, a3 = a0, a4 = a0;
            const float* wp = P.in[I_MODW] + ((size_t)(l * DM + hw * 128)) * MODN + j0 + l32 * 4;
#pragma unroll 8
            for (int kk = 0; kk < 128; ++kk) { const f32x4 w = ld_nt(wp + (size_t)kk * MODN); const int k = hw * 128 + kk;
                a0 += sil[k] * w; a1 += sil[DM + k] * w; a2 += sil[2 * DM + k] * w; a3 += sil[3 * DM + k] * w; a4 += sil[4 * DM + k] * w; }
            *(LAS f32x4*)(red + (hw * 5 + 0) * 128 + l32 * 4) = a0; *(LAS f32x4*)(red + (hw * 5 + 1) * 128 + l32 * 4) = a1; *(LAS f32x4*)(red + (hw * 5 + 2) * 128 + l32 * 4) = a2;
            *(LAS f32x4*)(red + (hw * 5 + 3) * 128 + l32 * 4) = a3; *(LAS f32x4*)(red + (hw * 5 + 4) * 128 + l32 * 4) = a4;
            __syncthreads();
            float* mod = (float*)(F.ws + WS_MOD);
            for (int o = tid; o < 640; o += 512) { const int v = o >> 7, col = o & 127; float s = 0.f;
#pragma unroll
                for (int h = 0; h < 16; ++h) s += red[(h * 5 + v) * 128 + col];
                mod[(size_t)(l * 5 + v) * MODN + j0 + col] = s + P.in[I_MODB][l * MODN + j0 + col]; }
            __syncthreads();
        } else {
            const int t = u - N_MOD_UNITS;
            if (t < CV_A)      { const int q = t;        const int kt = q / 36, nt = q % 36; const int drow = nt < 20 ? nt * 128 : (nt < 28 ? 2560 + (nt - 20) * 256 : 2560 + (nt - 28) * 256 + 128);
                cvt_tile(P.in[I_EVWIN]  + (size_t)kt * 128 * EV_IN + nt * 128, EV_IN, (bf16_t*)(F.ws + WS_WEVIN)  + (size_t)drow * DM + kt * 128, DM, tid); }
            else if (t < CV_B) { const int q = t - CV_A; const int kt = q / 16, nt = q % 16; cvt_tile(P.in[I_EVWOUT] + (size_t)kt * 128 * DM + nt * 128, DM, (bf16_t*)(F.ws + WS_WEVOUT) + (size_t)nt * 128 * DM + kt * 128, DM, tid); }
            else if (t < CV_C) { const int q = t - CV_B; const int kt = q / 40, nt = q % 40; cvt_tile(P.in[I_ODWIN]  + (size_t)kt * 128 * OD_IN + nt * 128, OD_IN, (bf16_t*)(F.ws + WS_WODIN)  + (size_t)nt * 128 * DM + kt * 128, DM, tid); }
            else if (t < CV_D) { const int q = t - CV_C; const int kt = q / 16, nt = q % 16; cvt_tile(P.in[I_ODWOUT] + (size_t)kt * 128 * DM + nt * 128, DM, (bf16_t*)(F.ws + WS_WODOUT) + (size_t)nt * 128 * LRUW + kt * 128, LRUW, tid); }
            else if (t < CV_E) { const int q = t - CV_D; const int m = q / 80, r = q % 80, dh = r >> 2, kt = (r >> 1) & 1, nt = r & 1;
                bf16_t* dst = (bf16_t*)(F.ws + WS_WLRU) + ((size_t)dh * 512 + nt * 256 + m * 128) * 256 + kt * 128; const size_t so = (size_t)dh * 65536 + (size_t)kt * 128 * 256 + nt * 128;
                if (m == 0) cvt_tile(P.in[I_ODWA] + so, 256, dst, 256, tid); else cvt_tile(P.in[I_ODWX] + so, 256, dst, 256, tid); }
            else { const int q = t - CV_E; const int g = q < GT0 ? q : GT13 + (q - GT0); moe_cvt_tile(F, g / MOE_TILES, g % MOE_TILES, tid); }
        }
    }
}

template <int MODE> __device__ __forceinline__ void norm_pair(const Ctx& F, const LAS float* lm, int lane, int row, const f32x4 (&nx)[2][8], const u32x2 (&nw)[2][8], int sm0, int sm1) {
    const Params& P = F.P; bf16_t* h = (bf16_t*)(F.ws + WS_H); bf16_t* act = (bf16_t*)(F.ws + WS_ACT); const unsigned char* eo = F.ws + WS_EO;
    const int b = row / TPB, p = row - b * TPB; const bool isctx = p < CTXL; const int mv = isctx ? 4 : b;
    f32x4 v[2][8];
#pragma unroll
    for (int q = 0; q < 2; ++q)
#pragma unroll
        for (int i = 0; i < 8; ++i) v[q][i] = MODE == 0 ? nx[q][i] : (f32x4){bf_lo(nw[q][i].x), bf_hi(nw[q][i].x), bf_lo(nw[q][i].y), bf_hi(nw[q][i].y)};
    if (MODE >= 1) {
        f32x4 gv[8]; { const LAS float* g2 = lm + 10 * DM + mv * DM + lane * 4;
#pragma unroll
          for (int i = 0; i < 8; ++i) gv[i] = *(const LAS f32x4*)(g2 + 256 * i); }
        unsigned sel0 = (unsigned)__ballot(sm0 >= 0) & 0xffffu, sel1 = (unsigned)__ballot(sm1 >= 0) & 0xffffu;
        while (sel0 | sel1) {
            constexpr int NE = MODE == 1 ? 3 : 2;
            int sl[2 * NE]; bool on[2 * NE];
#pragma unroll
            for (int t = 0; t < NE; ++t) { on[t] = sel0 != 0u; const int e = on[t] ? __builtin_ctz(sel0) : 0; if (on[t]) sel0 &= sel0 - 1u; sl[t] = on[t] ? __builtin_amdgcn_readlane(sm0, e) : (t ? sl[t - 1] : 0); }
#pragma unroll
            for (int t = NE; t < 2 * NE; ++t) { on[t] = sel1 != 0u; const int e = on[t] ? __builtin_ctz(sel1) : 0; if (on[t]) sel1 &= sel1 - 1u; sl[t] = on[t] ? __builtin_amdgcn_readlane(sm1, e) : (t > NE ? sl[t - 1] : 0); }
            unsigned w[2 * NE][8];
#pragma unroll
            for (int t = 0; t < 2 * NE; ++t)
#pragma unroll
                for (int i = 0; i < 8; ++i) w[t][i] = *(const unsigned*)(eo + (size_t)sl[t] * DM + lane * 4 + 256 * i);
#pragma unroll
            for (int t = 0; t < 2 * NE; ++t) { if (on[t]) {
#pragma unroll
                for (int i = 0; i < 8; ++i) v[t / NE][i] += gv[i] * (f32x4){__builtin_amdgcn_cvt_f32_fp8((int)w[t][i], 0), __builtin_amdgcn_cvt_f32_fp8((int)w[t][i], 1), __builtin_amdgcn_cvt_f32_fp8((int)w[t][i], 2), __builtin_amdgcn_cvt_f32_fp8((int)w[t][i], 3)}; } }
        }
        if (MODE == 1) {
#pragma unroll
            for (int q = 0; q < 2; ++q)
#pragma unroll
                for (int i = 0; i < 8; ++i) { u32x2 w2; w2.x = cvt_pk_bf16(v[q][i][0], v[q][i][1]); w2.y = cvt_pk_bf16(v[q][i][2], v[q][i][3]); *(u32x2*)(h + (size_t)(row + q) * DM + lane * 4 + 256 * i) = w2; } }
    }
    float rinv[2];
#pragma unroll
    for (int q = 0; q < 2; ++q) { float ss = 0.f;
#pragma unroll
        for (int i = 0; i < 8; ++i) ss += v[q][i][0] * v[q][i][0] + v[q][i][1] * v[q][i][1] + v[q][i][2] * v[q][i][2] + v[q][i][3] * v[q][i][3];
        ss = wave_sum(ss); rinv[q] = __builtin_amdgcn_rsqf(ss * (1.0f / DM) + EPS); }
    if (MODE == 2) {
        float* op = P.out + ((size_t)b * SEQ + (p - CTXL)) * DM + lane * 4; const LAS float* gf = lm + lane * 4;
#pragma unroll
        for (int i = 0; i < 8; ++i) { const f32x4 gv = *(const LAS f32x4*)(gf + 256 * i); st_nt(op + 256 * i, v[0][i] * rinv[0] * gv); st_nt(op + DM + 256 * i, v[1][i] * rinv[1] * gv); }
    } else {
        const LAS float* gsp = lm + mv * DM + lane * 4;
#pragma unroll
        for (int i = 0; i < 8; ++i) { const f32x4 gs = *(const LAS f32x4*)(gsp + 256 * i), sv = *(const LAS f32x4*)(gsp + 5 * DM + 256 * i);
#pragma unroll
            for (int q = 0; q < 2; ++q) { const f32x4 y = v[q][i] * rinv[q] * gs + sv;
                u32x2 w2; w2.x = cvt_pk_bf16(y[0], y[1]); w2.y = cvt_pk_bf16(y[2], y[3]); *(u32x2*)(act + (size_t)(row + q) * DM + lane * 4 + 256 * i) = w2; } }
    }
}
template <int MODE> __device__ __forceinline__ void phase_norm(const Ctx& F) {
    const Params& P = F.P; const int lane = lane_fresh();
    const float* mod = (const float*)(F.ws + WS_MOD); const bf16_t* h = (const bf16_t*)(F.ws + WS_H); const int* slotmap = (const int*)(F.ws + WS_SLOT);
    const int lprev = MODE == 2 ? 1 : 0, lnext = MODE == 0 ? 0 : 1;
    LAS float* lm = (LAS float*)F.lds;
    { const int tid = F.wid * 64 + lane;
      for (int i = tid; i < 5 * DM; i += 512) { const int mvv = i >> 11, k = i & 2047;
          if (MODE != 2) { const float* sh_ = mod + (size_t)(lnext * 5 + mvv) * MODN; lm[i] = P.in[I_N1G][lnext * DM + k] * (1.0f + sh_[2048 + k]); lm[5 * DM + i] = sh_[k]; }
          if (MODE >= 1) lm[10 * DM + i] = mod[(size_t)(lprev * 5 + mvv) * MODN + 10240 + k]; }
      if (MODE == 2) for (int i = tid; i < DM; i += 512) lm[i] = P.in[I_FNG][i];
      __syncthreads(); }
    const int npair = MODE == 2 ? NB * SEQ / 2 : MROWS / 2; const int pstep = F.G * 8;
#define NM_ROW(j) (MODE == 2 ? ((j) / (SEQ / 2)) * TPB + CTXL + ((j) % (SEQ / 2)) * 2 : (j) * 2)
#define NM_LOAD(j, nx, nw, nsm0, nsm1) { const int r_ = NM_ROW(j); \
        if (MODE == 0) { const int b_ = r_ / TPB, p_ = r_ - b_ * TPB; const float* src = p_ < CTXL ? P.in[I_CTX] + ((size_t)b_ * CTXL + p_) * DM : P.in[I_X] + ((size_t)b_ * SEQ + (p_ - CTXL)) * DM; \
            _Pragma("unroll") for (int q = 0; q < 2; ++q) _Pragma("unroll") for (int i = 0; i < 8; ++i) nx[q][i] = ld_nt(src + (size_t)q * DM + lane * 4 + 256 * i); \
        } else { \
            _Pragma("unroll") for (int q = 0; q < 2; ++q) _Pragma("unroll") for (int i = 0; i < 8; ++i) nw[q][i] = *(const u32x2*)(h + (size_t)(r_ + q) * DM + lane * 4 + 256 * i); \
            nsm0 = lane < 16 ? slotmap[(size_t)r_ * 16 + lane] : -1; nsm1 = lane < 16 ? slotmap[(size_t)(r_ + 1) * 16 + lane] : -1; } }
    f32x4 ax[2][8], bx[2][8]; u32x2 aw[2][8], bw[2][8]; int as0 = -1, as1 = -1, bs0 = -1, bs1 = -1; int jp = F.c * 8 + F.wid;
    if (jp < npair) {
        NM_LOAD(jp, ax, aw, as0, as1)
        for (;;) {
            if (jp + pstep >= npair) { norm_pair<MODE>(F, lm, lane, NM_ROW(jp), ax, aw, as0, as1); break; }
            NM_LOAD(jp + pstep, bx, bw, bs0, bs1)
            norm_pair<MODE>(F, lm, lane, NM_ROW(jp), ax, aw, as0, as1);
            jp += pstep;
            if (jp + pstep >= npair) { norm_pair<MODE>(F, lm, lane, NM_ROW(jp), bx, bw, bs0, bs1); break; }
            NM_LOAD(jp + pstep, ax, aw, as0, as1)
            norm_pair<MODE>(F, lm, lane, NM_ROW(jp), bx, bw, bs0, bs1);
            jp += pstep;
        }
    }
#undef NM_LOAD
#undef NM_ROW
}

__device__ __forceinline__ void phase_router(const Ctx& F, int layer) {
    const Params& P = F.P; const int lane = lane_fresh(), tid = F.wid * 64 + lane;
    const float* mod = (const float*)(F.ws + WS_MOD); const bf16_t* h = (const bf16_t*)(F.ws + WS_H); unsigned char* act8 = F.ws + WS_ACT; float* aff = (float*)(F.ws + WS_AFF);
    LAS float* Wt = (LAS float*)F.lds;
    const float* wr = P.in[I_ROUTER] + (size_t)layer * DM * 16;
    for (int i = tid; i < DM * 16; i += 512) Wt[(i & 15) * DM + (i >> 4)] = wr[i];
    __syncthreads();
    const int npair = layer == 0 ? MROWS / 2 : NB * SEQ / 2; const int pstep = F.G * 8;
#define RT_ROW(j) (layer == 0 ? (j) * 2 : ((j) / (SEQ / 2)) * TPB + CTXL + ((j) % (SEQ / 2)) * 2)
    u32x2 nw[2][8]; int jp = F.c * 8 + F.wid;
    if (jp < npair) { const int r_ = RT_ROW(jp);
#pragma unroll
        for (int q = 0; q < 2; ++q)
#pragma unroll
            for (int i = 0; i < 8; ++i) nw[q][i] = *(const u32x2*)(h + (size_t)(r_ + q) * DM + lane * 4 + 256 * i); }
    for (; jp < npair; jp += pstep) {
        const int row = RT_ROW(jp); const int b = row / TPB, p = row - b * TPB; const bool isctx = p < CTXL; const int mv = isctx ? 4 : b;
        f32x4 v[2][8];
#pragma unroll
        for (int q = 0; q < 2; ++q)
#pragma unroll
            for (int i = 0; i < 8; ++i) v[q][i] = (f32x4){bf_lo(nw[q][i].x), bf_hi(nw[q][i].x), bf_lo(nw[q][i].y), bf_hi(nw[q][i].y)};
        if (jp + pstep < npair) { const int r_ = RT_ROW(jp + pstep);
#pragma unroll
            for (int q = 0; q < 2; ++q)
#pragma unroll
                for (int i = 0; i < 8; ++i) nw[q][i] = *(const u32x2*)(h + (size_t)(r_ + q) * DM + lane * 4 + 256 * i); }
        float rinv[2];
#pragma unroll
        for (int q = 0; q < 2; ++q) { float ss = 0.f;
#pragma unroll
            for (int i = 0; i < 8; ++i) ss += v[q][i][0] * v[q][i][0] + v[q][i][1] * v[q][i][1] + v[q][i][2] * v[q][i][2] + v[q][i][3] * v[q][i][3];
            ss = wave_sum(ss); rinv[q] = __builtin_amdgcn_rsqf(ss * (1.0f / DM) + EPS); }
        const float* g = P.in[I_N2G] + layer * DM + lane * 4; const float* sh = mod + (size_t)(layer * 5 + mv) * MODN + 6144 + lane * 4; const float* sc = sh + 2048;
#pragma unroll
        for (int i = 0; i < 8; ++i) { const f32x4 gs = *(const f32x4*)(g + 256 * i) * (1.0f + *(const f32x4*)(sc + 256 * i)), sv = *(const f32x4*)(sh + 256 * i);
#pragma unroll
            for (int q = 0; q < 2; ++q) { v[q][i] = v[q][i] * rinv[q] * gs + sv;
                *(unsigned*)(act8 + (size_t)(row + q) * DM + lane * 4 + 256 * i) = pk4_fp8(v[q][i][0], v[q][i][1], v[q][i][2], v[q][i][3]); } }
        float lg[2][16];
#pragma unroll
        for (int e = 0; e < 16; ++e) { float s0 = 0.f, s1 = 0.f;
#pragma unroll
            for (int i = 0; i < 8; ++i) { const f32x4 w = *(const LAS f32x4*)(Wt + e * DM + lane * 4 + 256 * i);
                s0 += v[0][i][0] * w[0] + v[0][i][1] * w[1] + v[0][i][2] * w[2] + v[0][i][3] * w[3]; s1 += v[1][i][0] * w[0] + v[1][i][1] * w[1] + v[1][i][2] * w[2] + v[1][i][3] * w[3]; }
            lg[0][e] = wave_sum(s0); lg[1][e] = wave_sum(s1); __builtin_amdgcn_sched_barrier(0); }
#pragma unroll
        for (int q = 0; q < 2; ++q) { float mx = lg[q][0];
#pragma unroll
            for (int e = 1; e < 16; ++e) mx = fmaxf(mx, lg[q][e]);
            float sum = 0.f;
#pragma unroll
            for (int e = 0; e < 16; ++e) { lg[q][e] = __expf(lg[q][e] - mx); sum += lg[q][e]; }
            float mine = lg[q][0];
#pragma unroll
            for (int e = 1; e < 16; ++e) mine = (lane == e) ? lg[q][e] : mine;
            if (lane < 16) aff[(size_t)(row + q) * 16 + lane] = mine / sum; }
    }
#undef RT_ROW
    __syncthreads();
}

__device__ __forceinline__ unsigned block_excl_scan(unsigned x, LAS unsigned* wsum, int lane, int wid) {
    unsigned s = x;
#pragma unroll
    for (int o = 1; o < 64; o <<= 1) { const unsigned t = __shfl_up(s, o); if (lane >= o) s += t; }
    if (lane == 63) wsum[wid] = s;
    __syncthreads();
    unsigned below = 0;
#pragma unroll
    for (int w = 0; w < 8; ++w) below += (w < wid) ? wsum[w] : 0u;
    __syncthreads();
    return below + s - x;
}
__device__ __forceinline__ void phase_topk(const Ctx& F, int layer) {
    const int lane = lane_fresh(), tid = F.wid * 64 + lane; const int estr = layer == 0 ? 2304 : 2048;
    const float* aff = (const float*)(F.ws + WS_AFF); int* slotmap = (int*)(F.ws + WS_SLOT); float* gval = (float*)(F.ws + WS_GVAL);
    unsigned* offt = (unsigned*)(F.ws + WS_OFFT);
    LAS unsigned* key = (LAS unsigned*)F.lds;
    LAS unsigned* hist = key + 4096;
    LAS unsigned* wsum = hist + 256;
    LAS unsigned* bc = wsum + 16;
    LAS unsigned* list = bc + 16;
    const int nunits = layer == 0 ? 320 : 256;
    for (int u = F.c; u < nunits; u += F.G) {
        const bool lat = u < 256; const int be = lat ? (u >> 2) : (u - 256), q = lat ? (u & 3) : 0; const int b = be >> 4, e = be & 15;
        const int n = lat ? SEQ : CTXL, cap = n >> 3, row0 = b * TPB + (lat ? CTXL : 0);
        for (int i = tid; i < n; i += 512) key[i] = __float_as_uint(aff[(size_t)(row0 + i) * 16 + e]);
        unsigned prefix = 0u, mask = 0u, krem = (unsigned)cap;
#pragma unroll 1
        for (int pass = 0; pass < 4; ++pass) { const int shift = 24 - 8 * pass;
            if (tid < 256) hist[tid] = 0u;
            __syncthreads();
            for (int i = tid; i < n; i += 512) { const unsigned k = key[i]; if ((k & mask) == prefix) __hip_atomic_fetch_add(hist + ((k >> shift) & 255u), 1u, __ATOMIC_RELAXED, __HIP_MEMORY_SCOPE_WORKGROUP); }
            __syncthreads();
            unsigned sfx = 0u;
            if (tid < 256) { sfx = hist[tid];
#pragma unroll
                for (int o = 1; o < 64; o <<= 1) { const unsigned t = __shfl_down(sfx, o); if (lane + o < 64) sfx += t; }
                if (lane == 0) wsum[F.wid] = sfx; }
            __syncthreads();
            if (tid < 256) { unsigned above = 0u;
#pragma unroll
                for (int w = 1; w < 4; ++w) above += (w > F.wid) ? wsum[w] : 0u;
                const unsigned ge = sfx + above; unsigned gt = __shfl_down(sfx, 1); gt = (lane == 63) ? above : gt + above;
                if (ge >= krem && gt < krem) { bc[0] = (unsigned)tid; bc[1] = krem - gt; } }
            __syncthreads();
            prefix |= bc[0] << shift; mask |= 255u << shift; krem = bc[1];
        }
        const int per = lat ? 8 : 1; const bool own = tid * per < n; const int i0 = tid * per;
        unsigned eqc = 0u;
        if (own) for (int j = 0; j < per; ++j) eqc += (key[i0 + j] == prefix) ? 1u : 0u;
        unsigned eqb = block_excl_scan(eqc, wsum, lane, F.wid);
        unsigned selm = 0u, selc = 0u;
        if (own) for (int j = 0; j < per; ++j) { const unsigned k = key[i0 + j]; bool sl = k > prefix; if (k == prefix) { sl = eqb < krem; ++eqb; } if (sl) { selm |= 1u << j; ++selc; } }
        unsigned sb = block_excl_scan(selc, wsum, lane, F.wid);
        const int slot0 = e * estr + (lat ? b * 512 : 2048 + b * 32);
        const bool mine = lat ? ((tid >> 7) == q) : true;
        if (own) for (int j = 0; j < per; ++j) { const bool sl = (selm >> j) & 1u; if (sl) list[sb] = (unsigned)(i0 + j);
            if (mine) slotmap[(size_t)(row0 + i0 + j) * 16 + e] = sl ? slot0 + (int)sb : -1; if (sl) ++sb; }
        __syncthreads();
        const int r_lo = lat ? q * 128 : 0, r_hi = lat ? r_lo + 128 : 32;
        for (int r = r_lo + tid; r < r_hi; r += 512) { const unsigned t = list[r]; gval[slot0 + r] = __uint_as_float(key[t]); offt[slot0 + r] = (unsigned)(row0 + t) * (unsigned)DM; }
        if (layer == 0 && !lat && b == 0 && tid < 128) offt[e * estr + 2176 + tid] = 0u;
        __syncthreads();
    }
}

__device__ __forceinline__ void unpack8(const u32x4 v, float (&o)[8]) { o[0] = bf_lo(v.x); o[1] = bf_hi(v.x); o[2] = bf_lo(v.y); o[3] = bf_hi(v.y); o[4] = bf_lo(v.z); o[5] = bf_hi(v.z); o[6] = bf_lo(v.w); o[7] = bf_hi(v.w); }
__device__ __forceinline__ void load_cu(const bf16_t* prj, int row, int ch, float (&o)[8]) {
    const u32x4 cv = *(const u32x4*)(prj + (size_t)row * PRJ_LD + 2560 + ch), uv = *(const u32x4*)(prj + (size_t)row * PRJ_LD + 3584 + ch);
    o[0] = bf_lo(cv.x) * bf_lo(uv.x); o[1] = bf_hi(cv.x) * bf_hi(uv.x); o[2] = bf_lo(cv.y) * bf_lo(uv.y); o[3] = bf_hi(cv.y) * bf_hi(uv.y);
    o[4] = bf_lo(cv.z) * bf_lo(uv.z); o[5] = bf_hi(cv.z) * bf_hi(uv.z); o[6] = bf_lo(cv.w) * bf_lo(uv.w); o[7] = bf_hi(cv.w) * bf_hi(uv.w);
}
__device__ __forceinline__ void load_x8(const bf16_t* prj, int row, int ch, int seg_lo, int seg_hi, float (&o)[8]) {
    if (row < seg_lo || row >= seg_hi) {
#pragma unroll
        for (int j = 0; j < 8; ++j) o[j] = 0.f; }
    else { const u32x4 v = *(const u32x4*)(prj + (size_t)row * PRJ_LD + ch); o[0] = bf_lo(v.x); o[1] = bf_hi(v.x); o[2] = bf_lo(v.y); o[3] = bf_hi(v.y); o[4] = bf_lo(v.z); o[5] = bf_hi(v.z); o[6] = bf_lo(v.w); o[7] = bf_hi(v.w); }
}
__device__ __forceinline__ int rope_unit(int c, int k, int G) {
    constexpr int NROPE = MROWS / 16;
    if (G != 256) { const int u = c + k * G; return u < NROPE ? u : -1; }
    if (k < 3) return k * 256 + c;
    if (k == 3) return c >= 32 ? 768 + (c - 32) : -1;
    if (k == 4) return (c >= 32 && c < 128) ? 992 + (c - 32) : -1;
    return -1;
}
__device__ __forceinline__ void phase_rope_conv(const Ctx& F) {
    const Params& P = F.P; const int tid = F.wid * 64 + lane_fresh();
    bf16_t* prj = (bf16_t*)(F.ws + WS_PRJ); bf16_t* yin = (bf16_t*)(F.ws + WS_YIN);
    constexpr int NCONV = MROWS / 32, NROPE = MROWS / 16;
    {
        const int ch = (tid & 127) * 8;
        const float* cw = P.in[I_EVCW]; float w0[8], w1[8], w2[8], cb[8];
#pragma unroll
        for (int j = 0; j < 8; ++j) { w0[j] = cw[ch + j]; w1[j] = cw[1024 + ch + j]; w2[j] = cw[2048 + ch + j]; cb[j] = P.in[I_EVCB][ch + j]; }
        u32x4 ncin[10], nbin[8];
#define RC_LOAD(un) { const int r0_ = (un) * 32 + (tid >> 7) * 8; const int b_ = r0_ / TPB, p_ = r0_ - b_ * TPB; const int lo_ = b_ * TPB + (p_ < CTXL ? 0 : CTXL), hi_ = b_ * TPB + (p_ < CTXL ? CTXL : TPB); \
            _Pragma("unroll") for (int k = 0; k < 10; ++k) { const int row = r0_ - 1 + k; const int rc = row < lo_ ? lo_ : (row >= hi_ ? hi_ - 1 : row); \
                ncin[k] = *(const u32x4*)((const char*)prj + (unsigned)(rc * PRJ_LD + 2560 + ch) * 2u); if (row < lo_ || row >= hi_) ncin[k] = (u32x4){0u, 0u, 0u, 0u}; }         \
            _Pragma("unroll") for (int k = 0; k < 8; ++k) nbin[k] = *(const u32x4*)((const char*)prj + (unsigned)((r0_ + k) * PRJ_LD + 1536 + ch) * 2u); }
        int u = F.c; if (u < NCONV) RC_LOAD(u)
        for (; u < NCONV; u += F.G) {
            const int r0 = u * 32 + (tid >> 7) * 8;
            u32x4 cin[10], bin[8];
#pragma unroll
            for (int k = 0; k < 10; ++k) cin[k] = ncin[k];
#pragma unroll
            for (int k = 0; k < 8; ++k) bin[k] = nbin[k];
            if (u + F.G < NCONV) RC_LOAD(u + F.G)
            const unsigned so0 = (unsigned)(r0 * YLD + 1024 + ch) * 2u; __builtin_amdgcn_sched_barrier(0);
            float prev[8], cur[8], nxt[8];
            unpack8(cin[0], prev); unpack8(cin[1], cur);
#pragma unroll
            for (int rr = 0; rr < 8; ++rr) { float bb[8]; unpack8(cin[rr + 2], nxt); unpack8(bin[rr], bb);
                float o[8];
#pragma unroll
                for (int j = 0; j < 8; ++j) { o[j] = bb[j] * (w0[j] * prev[j] + w1[j] * cur[j] + w2[j] * nxt[j] + cb[j]); prev[j] = cur[j]; cur[j] = nxt[j]; }
                u32x4 w; w.x = cvt_pk_bf16(o[0], o[1]); w.y = cvt_pk_bf16(o[2], o[3]); w.z = cvt_pk_bf16(o[4], o[5]); w.w = cvt_pk_bf16(o[6], o[7]);
                *(u32x4*)((char*)yin + (so0 + (unsigned)(rr * YLD * 2))) = w; __builtin_amdgcn_sched_barrier(0); }
        }
#undef RC_LOAD
    }
    {
        const int i = tid & 31; const bool second = ((i >> 3) & 1) != 0;
        float gq[4], gk[4], fr[4];
#pragma unroll
        for (int j = 0; j < 4; ++j) { gq[j] = P.in[I_EVQN][4 * i + j]; gk[j] = P.in[I_EVKN][4 * i + j]; const int fi = 4 * (i & 7) + j; fr[j] = __powf(10000.0f, -(float)(2 * fi) * (1.0f / 64.0f)); }
        u32x2 nwv[10], nv0, nv1;
#define RR_LOAD(un) { const bf16_t* rp_ = prj + (size_t)((un) * 16 + (tid >> 5)) * PRJ_LD + 4 * i; \
            _Pragma("unroll") for (int hh = 0; hh < 10; ++hh) nwv[hh] = *(const u32x2*)(rp_ + hh * 128); nv0 = *(const u32x2*)(rp_ + 1280); nv1 = *(const u32x2*)(rp_ + 1408); }
        int k = 0, u = rope_unit(F.c, 0, F.G); if (u >= 0) RR_LOAD(u)
        for (; u >= 0; ++k) {
            const int un = rope_unit(F.c, k + 1, F.G);
            const int row = u * 16 + (tid >> 5);
            const int b = row / TPB, p = row - b * TPB; const bool lat = p >= CTXL; const int t = p - CTXL;
            u32x2 wv[10];
#pragma unroll
            for (int hh = 0; hh < 10; ++hh) wv[hh] = nwv[hh];
            const u32x2 vv0 = nv0, vv1 = nv1;
            if (un >= 0) RR_LOAD(un)
            float cs[4], sn[4];
            { const int blk = i >> 4; const float pos = lat ? (float)(blk == 0 ? (t >> 6) : (t & 63)) : 0.f;
#pragma unroll
              for (int j = 0; j < 4; ++j) { float s_, c_; sincosf(pos * fr[j], &s_, &c_); cs[j] = c_; sn[j] = s_; } }
            bf16_t* rowp = prj + (size_t)row * PRJ_LD + 4 * i;
#pragma unroll
            for (int hh = 0; hh < 10; ++hh) {
                const u32x2 w = wv[hh]; float x[4] = {bf_lo(w.x), bf_hi(w.x), bf_lo(w.y), bf_hi(w.y)};
                float ss = x[0] * x[0] + x[1] * x[1] + x[2] * x[2] + x[3] * x[3];
#pragma unroll
                for (int o = 16; o >= 1; o >>= 1) ss += __shfl_xor(ss, o);
                const float rinv = __builtin_amdgcn_rsqf(ss * (1.0f / 128.0f) + EPS);
                float y[4];
#pragma unroll
                for (int j = 0; j < 4; ++j) y[j] = x[j] * rinv * (hh < 8 ? gq[j] : gk[j]);
                float o4[4];
#pragma unroll
                for (int j = 0; j < 4; ++j) { const float pr = __shfl_xor(y[j], 8); o4[j] = second ? (pr * sn[j] + y[j] * cs[j]) : (y[j] * cs[j] - pr * sn[j]); }
                wv[hh].x = cvt_pk_bf16(o4[0], o4[1]); wv[hh].y = cvt_pk_bf16(o4[2], o4[3]);
            }
#pragma unroll
            for (int hh = 0; hh < 8; ++hh) *(u32x2*)(rowp + hh * 128) = wv[hh];
            bf16_t* kc = (bf16_t*)(F.ws + WS_KC) + ((size_t)(b * 2) * TPB + p) * 128 + 4 * i; bf16_t* vc = (bf16_t*)(F.ws + WS_VC) + ((size_t)(b * 2) * TPB + p) * 128 + 4 * i;
            *(u32x2*)kc = wv[8]; *(u32x2*)(kc + (size_t)TPB * 128) = wv[9]; *(u32x2*)vc = vv0; *(u32x2*)(vc + (size_t)TPB * 128) = vv1;
            u = un;
        }
#undef RR_LOAD
    }
}

__device__ __forceinline__ void phase_attn(const Ctx& F) {
    const bf16_t* prj = (const bf16_t*)(F.ws + WS_PRJ); bf16_t* yin = (bf16_t*)(F.ws + WS_YIN);
    const int combo = F.c & 7, b = combo >> 1, kvh = combo & 1;
    const bf16_t* Kh = (const bf16_t*)(F.ws + WS_KC) + (size_t)(b * 2 + kvh) * TPB * 128; const bf16_t* Vh = (const bf16_t*)(F.ws + WS_VC) + (size_t)(b * 2 + kvh) * TPB * 128;
#define ATT_UNIT(i) do { const int w = (F.c >> 3) + 32 * (i); const int hq = kvh * 4 + ((i) < 2 ? (w >> 4) : (F.c >> 3)), qb = w & 15; \
        const size_t qrow = (size_t)b * TPB + ((i) < 2 ? CTXL + qb * 256 : 0); \
        att::attn_dense_body(prj + qrow * PRJ_LD + hq * 128, Kh, Vh, yin + qrow * YLD + hq * 128, (i) < 2 ? TPB : CTXL, F.ldsg, F.wid); } while (0)
    ATT_UNIT(0);
    ATT_UNIT(1);
    if (F.c < 32) ATT_UNIT(2);
#undef ATT_UNIT
}

__device__ __forceinline__ void phase_lru_conv(const Ctx& F) {
    const Params& P = F.P; const int tid = F.wid * 64 + lane_fresh();
    const bf16_t* prj = (const bf16_t*)(F.ws + WS_PRJ); bf16_t* U = (bf16_t*)(F.ws + WS_U);
    constexpr int RG = 8, NRG = MROWS / RG;
    const int gt = F.c * 512 + tid, nth = (F.G * 512) / 320;
    if (gt < nth * 320) {
        const int ch = (gt % 320) * 8; int rg = gt / 320;
        const float* cw = P.in[I_ODCW]; float w0[8], w1[8], w2[8], w3[8], cb[8];
#pragma unroll
        for (int j = 0; j < 8; ++j) { w0[j] = cw[ch + j]; w1[j] = cw[LRUW + ch + j]; w2[j] = cw[2 * LRUW + ch + j]; w3[j] = cw[3 * LRUW + ch + j]; cb[j] = P.in[I_ODCB][ch + j]; }
        u32x4 nin[RG + 3];
#define LC_LOAD(g) { const int r0_ = (g) * RG; const int b_ = r0_ / TPB, p_ = r0_ - b_ * TPB; const int lo_ = b_ * TPB + (p_ < CTXL ? 0 : CTXL), hi_ = b_ * TPB + (p_ < CTXL ? CTXL : TPB); \
            _Pragma("unroll") for (int k = 0; k < RG + 3; ++k) { const int row = r0_ - 1 + k; const int rc = row < lo_ ? lo_ : (row >= hi_ ? hi_ - 1 : row); \
                nin[k] = *(const u32x4*)((const char*)prj + (unsigned)(rc * PRJ_LD + ch) * 2u); if (row < lo_ || row >= hi_) nin[k] = (u32x4){0u, 0u, 0u, 0u}; } }
        if (rg < NRG) LC_LOAD(rg)
        for (; rg < NRG; rg += nth) {
            u32x4 xin[RG + 3];
#pragma unroll
            for (int k = 0; k < RG + 3; ++k) xin[k] = nin[k];
            if (rg + nth < NRG) LC_LOAD(rg + nth)
            const unsigned so0 = (unsigned)(rg * RG * LRUW + ch) * 2u; __builtin_amdgcn_sched_barrier(0);
#pragma unroll
            for (int rr = 0; rr < RG; ++rr) { float xm[8], x0[8], x1[8], x2[8]; unpack8(xin[rr], xm); unpack8(xin[rr + 1], x0); unpack8(xin[rr + 2], x1); unpack8(xin[rr + 3], x2);
                float o[8];
#pragma unroll
                for (int j = 0; j < 8; ++j) o[j] = w0[j] * xm[j] + w1[j] * x0[j] + w2[j] * x1[j] + w3[j] * x2[j] + cb[j];
                u32x4 w; w.x = cvt_pk_bf16(o[0], o[1]); w.y = cvt_pk_bf16(o[2], o[3]); w.z = cvt_pk_bf16(o[4], o[5]); w.w = cvt_pk_bf16(o[6], o[7]);
                *(u32x4*)((char*)U + (so0 + (unsigned)(rr * LRUW * 2))) = w; __builtin_amdgcn_sched_barrier(0); }
        }
#undef LC_LOAD
    }
}

__device__ __forceinline__ int scan_chunk_at(int d, int k) { return d == 0 ? k : (k < 4 ? 3 - k : 71 - k); }
__device__ __forceinline__ int scan_order_of(int d, int c) { return d == 0 ? c : (c < 4 ? 3 - c : 71 - c); }
__device__ __forceinline__ void scan_dec(unsigned w, float sp0, float sp1, float& a0, float& b0, float& a1, float& b1) {
    const float q0 = (float)(w & 0xffu) * (1.0f / 255.0f), q1 = (float)((w >> 16) & 0xffu) * (1.0f / 255.0f);
    a0 = __expf(q0 * q0 * sp0); a1 = __expf(q1 * q1 * sp1); b0 = __builtin_amdgcn_cvt_f32_fp8((int)w, 1); b1 = __builtin_amdgcn_cvt_f32_fp8((int)w, 3);
}
__device__ __forceinline__ float lru_sp(const float* lam, int d, int ch) { const float lm = lam[d * LRUW + ch]; return -8.0f * (fmaxf(-lm, 0.f) + __logf(1.0f + __expf(-fabsf(lm)))); }
__device__ __forceinline__ void phase_scan1(const Ctx& F) {
    const unsigned short* lav = (const unsigned short*)(F.ws + WS_LAGI); float* agg = (float*)(F.ws + WS_AGG); const int lane = lane_fresh(); const float* lam = F.P.in[I_ODLAM];
    float* carry = (float*)(F.ws + WS_CARRY); unsigned* scnt = (unsigned*)(F.ws + WS_SCNT);
    constexpr int NU = 2 * NB * 68 * 10;
    const int half = lane >> 5, sub = lane & 31;
    for (int u = F.c * 8 + F.wid; u < NU; u += F.G * 8) {
        const int cg = u % 10, c = (u / 10) % 68, b = (u / (10 * 68)) % NB, d = u / (10 * 68 * NB);
        const int ch = cg * 256 + sub * 8;
        const int r0 = d == 0 ? half * 32 : 63 - half * 32; const int rstep = d == 0 ? LRUW * 2 : -LRUW * 2;
        unsigned off = (unsigned)((((size_t)d * MROWS + (size_t)b * TPB + c * 64 + r0) * LRUW + ch) * 2);
        float hh[8], ss[8], sp[8];
#pragma unroll
        for (int j = 0; j < 8; ++j) { hh[j] = 0.f; ss[j] = 0.f; sp[j] = lru_sp(lam, d, ch + j); asm volatile("" : "+v"(sp[j])); }
#pragma unroll
        for (int blk = 0; blk < 2; ++blk) { u32x4 w[16];
#pragma unroll
            for (int kk = 0; kk < 16; ++kk) { w[kk] = *(const u32x4*)((const char*)lav + off); off += (unsigned)rstep; }
#pragma unroll
            for (int kk = 0; kk < 16; ++kk) {
#pragma unroll
                for (int p = 0; p < 4; ++p) { const unsigned x = p == 0 ? w[kk].x : (p == 1 ? w[kk].y : (p == 2 ? w[kk].z : w[kk].w));
                    const float q0 = (float)(x & 0xffu) * (1.0f / 255.0f), q1 = (float)((x >> 16) & 0xffu) * (1.0f / 255.0f); const float la0 = q0 * q0 * sp[2 * p], la1 = q1 * q1 * sp[2 * p + 1];
                    hh[2 * p] = __expf(la0) * hh[2 * p] + __builtin_amdgcn_cvt_f32_fp8((int)x, 1); hh[2 * p + 1] = __expf(la1) * hh[2 * p + 1] + __builtin_amdgcn_cvt_f32_fp8((int)x, 3); ss[2 * p] += la0; ss[2 * p + 1] += la1;
                    asm volatile("" : "+v"(hh[2 * p]), "+v"(hh[2 * p + 1]), "+v"(ss[2 * p]), "+v"(ss[2 * p + 1])); }
                __builtin_amdgcn_sched_barrier(0); }
        }
        float so[8], ho[8];
#pragma unroll
        for (int j = 0; j < 8; ++j) { so[j] = __shfl_xor(ss[j], 32); ho[j] = __shfl_xor(hh[j], 32); }
        if (half == 1) { float* ap = agg + ((((size_t)d * NB + b) * 68 + c) * LRUW + ch) * 2;
#pragma unroll
            for (int p = 0; p < 4; ++p) { const float h0 = __expf(ss[2 * p]) * ho[2 * p] + hh[2 * p], h1 = __expf(ss[2 * p + 1]) * ho[2 * p + 1] + hh[2 * p + 1];
                st_wt16(ap + 4 * p, (f32x4){ss[2 * p] + so[2 * p], h0, ss[2 * p + 1] + so[2 * p + 1], h1}); } }
        asm volatile("s_waitcnt vmcnt(0)" ::: "memory");
        unsigned old_ = 0u;
        if (lane == 0) old_ = __hip_atomic_fetch_add(scnt + (((d * NB + b) * 10 + cg) * 16), 1u, __ATOMIC_RELAXED, __HIP_MEMORY_SCOPE_AGENT);
        old_ = (unsigned)__builtin_amdgcn_readfirstlane((int)old_);
        if (old_ == 67u) {
            __builtin_amdgcn_fence(__ATOMIC_ACQUIRE, "agent");
            const int pch = cg * 256 + lane * 4; float st[4] = {0.f, 0.f, 0.f, 0.f};
            const float* ab = agg + (((size_t)d * NB + b) * 68 * LRUW + pch) * 2; float* cb = carry + ((size_t)d * NB + b) * 68 * LRUW + pch;
#pragma unroll 1
            for (int k0 = 0; k0 < 68; k0 += 17) { f32x4 a0[17], a1[17];
#pragma unroll
                for (int j = 0; j < 17; ++j) { const int cc = scan_chunk_at(d, k0 + j); a0[j] = *(const f32x4*)(ab + (size_t)cc * LRUW * 2); a1[j] = *(const f32x4*)(ab + (size_t)cc * LRUW * 2 + 4); }
#pragma unroll
                for (int j = 0; j < 17; ++j) { const int cc = scan_chunk_at(d, k0 + j);
                    *(f32x4*)(cb + (size_t)cc * LRUW) = (f32x4){st[0], st[1], st[2], st[3]};
                    st[0] = __expf(a0[j][0]) * st[0] + a0[j][1]; st[1] = __expf(a0[j][2]) * st[1] + a0[j][3]; st[2] = __expf(a1[j][0]) * st[2] + a1[j][1]; st[3] = __expf(a1[j][2]) * st[3] + a1[j][3]; } }
        }
    }
}
__device__ __forceinline__ void scan_carry(const float* agg, int d, int b, int c, int ch, float& h0, float& h1) {
    h0 = 0.f; h1 = 0.f; const int ord = scan_order_of(d, c);
    for (int k0 = 0; k0 < ord; k0 += 16) { f32x4 a[16];
#pragma unroll
        for (int j = 0; j < 16; ++j) { const int cc = scan_chunk_at(d, (k0 + j < ord) ? k0 + j : 0); a[j] = *(const f32x4*)(agg + ((((size_t)d * NB + b) * 68 + cc) * LRUW + ch) * 2);
            if (k0 + j >= ord) a[j] = (f32x4){0.f, 0.f, 0.f, 0.f}; }
#pragma unroll
        for (int j = 0; j < 16; ++j) { h0 = __expf(a[j][0]) * h0 + a[j][1]; h1 = __expf(a[j][2]) * h1 + a[j][3]; } }
}
__device__ __forceinline__ void phase_scan2(const Ctx& F) {
    const unsigned short* lav = (const unsigned short*)(F.ws + WS_LAGI); const float* carry = (const float*)(F.ws + WS_CARRY); const float* lam = F.P.in[I_ODLAM];
    const bf16_t* prj = (const bf16_t*)(F.ws + WS_PRJ); bf16_t* yin = (bf16_t*)(F.ws + WS_YIN); const int lane = lane_fresh();
    constexpr int NU = NB * 64 * 20;
    for (int u = F.c * 8 + F.wid; u < NU; u += F.G * 8) {
        const int cg = u % 20, c = 4 + (u / 20) % 64, b = u / (20 * 64);
        const int ch = cg * 128 + lane * 2; const size_t row0 = (size_t)b * TPB + c * 64;
        unsigned yf[64]; float h0, h1;
        { const f32x2 cv = *(const f32x2*)(carry + (((size_t)0 * NB + b) * 68 + c) * LRUW + ch); h0 = cv.x; h1 = cv.y; }
        { const size_t base = row0 * LRUW + ch;
          const float sp0 = lru_sp(lam, 0, ch), sp1 = lru_sp(lam, 0, ch + 1);
#pragma unroll
          for (int blk = 0; blk < 4; ++blk) { unsigned w[16];
#pragma unroll
            for (int r = 0; r < 16; ++r) w[r] = *(const unsigned*)(lav + base + (size_t)(blk * 16 + r) * LRUW);
#pragma unroll
            for (int r = 0; r < 16; ++r) { float a0, b0, a1, b1; scan_dec(w[r], sp0, sp1, a0, b0, a1, b1); h0 = a0 * h0 + b0; h1 = a1 * h1 + b1; yf[blk * 16 + r] = cvt_pk_bf16(h0, h1); } } }
        { const f32x2 cv = *(const f32x2*)(carry + (((size_t)1 * NB + b) * 68 + c) * LRUW + ch); h0 = cv.x; h1 = cv.y; }
        { const size_t base = (size_t)MROWS * LRUW + row0 * LRUW + ch;
          const float sp0 = lru_sp(lam, 1, ch), sp1 = lru_sp(lam, 1, ch + 1);
#pragma unroll
          for (int blk = 3; blk >= 0; --blk) { unsigned w[16]; unsigned gw[16];
#pragma unroll
            for (int r = 0; r < 16; ++r) { w[r] = *(const unsigned*)(lav + base + (size_t)(blk * 16 + r) * LRUW); gw[r] = *(const unsigned*)(prj + (row0 + blk * 16 + r) * PRJ_LD + LRUW + ch); }
#pragma unroll
            for (int r = 15; r >= 0; --r) { float a0, b0, a1, b1; scan_dec(w[r], sp0, sp1, a0, b0, a1, b1); h0 = a0 * h0 + b0; h1 = a1 * h1 + b1;
                const unsigned f = yf[blk * 16 + r]; gw[r] = cvt_pk_bf16((h0 + bf_lo(f)) * bf_lo(gw[r]), (h1 + bf_hi(f)) * bf_hi(gw[r])); }
#pragma unroll
            for (int r = 0; r < 16; ++r) *(unsigned*)(yin + (row0 + blk * 16 + r) * YLD + ch) = gw[r]; } }
    }
}

constexpr int NPHASE = 22;
constexpr int LDS_BYTES = 147456;
constexpr int LDS_MISC = 135168;
__global__ void __launch_bounds__(512, 2) mk_fwd(Params prm) {
    extern __shared__ __attribute__((aligned(16))) unsigned char lds_raw[];
    Ctx F; F.P = prm; F.ws = prm.ws; F.wid = __builtin_amdgcn_readfirstlane((int)threadIdx.x >> 6); F.G = gridDim.x; F.c = blockIdx.x;
    F.lds = (LAS unsigned char*)lds_raw; F.ldsg = (char*)lds_raw;
    volatile LAS unsigned* misc = (volatile LAS unsigned*)(F.lds + LDS_MISC);
    if (threadIdx.x < 4) misc[threadIdx.x] = 0u;
    __syncthreads();
    XcdBarrier bar; bar.bar = (unsigned*)(F.ws + WS_CTL); bar.x = 0; bar.st = misc; bar.wid = F.wid;
    const int lo = prm.ph_lo, hi = prm.ph_hi;
    if (hi - lo > 1) bar = xcd_barrier_post((unsigned*)(F.ws + WS_CTL), misc, F.wid);
#ifndef PH_MASK
#define PH_MASK 0xffffffffu
#endif
#define IN(k) ((((unsigned)PH_MASK >> (k)) & 1u) && lo <= (k) && (k) < hi)
#define SEAM(k) do { if (IN((k) + 1)) xcd_barrier(bar); } while (0)
#ifndef REP_MASK
#define REP_MASK 0u
#endif
#define NREP(k) ((((unsigned)REP_MASK >> (k)) & 1u) ? 2 : 1)
#define PHASE(k, ...) if (IN(k)) { for (int rep_ = 0; rep_ < NREP(k); ++rep_) { __VA_ARGS__ if (rep_ + 1 < NREP(k)) xcd_barrier(bar); } SEAM(k); }
    const float* mod = (const float*)(F.ws + WS_MOD);
    PHASE(0, p0_prologue(F);)
    PHASE(1, phase_norm<0>(F);)
    PHASE(2, if (F.c < F.G - NCV2) { SchedDense S{(const char*)(F.ws + WS_ACT), (const char*)(F.ws + WS_WEVIN), NMT, EV_IN / 256, F.G - NCV2, F.c, DM, DM, 0};
        EpiEvIn E{(bf16_t*)(F.ws + WS_PRJ), PRJ_LD}; pg8::gemm_phase<false, false>(F.lds, F.wid, pg8::Shape{DM, DM}, S, E); } else conv_range(F, GT0, GT2, F.G - NCV2);)
    PHASE(3, phase_rope_conv(F);)
    PHASE(4, phase_attn(F);)
    PHASE(5, if (F.c < F.G - NCV5) { SchedDense S{(const char*)(F.ws + WS_YIN), (const char*)(F.ws + WS_WEVOUT), NMT, DM / 256, F.G - NCV5, F.c, YLD, DM, 0};
        EpiResid E{prm.in[I_X], prm.in[I_CTX], (bf16_t*)(F.ws + WS_H), mod, 1}; pg8::gemm_phase<false, false>(F.lds, F.wid, pg8::Shape{DM, YLD}, S, E); } else conv_range(F, GT2, GT5, F.G - NCV5);)
    PHASE(6, phase_router(F, 0);)
    PHASE(7, phase_topk(F, 0);)
    PHASE(8, SchedMoe S{(const char*)(F.ws + WS_ACT), (const char*)(F.ws + WS_WGU), 9, 16, 2304, 4096, F.G, F.c, (const unsigned*)(F.ws + WS_OFFT)};
        EpiSwiglu E{F.ws + WS_HID, 2304}; pg8::gemm_phase<true, true>(F.lds, F.wid, pg8::Shape{DM / 2, DM / 2}, S, E);)
    PHASE(9, if (F.c < F.G - NCV9) { SchedMoe S{(const char*)(F.ws + WS_HID), (const char*)(F.ws + WS_WDN), 9, 8, 2304, 2048, F.G - NCV9, F.c, nullptr};
        EpiDown E{F.ws + WS_EO, (const float*)(F.ws + WS_GVAL), 2304}; pg8::gemm_phase<true, false>(F.lds, F.wid, pg8::Shape{DM / 2, DM / 2}, S, E); } else conv_range(F, GT5, GT9, F.G - NCV9);)
    PHASE(10, phase_norm<1>(F);)
    PHASE(11, if (F.c < F.G - NCV11) { SchedOdIn S{(const char*)(F.ws + WS_ACT), (const char*)(F.ws + WS_WODIN), F.G - NCV11, F.c};
        EpiPlainBf16 E{(bf16_t*)(F.ws + WS_PRJ), PRJ_LD, 10}; pg8::gemm_phase<false, false>(F.lds, F.wid, pg8::Shape{DM, DM}, S, E); } else conv_range(F, GT9, GT11, F.G - NCV11);)
    PHASE(12, phase_lru_conv(F);)
    PHASE(13, if (F.c < F.G - NCV13) { SchedLru S{(const char*)(F.ws + WS_U), (const char*)(F.ws + WS_WLRU), F.G - NCV13, F.c};
        EpiLru E{(const bf16_t*)(F.ws + WS_U), (unsigned*)(F.ws + WS_LAGI), prm.in[I_ODBA], prm.in[I_ODBX], prm.in[I_ODLAM]}; pg8::gemm_phase<false, false>(F.lds, F.wid, pg8::Shape{256, LRUW}, S, E); } else conv_range(F, GT11, GT13, F.G - NCV13);)
    PHASE(14, phase_scan1(F);)
    PHASE(15, phase_scan2(F);)
    PHASE(16, SchedDense S{(const char*)(F.ws + WS_YIN), (const char*)(F.ws + WS_WODOUT), 64, DM / 256, F.G, F.c, YLD, LRUW, 1};
        EpiResid E{prm.in[I_X], prm.in[I_CTX], (bf16_t*)(F.ws + WS_H), mod + 5 * MODN, 0}; pg8::gemm_phase<false, false>(F.lds, F.wid, pg8::Shape{LRUW, YLD}, S, E);)
    PHASE(17, phase_router(F, 1);)
    PHASE(18, phase_topk(F, 1);)
    PHASE(19, SchedMoe S{(const char*)(F.ws + WS_ACT), (const char*)(F.ws + WS_WGU) + (size_t)NEXP * 4096 * DM, 8, 16, 2048, 4096, F.G, F.c, (const unsigned*)(F.ws + WS_OFFT)};
        EpiSwiglu E{F.ws + WS_HID, 2048}; pg8::gemm_phase<true, true>(F.lds, F.wid, pg8::Shape{DM / 2, DM / 2}, S, E);)
    PHASE(20, SchedMoe S{(const char*)(F.ws + WS_HID), (const char*)(F.ws + WS_WDN) + (size_t)NEXP * DM * DM, 8, 8, 2048, 2048, F.G, F.c, nullptr};
        EpiDown E{F.ws + WS_EO, (const float*)(F.ws + WS_GVAL), 2048}; pg8::gemm_phase<true, false>(F.lds, F.wid, pg8::Shape{DM / 2, DM / 2}, S, E);)
    PHASE(21, phase_norm<2>(F);)
#undef IN
#undef SEAM
}

extern "C" void kernel_launch(void* const* d_in, const int* in_sizes, int n_in, void* d_out, int out_size, void* d_ws, size_t ws_size, hipStream_t stream) {
    static int grid = 0;
    if (grid == 0) {
        if (n_in != 28 || out_size != NB * SEQ * DM || ws_size < WS_END) { fprintf(stderr, "kernel_launch: bad shapes: n_in %d out %d ws %zu (need %zu)\n", n_in, out_size, ws_size, (size_t)WS_END); grid = -1; return; }
        int dev = 0, cus = 0, per_cu = 0;
        if (hipGetDevice(&dev) != hipSuccess || hipDeviceGetAttribute(&cus, hipDeviceAttributeMultiprocessorCount, dev) != hipSuccess) { grid = -1; return; }
        if (hipFuncSetAttribute((const void*)mk_fwd, hipFuncAttributeMaxDynamicSharedMemorySize, LDS_BYTES) != hipSuccess) { fprintf(stderr, "kernel_launch: hipFuncSetAttribute failed\n"); grid = -1; return; }
        if (hipOccupancyMaxActiveBlocksPerMultiprocessor(&per_cu, (const void*)mk_fwd, 512, LDS_BYTES) != hipSuccess || per_cu < 1) fprintf(stderr, "kernel_launch: occupancy query says %d\n", per_cu);
        (void)hipGetLastError();
        grid = cus;
    }
    if (grid < 0) return;
    (void)in_sizes;
    (void)hipMemsetAsync((char*)d_ws + WS_CTL, 0, 65536, stream);
    Params p{};
    for (int i = 0; i < 28; ++i) p.in[i] = (const float*)d_in[i];
    p.out = (float*)d_out; p.ws = (unsigned char*)d_ws;
#if MK_PER_PHASE
    for (int ph = 0; ph < NPHASE; ++ph) { p.ph_lo = ph; p.ph_hi = ph + 1; hipLaunchKernelGGL(mk_fwd, dim3(grid), dim3(512), LDS_BYTES, stream, p); }
#else
    p.ph_lo = 0; p.ph_hi = NPHASE; hipLaunchKernelGGL(mk_fwd, dim3(grid), dim3(512), LDS_BYTES, stream, p);
#endif
    const hipError_t le = hipPeekAtLastError();
    if (le != hipSuccess) fprintf(stderr, "kernel_launch: launch failed: %s\n", hipGetErrorName(le));
}
```

```cpp
#include <hip/hip_runtime.h>
#include <cstdio>
#include <cstdint>

#ifndef MK_PER_PHASE
#define MK_PER_PHASE 0
#endif

#define LAS __attribute__((address_space(3)))
typedef unsigned short bf16_t;
typedef short bf16x8 __attribute__((ext_vector_type(8)));
typedef short s16x4 __attribute__((ext_vector_type(4)));
typedef float f32x4 __attribute__((ext_vector_type(4)));
typedef float f32x2 __attribute__((ext_vector_type(2)));
typedef float f32x16 __attribute__((ext_vector_type(16)));
typedef unsigned u32x4 __attribute__((ext_vector_type(4)));
typedef unsigned u32x2 __attribute__((ext_vector_type(2)));
typedef int i32x8 __attribute__((ext_vector_type(8)));
typedef int i32x8a __attribute__((ext_vector_type(8), aligned(16)));
typedef int i32x4a __attribute__((ext_vector_type(4), aligned(16)));

#define XB_TMO      128
#define XB_XCNT(j)  (256  + 64 * (j))
#define XB_XSUB(j)  (1280 + 64 * (j))
#define XB_XGEN(j)  (2304 + 64 * (j))
#define XB_TOP      3328
#define XB_TOPGEN   3392
#define XCD_BAR_WORDS 3456
#define XB_SPIN_CAP (1u << 18)

__device__ __forceinline__ unsigned xb_ld(unsigned* p)              { return __hip_atomic_load(p, __ATOMIC_RELAXED, __HIP_MEMORY_SCOPE_AGENT); }
__device__ __forceinline__ unsigned xb_add(unsigned* p, unsigned v) { return __hip_atomic_fetch_add(p, v, __ATOMIC_RELAXED, __HIP_MEMORY_SCOPE_AGENT); }
__device__ __forceinline__ unsigned xb_xcc_id() { return (unsigned)__builtin_amdgcn_s_getreg((3 << 11) | 20) & 0xFu; }
#define XB_SPIN(cond, bar) do { unsigned _sp = 0; while (cond) { __builtin_amdgcn_s_sleep(1); \
    if ((++_sp & 255u) == 0u) { if (xb_ld(&(bar)[XB_TMO])) break; if (_sp > XB_SPIN_CAP) { atomicAdd(&(bar)[XB_TMO], 1u); break; } } } } while (0)

struct XcdBarrier { unsigned* bar; unsigned x; volatile LAS unsigned* st; int wid; };

__device__ __forceinline__ int xb_lane() { int l; asm volatile("v_mbcnt_lo_u32_b32 %0, -1, 0\n\tv_mbcnt_hi_u32_b32 %0, -1, %0" : "=v"(l)); return l; }
__device__ __forceinline__ XcdBarrier xcd_barrier_post(unsigned* bar, volatile LAS unsigned* st, int wid) {
    XcdBarrier b; b.bar = bar; b.x = xb_xcc_id(); b.st = st; b.wid = wid;
    if (wid == 0 && xb_lane() == 0) (void)xb_add(&bar[XB_XCNT(b.x)], 1u);
    return b;
}
__device__ __forceinline__ void xcd_barrier_complete(unsigned* bar, unsigned x, unsigned& nloc, unsigned& nx) {
    const unsigned G = gridDim.x * gridDim.y * gridDim.z;
    unsigned sum, cnt, mine, sp = 0u;
    for (;;) {
        sum = 0u; cnt = 0u; mine = 0u;
#pragma unroll
        for (unsigned j = 0; j < 16; ++j) { const unsigned c = xb_ld(&bar[XB_XCNT(j)]); sum += c; cnt += (c > 0u) ? 1u : 0u; mine = (j == x) ? c : mine; }
        if (sum == G) break;
        __builtin_amdgcn_s_sleep(1);
        if ((++sp & 255u) == 0u) { if (xb_ld(&bar[XB_TMO])) break; if (sp > XB_SPIN_CAP) { atomicAdd(&bar[XB_TMO], 1u); break; } }
    }
    nloc = mine > 0u ? mine : 1u; nx = cnt > 0u ? cnt : 1u;
}
__device__ __forceinline__ void xcd_barrier(const XcdBarrier& b) {
    asm volatile("s_waitcnt vmcnt(0)" ::: "memory");
    __syncthreads();
    if (b.wid == 0 && xb_lane() == 0) {
        unsigned* bar = b.bar;
        __builtin_amdgcn_s_waitcnt(0);
        unsigned nloc = b.st[0], nx = b.st[1];
        if (nloc == 0u) { xcd_barrier_complete(bar, b.x, nloc, nx); b.st[0] = nloc; b.st[1] = nx; }
        const unsigned old = xb_add(&bar[XB_XSUB(b.x)], 1u);
        const unsigned gen = old / nloc;
        if (old + 1u == (gen + 1u) * nloc) {
            __builtin_amdgcn_fence(__ATOMIC_RELEASE, "agent");
            asm volatile("s_waitcnt vmcnt(0)" ::: "memory");
            const unsigned og = xb_add(&bar[XB_TOP], 1u);
            const unsigned tg = og / nx;
            if (og + 1u == (tg + 1u) * nx) xb_add(&bar[XB_TOPGEN], 1u);
            else XB_SPIN(xb_ld(&bar[XB_TOPGEN]) == tg, bar);
            __builtin_amdgcn_fence(__ATOMIC_ACQUIRE, "agent");
            xb_add(&bar[XB_XGEN(b.x)], 1u);
            asm volatile("s_waitcnt vmcnt(0)" ::: "memory");
        } else {
            XB_SPIN(xb_ld(&bar[XB_XGEN(b.x)]) == gen, bar);
            __builtin_amdgcn_fence(__ATOMIC_ACQUIRE, "agent");
            asm volatile("s_waitcnt vmcnt(0)" ::: "memory");
        }
    }
    __syncthreads();
}

constexpr int DM = 2048, NB = 4, SEQ = 4096, CTXL = 256, TPB = SEQ + CTXL  , MROWS = NB * TPB  ;
constexpr int NMT = MROWS / 256;
constexpr int EV_IN = 4608, OD_IN = 5120, LRUW = 2560, PRJ_LD = 5120, YLD = 2560, MODN = 12288;
constexpr int NEXP = 16, FF = 2048;
constexpr float EPS = 1e-6f;
constexpr float W8_SCALE = 32.0f, W8_INV = 1.0f / 32.0f;

constexpr size_t al256(size_t x) { return (x + 255) / 256 * 256; }
constexpr size_t WS_CTL   = 0;
constexpr size_t WS_MOD   = 65536;
constexpr size_t WS_WEVIN = WS_MOD   + al256((size_t)2 * 5 * MODN * 4);
constexpr size_t WS_WEVOUT= WS_WEVIN + (size_t)EV_IN * DM * 2;
constexpr size_t WS_WODIN = WS_WEVOUT+ (size_t)DM * DM * 2;
constexpr size_t WS_WLRU  = WS_WODIN + (size_t)OD_IN * DM * 2;
constexpr size_t WS_WODOUT= WS_WLRU  + (size_t)2 * 10 * 512 * 256 * 2;
constexpr size_t WS_WGU   = WS_WODOUT+ (size_t)DM * LRUW * 2;
constexpr size_t WS_WDN   = WS_WGU   + (size_t)2 * NEXP * 4096 * DM;
constexpr size_t WS_H     = WS_WDN   + (size_t)2 * NEXP * DM * DM;
constexpr size_t WS_ACT   = WS_H     + (size_t)MROWS * DM * 4;
constexpr size_t WS_PRJ   = WS_ACT   + (size_t)MROWS * DM * 2;
constexpr size_t WS_U     = WS_PRJ   + (size_t)MROWS * PRJ_LD * 2;
constexpr size_t WS_YIN   = WS_U     + (size_t)MROWS * LRUW * 2;
constexpr size_t WS_AFF   = WS_YIN   + (size_t)MROWS * YLD * 2;
constexpr size_t WS_SLOT  = WS_AFF   + (size_t)MROWS * 16 * 4;
constexpr size_t WS_GVAL  = WS_SLOT  + (size_t)MROWS * 16 * 4;
constexpr size_t WS_OFFT  = WS_GVAL  + al256((size_t)NEXP * 2304 * 4);
constexpr size_t WS_AGG   = WS_OFFT  + al256((size_t)NEXP * 2304 * 4);
constexpr size_t WS_XS    = WS_AGG   + (size_t)2 * NB * 68 * LRUW * 8;
constexpr size_t WS_HID   = WS_XS    + (size_t)NEXP * 2304 * DM * 2;
constexpr size_t WS_EO    = WS_HID   + (size_t)NEXP * 2304 * DM * 2;
constexpr size_t WS_KC    = WS_EO    + (size_t)NEXP * 2304 * DM * 2;
constexpr size_t WS_VC    = WS_KC    + (size_t)NB * 2 * TPB * 128 * 2;
constexpr size_t WS_CARRY = WS_VC    + (size_t)NB * 2 * TPB * 128 * 2;
constexpr size_t WS_END   = WS_CARRY + (size_t)2 * NB * 68 * LRUW * 4;
constexpr size_t WS_SCNT  = WS_CTL + 16384;
constexpr size_t WS_LAGI  = WS_XS;
static_assert((size_t)2 * MROWS * LRUW * 4 <= WS_KC - WS_XS, "LAGI alias");

struct Params { const float* in[28]; float* out; unsigned char* ws; int ph_lo, ph_hi; };
enum { I_X = 0, I_C, I_CTX, I_CCTX, I_MODW, I_MODB, I_N1G, I_N2G, I_EVWIN, I_EVQN, I_EVKN, I_EVCW, I_EVCB, I_EVWOUT, I_ODWIN, I_ODCW, I_ODCB, I_ODWA, I_ODBA, I_ODWX, I_ODBX,
       I_ODLAM, I_ODWOUT, I_ROUTER, I_WGATE, I_WUP, I_WDOWN, I_FNG };

__device__ __forceinline__ unsigned cvt_pk_bf16(float lo, float hi) { unsigned r; asm volatile("v_cvt_pk_bf16_f32 %0, %1, %2" : "=v"(r) : "v"(lo), "v"(hi)); return r; }
__device__ __forceinline__ unsigned pk4_fp8(float a, float b, float c, float d) { int w = 0; w = __builtin_amdgcn_cvt_pk_fp8_f32(a, b, w, false); w = __builtin_amdgcn_cvt_pk_fp8_f32(c, d, w, true); return (unsigned)w; }
#define GAS __attribute__((address_space(1)))
__device__ __forceinline__ f32x4 ld_nt(const float* p) { return __builtin_nontemporal_load((const GAS f32x4*)(const GAS float*)p); }
__device__ __forceinline__ void st_nt(float* p, f32x4 v) { __builtin_nontemporal_store(v, (GAS f32x4*)(GAS float*)p); }
__device__ __forceinline__ void st_wt16(float* p, f32x4 v) { asm volatile("global_store_dwordx4 %0, %1, off sc1\n\ts_nop 1" :: "v"(p), "v"(v) : "memory"); }
__device__ __forceinline__ float bf_lo(unsigned w) { return __uint_as_float(w << 16); }
__device__ __forceinline__ float bf_hi(unsigned w) { return __uint_as_float(w & 0xffff0000u); }
__device__ __forceinline__ int lane_fresh() { int l; asm volatile("v_mbcnt_lo_u32_b32 %0, -1, 0\n\tv_mbcnt_hi_u32_b32 %0, -1, %0" : "=v"(l)); return l; }
__device__ __forceinline__ float wave_sum(float v) {
#pragma unroll
    for (int o = 32; o >= 1; o >>= 1) v += __shfl_xor(v, o);
    return v;
}
__device__ __forceinline__ float fast_sigmoid(float x) { return __builtin_amdgcn_rcpf(1.0f + __builtin_amdgcn_exp2f(-1.4426950408889634f * x)); }
__device__ __forceinline__ float gelu_tanh(float x) { const float t = 0.7978845608028654f * (x + 0.044715f * x * x * x); return x * fast_sigmoid(2.0f * t); }
__device__ __forceinline__ int xcd_remap(int L, int nwg) { const int q = nwg >> 3, r = nwg & 7, xcd = L & 7, off = L >> 3; return (xcd < r ? xcd * (q + 1) : r * (q + 1) + (xcd - r) * q) + off; }

namespace pg8 {
constexpr int BM = 256, BK = 64, HALF = 128, HTB = HALF * BK * 2, STAGE_BYTES = 8 * HTB;
__device__ __forceinline__ int lds_byte(int r, int c) { const int st = (r >> 4) * 2 + (c >> 5), rr = r & 15, cc = c & 31, ob = rr * 64 + cc * 2; return st * 1024 + (ob ^ (((ob >> 9) & 1) << 5)); }
__device__ __forceinline__ void stage_rc(int b, int& R, int& C) { const int st = b / 1024, sb = b % 1024, swz = sb ^ (((sb >> 9) & 1) << 5); R = (st >> 1) * 16 + swz / 64; C = (st & 1) * 32 + (swz % 64) / 2; }
__device__ __forceinline__ int perm32(int rho) { const int n = rho >> 4, i = rho & 15; return 8 * (i >> 2) + 4 * n + (i & 3); }
struct Unit { int pm, pn, e; };
__device__ __forceinline__ void glds16_s(const void* base_uniform, unsigned voff, unsigned lds_dst) {
    unsigned keep;
    asm volatile("s_mov_b32 %0, m0\n\ts_mov_b32 m0, %3\n\ts_nop 0\n\tglobal_load_lds_dwordx4 %1, %2\n\ts_mov_b32 m0, %0" : "=&s"(keep) : "v"(voff), "s"(base_uniform), "s"(lds_dst) : "memory");
}
struct Shape { int K, lda; };

template <bool FP8, bool GATHER, class Epi, class Sched>
__device__ __forceinline__ void gemm_phase(LAS unsigned char* lds, int wid_in, const Shape g, const Sched& S, const Epi& E) {
    const int lane = lane_fresh(), wid = wid_in, tid = wid * 64 + lane, wr = wid >> 2, wc = wid & 3, fr = lane & 15, fq = lane >> 4;
    const int K = g.K, nt = K / BK;
    unsigned voffA[2], voffB[2]; int gR[2]; unsigned gC[2];
#pragma unroll
    for (int i = 0; i < 2; ++i) { int R, C; stage_rc(tid * 16 + i * 8192, R, C); const int Rb = Epi::PERM ? ((R & ~31) + perm32(R & 31)) : R;
        voffA[i] = (unsigned)(R * g.lda + C) * 2u; voffB[i] = (unsigned)(Rb * K + C) * 2u; gR[i] = R; gC[i] = (unsigned)C * 2u; }
    unsigned coff[2][2], noff[2][2], nnoff[2][2];
#define PG8_LOADOFF(dst, un) do { const unsigned* tb_ = S.offtab() + S.slotbase(un); _Pragma("unroll") for (int h_ = 0; h_ < 2; ++h_) _Pragma("unroll") for (int i_ = 0; i_ < 2; ++i_) dst[h_][i_] = tb_[h_ * 128 + gR[i_]] + gC[i_]; } while (0)
#define PG8_STAGE_A(bufoff, kb, h, nx) do { if constexpr (GATHER) { _Pragma("unroll") for (int _i = 0; _i < 2; ++_i) glds16_s(S.gbase() + (kb), (nx) ? noff[h][_i] : coff[h][_i], ldsb + (unsigned)((bufoff) + _i * 8192)); } \
        else { PG8_STAGE(bufoff, ((nx) ? nA : cA) + (kb) + (h) * hstepA, voffA); } } while (0)
    const size_t kstep = (size_t)(BK * 2);
    const size_t hstepA = (size_t)HALF * g.lda * 2, hstepB = (size_t)HALF * K * 2;
    const unsigned ldsb = (unsigned)(uintptr_t)lds + (unsigned)wid * 1024u;
    const int aoff = lds_byte(wr * 64 + fr, fq * 8), boff = lds_byte(wc * 32 + fr, fq * 8);
#define PG8_SA(b, h) (((b) * 2 + (h)) * HTB)
#define PG8_SB(b, h) ((4 + (b) * 2 + (h)) * HTB)
#define PG8_STAGE(bufoff, gbase, voff) do { _Pragma("unroll") for (int _i = 0; _i < 2; ++_i) glds16_s((gbase), (voff)[_i], ldsb + (unsigned)((bufoff) + _i * 8192)); } while (0)
#define PG8_LD32(p) __builtin_shufflevector(*(const LAS i32x4a*)(p), *(const LAS i32x4a*)((p) + 1024), 0, 1, 2, 3, 4, 5, 6, 7)
#define PG8_LDA(dst, b, h) do { if constexpr (FP8) { _Pragma("unroll") for (int m = 0; m < 4; ++m) dst##8[m] = PG8_LD32(lds + PG8_SA(b, h) + aoff + m * 2048); } \
        else { _Pragma("unroll") for (int m = 0; m < 4; ++m) _Pragma("unroll") for (int k = 0; k < 2; ++k) dst[m][k] = *(const LAS bf16x8*)(lds + PG8_SA(b, h) + aoff + m * 2048 + k * 1024); } } while (0)
#define PG8_LDB(dst, b, h) do { if constexpr (FP8) { _Pragma("unroll") for (int n = 0; n < 2; ++n) dst##8[n] = PG8_LD32(lds + PG8_SB(b, h) + boff + n * 2048); } \
        else { _Pragma("unroll") for (int n = 0; n < 2; ++n) _Pragma("unroll") for (int k = 0; k < 2; ++k) dst[n][k] = *(const LAS bf16x8*)(lds + PG8_SB(b, h) + boff + n * 2048 + k * 1024); } } while (0)
#define PG8_MMA(ai, bj, At, Bt) do { __builtin_amdgcn_s_setprio(1); _Pragma("unroll") for (int m = 0; m < 4; ++m) _Pragma("unroll") for (int n = 0; n < 2; ++n) { \
        f32x16& av_ = accv[ai][bj][m >> 1]; constexpr int dummy_ = 0; (void)dummy_; const int g_ = ((m & 1) * 2 + n) * 4; f32x4 c_ = (f32x4){av_[g_], av_[g_ + 1], av_[g_ + 2], av_[g_ + 3]}; \
        if constexpr (FP8) c_ = __builtin_amdgcn_mfma_scale_f32_16x16x128_f8f6f4(Bt##8[n], At##8[m], c_, 0, 0, 0, 127, 0, 127); \
        else { _Pragma("unroll") for (int k = 0; k < 2; ++k) c_ = __builtin_amdgcn_mfma_f32_16x16x32_bf16(Bt[n][k], At[m][k], c_, 0, 0, 0); } \
        av_[g_] = c_[0]; av_[g_ + 1] = c_[1]; av_[g_ + 2] = c_[2]; av_[g_ + 3] = c_[3]; } __builtin_amdgcn_s_setprio(0); } while (0)
#define PG8_WAIT_V(n) asm volatile("s_waitcnt vmcnt(" #n ")" ::: "memory")
#define PG8_WAIT_L(n) asm volatile("s_waitcnt lgkmcnt(" #n ")" ::: "memory")
#define PG8_BAR __builtin_amdgcn_s_barrier()
#define PG8_SCHED __builtin_amdgcn_sched_barrier(0)
    Unit cur, nxt; int ui = 0;
    if (!S.next(0, cur)) return;
    f32x16 accv[2][2][2];
#pragma unroll
    for (int a = 0; a < 2; ++a)
#pragma unroll
        for (int b = 0; b < 2; ++b)
#pragma unroll
            for (int m = 0; m < 2; ++m)
#pragma unroll
                for (int j = 0; j < 16; ++j) accv[a][b][m][j] = 0.f;
    bf16x8 At[4][2], B0[2][2], B1[2][2]; i32x8 At8[4], B08[2], B18[2];
    const char* cA = S.abase(cur); const char* cB = S.bbase(cur); const char* nA = cA;
    if constexpr (GATHER) { PG8_LOADOFF(coff, cur); Unit n1; if (S.next(1, n1)) PG8_LOADOFF(noff, n1); else PG8_LOADOFF(noff, cur); }
    PG8_STAGE(PG8_SB(0, 0), cB, voffB); PG8_STAGE_A(PG8_SA(0, 0), 0, 0, false); PG8_STAGE(PG8_SB(0, 1), cB + hstepB, voffB); PG8_STAGE_A(PG8_SA(0, 1), 0, 1, false);
    if (wr == 1) PG8_BAR;
    PG8_WAIT_V(4); PG8_BAR;
    PG8_STAGE(PG8_SB(1, 0), cB + kstep, voffB); PG8_STAGE_A(PG8_SA(1, 0), kstep, 0, false); PG8_STAGE(PG8_SB(1, 1), cB + hstepB + kstep, voffB);
    PG8_WAIT_V(6); PG8_BAR;
    for (;;) {
        const bool has_next = S.next(ui + 1, nxt);
        nA = has_next ? S.abase(nxt) : cA; const char* nB = has_next ? S.bbase(nxt) : cB;
        bool has_nn = false;
        if constexpr (GATHER) { Unit nn; has_nn = S.next(ui + 2, nn);
            if (has_nn) { const unsigned* tb_ = S.offtab() + S.slotbase(nn); _Pragma("unroll") for (int h_ = 0; h_ < 2; ++h_) _Pragma("unroll") for (int i_ = 0; i_ < 2; ++i_) nnoff[h_][i_] = tb_[h_ * 128 + gR[i_]]; } }
        for (int t = 0; t < nt; t += 2) {
            const bool last = (t == nt - 2);
            const size_t k1 = (size_t)(t + 1) * kstep, k2 = last ? 0 : (size_t)(t + 2) * kstep, k3 = k2 + kstep;
            const char* b2 = last ? nB : cB + (size_t)(t + 2) * kstep; const char* b3 = b2 + kstep;
            PG8_LDB(B0, 0, 0); PG8_SCHED; PG8_LDA(At, 0, 0); PG8_STAGE_A(PG8_SA(1, 1), k1, 1, false);
            PG8_WAIT_L(8); PG8_BAR; PG8_WAIT_L(0); PG8_MMA(0, 0, At, B0); PG8_BAR; PG8_SCHED;
            PG8_LDB(B1, 0, 1); PG8_STAGE(PG8_SB(0, 0), b2, voffB);
            PG8_BAR; PG8_WAIT_L(0); PG8_MMA(0, 1, At, B1); PG8_BAR;
            PG8_LDA(At, 0, 1); PG8_STAGE_A(PG8_SA(0, 0), k2, 0, last);
            PG8_BAR; PG8_WAIT_L(0); PG8_MMA(1, 0, At, B0); PG8_BAR; PG8_SCHED;
            PG8_STAGE(PG8_SB(0, 1), b2 + hstepB, voffB);
            PG8_WAIT_V(6); PG8_BAR; PG8_MMA(1, 1, At, B1); PG8_BAR;
            PG8_LDB(B0, 1, 0); PG8_SCHED; PG8_LDA(At, 1, 0); PG8_STAGE_A(PG8_SA(0, 1), k2, 1, last);
            PG8_WAIT_L(8); PG8_BAR; PG8_WAIT_L(0); PG8_MMA(0, 0, At, B0); PG8_BAR; PG8_SCHED;
            PG8_LDB(B1, 1, 1); PG8_STAGE(PG8_SB(1, 0), b3, voffB);
            PG8_BAR; PG8_WAIT_L(0); PG8_MMA(0, 1, At, B1); PG8_BAR;
            PG8_LDA(At, 1, 1); PG8_STAGE_A(PG8_SA(1, 0), k3, 0, last);
            PG8_BAR; PG8_WAIT_L(0); PG8_MMA(1, 0, At, B0); PG8_BAR; PG8_SCHED;
            PG8_STAGE(PG8_SB(1, 1), b3 + hstepB, voffB);
            PG8_WAIT_V(6); PG8_BAR; PG8_MMA(1, 1, At, B1); PG8_BAR;
        }
        { f32x4 acc[2][2][4][2];
#pragma unroll
          for (int a = 0; a < 2; ++a)
#pragma unroll
            for (int b = 0; b < 2; ++b)
#pragma unroll
              for (int m = 0; m < 4; ++m)
#pragma unroll
                for (int n = 0; n < 2; ++n) { const int g_ = ((m & 1) * 2 + n) * 4; acc[a][b][m][n] = (f32x4){accv[a][b][m >> 1][g_], accv[a][b][m >> 1][g_ + 1], accv[a][b][m >> 1][g_ + 2], accv[a][b][m >> 1][g_ + 3]}; }
          const int le_ = lane_fresh(); E(acc, cur, wr, wc, le_ & 15, le_ >> 4); }
        if (!has_next) break;
#pragma unroll
        for (int a = 0; a < 2; ++a)
#pragma unroll
            for (int b = 0; b < 2; ++b)
#pragma unroll
                for (int m = 0; m < 2; ++m)
#pragma unroll
                    for (int j = 0; j < 16; ++j) accv[a][b][m][j] = 0.f;
        cur = nxt; cA = nA; cB = nB; ++ui;
        if constexpr (GATHER) {
#pragma unroll
            for (int h_ = 0; h_ < 2; ++h_)
#pragma unroll
                for (int i_ = 0; i_ < 2; ++i_) { coff[h_][i_] = noff[h_][i_]; if (has_nn) noff[h_][i_] = nnoff[h_][i_] + gC[i_]; } }
    }
    PG8_WAIT_V(0);
    if (wr == 0) PG8_BAR;
    PG8_BAR;
#undef PG8_SA
#undef PG8_SB
#undef PG8_STAGE
#undef PG8_STAGE_A
#undef PG8_LOADOFF
#undef PG8_LDA
#undef PG8_LD32
#undef PG8_LDB
#undef PG8_MMA
#undef PG8_WAIT_V
#undef PG8_WAIT_L
#undef PG8_BAR
#undef PG8_SCHED
}
}
using pg8::Unit;

struct SchedDense {
    __device__ __forceinline__ const unsigned* offtab() const { return nullptr; }
    __device__ __forceinline__ int slotbase(const Unit&) const { return 0; }
    __device__ __forceinline__ const char* gbase() const { return nullptr; }
    const char* A; const char* Bt; int nM, nN, G, c, lda, K, lat_only;
    __device__ __forceinline__ bool next(int i, Unit& u) const {
        const int nwg = nM * nN; const int L = i * G + c; if (L >= nwg) return false;
        const int w = xcd_remap(L, nwg);
        const int nig = 8 * nN, gid = w / nig, fm = gid * 8, gsz = (nM - fm) < 8 ? (nM - fm) : 8;
        const int lm = fm + ((w % nig) % gsz); u.pn = (w % nig) / gsz; u.pm = lat_only ? (lm + (lm >> 4) + 1) : lm; u.e = 0; return true;
    }
    __device__ __forceinline__ const char* abase(const Unit& u) const { return A + (size_t)u.pm * 256 * lda * 2; }
    __device__ __forceinline__ const char* bbase(const Unit& u) const { return Bt + (size_t)u.pn * 256 * K * 2; }
};
struct SchedOdIn {
    __device__ __forceinline__ const unsigned* offtab() const { return nullptr; }
    __device__ __forceinline__ int slotbase(const Unit&) const { return 0; }
    __device__ __forceinline__ const char* gbase() const { return nullptr; }
    const char* A; const char* Bt; int G, c;
    __device__ __forceinline__ bool next(int i, Unit& u) const {
        const int L = i * G + c; if (L >= 1320) return false;
        if (L < 1280) { const int w = xcd_remap(L, 1280); const int nig = 8 * 20, gid = w / nig, fm = gid * 8; const int lm = fm + ((w % nig) % 8); u.pn = (w % nig) / 8; u.pm = lm + (lm >> 4) + 1; }
        else { const int q = L - 1280; u.pm = 17 * (q & 3); u.pn = q >> 2; }
        u.e = 0; return true;
    }
    __device__ __forceinline__ const char* abase(const Unit& u) const { return A + (size_t)u.pm * 256 * DM * 2; }
    __device__ __forceinline__ const char* bbase(const Unit& u) const { return Bt + (size_t)u.pn * 256 * DM * 2; }
};
struct SchedLru {
    __device__ __forceinline__ const unsigned* offtab() const { return nullptr; }
    __device__ __forceinline__ int slotbase(const Unit&) const { return 0; }
    __device__ __forceinline__ const char* gbase() const { return nullptr; }
    const char* A; const char* Bt; int G, c;
    __device__ __forceinline__ bool next(int i, Unit& u) const {
        const int L = i * G + c; if (L >= NMT * 40) return false;
        const int w = xcd_remap(L, NMT * 40); const int q = w % 40; u.pm = w / 40; u.e = q >> 1; u.pn = q & 1; return true;
    }
    __device__ __forceinline__ const char* abase(const Unit& u) const { return A + ((size_t)u.pm * 256 * LRUW + (u.e % 10) * 256) * 2; }
    __device__ __forceinline__ const char* bbase(const Unit& u) const { return Bt + ((size_t)u.e * 512 + u.pn * 256) * 256 * 2; }
};
struct SchedMoe {
    const char* A; const char* Bt; int nMe, nN, estr, brows, G, c; const unsigned* otab;
    __device__ __forceinline__ const unsigned* offtab() const { return otab; }
    __device__ __forceinline__ int slotbase(const Unit& u) const { return u.e * estr + u.pm * 256; }
    __device__ __forceinline__ const char* gbase() const { return A; }
    __device__ __forceinline__ bool next(int i, Unit& u) const {
        const int per = nMe * nN, nwg = NEXP * per; const int L = i * G + c; if (L >= nwg) return false;
        const int w = xcd_remap(L, nwg); u.e = w / per; const int r = w % per; u.pm = r % nMe; u.pn = r / nMe; return true;
    }
    __device__ __forceinline__ const char* abase(const Unit& u) const { return A + ((size_t)u.e * estr + u.pm * 256) * DM; }
    __device__ __forceinline__ const char* bbase(const Unit& u) const { return Bt + ((size_t)u.e * brows + u.pn * 256) * DM; }
};

struct EpiPlainBf16 {
    static constexpr bool PERM = true;
    bf16_t* O; int ldc; int gelu_from;
    __device__ __forceinline__ void operator()(const f32x4 (&acc)[2][2][4][2], const Unit& u, int wr, int wc, int fr, int fq) const {
        const int row0 = u.pm * 256 + wr * 64 + fr, col0 = u.pn * 256 + wc * 32 + 8 * fq; const bool gl = u.pn >= gelu_from;
#pragma unroll
        for (int ai = 0; ai < 2; ++ai)
#pragma unroll
            for (int m = 0; m < 4; ++m) { bf16_t* rowp = O + (size_t)(row0 + ai * 128 + m * 16) * ldc + col0;
#pragma unroll
                for (int bj = 0; bj < 2; ++bj) { f32x4 v0 = acc[ai][bj][m][0], v1 = acc[ai][bj][m][1];
                    if (gl) {
#pragma unroll
                        for (int j = 0; j < 4; ++j) { v0[j] = gelu_tanh(v0[j]); v1[j] = gelu_tanh(v1[j]); } }
                    u32x4 w; w.x = cvt_pk_bf16(v0[0], v0[1]); w.y = cvt_pk_bf16(v0[2], v0[3]); w.z = cvt_pk_bf16(v1[0], v1[1]); w.w = cvt_pk_bf16(v1[2], v1[3]);
                    *(u32x4*)(rowp + bj * 128) = w; } }
    }
};
struct EpiEvIn {
    static constexpr bool PERM = true;
    bf16_t* O; int ldc;
    __device__ __forceinline__ void operator()(const f32x4 (&acc)[2][2][4][2], const Unit& u, int wr, int wc, int fr, int fq) const {
        const int row0 = u.pm * 256 + wr * 64 + fr;
        if (u.pn < 10) { const int col0 = u.pn * 256 + wc * 32 + 8 * fq;
#pragma unroll
            for (int ai = 0; ai < 2; ++ai)
#pragma unroll
                for (int m = 0; m < 4; ++m) { bf16_t* rowp = O + (size_t)(row0 + ai * 128 + m * 16) * ldc + col0;
#pragma unroll
                    for (int bj = 0; bj < 2; ++bj) { const f32x4 v0 = acc[ai][bj][m][0], v1 = acc[ai][bj][m][1];
                        u32x4 w; w.x = cvt_pk_bf16(v0[0], v0[1]); w.y = cvt_pk_bf16(v0[2], v0[3]); w.z = cvt_pk_bf16(v1[0], v1[1]); w.w = cvt_pk_bf16(v1[2], v1[3]);
                        *(u32x4*)(rowp + bj * 128) = w; } }
        } else { const int col0 = 2560 + (u.pn - 10) * 128 + wc * 32 + 8 * fq;
#pragma unroll
            for (int ai = 0; ai < 2; ++ai)
#pragma unroll
                for (int m = 0; m < 4; ++m) { const f32x4 v0 = acc[ai][0][m][0] * acc[ai][1][m][0], v1 = acc[ai][0][m][1] * acc[ai][1][m][1];
                    u32x4 w; w.x = cvt_pk_bf16(v0[0], v0[1]); w.y = cvt_pk_bf16(v0[2], v0[3]); w.z = cvt_pk_bf16(v1[0], v1[1]); w.w = cvt_pk_bf16(v1[2], v1[3]);
                    *(u32x4*)(O + (size_t)(row0 + ai * 128 + m * 16) * ldc + col0) = w; }
        }
    }
};
struct EpiResid {
    static constexpr bool PERM = true;
    const float* x; const float* ctx; bf16_t* h; const float* mod; int layer0;
    __device__ __forceinline__ void operator()(const f32x4 (&acc)[2][2][4][2], const Unit& u, int wr, int wc, int fr, int fq) const {
        const int b = u.pm / 17, pt = u.pm - b * 17;
        const float* hold = pt == 0 ? ctx + (size_t)b * CTXL * DM : x + ((size_t)b * SEQ + (pt - 1) * 256) * DM;
        bf16_t* ho = h + (size_t)u.pm * 256 * DM;
        const float* gate = mod + (size_t)(pt == 0 ? 4 : b) * MODN + 4096;
        const int r0 = wr * 64 + fr, col0 = u.pn * 256 + wc * 32 + 8 * fq;
        f32x4 gv[2][2];
#pragma unroll
        for (int bj = 0; bj < 2; ++bj)
#pragma unroll
            for (int n = 0; n < 2; ++n) gv[bj][n] = *(const f32x4*)(gate + col0 + bj * 128 + n * 4);
#pragma unroll
        for (int ai = 0; ai < 2; ++ai) {
            if (layer0) { f32x4 hv[4][2][2];
#pragma unroll
                for (int m = 0; m < 4; ++m) { const size_t off = (size_t)(r0 + ai * 128 + m * 16) * DM + col0;
#pragma unroll
                    for (int bj = 0; bj < 2; ++bj)
#pragma unroll
                        for (int n = 0; n < 2; ++n) hv[m][bj][n] = *(const f32x4*)(hold + off + bj * 128 + n * 4); }
#pragma unroll
                for (int m = 0; m < 4; ++m) { const size_t off = (size_t)(r0 + ai * 128 + m * 16) * DM + col0;
#pragma unroll
                    for (int bj = 0; bj < 2; ++bj) { const f32x4 v0 = hv[m][bj][0] + gv[bj][0] * acc[ai][bj][m][0], v1 = hv[m][bj][1] + gv[bj][1] * acc[ai][bj][m][1];
                        u32x4 w; w.x = cvt_pk_bf16(v0[0], v0[1]); w.y = cvt_pk_bf16(v0[2], v0[3]); w.z = cvt_pk_bf16(v1[0], v1[1]); w.w = cvt_pk_bf16(v1[2], v1[3]); *(u32x4*)(ho + off + bj * 128) = w; } }
            } else { u32x4 hw[4][2];
#pragma unroll
                for (int m = 0; m < 4; ++m) { const size_t off = (size_t)(r0 + ai * 128 + m * 16) * DM + col0;
#pragma unroll
                    for (int bj = 0; bj < 2; ++bj) hw[m][bj] = *(const u32x4*)(ho + off + bj * 128); }
#pragma unroll
                for (int m = 0; m < 4; ++m) { const size_t off = (size_t)(r0 + ai * 128 + m * 16) * DM + col0;
#pragma unroll
                    for (int bj = 0; bj < 2; ++bj) { const u32x4 q = hw[m][bj];
                        const f32x4 v0 = (f32x4){bf_lo(q.x), bf_hi(q.x), bf_lo(q.y), bf_hi(q.y)} + gv[bj][0] * acc[ai][bj][m][0], v1 = (f32x4){bf_lo(q.z), bf_hi(q.z), bf_lo(q.w), bf_hi(q.w)} + gv[bj][1] * acc[ai][bj][m][1];
                        u32x4 w; w.x = cvt_pk_bf16(v0[0], v0[1]); w.y = cvt_pk_bf16(v0[2], v0[3]); w.z = cvt_pk_bf16(v1[0], v1[1]); w.w = cvt_pk_bf16(v1[2], v1[3]); *(u32x4*)(ho + off + bj * 128) = w; } } }
        }
    }
};
struct EpiSwiglu {
    static constexpr bool PERM = true;
    unsigned char* O; int estr;
    __device__ __forceinline__ void operator()(const f32x4 (&acc)[2][2][4][2], const Unit& u, int wr, int wc, int fr, int fq) const {
        const unsigned row0 = (unsigned)(u.e * estr + u.pm * 256 + wr * 64 + fr); const unsigned col0 = (unsigned)(u.pn * 128 + wc * 32 + 8 * fq);
#pragma unroll
        for (int ai = 0; ai < 2; ++ai)
#pragma unroll
            for (int m = 0; m < 4; ++m) { float o[8];
#pragma unroll
                for (int n = 0; n < 2; ++n)
#pragma unroll
                    for (int j = 0; j < 4; ++j) { const float gt = acc[ai][0][m][n][j] * W8_INV, up = acc[ai][1][m][n][j] * W8_INV; o[n * 4 + j] = gt * fast_sigmoid(gt) * up; }
                u32x2 w; w.x = pk4_fp8(o[0], o[1], o[2], o[3]); w.y = pk4_fp8(o[4], o[5], o[6], o[7]);
                *(u32x2*)(O + (unsigned)((row0 + ai * 128 + m * 16) * DM + col0)) = w; __builtin_amdgcn_sched_barrier(0); }
    }
};
struct EpiDown {
    static constexpr bool PERM = true;
    unsigned char* O; const float* gval; int estr;
    __device__ __forceinline__ void operator()(const f32x4 (&acc)[2][2][4][2], const Unit& u, int wr, int wc, int fr, int fq) const {
        const unsigned row0 = (unsigned)(u.e * estr + u.pm * 256 + wr * 64 + fr); const unsigned col0 = (unsigned)(u.pn * 256 + wc * 32 + 8 * fq);
#pragma unroll
        for (int ai = 0; ai < 2; ++ai) { float gvv[4];
#pragma unroll
            for (int m = 0; m < 4; ++m) gvv[m] = gval[row0 + ai * 128 + m * 16] * W8_INV;
            __builtin_amdgcn_sched_barrier(0);
#pragma unroll
            for (int m = 0; m < 4; ++m) { const unsigned slot = row0 + ai * 128 + m * 16; const float gv = gvv[m];
#pragma unroll
                for (int bj = 0; bj < 2; ++bj) { const f32x4 v0 = acc[ai][bj][m][0] * gv, v1 = acc[ai][bj][m][1] * gv;
                    u32x2 w; w.x = pk4_fp8(v0[0], v0[1], v0[2], v0[3]); w.y = pk4_fp8(v1[0], v1[1], v1[2], v1[3]);
                    *(u32x2*)(O + (slot * DM + col0 + bj * 128)) = w; }
                __builtin_amdgcn_sched_barrier(0); } }
    }
};
struct EpiLru {
    static constexpr bool PERM = true;
    const bf16_t* U; unsigned* lagi; const float* ba; const float* bx; const float* lam;
    __device__ __forceinline__ void operator()(const f32x4 (&acc)[2][2][4][2], const Unit& u, int wr, int wc, int fr, int fq) const {
        const int d = u.e / 10, hb = u.e - d * 10; const int ch0 = hb * 256 + u.pn * 128 + wc * 32 + 8 * fq; const int row0 = u.pm * 256 + wr * 64 + fr;
        unsigned short* outp = (unsigned short*)lagi + (size_t)d * MROWS * LRUW;
        constexpr float NL2E = -1.4426950408889634f;
#pragma unroll
        for (int n = 0; n < 2; ++n) { const int chn = ch0 + 4 * n; f32x2 vba[2], vbx[2], sp[2], csp[2];
#pragma unroll
            for (int j = 0; j < 4; ++j) { const float lm = lam[d * LRUW + chn + j]; const float spl = fmaxf(-lm, 0.f) + __logf(1.0f + __expf(-fabsf(lm)));
                vba[j >> 1][j & 1] = NL2E * ba[d * LRUW + chn + j]; vbx[j >> 1][j & 1] = NL2E * bx[d * LRUW + chn + j]; sp[j >> 1][j & 1] = -8.0f * spl; csp[j >> 1][j & 1] = 4.0f * __builtin_amdgcn_sqrtf(spl); }
            u32x2 uws[2][4];
#pragma unroll
            for (int ai = 0; ai < 2; ++ai)
#pragma unroll
                for (int m = 0; m < 4; ++m) uws[ai][m] = *(const u32x2*)(U + (size_t)(row0 + ai * 128 + m * 16) * LRUW + chn);
#pragma unroll
            for (int ai = 0; ai < 2; ++ai)
#pragma unroll
                for (int m = 0; m < 4; ++m) { const size_t row = (size_t)(row0 + ai * 128 + m * 16); const u32x2 uw = uws[ai][m]; unsigned o[2];
#pragma unroll
                    for (int h = 0; h < 2; ++h) { const unsigned uwh = h ? uw.y : uw.x; const f32x2 uv = {bf_lo(uwh), bf_hi(uwh)};
                        f32x2 ta = (f32x2){acc[ai][0][m][n][2 * h], acc[ai][0][m][n][2 * h + 1]} * NL2E + vba[h], tx = (f32x2){acc[ai][1][m][n][2 * h], acc[ai][1][m][n][2 * h + 1]} * NL2E + vbx[h];
                        f32x2 ea, ex; ea.x = __builtin_amdgcn_exp2f(fminf(ta.x, 40.f)); ea.y = __builtin_amdgcn_exp2f(fminf(ta.y, 40.f)); ex.x = __builtin_amdgcn_exp2f(fminf(tx.x, 40.f)); ex.y = __builtin_amdgcn_exp2f(fminf(tx.y, 40.f));
                        ea = ea + 1.0f; ex = ex + 1.0f;
                        const f32x2 dd = (ea * ex) * ex; f32x2 g; g.x = __builtin_amdgcn_rsqf(dd.x); g.y = __builtin_amdgcn_rsqf(dd.y);
                        const f32x2 q = g * ex, r = q * q, la = r * sp[h], y = la + la;
                        f32x2 t = y * 0.041666668f + 0.16666667f; t = t * y + 0.5f; t = t * y;
                        f32x2 s1 = t * (-0.125f) + 0.5f; s1 = s1 * t + 1.0f;
                        const f32x2 bt = ((csp[h] * uv) * g) * s1;
                        (void)la; const int bb = __builtin_amdgcn_cvt_pk_fp8_f32(bt.x, bt.y, 0, false);
                        const unsigned c0 = (unsigned)(q.x * 255.0f + 0.5f), c1 = (unsigned)(q.y * 255.0f + 0.5f);
                        o[h] = c0 | (((unsigned)bb & 0xffu) << 8) | (c1 << 16) | (((unsigned)bb & 0xff00u) << 16); }
                    *(u32x2*)(outp + row * LRUW + chn) = (u32x2){o[0], o[1]}; } }
    }
};

namespace att {
constexpr int D = 128, NW = 8, QBLK = 32, KVBLK = 64;
constexpr float SCALE = 0.088388347648318440f;
constexpr float THR = 8.f;
constexpr int LDQ = PRJ_LD, LDK = 128, LDO = YLD;
constexpr size_t SHM_V = KVBLK * D * 2, SHM_K = KVBLK * D * 2, SHM_ATTN = 2 * SHM_V + 2 * SHM_K + NW * 64 * 4;
#define KSWZ(row, colB) ((row) * 256 + ((colB) ^ (((row) & 7) << 4)))
#define SBAR() __builtin_amdgcn_sched_barrier(0)
__device__ __forceinline__ int crow(int r, int hi) { return (r & 3) + 8 * (r >> 2) + 4 * hi; }
__device__ __forceinline__ void partialSM(f32x16& p0, f32x16& p1, float& m_reg, float& mn, float& alpha) {
  constexpr float C = SCALE * 1.4426950408889634f;
  float pmax = p0[0]; for (int r = 1; r < 16; ++r) pmax = fmaxf(pmax, p0[r]); for (int r = 0; r < 16; ++r) pmax = fmaxf(pmax, p1[r]);
  { auto rr = __builtin_amdgcn_permlane32_swap(__float_as_uint(pmax), __float_as_uint(pmax), false, false);
    pmax = fmaxf(__uint_as_float(rr[0]), __uint_as_float(rr[1])); }
  if (__builtin_expect(__all(pmax - m_reg <= THR / SCALE), 1)) { mn = m_reg; alpha = 1.f; }
  else { mn = fmaxf(m_reg, pmax); alpha = __builtin_amdgcn_exp2f((m_reg - mn) * C); m_reg = mn; }
  float mnC = -mn * C;
  for (int r = 0; r < 16; ++r) p0[r] = fmaf(p0[r], C, mnC); for (int r = 0; r < 16; ++r) p1[r] = fmaf(p1[r], C, mnC);
  for (int r = 0; r < 16; ++r) p0[r] = __builtin_amdgcn_exp2f(p0[r]);
}
__device__ __forceinline__ void finishSM(f32x16& p0, f32x16& p1, float alpha, float& l_reg, bf16x8& pa0, bf16x8& pa1, bf16x8& pa2, bf16x8& pa3) {
  for (int r = 0; r < 16; ++r) p1[r] = __builtin_amdgcn_exp2f(p1[r]);
  float ps = 0; for (int r = 0; r < 16; ++r) ps += p0[r]; for (int r = 0; r < 16; ++r) ps += p1[r];
  { auto rr = __builtin_amdgcn_permlane32_swap(__float_as_uint(ps), __float_as_uint(ps), false, false);
    ps = __uint_as_float(rr[0]) + __uint_as_float(rr[1]); }
  l_reg = l_reg * alpha + ps;
#define PK4(P, BASE, OUT) do { unsigned a0 = cvt_pk_bf16(P[BASE + 0], P[BASE + 1]), a1 = cvt_pk_bf16(P[BASE + 2], P[BASE + 3]);   \
    unsigned b0 = cvt_pk_bf16(P[BASE + 4], P[BASE + 5]), b1 = cvt_pk_bf16(P[BASE + 6], P[BASE + 7]);                              \
    auto r0 = __builtin_amdgcn_permlane32_swap(a0, b0, false, false); auto r1 = __builtin_amdgcn_permlane32_swap(a1, b1, false, false); \
    u32x4 w = {r0[0], r1[0], r0[1], r1[1]}; OUT = *reinterpret_cast<bf16x8*>(&w); } while (0)
  PK4(p0, 0, pa0); PK4(p0, 8, pa1); PK4(p1, 0, pa2); PK4(p1, 8, pa3);
#undef PK4
}
__device__ __forceinline__ void qkt(f32x16& p0, f32x16& p1, const bf16_t* Ks, const bf16x8* qr, int r32, int hi) {
  p0 = f32x16{}; p1 = f32x16{};
  for (int d0 = 0; d0 < 8; ++d0) { int cb = (d0 * 16 + hi * 8) * 2;
    bf16x8 b0 = *reinterpret_cast<const bf16x8*>((const char*)Ks + KSWZ(r32, cb));
    bf16x8 b1 = *reinterpret_cast<const bf16x8*>((const char*)Ks + KSWZ(32 + r32, cb));
    p0 = __builtin_amdgcn_mfma_f32_32x32x16_bf16(b0, qr[d0], p0, 0, 0, 0);
    p1 = __builtin_amdgcn_mfma_f32_32x32x16_bf16(b1, qr[d0], p1, 0, 0, 0); }
}
__device__ __forceinline__ int v_st(int k, int c) { const int kk = (k & ~0xC) | ((k & 4) << 1) | ((k & 8) >> 1); return ((kk >> 3) * 4 + (c >> 5)) * 512 + ((kk & 7) * 32 + (c & 31)) * 2; }
__device__ __forceinline__ int v_rd_base(int lane) { return ((lane & 3) << 3) | (((lane >> 2) & 3) << 6) | (((lane >> 4) & 1) << 5) | (((lane >> 5) & 1) << 8); }
constexpr int v_rd_off(int d0, int ks, int half) { return d0 * 512 + ks * 4096 + half * 2048; }
template <int OFF> __device__ __forceinline__ s16x4 tr_read(int vb) {
  s16x4 r; asm volatile("ds_read_b64_tr_b16 %0, %1 offset:%2" : "=&v"(r) : "v"(vb), "i"(OFF) : "memory"); return r;
}
template <int D0> __device__ __forceinline__ void pv_one(f32x16& od, int vb, bf16x8 pa0, bf16x8 pa1, bf16x8 pa2, bf16x8 pa3) {
  const s16x4 l0 = tr_read<v_rd_off(D0, 0, 0)>(vb), h0 = tr_read<v_rd_off(D0, 0, 1)>(vb), l1 = tr_read<v_rd_off(D0, 1, 0)>(vb), h1 = tr_read<v_rd_off(D0, 1, 1)>(vb);
  const s16x4 l2 = tr_read<v_rd_off(D0, 2, 0)>(vb), h2 = tr_read<v_rd_off(D0, 2, 1)>(vb), l3 = tr_read<v_rd_off(D0, 3, 0)>(vb), h3 = tr_read<v_rd_off(D0, 3, 1)>(vb);
  asm volatile("s_waitcnt lgkmcnt(0)" ::: "memory"); SBAR();
#define PK(L, H) (bf16x8){L[0], L[1], L[2], L[3], H[0], H[1], H[2], H[3]}
  od = __builtin_amdgcn_mfma_f32_32x32x16_bf16(pa0, PK(l0, h0), od, 0, 0, 0);
  od = __builtin_amdgcn_mfma_f32_32x32x16_bf16(pa1, PK(l1, h1), od, 0, 0, 0);
  od = __builtin_amdgcn_mfma_f32_32x32x16_bf16(pa2, PK(l2, h2), od, 0, 0, 0);
  od = __builtin_amdgcn_mfma_f32_32x32x16_bf16(pa3, PK(l3, h3), od, 0, 0, 0);
#undef PK
}
__device__ __forceinline__ void pv_d0(f32x16* o, int vb, bf16x8 pa0, bf16x8 pa1, bf16x8 pa2, bf16x8 pa3) {
  pv_one<0>(o[0], vb, pa0, pa1, pa2, pa3); pv_one<1>(o[1], vb, pa0, pa1, pa2, pa3); pv_one<2>(o[2], vb, pa0, pa1, pa2, pa3); pv_one<3>(o[3], vb, pa0, pa1, pa2, pa3);
}
__device__ __forceinline__ void attn_dense_body(const bf16_t* __restrict__ Qb, const bf16_t* __restrict__ Kh, const bf16_t* __restrict__ Vh, bf16_t* __restrict__ Ob, int seq, char* lds, int wid_in) {
  const int lane = lane_fresh();
  const int wid = wid_in, tid = wid * 64 + lane, r32 = lane & 31, hi = lane >> 5;
  bf16_t* V_lds = (bf16_t*)lds; bf16_t* K_lds = (bf16_t*)(lds + 2 * SHM_V);
  float* ws = (float*)(lds + 2 * SHM_V + 2 * SHM_K) + wid * 64; float* li_l = ws; float* al_l = ws + 32;
  float m_reg = -1e30f, l_reg = 0; f32x16 o[4] = {}; bf16x8 qr[8];
  const bf16_t* Qw = Qb + (long)(wid * QBLK + r32) * LDQ + hi * 8;
#pragma unroll
  for (int d0 = 0; d0 < 8; ++d0) qr[d0] = *reinterpret_cast<const bf16x8*>(Qw + d0 * 16);
  const int sr = tid >> 4, sc = (tid & 15) * 8, vst0 = v_st(sr, sc), vst1 = v_st(32 + sr, sc);
  const int vb0 = (int)(uintptr_t)V_lds + v_rd_base(lane);
  const unsigned toff = (unsigned)(sr * LDK + sc) * 2u;
  struct { bf16x8 vs0, vs1, ks0, ks1; } sr_[2];
#define SLOAD(i, k0) do { const char* vp_ = (const char*)(Vh + (long)(k0) * LDK); const char* kp_ = (const char*)(Kh + (long)(k0) * LDK); \
    sr_[i].vs0 = *reinterpret_cast<const bf16x8*>(vp_ + toff); sr_[i].vs1 = *reinterpret_cast<const bf16x8*>(vp_ + 32 * LDK * 2 + toff); \
    sr_[i].ks0 = *reinterpret_cast<const bf16x8*>(kp_ + toff); sr_[i].ks1 = *reinterpret_cast<const bf16x8*>(kp_ + 32 * LDK * 2 + toff); } while (0)
#define SWRITE(b, i) do { *(bf16x8*)((char*)V_lds + (b) * SHM_V + vst0) = sr_[i].vs0;          \
    *(bf16x8*)((char*)V_lds + (b) * SHM_V + vst1) = sr_[i].vs1; int kc = sc * 2;               \
    *(bf16x8*)((char*)K_lds + (b) * SHM_K + KSWZ(sr, kc)) = sr_[i].ks0;                       \
    *(bf16x8*)((char*)K_lds + (b) * SHM_K + KSWZ(32 + sr, kc)) = sr_[i].ks1; } while (0)
#define SWAIT() asm volatile("s_waitcnt vmcnt(4)" ::: "memory")
#define RESC(a) do { if (__any((a) < 1.f)) { if (hi == 0) al_l[r32] = (a); asm volatile("s_waitcnt lgkmcnt(0)" ::: "memory"); \
    for (int d = 0; d < 4; ++d) for (int r = 0; r < 16; ++r) o[d][r] *= al_l[crow(r, hi)]; } } while (0)
  f32x16 pA0, pA1, pB0, pB1; float mnA, mnB, alA, alB; bf16x8 pa0, pa1, pa2, pa3; const int NT = seq / KVBLK;
  constexpr int SE = 0, SO = 1;
  SLOAD(SE, 0); asm volatile("s_waitcnt vmcnt(0)" ::: "memory"); SWRITE(0, SE); __syncthreads();
  qkt(pA0, pA1, K_lds, qr, r32, hi); partialSM(pA0, pA1, m_reg, mnA, alA);
  SLOAD(SO, KVBLK); if (2 < NT) SLOAD(SE, 2 * KVBLK);
  SWAIT(); SWRITE(1, SO); __syncthreads();
  for (int j = 1; j + 1 < NT; j += 2) {
    SBAR(); qkt(pB0, pB1, (bf16_t*)((char*)K_lds + SHM_K), qr, r32, hi);
    finishSM(pA0, pA1, alA, l_reg, pa0, pa1, pa2, pa3); SBAR();
    SLOAD(SO, (j + 2) * KVBLK); SBAR();
    pv_d0(o, vb0, pa0, pa1, pa2, pa3); partialSM(pB0, pB1, m_reg, mnB, alB);
    __syncthreads(); SWAIT(); SWRITE(0, SE);
    RESC(alB); __syncthreads();
    SBAR(); qkt(pA0, pA1, K_lds, qr, r32, hi);
    finishSM(pB0, pB1, alB, l_reg, pa0, pa1, pa2, pa3); SBAR();
    if (j + 3 < NT) SLOAD(SE, (j + 3) * KVBLK); SBAR();
    pv_d0(o, vb0 + (int)SHM_V, pa0, pa1, pa2, pa3); partialSM(pA0, pA1, m_reg, mnA, alA);
    __syncthreads(); SWAIT(); SWRITE(1, SO);
    RESC(alA); __syncthreads();
  }
  SBAR(); qkt(pB0, pB1, (bf16_t*)((char*)K_lds + SHM_K), qr, r32, hi);
  finishSM(pA0, pA1, alA, l_reg, pa0, pa1, pa2, pa3); SBAR();
  pv_d0(o, vb0, pa0, pa1, pa2, pa3); partialSM(pB0, pB1, m_reg, mnB, alB);
  __syncthreads(); RESC(alB);
  finishSM(pB0, pB1, alB, l_reg, pa0, pa1, pa2, pa3); SBAR();
  pv_d0(o, vb0 + (int)SHM_V, pa0, pa1, pa2, pa3);
  if (hi == 0) li_l[r32] = l_reg; asm volatile("s_waitcnt lgkmcnt(0)" ::: "memory");
  float rli[16];
#pragma unroll
  for (int r = 0; r < 16; ++r) rli[r] = __builtin_amdgcn_rcpf(li_l[crow(r, hi)]);
  bf16_t* Ow = Ob + (long)(wid * QBLK) * LDO;
#pragma unroll
  for (int r = 0; r < 16; ++r) { int orow = crow(r, hi);
    for (int d0 = 0; d0 < 4; ++d0) Ow[(long)orow * LDO + d0 * 32 + r32] = (bf16_t)(cvt_pk_bf16(o[d0][r] * rli[r], 0.f) & 0xffffu); }
  __syncthreads();
#undef SLOAD
#undef SWRITE
#undef SWAIT
#undef RESC
}
}

struct Ctx {
    Params P; unsigned char* ws; int wid, G, c;
    LAS unsigned char* lds; char* ldsg;
};

constexpr int N_MOD_UNITS = 192;
constexpr int CV_A = 576, CV_B = CV_A + 256, CV_C = CV_B + 640, CV_D = CV_C + 320, CV_E = CV_D + 160, CV_F = CV_E + 424 + 2 * 3 * 16 * 128 - 11424  ;
__device__ __noinline__ void cvt_tile(const float* __restrict__ src, int ld, bf16_t* __restrict__ dst, int ldd, int tid) {
    const int c4 = ((tid >> 6) & 3) * 8 + (tid & 7), kq = (tid >> 8) * 8 + ((tid >> 3) & 7);
    const float* s = src + (size_t)(kq * 8) * ld + c4 * 4;
    f32x4 v[8];
#pragma unroll
    for (int i = 0; i < 8; ++i) v[i] = ld_nt(s + (size_t)i * ld);
#pragma unroll
    for (int j = 0; j < 4; ++j) { u32x4 w; w.x = cvt_pk_bf16(v[0][j], v[1][j]); w.y = cvt_pk_bf16(v[2][j], v[3][j]); w.z = cvt_pk_bf16(v[4][j], v[5][j]); w.w = cvt_pk_bf16(v[6][j], v[7][j]);
        __builtin_nontemporal_store(w, (GAS u32x4*)(GAS bf16_t*)(dst + (size_t)(c4 * 4 + j) * ldd + kq * 8)); }
}
__device__ __noinline__ void cvt_tile8(const float* __restrict__ src, int ld, unsigned char* __restrict__ dst, int ldd, int split, int tid) {
    const int c4 = (tid >> 6) * 8 + (tid & 7), kq = (tid >> 3) & 7;
    const float* s = src + (size_t)(kq * 16) * ld + c4 * 4;
    f32x4 v[16];
#pragma unroll
    for (int i = 0; i < 16; ++i) v[i] = ld_nt(s + (size_t)i * ld);
    const int rbase = split ? ((c4 >> 5) * 256 + (c4 & 31) * 4) : c4 * 4;
#pragma unroll
    for (int j = 0; j < 4; ++j) { u32x4 w;
        w.x = pk4_fp8(v[0][j] * W8_SCALE, v[1][j] * W8_SCALE, v[2][j] * W8_SCALE, v[3][j] * W8_SCALE); w.y = pk4_fp8(v[4][j] * W8_SCALE, v[5][j] * W8_SCALE, v[6][j] * W8_SCALE, v[7][j] * W8_SCALE);
        w.z = pk4_fp8(v[8][j] * W8_SCALE, v[9][j] * W8_SCALE, v[10][j] * W8_SCALE, v[11][j] * W8_SCALE); w.w = pk4_fp8(v[12][j] * W8_SCALE, v[13][j] * W8_SCALE, v[14][j] * W8_SCALE, v[15][j] * W8_SCALE);
        __builtin_nontemporal_store(w, (GAS u32x4*)(GAS unsigned char*)(dst + (size_t)(rbase + j) * ldd + kq * 16)); }
}
constexpr int MOE_TILES = 3 * 16 * 128;
__device__ __forceinline__ void moe_cvt_tile(const Ctx& F, int layer, int q, int tid) {
    const Params& P = F.P; const int m = q / 2048, r = q % 2048, le = layer * 16 + (r >> 7), kt = (r >> 3) & 15, nt = r & 7;
    const size_t so = (size_t)le * DM * DM + (size_t)kt * 128 * DM + nt * 256;
    if (m == 0)      cvt_tile8(P.in[I_WGATE] + so, DM, F.ws + WS_WGU + ((size_t)le * 4096 + nt * 512) * DM + kt * 128, DM, 1, tid);
    else if (m == 1) cvt_tile8(P.in[I_WUP]   + so, DM, F.ws + WS_WGU + ((size_t)le * 4096 + nt * 512 + 128) * DM + kt * 128, DM, 1, tid);
    else             cvt_tile8(P.in[I_WDOWN] + so, DM, F.ws + WS_WDN + ((size_t)le * DM + nt * 256) * DM + kt * 128, DM, 0, tid);
}
struct CvtJob { const float* src; unsigned char* dst; int split; };
__device__ __forceinline__ CvtJob moe_job(const Ctx& F, int g) {
    const Params& P = F.P; const int layer = g / MOE_TILES, q = g - layer * MOE_TILES, m = q >> 11, r = q & 2047, le = layer * 16 + (r >> 7), kt = (r >> 3) & 15, nt = r & 7;
    const float* pg = P.in[I_WGATE]; const float* pu = P.in[I_WUP]; const float* pd = P.in[I_WDOWN];
    asm volatile("" : "+s"(pg), "+s"(pu), "+s"(pd));
    const size_t so = (size_t)le * DM * DM + (size_t)kt * 128 * DM + nt * 256;
    CvtJob j; j.src = (m == 0 ? pg : (m == 1 ? pu : pd)) + so; j.split = m < 2 ? 1 : 0;
    j.dst = m < 2 ? F.ws + WS_WGU + ((size_t)le * 4096 + nt * 512 + (m == 1 ? 128 : 0)) * DM + kt * 128 : F.ws + WS_WDN + ((size_t)le * DM + nt * 256) * DM + kt * 128;
    return j;
}
__device__ __forceinline__ void conv_range(const Ctx& F, int g0, int g1, int first_cu) {
    const int tid = F.wid * 64 + lane_fresh(); const int c4 = (tid >> 6) * 8 + (tid & 7), kq = (tid >> 3) & 7; constexpr int n = 1;
    const int cnt = (g1 - g0 + (F.G - first_cu) - 1) / (F.G - first_cu);
    int g = g0 + (F.c - first_cu) * cnt; g1 = g + cnt < g1 ? g + cnt : g1; if (g >= g1) return;
#define CV8_LOAD(v_, src_) { const GAS float* s_ = (const GAS float*)(src_) + (size_t)(kq * 16) * DM + c4 * 4; _Pragma("unroll") for (int i = 0; i < 16; ++i) v_[i] = __builtin_nontemporal_load((const GAS f32x4*)(s_ + (size_t)i * DM)); }
#define CV8_STORE(v_, job_) { const int rbase = (job_).split ? ((c4 >> 5) * 256 + (c4 & 31) * 4) : c4 * 4; \
        _Pragma("unroll") for (int j = 0; j < 4; ++j) { u32x4 w; \
            w.x = pk4_fp8(v_[0][j] * W8_SCALE, v_[1][j] * W8_SCALE, v_[2][j] * W8_SCALE, v_[3][j] * W8_SCALE); w.y = pk4_fp8(v_[4][j] * W8_SCALE, v_[5][j] * W8_SCALE, v_[6][j] * W8_SCALE, v_[7][j] * W8_SCALE); \
            w.z = pk4_fp8(v_[8][j] * W8_SCALE, v_[9][j] * W8_SCALE, v_[10][j] * W8_SCALE, v_[11][j] * W8_SCALE); w.w = pk4_fp8(v_[12][j] * W8_SCALE, v_[13][j] * W8_SCALE, v_[14][j] * W8_SCALE, v_[15][j] * W8_SCALE); \
            __builtin_nontemporal_store(w, (GAS u32x4*)(GAS unsigned char*)((job_).dst + (size_t)(rbase + j) * DM + kq * 16)); } }
    f32x4 va[16], vb[16]; CvtJob ja = moe_job(F, g), jb = ja; CV8_LOAD(va, ja.src)
    for (;;) {
        if (g + n >= g1) { CV8_STORE(va, ja) break; }
        jb = moe_job(F, g + n); CV8_LOAD(vb, jb.src)
        CV8_STORE(va, ja)
        g += n;
        if (g + n >= g1) { CV8_STORE(vb, jb) break; }
        ja = moe_job(F, g + n); CV8_LOAD(va, ja.src)
        CV8_STORE(vb, jb)
        g += n;
    }
#undef CV8_STORE
#undef CV8_LOAD
}
constexpr int NCV2 = 48, NCV5 = 72, NCV9 = 64, NCV11 = 32, NCV13 = 8;
constexpr int GT0 = 424, GT2 = 3694, GT5 = 6144, GT9 = 9024, GT11 = 11204, GT13 = 11424;
static_assert(GT5 >= MOE_TILES, "layer 0's expert weights must be complete before P8");
__device__ __forceinline__ void p0_prologue(const Ctx& F) {
    const Params& P = F.P; const int tid = F.wid * 64 + lane_fresh();
    LAS float* sil = (LAS float*)F.lds;
    LAS float* red = (LAS float*)(F.lds + 40960);
    for (int u = F.c; u < N_MOD_UNITS + CV_F; u += F.G) {
        if (u < N_MOD_UNITS) {
            const int l = u / 96, j0 = (u % 96) * 128;
            for (int i = tid; i < 5 * DM; i += 512) { const int v = i >> 11, k = i & 2047; const float cv = v < 4 ? P.in[I_C][v * DM + k] : P.in[I_CCTX][k]; sil[i] = cv * fast_sigmoid(cv); }
            __syncthreads();
            const int hw = tid >> 5, l32 = tid & 31;
            f32x4 a0 = {0, 0, 0, 0}, a1 = a0, a2 = a0, a3 = a0, a4 = a0;
            const float* wp = P.in[I_MODW] + ((size_t)(l * DM + hw * 128)) * MODN + j0 + l32 * 4;
#pragma unroll 8
            for (int kk = 0; kk < 128; ++kk) { const f32x4 w = ld_nt(wp + (size_t)kk * MODN); const int k = hw * 128 + kk;
                a0 += sil[k] * w; a1 += sil[DM + k] * w; a2 += sil[2 * DM + k] * w; a3 += sil[3 * DM + k] * w; a4 += sil[4 * DM + k] * w; }
            *(LAS f32x4*)(red + (hw * 5 + 0) * 128 + l32 * 4) = a0; *(LAS f32x4*)(red + (hw * 5 + 1) * 128 + l32 * 4) = a1; *(LAS f32x4*)(red + (hw * 5 + 2) * 128 + l32 * 4) = a2;
            *(LAS f32x4*)(red + (hw * 5 + 3) * 128 + l32 * 4) = a3; *(LAS f32x4*)(red + (hw * 5 + 4) * 128 + l32 * 4) = a4;
            __syncthreads();
            float* mod = (float*)(F.ws + WS_MOD);
            for (int o = tid; o < 640; o += 512) { const int v = o >> 7, col = o & 127; float s = 0.f;
#pragma unroll
                for (int h = 0; h < 16; ++h) s += red[(h * 5 + v) * 128 + col];
                mod[(size_t)(l * 5 + v) * MODN + j0 + col] = s + P.in[I_MODB][l * MODN + j0 + col]; }
            __syncthreads();
        } else {
            const int t = u - N_MOD_UNITS;
            if (t < CV_A)      { const int q = t;        const int kt = q / 36, nt = q % 36; const int drow = nt < 20 ? nt * 128 : (nt < 28 ? 2560 + (nt - 20) * 256 : 2560 + (nt - 28) * 256 + 128);
                cvt_tile(P.in[I_EVWIN]  + (size_t)kt * 128 * EV_IN + nt * 128, EV_IN, (bf16_t*)(F.ws + WS_WEVIN)  + (size_t)drow * DM + kt * 128, DM, tid); }
            else if (t < CV_B) { const int q = t - CV_A; const int kt = q / 16, nt = q % 16; cvt_tile(P.in[I_EVWOUT] + (size_t)kt * 128 * DM + nt * 128, DM, (bf16_t*)(F.ws + WS_WEVOUT) + (size_t)nt * 128 * DM + kt * 128, DM, tid); }
            else if (t < CV_C) { const int q = t - CV_B; const int kt = q / 40, nt = q % 40; cvt_tile(P.in[I_ODWIN]  + (size_t)kt * 128 * OD_IN + nt * 128, OD_IN, (bf16_t*)(F.ws + WS_WODIN)  + (size_t)nt * 128 * DM + kt * 128, DM, tid); }
            else if (t < CV_D) { const int q = t - CV_C; const int kt = q / 16, nt = q % 16; cvt_tile(P.in[I_ODWOUT] + (size_t)kt * 128 * DM + nt * 128, DM, (bf16_t*)(F.ws + WS_WODOUT) + (size_t)nt * 128 * LRUW + kt * 128, LRUW, tid); }
            else if (t < CV_E) { const int q = t - CV_D; const int m = q / 80, r = q % 80, dh = r >> 2, kt = (r >> 1) & 1, nt = r & 1;
                bf16_t* dst = (bf16_t*)(F.ws + WS_WLRU) + ((size_t)dh * 512 + nt * 256 + m * 128) * 256 + kt * 128; const size_t so = (size_t)dh * 65536 + (size_t)kt * 128 * 256 + nt * 128;
                if (m == 0) cvt_tile(P.in[I_ODWA] + so, 256, dst, 256, tid); else cvt_tile(P.in[I_ODWX] + so, 256, dst, 256, tid); }
            else { const int q = t - CV_E; const int g = q < GT0 ? q : GT13 + (q - GT0); moe_cvt_tile(F, g / MOE_TILES, g % MOE_TILES, tid); }
        }
    }
}

template <int MODE> __device__ __forceinline__ void norm_pair(const Ctx& F, const LAS float* lm, int lane, int row, const f32x4 (&nx)[2][8], const u32x2 (&nw)[2][8], int sm0, int sm1) {
    const Params& P = F.P; bf16_t* h = (bf16_t*)(F.ws + WS_H); bf16_t* act = (bf16_t*)(F.ws + WS_ACT); const unsigned char* eo = F.ws + WS_EO;
    const int b = row / TPB, p = row - b * TPB; const bool isctx = p < CTXL; const int mv = isctx ? 4 : b;
    f32x4 v[2][8];
#pragma unroll
    for (int q = 0; q < 2; ++q)
#pragma unroll
        for (int i = 0; i < 8; ++i) v[q][i] = MODE == 0 ? nx[q][i] : (f32x4){bf_lo(nw[q][i].x), bf_hi(nw[q][i].x), bf_lo(nw[q][i].y), bf_hi(nw[q][i].y)};
    if (MODE >= 1) {
        f32x4 a[2][8];
#pragma unroll
        for (int q = 0; q < 2; ++q)
#pragma unroll
            for (int i = 0; i < 8; ++i) a[q][i] = (f32x4){0.f, 0.f, 0.f, 0.f};
        unsigned sel0 = (unsigned)__ballot(sm0 >= 0) & 0xffffu, sel1 = (unsigned)__ballot(sm1 >= 0) & 0xffffu;
        while (sel0 | sel1) {
            int sl[4]; bool on[4];
            { on[0] = sel0 != 0u; const int e = on[0] ? __builtin_ctz(sel0) : 0; if (on[0]) sel0 &= sel0 - 1u; sl[0] = on[0] ? __builtin_amdgcn_readlane(sm0, e) : 0; }
            { on[1] = sel0 != 0u; const int e = on[1] ? __builtin_ctz(sel0) : 0; if (on[1]) sel0 &= sel0 - 1u; sl[1] = on[1] ? __builtin_amdgcn_readlane(sm0, e) : sl[0]; }
            { on[2] = sel1 != 0u; const int e = on[2] ? __builtin_ctz(sel1) : 0; if (on[2]) sel1 &= sel1 - 1u; sl[2] = on[2] ? __builtin_amdgcn_readlane(sm1, e) : 0; }
            { on[3] = sel1 != 0u; const int e = on[3] ? __builtin_ctz(sel1) : 0; if (on[3]) sel1 &= sel1 - 1u; sl[3] = on[3] ? __builtin_amdgcn_readlane(sm1, e) : sl[2]; }
            unsigned w[4][8];
#pragma unroll
            for (int t = 0; t < 4; ++t)
#pragma unroll
                for (int i = 0; i < 8; ++i) w[t][i] = *(const unsigned*)(eo + (size_t)sl[t] * DM + lane * 4 + 256 * i);
#pragma unroll
            for (int t = 0; t < 4; ++t) { if (on[t]) {
#pragma unroll
                for (int i = 0; i < 8; ++i) a[t >> 1][i] += (f32x4){__builtin_amdgcn_cvt_f32_fp8((int)w[t][i], 0), __builtin_amdgcn_cvt_f32_fp8((int)w[t][i], 1), __builtin_amdgcn_cvt_f32_fp8((int)w[t][i], 2), __builtin_amdgcn_cvt_f32_fp8((int)w[t][i], 3)}; } }
        }
        const LAS float* g2 = lm + 10 * DM + mv * DM + lane * 4;
#pragma unroll
        for (int i = 0; i < 8; ++i) { const f32x4 gv = *(const LAS f32x4*)(g2 + 256 * i); v[0][i] += gv * a[0][i]; v[1][i] += gv * a[1][i]; }
        if (MODE == 1) {
#pragma unroll
            for (int q = 0; q < 2; ++q)
#pragma unroll
                for (int i = 0; i < 8; ++i) { u32x2 w2; w2.x = cvt_pk_bf16(v[q][i][0], v[q][i][1]); w2.y = cvt_pk_bf16(v[q][i][2], v[q][i][3]); *(u32x2*)(h + (size_t)(row + q) * DM + lane * 4 + 256 * i) = w2; } }
    }
    float rinv[2];
#pragma unroll
    for (int q = 0; q < 2; ++q) { float ss = 0.f;
#pragma unroll
        for (int i = 0; i < 8; ++i) ss += v[q][i][0] * v[q][i][0] + v[q][i][1] * v[q][i][1] + v[q][i][2] * v[q][i][2] + v[q][i][3] * v[q][i][3];
        ss = wave_sum(ss); rinv[q] = __builtin_amdgcn_rsqf(ss * (1.0f / DM) + EPS); }
    if (MODE == 2) {
        float* op = P.out + ((size_t)b * SEQ + (p - CTXL)) * DM + lane * 4; const LAS float* gf = lm + lane * 4;
#pragma unroll
        for (int i = 0; i < 8; ++i) { const f32x4 gv = *(const LAS f32x4*)(gf + 256 * i); st_nt(op + 256 * i, v[0][i] * rinv[0] * gv); st_nt(op + DM + 256 * i, v[1][i] * rinv[1] * gv); }
    } else {
        const LAS float* gsp = lm + mv * DM + lane * 4;
#pragma unroll
        for (int i = 0; i < 8; ++i) { const f32x4 gs = *(const LAS f32x4*)(gsp + 256 * i), sv = *(const LAS f32x4*)(gsp + 5 * DM + 256 * i);
#pragma unroll
            for (int q = 0; q < 2; ++q) { const f32x4 y = v[q][i] * rinv[q] * gs + sv;
                u32x2 w2; w2.x = cvt_pk_bf16(y[0], y[1]); w2.y = cvt_pk_bf16(y[2], y[3]); *(u32x2*)(act + (size_t)(row + q) * DM + lane * 4 + 256 * i) = w2; } }
    }
}
template <int MODE> __device__ __forceinline__ void phase_norm(const Ctx& F) {
    const Params& P = F.P; const int lane = lane_fresh();
    const float* mod = (const float*)(F.ws + WS_MOD); const bf16_t* h = (const bf16_t*)(F.ws + WS_H); const int* slotmap = (const int*)(F.ws + WS_SLOT);
    const int lprev = MODE == 2 ? 1 : 0, lnext = MODE == 0 ? 0 : 1;
    LAS float* lm = (LAS float*)F.lds;
    { const int tid = F.wid * 64 + lane;
      for (int i = tid; i < 5 * DM; i += 512) { const int mvv = i >> 11, k = i & 2047;
          if (MODE != 2) { const float* sh_ = mod + (size_t)(lnext * 5 + mvv) * MODN; lm[i] = P.in[I_N1G][lnext * DM + k] * (1.0f + sh_[2048 + k]); lm[5 * DM + i] = sh_[k]; }
          if (MODE >= 1) lm[10 * DM + i] = mod[(size_t)(lprev * 5 + mvv) * MODN + 10240 + k]; }
      if (MODE == 2) for (int i = tid; i < DM; i += 512) lm[i] = P.in[I_FNG][i];
      __syncthreads(); }
    const int npair = MODE == 2 ? NB * SEQ / 2 : MROWS / 2; const int pstep = F.G * 8;
#define NM_ROW(j) (MODE == 2 ? ((j) / (SEQ / 2)) * TPB + CTXL + ((j) % (SEQ / 2)) * 2 : (j) * 2)
#define NM_LOAD(j, nx, nw, nsm0, nsm1) { const int r_ = NM_ROW(j); \
        if (MODE == 0) { const int b_ = r_ / TPB, p_ = r_ - b_ * TPB; const float* src = p_ < CTXL ? P.in[I_CTX] + ((size_t)b_ * CTXL + p_) * DM : P.in[I_X] + ((size_t)b_ * SEQ + (p_ - CTXL)) * DM; \
            _Pragma("unroll") for (int q = 0; q < 2; ++q) _Pragma("unroll") for (int i = 0; i < 8; ++i) nx[q][i] = ld_nt(src + (size_t)q * DM + lane * 4 + 256 * i); \
        } else { \
            _Pragma("unroll") for (int q = 0; q < 2; ++q) _Pragma("unroll") for (int i = 0; i < 8; ++i) nw[q][i] = *(const u32x2*)(h + (size_t)(r_ + q) * DM + lane * 4 + 256 * i); \
            nsm0 = lane < 16 ? slotmap[(size_t)r_ * 16 + lane] : -1; nsm1 = lane < 16 ? slotmap[(size_t)(r_ + 1) * 16 + lane] : -1; } }
    f32x4 ax[2][8], bx[2][8]; u32x2 aw[2][8], bw[2][8]; int as0 = -1, as1 = -1, bs0 = -1, bs1 = -1; int jp = F.c * 8 + F.wid;
    if (jp < npair) {
        NM_LOAD(jp, ax, aw, as0, as1)
        for (;;) {
            if (jp + pstep >= npair) { norm_pair<MODE>(F, lm, lane, NM_ROW(jp), ax, aw, as0, as1); break; }
            NM_LOAD(jp + pstep, bx, bw, bs0, bs1)
            norm_pair<MODE>(F, lm, lane, NM_ROW(jp), ax, aw, as0, as1);
            jp += pstep;
            if (jp + pstep >= npair) { norm_pair<MODE>(F, lm, lane, NM_ROW(jp), bx, bw, bs0, bs1); break; }
            NM_LOAD(jp + pstep, ax, aw, as0, as1)
            norm_pair<MODE>(F, lm, lane, NM_ROW(jp), bx, bw, bs0, bs1);
            jp += pstep;
        }
    }
#undef NM_LOAD
#undef NM_ROW
}

__device__ __forceinline__ void phase_router(const Ctx& F, int layer) {
    const Params& P = F.P; const int lane = lane_fresh(), tid = F.wid * 64 + lane;
    const float* mod = (const float*)(F.ws + WS_MOD); const bf16_t* h = (const bf16_t*)(F.ws + WS_H); unsigned char* act8 = F.ws + WS_ACT; float* aff = (float*)(F.ws + WS_AFF);
    LAS float* Wt = (LAS float*)F.lds;
    const float* wr = P.in[I_ROUTER] + (size_t)layer * DM * 16;
    for (int i = tid; i < DM * 16; i += 512) Wt[(i & 15) * DM + (i >> 4)] = wr[i];
    __syncthreads();
    const int npair = layer == 0 ? MROWS / 2 : NB * SEQ / 2; const int pstep = F.G * 8;
#define RT_ROW(j) (layer == 0 ? (j) * 2 : ((j) / (SEQ / 2)) * TPB + CTXL + ((j) % (SEQ / 2)) * 2)
    u32x2 nw[2][8]; int jp = F.c * 8 + F.wid;
    if (jp < npair) { const int r_ = RT_ROW(jp);
#pragma unroll
        for (int q = 0; q < 2; ++q)
#pragma unroll
            for (int i = 0; i < 8; ++i) nw[q][i] = *(const u32x2*)(h + (size_t)(r_ + q) * DM + lane * 4 + 256 * i); }
    for (; jp < npair; jp += pstep) {
        const int row = RT_ROW(jp); const int b = row / TPB, p = row - b * TPB; const bool isctx = p < CTXL; const int mv = isctx ? 4 : b;
        f32x2 pv[8][4];
#pragma unroll
        for (int i = 0; i < 8; ++i) { pv[i][0] = (f32x2){bf_lo(nw[0][i].x), bf_lo(nw[1][i].x)}; pv[i][1] = (f32x2){bf_hi(nw[0][i].x), bf_hi(nw[1][i].x)};
                                       pv[i][2] = (f32x2){bf_lo(nw[0][i].y), bf_lo(nw[1][i].y)}; pv[i][3] = (f32x2){bf_hi(nw[0][i].y), bf_hi(nw[1][i].y)}; }
        if (jp + pstep < npair) { const int r_ = RT_ROW(jp + pstep);
#pragma unroll
            for (int q = 0; q < 2; ++q)
#pragma unroll
                for (int i = 0; i < 8; ++i) nw[q][i] = *(const u32x2*)(h + (size_t)(r_ + q) * DM + lane * 4 + 256 * i); }
        f32x2 ss2 = {0.f, 0.f};
#pragma unroll
        for (int i = 0; i < 8; ++i)
#pragma unroll
            for (int k = 0; k < 4; ++k) ss2 += pv[i][k] * pv[i][k];
        f32x2 rinv2; rinv2.x = __builtin_amdgcn_rsqf(wave_sum(ss2.x) * (1.0f / DM) + EPS); rinv2.y = __builtin_amdgcn_rsqf(wave_sum(ss2.y) * (1.0f / DM) + EPS);
        const float* g = P.in[I_N2G] + layer * DM + lane * 4; const float* sh = mod + (size_t)(layer * 5 + mv) * MODN + 6144 + lane * 4; const float* sc = sh + 2048;
#pragma unroll
        for (int i = 0; i < 8; ++i) { const f32x4 gs = *(const f32x4*)(g + 256 * i) * (1.0f + *(const f32x4*)(sc + 256 * i)), sv = *(const f32x4*)(sh + 256 * i);
#pragma unroll
            for (int k = 0; k < 4; ++k) pv[i][k] = (pv[i][k] * rinv2) * (f32x2){gs[k], gs[k]} + (f32x2){sv[k], sv[k]};
            *(unsigned*)(act8 + (size_t)row * DM + lane * 4 + 256 * i) = pk4_fp8(pv[i][0].x, pv[i][1].x, pv[i][2].x, pv[i][3].x);
            *(unsigned*)(act8 + (size_t)(row + 1) * DM + lane * 4 + 256 * i) = pk4_fp8(pv[i][0].y, pv[i][1].y, pv[i][2].y, pv[i][3].y); }
        f32x2 lg2[16];
#pragma unroll
        for (int e = 0; e < 16; ++e) { f32x2 acc[4] = {{0.f, 0.f}, {0.f, 0.f}, {0.f, 0.f}, {0.f, 0.f}};
#pragma unroll
            for (int i = 0; i < 8; ++i) { const f32x4 w = *(const LAS f32x4*)(Wt + e * DM + lane * 4 + 256 * i);
#pragma unroll
                for (int k = 0; k < 4; ++k) acc[k] += pv[i][k] * (f32x2){w[k], w[k]}; }
            lg2[e] = (acc[0] + acc[1]) + (acc[2] + acc[3]); __builtin_amdgcn_sched_barrier(0); }
        const bool b0 = (lane & 1) != 0, b1 = (lane & 2) != 0, b2 = (lane & 4) != 0, b3 = (lane & 8) != 0, b4 = (lane & 16) != 0;
        float u16[16], u8[8], u4[4], u2[2];
#pragma unroll
        for (int j = 0; j < 16; ++j) { const float send = b0 ? lg2[j].x : lg2[j].y, keep = b0 ? lg2[j].y : lg2[j].x;
            u16[j] = keep + __int_as_float(__builtin_amdgcn_update_dpp(0, __float_as_int(send), 0xB1, 0xf, 0xf, true)); }
#pragma unroll
        for (int j = 0; j < 8; ++j) { const float send = b1 ? u16[j] : u16[8 + j], keep = b1 ? u16[8 + j] : u16[j];
            u8[j] = keep + __int_as_float(__builtin_amdgcn_update_dpp(0, __float_as_int(send), 0x4E, 0xf, 0xf, true)); }
#pragma unroll
        for (int j = 0; j < 4; ++j) { const float send = b2 ? u8[j] : u8[4 + j], keep = b2 ? u8[4 + j] : u8[j]; u4[j] = keep + __shfl_xor(send, 4); }
#pragma unroll
        for (int j = 0; j < 2; ++j) { const float send = b3 ? u4[j] : u4[2 + j], keep = b3 ? u4[2 + j] : u4[j]; u2[j] = keep + __shfl_xor(send, 8); }
        float lgt; { const float send = b4 ? u2[0] : u2[1], keep = b4 ? u2[1] : u2[0]; lgt = keep + __shfl_xor(send, 16); }
        lgt += __shfl_xor(lgt, 32);
        float mx = lgt;
#pragma unroll
        for (int o = 2; o <= 16; o <<= 1) mx = fmaxf(mx, __shfl_xor(mx, o));
        const float pe = __expf(lgt - mx); float sum = pe;
#pragma unroll
        for (int o = 2; o <= 16; o <<= 1) sum += __shfl_xor(sum, o);
        if (lane < 32) { const int e = (b1 ? 8 : 0) + (b2 ? 4 : 0) + (b3 ? 2 : 0) + (b4 ? 1 : 0); aff[(size_t)(row + (b0 ? 1 : 0)) * 16 + e] = pe / sum; }
    }
#undef RT_ROW
    __syncthreads();
}

__device__ __forceinline__ unsigned block_excl_scan(unsigned x, LAS unsigned* wsum, int lane, int wid) {
    unsigned s = x;
#pragma unroll
    for (int o = 1; o < 64; o <<= 1) { const unsigned t = __shfl_up(s, o); if (lane >= o) s += t; }
    if (lane == 63) wsum[wid] = s;
    __syncthreads();
    unsigned below = 0;
#pragma unroll
    for (int w = 0; w < 8; ++w) below += (w < wid) ? wsum[w] : 0u;
    __syncthreads();
    return below + s - x;
}
__device__ __forceinline__ void phase_topk(const Ctx& F, int layer) {
    const int lane = lane_fresh(), tid = F.wid * 64 + lane; const int estr = layer == 0 ? 2304 : 2048;
    const float* aff = (const float*)(F.ws + WS_AFF); int* slotmap = (int*)(F.ws + WS_SLOT); float* gval = (float*)(F.ws + WS_GVAL);
    unsigned* offt = (unsigned*)(F.ws + WS_OFFT);
    LAS unsigned* key = (LAS unsigned*)F.lds;
    LAS unsigned* hist = key + 4096;
    LAS unsigned* wsum = hist + 256;
    LAS unsigned* bc = wsum + 16;
    LAS unsigned* list = bc + 16;
    const int nunits = layer == 0 ? 320 : 256;
    for (int u = F.c; u < nunits; u += F.G) {
        const bool lat = u < 256; const int be = lat ? (u >> 2) : (u - 256), q = lat ? (u & 3) : 0; const int b = be >> 4, e = be & 15;
        const int n = lat ? SEQ : CTXL, cap = n >> 3, row0 = b * TPB + (lat ? CTXL : 0);
        for (int i = tid; i < n; i += 512) key[i] = __float_as_uint(aff[(size_t)(row0 + i) * 16 + e]);
        unsigned prefix = 0u, mask = 0u, krem = (unsigned)cap;
#pragma unroll 1
        for (int pass = 0; pass < 4; ++pass) { const int shift = 24 - 8 * pass;
            if (tid < 256) hist[tid] = 0u;
            __syncthreads();
            for (int i = tid; i < n; i += 512) { const unsigned k = key[i]; if ((k & mask) == prefix) __hip_atomic_fetch_add(hist + ((k >> shift) & 255u), 1u, __ATOMIC_RELAXED, __HIP_MEMORY_SCOPE_WORKGROUP); }
            __syncthreads();
            unsigned sfx = 0u;
            if (tid < 256) { sfx = hist[tid];
#pragma unroll
                for (int o = 1; o < 64; o <<= 1) { const unsigned t = __shfl_down(sfx, o); if (lane + o < 64) sfx += t; }
                if (lane == 0) wsum[F.wid] = sfx; }
            __syncthreads();
            if (tid < 256) { unsigned above = 0u;
#pragma unroll
                for (int w = 1; w < 4; ++w) above += (w > F.wid) ? wsum[w] : 0u;
                const unsigned ge = sfx + above; unsigned gt = __shfl_down(sfx, 1); gt = (lane == 63) ? above : gt + above;
                if (ge >= krem && gt < krem) { bc[0] = (unsigned)tid; bc[1] = krem - gt; } }
            __syncthreads();
            prefix |= bc[0] << shift; mask |= 255u << shift; krem = bc[1];
        }
        const int per = lat ? 8 : 1; const bool own = tid * per < n; const int i0 = tid * per;
        unsigned eqc = 0u;
        if (own) for (int j = 0; j < per; ++j) eqc += (key[i0 + j] == prefix) ? 1u : 0u;
        unsigned eqb = block_excl_scan(eqc, wsum, lane, F.wid);
        unsigned selm = 0u, selc = 0u;
        if (own) for (int j = 0; j < per; ++j) { const unsigned k = key[i0 + j]; bool sl = k > prefix; if (k == prefix) { sl = eqb < krem; ++eqb; } if (sl) { selm |= 1u << j; ++selc; } }
        unsigned sb = block_excl_scan(selc, wsum, lane, F.wid);
        const int slot0 = e * estr + (lat ? b * 512 : 2048 + b * 32);
        const bool mine = lat ? ((tid >> 7) == q) : true;
        if (own) for (int j = 0; j < per; ++j) { const bool sl = (selm >> j) & 1u; if (sl) list[sb] = (unsigned)(i0 + j);
            if (mine) slotmap[(size_t)(row0 + i0 + j) * 16 + e] = sl ? slot0 + (int)sb : -1; if (sl) ++sb; }
        __syncthreads();
        const int r_lo = lat ? q * 128 : 0, r_hi = lat ? r_lo + 128 : 32;
        for (int r = r_lo + tid; r < r_hi; r += 512) { const unsigned t = list[r]; gval[slot0 + r] = __uint_as_float(key[t]); offt[slot0 + r] = (unsigned)(row0 + t) * (unsigned)DM; }
        if (layer == 0 && !lat && b == 0 && tid < 128) offt[e * estr + 2176 + tid] = 0u;
        __syncthreads();
    }
}

__device__ __forceinline__ void unpack8(const u32x4 v, float (&o)[8]) { o[0] = bf_lo(v.x); o[1] = bf_hi(v.x); o[2] = bf_lo(v.y); o[3] = bf_hi(v.y); o[4] = bf_lo(v.z); o[5] = bf_hi(v.z); o[6] = bf_lo(v.w); o[7] = bf_hi(v.w); }
__device__ __forceinline__ void load_cu(const bf16_t* prj, int row, int ch, float (&o)[8]) {
    const u32x4 cv = *(const u32x4*)(prj + (size_t)row * PRJ_LD + 2560 + ch), uv = *(const u32x4*)(prj + (size_t)row * PRJ_LD + 3584 + ch);
    o[0] = bf_lo(cv.x) * bf_lo(uv.x); o[1] = bf_hi(cv.x) * bf_hi(uv.x); o[2] = bf_lo(cv.y) * bf_lo(uv.y); o[3] = bf_hi(cv.y) * bf_hi(uv.y);
    o[4] = bf_lo(cv.z) * bf_lo(uv.z); o[5] = bf_hi(cv.z) * bf_hi(uv.z); o[6] = bf_lo(cv.w) * bf_lo(uv.w); o[7] = bf_hi(cv.w) * bf_hi(uv.w);
}
__device__ __forceinline__ void load_x8(const bf16_t* prj, int row, int ch, int seg_lo, int seg_hi, float (&o)[8]) {
    if (row < seg_lo || row >= seg_hi) {
#pragma unroll
        for (int j = 0; j < 8; ++j) o[j] = 0.f; }
    else { const u32x4 v = *(const u32x4*)(prj + (size_t)row * PRJ_LD + ch); o[0] = bf_lo(v.x); o[1] = bf_hi(v.x); o[2] = bf_lo(v.y); o[3] = bf_hi(v.y); o[4] = bf_lo(v.z); o[5] = bf_hi(v.z); o[6] = bf_lo(v.w); o[7] = bf_hi(v.w); }
}
__device__ __forceinline__ int rope_unit(int c, int k, int G) {
    constexpr int NROPE = MROWS / 16;
    if (G != 256) { const int u = c + k * G; return u < NROPE ? u : -1; }
    if (k < 3) return k * 256 + c;
    if (k == 3) return c >= 32 ? 768 + (c - 32) : -1;
    if (k == 4) return (c >= 32 && c < 128) ? 992 + (c - 32) : -1;
    return -1;
}
__device__ __forceinline__ void phase_rope_conv(const Ctx& F) {
    const Params& P = F.P; const int tid = F.wid * 64 + lane_fresh();
    bf16_t* prj = (bf16_t*)(F.ws + WS_PRJ); bf16_t* yin = (bf16_t*)(F.ws + WS_YIN);
    constexpr int NCONV = MROWS / 32, NROPE = MROWS / 16;
    {
        const int ch = (tid & 127) * 8;
        const float* cw = P.in[I_EVCW]; float w0[8], w1[8], w2[8], cb[8];
#pragma unroll
        for (int j = 0; j < 8; ++j) { w0[j] = cw[ch + j]; w1[j] = cw[1024 + ch + j]; w2[j] = cw[2048 + ch + j]; cb[j] = P.in[I_EVCB][ch + j]; }
        u32x4 ncin[10], nbin[8];
#define RC_LOAD(un) { const int r0_ = (un) * 32 + (tid >> 7) * 8; const int b_ = r0_ / TPB, p_ = r0_ - b_ * TPB; const int lo_ = b_ * TPB + (p_ < CTXL ? 0 : CTXL), hi_ = b_ * TPB + (p_ < CTXL ? CTXL : TPB); \
            _Pragma("unroll") for (int k = 0; k < 10; ++k) { const int row = r0_ - 1 + k; const int rc = row < lo_ ? lo_ : (row >= hi_ ? hi_ - 1 : row); \
                ncin[k] = *(const u32x4*)((const char*)prj + (unsigned)(rc * PRJ_LD + 2560 + ch) * 2u); if (row < lo_ || row >= hi_) ncin[k] = (u32x4){0u, 0u, 0u, 0u}; }         \
            _Pragma("unroll") for (int k = 0; k < 8; ++k) nbin[k] = *(const u32x4*)((const char*)prj + (unsigned)((r0_ + k) * PRJ_LD + 1536 + ch) * 2u); }
        int u = F.c; if (u < NCONV) RC_LOAD(u)
        for (; u < NCONV; u += F.G) {
            const int r0 = u * 32 + (tid >> 7) * 8;
            u32x4 cin[10], bin[8];
#pragma unroll
            for (int k = 0; k < 10; ++k) cin[k] = ncin[k];
#pragma unroll
            for (int k = 0; k < 8; ++k) bin[k] = nbin[k];
            if (u + F.G < NCONV) RC_LOAD(u + F.G)
            const unsigned so0 = (unsigned)(r0 * YLD + 1024 + ch) * 2u; __builtin_amdgcn_sched_barrier(0);
            float prev[8], cur[8], nxt[8];
            unpack8(cin[0], prev); unpack8(cin[1], cur);
#pragma unroll
            for (int rr = 0; rr < 8; ++rr) { float bb[8]; unpack8(cin[rr + 2], nxt); unpack8(bin[rr], bb);
                float o[8];
#pragma unroll
                for (int j = 0; j < 8; ++j) { o[j] = bb[j] * (w0[j] * prev[j] + w1[j] * cur[j] + w2[j] * nxt[j] + cb[j]); prev[j] = cur[j]; cur[j] = nxt[j]; }
                u32x4 w; w.x = cvt_pk_bf16(o[0], o[1]); w.y = cvt_pk_bf16(o[2], o[3]); w.z = cvt_pk_bf16(o[4], o[5]); w.w = cvt_pk_bf16(o[6], o[7]);
                *(u32x4*)((char*)yin + (so0 + (unsigned)(rr * YLD * 2))) = w; __builtin_amdgcn_sched_barrier(0); }
        }
#undef RC_LOAD
    }
    {
        const int i = tid & 31; const bool second = ((i >> 3) & 1) != 0;
        float gq[4], gk[4], fr[4];
#pragma unroll
        for (int j = 0; j < 4; ++j) { gq[j] = P.in[I_EVQN][4 * i + j]; gk[j] = P.in[I_EVKN][4 * i + j]; const int fi = 4 * (i & 7) + j; fr[j] = __powf(10000.0f, -(float)(2 * fi) * (1.0f / 64.0f)); }
        u32x2 nwv[10], nv0, nv1;
#define RR_LOAD(un) { const bf16_t* rp_ = prj + (size_t)((un) * 16 + (tid >> 5)) * PRJ_LD + 4 * i; \
            _Pragma("unroll") for (int hh = 0; hh < 10; ++hh) nwv[hh] = *(const u32x2*)(rp_ + hh * 128); nv0 = *(const u32x2*)(rp_ + 1280); nv1 = *(const u32x2*)(rp_ + 1408); }
        int k = 0, u = rope_unit(F.c, 0, F.G); if (u >= 0) RR_LOAD(u)
        for (; u >= 0; ++k) {
            const int un = rope_unit(F.c, k + 1, F.G);
            const int row = u * 16 + (tid >> 5);
            const int b = row / TPB, p = row - b * TPB; const bool lat = p >= CTXL; const int t = p - CTXL;
            u32x2 wv[10];
#pragma unroll
            for (int hh = 0; hh < 10; ++hh) wv[hh] = nwv[hh];
            const u32x2 vv0 = nv0, vv1 = nv1;
            if (un >= 0) RR_LOAD(un)
            float cs[4], sn[4];
            { const int blk = i >> 4; const float pos = lat ? (float)(blk == 0 ? (t >> 6) : (t & 63)) : 0.f;
#pragma unroll
              for (int j = 0; j < 4; ++j) { float s_, c_; sincosf(pos * fr[j], &s_, &c_); cs[j] = c_; sn[j] = s_; } }
            bf16_t* rowp = prj + (size_t)row * PRJ_LD + 4 * i;
#pragma unroll
            for (int hh = 0; hh < 10; ++hh) {
                const u32x2 w = wv[hh]; float x[4] = {bf_lo(w.x), bf_hi(w.x), bf_lo(w.y), bf_hi(w.y)};
                float ss = x[0] * x[0] + x[1] * x[1] + x[2] * x[2] + x[3] * x[3];
#pragma unroll
                for (int o = 16; o >= 1; o >>= 1) ss += __shfl_xor(ss, o);
                const float rinv = __builtin_amdgcn_rsqf(ss * (1.0f / 128.0f) + EPS);
                float y[4];
#pragma unroll
                for (int j = 0; j < 4; ++j) y[j] = x[j] * rinv * (hh < 8 ? gq[j] : gk[j]);
                float o4[4];
#pragma unroll
                for (int j = 0; j < 4; ++j) { const float pr = __shfl_xor(y[j], 8); o4[j] = second ? (pr * sn[j] + y[j] * cs[j]) : (y[j] * cs[j] - pr * sn[j]); }
                wv[hh].x = cvt_pk_bf16(o4[0], o4[1]); wv[hh].y = cvt_pk_bf16(o4[2], o4[3]);
            }
#pragma unroll
            for (int hh = 0; hh < 8; ++hh) *(u32x2*)(rowp + hh * 128) = wv[hh];
            bf16_t* kc = (bf16_t*)(F.ws + WS_KC) + ((size_t)(b * 2) * TPB + p) * 128 + 4 * i; bf16_t* vc = (bf16_t*)(F.ws + WS_VC) + ((size_t)(b * 2) * TPB + p) * 128 + 4 * i;
            *(u32x2*)kc = wv[8]; *(u32x2*)(kc + (size_t)TPB * 128) = wv[9]; *(u32x2*)vc = vv0; *(u32x2*)(vc + (size_t)TPB * 128) = vv1;
            u = un;
        }
#undef RR_LOAD
    }
}

__device__ __forceinline__ void phase_attn(const Ctx& F) {
    const bf16_t* prj = (const bf16_t*)(F.ws + WS_PRJ); bf16_t* yin = (bf16_t*)(F.ws + WS_YIN);
    const int combo = F.c & 7, b = combo >> 1, kvh = combo & 1;
    const bf16_t* Kh = (const bf16_t*)(F.ws + WS_KC) + (size_t)(b * 2 + kvh) * TPB * 128; const bf16_t* Vh = (const bf16_t*)(F.ws + WS_VC) + (size_t)(b * 2 + kvh) * TPB * 128;
#define ATT_UNIT(i) do { const int w = (F.c >> 3) + 32 * (i); const int hq = kvh * 4 + ((i) < 2 ? (w >> 4) : (F.c >> 3)), qb = w & 15; \
        const size_t qrow = (size_t)b * TPB + ((i) < 2 ? CTXL + qb * 256 : 0); \
        att::attn_dense_body(prj + qrow * PRJ_LD + hq * 128, Kh, Vh, yin + qrow * YLD + hq * 128, (i) < 2 ? TPB : CTXL, F.ldsg, F.wid); } while (0)
    ATT_UNIT(0);
    ATT_UNIT(1);
    if (F.c < 32) ATT_UNIT(2);
#undef ATT_UNIT
}

__device__ __forceinline__ void phase_lru_conv(const Ctx& F) {
    const Params& P = F.P; const int tid = F.wid * 64 + lane_fresh();
    const bf16_t* prj = (const bf16_t*)(F.ws + WS_PRJ); bf16_t* U = (bf16_t*)(F.ws + WS_U);
    constexpr int RG = 8, NRG = MROWS / RG;
    const int gt = F.c * 512 + tid, nth = (F.G * 512) / 320;
    if (gt < nth * 320) {
        const int ch = (gt % 320) * 8; int rg = gt / 320;
        const float* cw = P.in[I_ODCW]; float w0[8], w1[8], w2[8], w3[8], cb[8];
#pragma unroll
        for (int j = 0; j < 8; ++j) { w0[j] = cw[ch + j]; w1[j] = cw[LRUW + ch + j]; w2[j] = cw[2 * LRUW + ch + j]; w3[j] = cw[3 * LRUW + ch + j]; cb[j] = P.in[I_ODCB][ch + j]; }
        u32x4 nin[RG + 3];
#define LC_LOAD(g) { const int r0_ = (g) * RG; const int b_ = r0_ / TPB, p_ = r0_ - b_ * TPB; const int lo_ = b_ * TPB + (p_ < CTXL ? 0 : CTXL), hi_ = b_ * TPB + (p_ < CTXL ? CTXL : TPB); \
            _Pragma("unroll") for (int k = 0; k < RG + 3; ++k) { const int row = r0_ - 1 + k; const int rc = row < lo_ ? lo_ : (row >= hi_ ? hi_ - 1 : row); \
                nin[k] = *(const u32x4*)((const char*)prj + (unsigned)(rc * PRJ_LD + ch) * 2u); if (row < lo_ || row >= hi_) nin[k] = (u32x4){0u, 0u, 0u, 0u}; } }
        if (rg < NRG) LC_LOAD(rg)
        for (; rg < NRG; rg += nth) {
            u32x4 xin[RG + 3];
#pragma unroll
            for (int k = 0; k < RG + 3; ++k) xin[k] = nin[k];
            if (rg + nth < NRG) LC_LOAD(rg + nth)
            const unsigned so0 = (unsigned)(rg * RG * LRUW + ch) * 2u; __builtin_amdgcn_sched_barrier(0);
#pragma unroll
            for (int rr = 0; rr < RG; ++rr) { float xm[8], x0[8], x1[8], x2[8]; unpack8(xin[rr], xm); unpack8(xin[rr + 1], x0); unpack8(xin[rr + 2], x1); unpack8(xin[rr + 3], x2);
                float o[8];
#pragma unroll
                for (int j = 0; j < 8; ++j) o[j] = w0[j] * xm[j] + w1[j] * x0[j] + w2[j] * x1[j] + w3[j] * x2[j] + cb[j];
                u32x4 w; w.x = cvt_pk_bf16(o[0], o[1]); w.y = cvt_pk_bf16(o[2], o[3]); w.z = cvt_pk_bf16(o[4], o[5]); w.w = cvt_pk_bf16(o[6], o[7]);
                *(u32x4*)((char*)U + (so0 + (unsigned)(rr * LRUW * 2))) = w; __builtin_amdgcn_sched_barrier(0); }
        }
#undef LC_LOAD
    }
}

__device__ __forceinline__ int scan_chunk_at(int d, int k) { return d == 0 ? k : (k < 4 ? 3 - k : 71 - k); }
__device__ __forceinline__ int scan_order_of(int d, int c) { return d == 0 ? c : (c < 4 ? 3 - c : 71 - c); }
__device__ __forceinline__ void scan_dec(unsigned w, float sp0, float sp1, float& a0, float& b0, float& a1, float& b1) {
    const float q0 = (float)(w & 0xffu) * (1.0f / 255.0f), q1 = (float)((w >> 16) & 0xffu) * (1.0f / 255.0f);
    a0 = __expf(q0 * q0 * sp0); a1 = __expf(q1 * q1 * sp1); b0 = __builtin_amdgcn_cvt_f32_fp8((int)w, 1); b1 = __builtin_amdgcn_cvt_f32_fp8((int)w, 3);
}
__device__ __forceinline__ float lru_sp(const float* lam, int d, int ch) { const float lm = lam[d * LRUW + ch]; return -8.0f * (fmaxf(-lm, 0.f) + __logf(1.0f + __expf(-fabsf(lm)))); }
__device__ __forceinline__ void phase_scan1(const Ctx& F) {
    const unsigned short* lav = (const unsigned short*)(F.ws + WS_LAGI); float* agg = (float*)(F.ws + WS_AGG); const int lane = lane_fresh(); const float* lam = F.P.in[I_ODLAM];
    float* carry = (float*)(F.ws + WS_CARRY); unsigned* scnt = (unsigned*)(F.ws + WS_SCNT);
    constexpr int NU = 2 * NB * 68 * 10;
    const int half = lane >> 5, sub = lane & 31;
    for (int u = F.c * 8 + F.wid; u < NU; u += F.G * 8) {
        const int cg = u % 10, c = (u / 10) % 68, b = (u / (10 * 68)) % NB, d = u / (10 * 68 * NB);
        const int ch = cg * 256 + sub * 8;
        const int r0 = d == 0 ? half * 32 : 63 - half * 32; const int rstep = d == 0 ? LRUW * 2 : -LRUW * 2;
        unsigned off = (unsigned)((((size_t)d * MROWS + (size_t)b * TPB + c * 64 + r0) * LRUW + ch) * 2);
        float hh[8], ss[8], sp[8];
#pragma unroll
        for (int j = 0; j < 8; ++j) { hh[j] = 0.f; ss[j] = 0.f; sp[j] = lru_sp(lam, d, ch + j); asm volatile("" : "+v"(sp[j])); }
#pragma unroll
        for (int blk = 0; blk < 2; ++blk) { u32x4 w[16];
#pragma unroll
            for (int kk = 0; kk < 16; ++kk) { w[kk] = *(const u32x4*)((const char*)lav + off); off += (unsigned)rstep; }
#pragma unroll
            for (int kk = 0; kk < 16; ++kk) {
#pragma unroll
                for (int p = 0; p < 4; ++p) { const unsigned x = p == 0 ? w[kk].x : (p == 1 ? w[kk].y : (p == 2 ? w[kk].z : w[kk].w));
                    const float q0 = (float)(x & 0xffu) * (1.0f / 255.0f), q1 = (float)((x >> 16) & 0xffu) * (1.0f / 255.0f); const float la0 = q0 * q0 * sp[2 * p], la1 = q1 * q1 * sp[2 * p + 1];
                    hh[2 * p] = __expf(la0) * hh[2 * p] + __builtin_amdgcn_cvt_f32_fp8((int)x, 1); hh[2 * p + 1] = __expf(la1) * hh[2 * p + 1] + __builtin_amdgcn_cvt_f32_fp8((int)x, 3); ss[2 * p] += la0; ss[2 * p + 1] += la1;
                    asm volatile("" : "+v"(hh[2 * p]), "+v"(hh[2 * p + 1]), "+v"(ss[2 * p]), "+v"(ss[2 * p + 1])); }
                __builtin_amdgcn_sched_barrier(0); }
        }
        float so[8], ho[8];
#pragma unroll
        for (int j = 0; j < 8; ++j) { so[j] = __shfl_xor(ss[j], 32); ho[j] = __shfl_xor(hh[j], 32); }
        if (half == 1) { float* ap = agg + ((((size_t)d * NB + b) * 68 + c) * LRUW + ch) * 2;
#pragma unroll
            for (int p = 0; p < 4; ++p) { const float h0 = __expf(ss[2 * p]) * ho[2 * p] + hh[2 * p], h1 = __expf(ss[2 * p + 1]) * ho[2 * p + 1] + hh[2 * p + 1];
                st_wt16(ap + 4 * p, (f32x4){ss[2 * p] + so[2 * p], h0, ss[2 * p + 1] + so[2 * p + 1], h1}); } }
        asm volatile("s_waitcnt vmcnt(0)" ::: "memory");
        unsigned old_ = 0u;
        if (lane == 0) old_ = __hip_atomic_fetch_add(scnt + (((d * NB + b) * 10 + cg) * 16), 1u, __ATOMIC_RELAXED, __HIP_MEMORY_SCOPE_AGENT);
        old_ = (unsigned)__builtin_amdgcn_readfirstlane((int)old_);
        if (old_ == 67u) {
            __builtin_amdgcn_fence(__ATOMIC_ACQUIRE, "agent");
            const int pch = cg * 256 + lane * 4; float st[4] = {0.f, 0.f, 0.f, 0.f};
            const float* ab = agg + (((size_t)d * NB + b) * 68 * LRUW + pch) * 2; float* cb = carry + ((size_t)d * NB + b) * 68 * LRUW + pch;
#pragma unroll 1
            for (int k0 = 0; k0 < 68; k0 += 17) { f32x4 a0[17], a1[17];
#pragma unroll
                for (int j = 0; j < 17; ++j) { const int cc = scan_chunk_at(d, k0 + j); a0[j] = *(const f32x4*)(ab + (size_t)cc * LRUW * 2); a1[j] = *(const f32x4*)(ab + (size_t)cc * LRUW * 2 + 4); }
#pragma unroll
                for (int j = 0; j < 17; ++j) { const int cc = scan_chunk_at(d, k0 + j);
                    *(f32x4*)(cb + (size_t)cc * LRUW) = (f32x4){st[0], st[1], st[2], st[3]};
                    st[0] = __expf(a0[j][0]) * st[0] + a0[j][1]; st[1] = __expf(a0[j][2]) * st[1] + a0[j][3]; st[2] = __expf(a1[j][0]) * st[2] + a1[j][1]; st[3] = __expf(a1[j][2]) * st[3] + a1[j][3]; } }
        }
    }
}
__device__ __forceinline__ void scan_carry(const float* agg, int d, int b, int c, int ch, float& h0, float& h1) {
    h0 = 0.f; h1 = 0.f; const int ord = scan_order_of(d, c);
    for (int k0 = 0; k0 < ord; k0 += 16) { f32x4 a[16];
#pragma unroll
        for (int j = 0; j < 16; ++j) { const int cc = scan_chunk_at(d, (k0 + j < ord) ? k0 + j : 0); a[j] = *(const f32x4*)(agg + ((((size_t)d * NB + b) * 68 + cc) * LRUW + ch) * 2);
            if (k0 + j >= ord) a[j] = (f32x4){0.f, 0.f, 0.f, 0.f}; }
#pragma unroll
        for (int j = 0; j < 16; ++j) { h0 = __expf(a[j][0]) * h0 + a[j][1]; h1 = __expf(a[j][2]) * h1 + a[j][3]; } }
}
__device__ __forceinline__ void phase_scan2(const Ctx& F) {
    const unsigned short* lav = (const unsigned short*)(F.ws + WS_LAGI); const float* carry = (const float*)(F.ws + WS_CARRY); const float* lam = F.P.in[I_ODLAM];
    const bf16_t* prj = (const bf16_t*)(F.ws + WS_PRJ); bf16_t* yin = (bf16_t*)(F.ws + WS_YIN); const int lane = lane_fresh();
    constexpr int NU = NB * 64 * 20;
    for (int u = F.c * 8 + F.wid; u < NU; u += F.G * 8) {
        const int cg = u % 20, c = 4 + (u / 20) % 64, b = u / (20 * 64);
        const int ch = cg * 128 + lane * 2; const size_t row0 = (size_t)b * TPB + c * 64;
        unsigned yf[64]; float h0, h1;
        { const f32x2 cv = *(const f32x2*)(carry + (((size_t)0 * NB + b) * 68 + c) * LRUW + ch); h0 = cv.x; h1 = cv.y; }
        { const size_t base = row0 * LRUW + ch;
          const float sp0 = lru_sp(lam, 0, ch), sp1 = lru_sp(lam, 0, ch + 1);
#pragma unroll
          for (int blk = 0; blk < 4; ++blk) { unsigned w[16];
#pragma unroll
            for (int r = 0; r < 16; ++r) w[r] = *(const unsigned*)(lav + base + (size_t)(blk * 16 + r) * LRUW);
#pragma unroll
            for (int r = 0; r < 16; ++r) { float a0, b0, a1, b1; scan_dec(w[r], sp0, sp1, a0, b0, a1, b1); h0 = a0 * h0 + b0; h1 = a1 * h1 + b1; yf[blk * 16 + r] = cvt_pk_bf16(h0, h1); } } }
        { const f32x2 cv = *(const f32x2*)(carry + (((size_t)1 * NB + b) * 68 + c) * LRUW + ch); h0 = cv.x; h1 = cv.y; }
        { const size_t base = (size_t)MROWS * LRUW + row0 * LRUW + ch;
          const float sp0 = lru_sp(lam, 1, ch), sp1 = lru_sp(lam, 1, ch + 1);
#pragma unroll
          for (int blk = 3; blk >= 0; --blk) { unsigned w[16]; unsigned gw[16];
#pragma unroll
            for (int r = 0; r < 16; ++r) { w[r] = *(const unsigned*)(lav + base + (size_t)(blk * 16 + r) * LRUW); gw[r] = *(const unsigned*)(prj + (row0 + blk * 16 + r) * PRJ_LD + LRUW + ch); }
#pragma unroll
            for (int r = 15; r >= 0; --r) { float a0, b0, a1, b1; scan_dec(w[r], sp0, sp1, a0, b0, a1, b1); h0 = a0 * h0 + b0; h1 = a1 * h1 + b1;
                const unsigned f = yf[blk * 16 + r]; gw[r] = cvt_pk_bf16((h0 + bf_lo(f)) * bf_lo(gw[r]), (h1 + bf_hi(f)) * bf_hi(gw[r])); }
#pragma unroll
            for (int r = 0; r < 16; ++r) *(unsigned*)(yin + (row0 + blk * 16 + r) * YLD + ch) = gw[r]; } }
    }
}

constexpr int NPHASE = 22;
constexpr int LDS_BYTES = 147456;
constexpr int LDS_MISC = 135168;
__global__ void __launch_bounds__(512, 2) mk_fwd(Params prm) {
    extern __shared__ __attribute__((aligned(16))) unsigned char lds_raw[];
    Ctx F; F.P = prm; F.ws = prm.ws; F.wid = __builtin_amdgcn_readfirstlane((int)threadIdx.x >> 6); F.G = gridDim.x; F.c = blockIdx.x;
    F.lds = (LAS unsigned char*)lds_raw; F.ldsg = (char*)lds_raw;
    volatile LAS unsigned* misc = (volatile LAS unsigned*)(F.lds + LDS_MISC);
    if (threadIdx.x < 4) misc[threadIdx.x] = 0u;
    __syncthreads();
    XcdBarrier bar; bar.bar = (unsigned*)(F.ws + WS_CTL); bar.x = 0; bar.st = misc; bar.wid = F.wid;
    const int lo = prm.ph_lo, hi = prm.ph_hi;
    if (hi - lo > 1) bar = xcd_barrier_post((unsigned*)(F.ws + WS_CTL), misc, F.wid);
#ifndef PH_MASK
#define PH_MASK 0xffffffffu
#endif
#define IN(k) ((((unsigned)PH_MASK >> (k)) & 1u) && lo <= (k) && (k) < hi)
#define SEAM(k) do { if (IN((k) + 1)) xcd_barrier(bar); } while (0)
#ifndef REP_MASK
#define REP_MASK 0u
#endif
#define NREP(k) ((((unsigned)REP_MASK >> (k)) & 1u) ? 2 : 1)
#define PHASE(k, ...) if (IN(k)) { for (int rep_ = 0; rep_ < NREP(k); ++rep_) { __VA_ARGS__ if (rep_ + 1 < NREP(k)) xcd_barrier(bar); } SEAM(k); }
    const float* mod = (const float*)(F.ws + WS_MOD);
    PHASE(0, p0_prologue(F);)
    PHASE(1, phase_norm<0>(F);)
    PHASE(2, if (F.c < F.G - NCV2) { SchedDense S{(const char*)(F.ws + WS_ACT), (const char*)(F.ws + WS_WEVIN), NMT, EV_IN / 256, F.G - NCV2, F.c, DM, DM, 0};
        EpiEvIn E{(bf16_t*)(F.ws + WS_PRJ), PRJ_LD}; pg8::gemm_phase<false, false>(F.lds, F.wid, pg8::Shape{DM, DM}, S, E); } else conv_range(F, GT0, GT2, F.G - NCV2);)
    PHASE(3, phase_rope_conv(F);)
    PHASE(4, phase_attn(F);)
    PHASE(5, if (F.c < F.G - NCV5) { SchedDense S{(const char*)(F.ws + WS_YIN), (const char*)(F.ws + WS_WEVOUT), NMT, DM / 256, F.G - NCV5, F.c, YLD, DM, 0};
        EpiResid E{prm.in[I_X], prm.in[I_CTX], (bf16_t*)(F.ws + WS_H), mod, 1}; pg8::gemm_phase<false, false>(F.lds, F.wid, pg8::Shape{DM, YLD}, S, E); } else conv_range(F, GT2, GT5, F.G - NCV5);)
    PHASE(6, phase_router(F, 0);)
    PHASE(7, phase_topk(F, 0);)
    PHASE(8, SchedMoe S{(const char*)(F.ws + WS_ACT), (const char*)(F.ws + WS_WGU), 9, 16, 2304, 4096, F.G, F.c, (const unsigned*)(F.ws + WS_OFFT)};
        EpiSwiglu E{F.ws + WS_HID, 2304}; pg8::gemm_phase<true, true>(F.lds, F.wid, pg8::Shape{DM / 2, DM / 2}, S, E);)
    PHASE(9, if (F.c < F.G - NCV9) { SchedMoe S{(const char*)(F.ws + WS_HID), (const char*)(F.ws + WS_WDN), 9, 8, 2304, 2048, F.G - NCV9, F.c, nullptr};
        EpiDown E{F.ws + WS_EO, (const float*)(F.ws + WS_GVAL), 2304}; pg8::gemm_phase<true, false>(F.lds, F.wid, pg8::Shape{DM / 2, DM / 2}, S, E); } else conv_range(F, GT5, GT9, F.G - NCV9);)
    PHASE(10, phase_norm<1>(F);)
    PHASE(11, if (F.c < F.G - NCV11) { SchedOdIn S{(const char*)(F.ws + WS_ACT), (const char*)(F.ws + WS_WODIN), F.G - NCV11, F.c};
        EpiPlainBf16 E{(bf16_t*)(F.ws + WS_PRJ), PRJ_LD, 10}; pg8::gemm_phase<false, false>(F.lds, F.wid, pg8::Shape{DM, DM}, S, E); } else conv_range(F, GT9, GT11, F.G - NCV11);)
    PHASE(12, phase_lru_conv(F);)
    PHASE(13, if (F.c < F.G - NCV13) { SchedLru S{(const char*)(F.ws + WS_U), (const char*)(F.ws + WS_WLRU), F.G - NCV13, F.c};
        EpiLru E{(const bf16_t*)(F.ws + WS_U), (unsigned*)(F.ws + WS_LAGI), prm.in[I_ODBA], prm.in[I_ODBX], prm.in[I_ODLAM]}; pg8::gemm_phase<false, false>(F.lds, F.wid, pg8::Shape{256, LRUW}, S, E); } else conv_range(F, GT11, GT13, F.G - NCV13);)
    PHASE(14, phase_scan1(F);)
    PHASE(15, phase_scan2(F);)
    PHASE(16, SchedDense S{(const char*)(F.ws + WS_YIN), (const char*)(F.ws + WS_WODOUT), 64, DM / 256, F.G, F.c, YLD, LRUW, 1};
        EpiResid E{prm.in[I_X], prm.in[I_CTX], (bf16_t*)(F.ws + WS_H), mod + 5 * MODN, 0}; pg8::gemm_phase<false, false>(F.lds, F.wid, pg8::Shape{LRUW, YLD}, S, E);)
    PHASE(17, phase_router(F, 1);)
    PHASE(18, phase_topk(F, 1);)
    PHASE(19, SchedMoe S{(const char*)(F.ws + WS_ACT), (const char*)(F.ws + WS_WGU) + (size_t)NEXP * 4096 * DM, 8, 16, 2048, 4096, F.G, F.c, (const unsigned*)(F.ws + WS_OFFT)};
        EpiSwiglu E{F.ws + WS_HID, 2048}; pg8::gemm_phase<true, true>(F.lds, F.wid, pg8::Shape{DM / 2, DM / 2}, S, E);)
    PHASE(20, SchedMoe S{(const char*)(F.ws + WS_HID), (const char*)(F.ws + WS_WDN) + (size_t)NEXP * DM * DM, 8, 8, 2048, 2048, F.G, F.c, nullptr};
        EpiDown E{F.ws + WS_EO, (const float*)(F.ws + WS_GVAL), 2048}; pg8::gemm_phase<true, false>(F.lds, F.wid, pg8::Shape{DM / 2, DM / 2}, S, E);)
    PHASE(21, phase_norm<2>(F);)
#undef IN
#undef SEAM
}

extern "C" void kernel_launch(void* const* d_in, const int* in_sizes, int n_in, void* d_out, int out_size, void* d_ws, size_t ws_size, hipStream_t stream) {
    static int grid = 0;
    if (grid == 0) {
        if (n_in != 28 || out_size != NB * SEQ * DM || ws_size < WS_END) { fprintf(stderr, "kernel_launch: bad shapes: n_in %d out %d ws %zu (need %zu)\n", n_in, out_size, ws_size, (size_t)WS_END); grid = -1; return; }
        int dev = 0, cus = 0, per_cu = 0;
        if (hipGetDevice(&dev) != hipSuccess || hipDeviceGetAttribute(&cus, hipDeviceAttributeMultiprocessorCount, dev) != hipSuccess) { grid = -1; return; }
        if (hipFuncSetAttribute((const void*)mk_fwd, hipFuncAttributeMaxDynamicSharedMemorySize, LDS_BYTES) != hipSuccess) { fprintf(stderr, "kernel_launch: hipFuncSetAttribute failed\n"); grid = -1; return; }
        if (hipOccupancyMaxActiveBlocksPerMultiprocessor(&per_cu, (const void*)mk_fwd, 512, LDS_BYTES) != hipSuccess || per_cu < 1) fprintf(stderr, "kernel_launch: occupancy query says %d\n", per_cu);
        (void)hipGetLastError();
        grid = cus;
    }
    if (grid < 0) return;
    (void)in_sizes;
    (void)hipMemsetAsync((char*)d_ws + WS_CTL, 0, 65536, stream);
    Params p{};
    for (int i = 0; i < 28; ++i) p.in[i] = (const float*)d_in[i];
    p.out = (float*)d_out; p.ws = (unsigned char*)d_ws;
#if MK_PER_PHASE
    for (int ph = 0; ph < NPHASE; ++ph) { p.ph_lo = ph; p.ph_hi = ph + 1; hipLaunchKernelGGL(mk_fwd, dim3(grid), dim3(512), LDS_BYTES, stream, p); }
#else
    p.ph_lo = 0; p.ph_hi = NPHASE; hipLaunchKernelGGL(mk_fwd, dim3(grid), dim3(512), LDS_BYTES, stream, p);
#endif
    const hipError_t le = hipPeekAtLastError();
    if (le != hipSuccess) fprintf(stderr, "kernel_launch: launch failed: %s\n", hipGetErrorName(le));
}
```

```cpp
#include <hip/hip_runtime.h>
#include <cstdio>
#include <cstdint>

#ifndef MK_PER_PHASE
#define MK_PER_PHASE 0
#endif

#define LAS __attribute__((address_space(3)))
typedef unsigned short bf16_t;
typedef short bf16x8 __attribute__((ext_vector_type(8)));
typedef short s16x4 __attribute__((ext_vector_type(4)));
typedef float f32x4 __attribute__((ext_vector_type(4)));
typedef float f32x2 __attribute__((ext_vector_type(2)));
typedef float f32x16 __attribute__((ext_vector_type(16)));
typedef unsigned u32x4 __attribute__((ext_vector_type(4)));
typedef unsigned u32x2 __attribute__((ext_vector_type(2)));
typedef int i32x8 __attribute__((ext_vector_type(8)));
typedef int i32x8a __attribute__((ext_vector_type(8), aligned(16)));
typedef int i32x4a __attribute__((ext_vector_type(4), aligned(16)));

#define XB_TMO      128
#define XB_XCNT(j)  (256  + 64 * (j))
#define XB_XSUB(j)  (1280 + 64 * (j))
#define XB_XGEN(j)  (2304 + 64 * (j))
#define XB_TOP      3328
#define XB_TOPGEN   3392
#define XCD_BAR_WORDS 3456
#define XB_SPIN_CAP (1u << 18)

__device__ __forceinline__ unsigned xb_ld(unsigned* p)              { return __hip_atomic_load(p, __ATOMIC_RELAXED, __HIP_MEMORY_SCOPE_AGENT); }
__device__ __forceinline__ unsigned xb_add(unsigned* p, unsigned v) { return __hip_atomic_fetch_add(p, v, __ATOMIC_RELAXED, __HIP_MEMORY_SCOPE_AGENT); }
__device__ __forceinline__ unsigned xb_xcc_id() { return (unsigned)__builtin_amdgcn_s_getreg((3 << 11) | 20) & 0xFu; }
#define XB_SPIN(cond, bar) do { unsigned _sp = 0; while (cond) { __builtin_amdgcn_s_sleep(1); \
    if ((++_sp & 255u) == 0u) { if (xb_ld(&(bar)[XB_TMO])) break; if (_sp > XB_SPIN_CAP) { atomicAdd(&(bar)[XB_TMO], 1u); break; } } } } while (0)

struct XcdBarrier { unsigned* bar; unsigned x; volatile LAS unsigned* st; int wid; };

__device__ __forceinline__ int xb_lane() { int l; asm volatile("v_mbcnt_lo_u32_b32 %0, -1, 0\n\tv_mbcnt_hi_u32_b32 %0, -1, %0" : "=v"(l)); return l; }
__device__ __forceinline__ XcdBarrier xcd_barrier_post(unsigned* bar, volatile LAS unsigned* st, int wid) {
    XcdBarrier b; b.bar = bar; b.x = xb_xcc_id(); b.st = st; b.wid = wid;
    if (wid == 0 && xb_lane() == 0) (void)xb_add(&bar[XB_XCNT(b.x)], 1u);
    return b;
}
__device__ __forceinline__ void xcd_barrier_complete(unsigned* bar, unsigned x, unsigned& nloc, unsigned& nx) {
    const unsigned G = gridDim.x * gridDim.y * gridDim.z;
    unsigned sum, cnt, mine, sp = 0u;
    for (;;) {
        sum = 0u; cnt = 0u; mine = 0u;
#pragma unroll
        for (unsigned j = 0; j < 16; ++j) { const unsigned c = xb_ld(&bar[XB_XCNT(j)]); sum += c; cnt += (c > 0u) ? 1u : 0u; mine = (j == x) ? c : mine; }
        if (sum == G) break;
        __builtin_amdgcn_s_sleep(1);
        if ((++sp & 255u) == 0u) { if (xb_ld(&bar[XB_TMO])) break; if (sp > XB_SPIN_CAP) { atomicAdd(&bar[XB_TMO], 1u); break; } }
    }
    nloc = mine > 0u ? mine : 1u; nx = cnt > 0u ? cnt : 1u;
}
__device__ __forceinline__ void xcd_barrier(const XcdBarrier& b) {
    asm volatile("s_waitcnt vmcnt(0)" ::: "memory");
    __syncthreads();
    if (b.wid == 0 && xb_lane() == 0) {
        unsigned* bar = b.bar;
        __builtin_amdgcn_s_waitcnt(0);
        unsigned nloc = b.st[0], nx = b.st[1];
        if (nloc == 0u) { xcd_barrier_complete(bar, b.x, nloc, nx); b.st[0] = nloc; b.st[1] = nx; }
        const unsigned old = xb_add(&bar[XB_XSUB(b.x)], 1u);
        const unsigned gen = old / nloc;
        if (old + 1u == (gen + 1u) * nloc) {
            __builtin_amdgcn_fence(__ATOMIC_RELEASE, "agent");
            asm volatile("s_waitcnt vmcnt(0)" ::: "memory");
            const unsigned og = xb_add(&bar[XB_TOP], 1u);
            const unsigned tg = og / nx;
            if (og + 1u == (tg + 1u) * nx) xb_add(&bar[XB_TOPGEN], 1u);
            else XB_SPIN(xb_ld(&bar[XB_TOPGEN]) == tg, bar);
            __builtin_amdgcn_fence(__ATOMIC_ACQUIRE, "agent");
            xb_add(&bar[XB_XGEN(b.x)], 1u);
            asm volatile("s_waitcnt vmcnt(0)" ::: "memory");
        } else {
            XB_SPIN(xb_ld(&bar[XB_XGEN(b.x)]) == gen, bar);
            __builtin_amdgcn_fence(__ATOMIC_ACQUIRE, "agent");
            asm volatile("s_waitcnt vmcnt(0)" ::: "memory");
        }
    }
    __syncthreads();
}

constexpr int DM = 2048, NB = 4, SEQ = 4096, CTXL = 256, TPB = SEQ + CTXL  , MROWS = NB * TPB  ;
constexpr int NMT = MROWS / 256;
constexpr int EV_IN = 4608, OD_IN = 5120, LRUW = 2560, PRJ_LD = 5120, YLD = 2560, MODN = 12288;
constexpr int NEXP = 16, FF = 2048;
constexpr float EPS = 1e-6f;
constexpr float W8_SCALE = 32.0f, W8_INV = 1.0f / 32.0f;

constexpr size_t al256(size_t x) { return (x + 255) / 256 * 256; }
constexpr size_t WS_CTL   = 0;
constexpr size_t WS_MOD   = 65536;
constexpr size_t WS_WEVIN = WS_MOD   + al256((size_t)2 * 5 * MODN * 4);
constexpr size_t WS_WEVOUT= WS_WEVIN + (size_t)EV_IN * DM * 2;
constexpr size_t WS_WODIN = WS_WEVOUT+ (size_t)DM * DM * 2;
constexpr size_t WS_WLRU  = WS_WODIN + (size_t)OD_IN * DM * 2;
constexpr size_t WS_WODOUT= WS_WLRU  + (size_t)2 * 10 * 512 * 256 * 2;
constexpr size_t WS_WGU   = WS_WODOUT+ (size_t)DM * LRUW * 2;
constexpr size_t WS_WDN   = WS_WGU   + (size_t)2 * NEXP * 4096 * DM;
constexpr size_t WS_H     = WS_WDN   + (size_t)2 * NEXP * DM * DM;
constexpr size_t WS_ACT   = WS_H     + (size_t)MROWS * DM * 4;
constexpr size_t WS_PRJ   = WS_ACT   + (size_t)MROWS * DM * 2;
constexpr size_t WS_U     = WS_PRJ   + (size_t)MROWS * PRJ_LD * 2;
constexpr size_t WS_YIN   = WS_U     + (size_t)MROWS * LRUW * 2;
constexpr size_t WS_AFF   = WS_YIN   + (size_t)MROWS * YLD * 2;
constexpr size_t WS_SLOT  = WS_AFF   + (size_t)MROWS * 16 * 4;
constexpr size_t WS_GVAL  = WS_SLOT  + (size_t)MROWS * 16 * 4;
constexpr size_t WS_OFFT  = WS_GVAL  + al256((size_t)NEXP * 2304 * 4);
constexpr size_t WS_AGG   = WS_OFFT  + al256((size_t)NEXP * 2304 * 4);
constexpr size_t WS_XS    = WS_AGG   + (size_t)2 * NB * 68 * LRUW * 8;
constexpr size_t WS_HID   = WS_XS    + (size_t)NEXP * 2304 * DM * 2;
constexpr size_t WS_EO    = WS_HID   + (size_t)NEXP * 2304 * DM * 2;
constexpr size_t WS_KC    = WS_EO    + (size_t)NEXP * 2304 * DM * 2;
constexpr size_t WS_VC    = WS_KC    + (size_t)NB * 2 * TPB * 128 * 2;
constexpr size_t WS_CARRY = WS_VC    + (size_t)NB * 2 * TPB * 128 * 2;
constexpr size_t WS_END   = WS_CARRY + (size_t)2 * NB * 68 * LRUW * 4;
constexpr size_t WS_SCNT  = WS_CTL + 16384;
constexpr size_t WS_LAGI  = WS_XS;
static_assert((size_t)2 * MROWS * LRUW * 4 <= WS_KC - WS_XS, "LAGI alias");

struct Params { const float* in[28]; float* out; unsigned char* ws; int ph_lo, ph_hi; };
enum { I_X = 0, I_C, I_CTX, I_CCTX, I_MODW, I_MODB, I_N1G, I_N2G, I_EVWIN, I_EVQN, I_EVKN, I_EVCW, I_EVCB, I_EVWOUT, I_ODWIN, I_ODCW, I_ODCB, I_ODWA, I_ODBA, I_ODWX, I_ODBX,
       I_ODLAM, I_ODWOUT, I_ROUTER, I_WGATE, I_WUP, I_WDOWN, I_FNG };

__device__ __forceinline__ unsigned cvt_pk_bf16(float lo, float hi) { unsigned r; asm volatile("v_cvt_pk_bf16_f32 %0, %1, %2" : "=v"(r) : "v"(lo), "v"(hi)); return r; }
__device__ __forceinline__ unsigned pk4_fp8(float a, float b, float c, float d) { int w = 0; w = __builtin_amdgcn_cvt_pk_fp8_f32(a, b, w, false); w = __builtin_amdgcn_cvt_pk_fp8_f32(c, d, w, true); return (unsigned)w; }
#define GAS __attribute__((address_space(1)))
__device__ __forceinline__ f32x4 ld_nt(const float* p) { return __builtin_nontemporal_load((const GAS f32x4*)(const GAS float*)p); }
__device__ __forceinline__ void st_nt(float* p, f32x4 v) { __builtin_nontemporal_store(v, (GAS f32x4*)(GAS float*)p); }
__device__ __forceinline__ void st_wt16(float* p, f32x4 v) { asm volatile("global_store_dwordx4 %0, %1, off sc1\n\ts_nop 1" :: "v"(p), "v"(v) : "memory"); }
__device__ __forceinline__ float bf_lo(unsigned w) { return __uint_as_float(w << 16); }
__device__ __forceinline__ float bf_hi(unsigned w) { return __uint_as_float(w & 0xffff0000u); }
__device__ __forceinline__ int lane_fresh() { int l; asm volatile("v_mbcnt_lo_u32_b32 %0, -1, 0\n\tv_mbcnt_hi_u32_b32 %0, -1, %0" : "=v"(l)); return l; }
__device__ __forceinline__ float wave_sum(float v) {
#pragma unroll
    for (int o = 32; o >= 1; o >>= 1) v += __shfl_xor(v, o);
    return v;
}
__device__ __forceinline__ float fast_sigmoid(float x) { return __builtin_amdgcn_rcpf(1.0f + __builtin_amdgcn_exp2f(-1.4426950408889634f * x)); }
__device__ __forceinline__ float gelu_tanh(float x) { const float t = 0.7978845608028654f * (x + 0.044715f * x * x * x); return x * fast_sigmoid(2.0f * t); }
__device__ __forceinline__ int xcd_remap(int L, int nwg) { const int q = nwg >> 3, r = nwg & 7, xcd = L & 7, off = L >> 3; return (xcd < r ? xcd * (q + 1) : r * (q + 1) + (xcd - r) * q) + off; }

namespace pg8 {
constexpr int BM = 256, BK = 64, HALF = 128, HTB = HALF * BK * 2, STAGE_BYTES = 8 * HTB;
__device__ __forceinline__ int lds_byte(int r, int c) { const int st = (r >> 4) * 2 + (c >> 5), rr = r & 15, cc = c & 31, ob = rr * 64 + cc * 2; return st * 1024 + (ob ^ (((ob >> 9) & 1) << 5)); }
__device__ __forceinline__ void stage_rc(int b, int& R, int& C) { const int st = b / 1024, sb = b % 1024, swz = sb ^ (((sb >> 9) & 1) << 5); R = (st >> 1) * 16 + swz / 64; C = (st & 1) * 32 + (swz % 64) / 2; }
__device__ __forceinline__ int perm32(int rho) { const int n = rho >> 4, i = rho & 15; return 8 * (i >> 2) + 4 * n + (i & 3); }
struct Unit { int pm, pn, e; };
__device__ __forceinline__ void glds16_s(const void* base_uniform, unsigned voff, unsigned lds_dst) {
    unsigned keep;
    asm volatile("s_mov_b32 %0, m0\n\ts_mov_b32 m0, %3\n\ts_nop 0\n\tglobal_load_lds_dwordx4 %1, %2\n\ts_mov_b32 m0, %0" : "=&s"(keep) : "v"(voff), "s"(base_uniform), "s"(lds_dst) : "memory");
}
struct Shape { int K, lda; };

template <bool FP8, bool GATHER, class Epi, class Sched>
__device__ __forceinline__ void gemm_phase(LAS unsigned char* lds, int wid_in, const Shape g, const Sched& S, const Epi& E) {
    const int lane = lane_fresh(), wid = wid_in, tid = wid * 64 + lane, wr = wid >> 2, wc = wid & 3, fr = lane & 15, fq = lane >> 4;
    const int K = g.K, nt = K / BK;
    unsigned voffA[2], voffB[2]; int gR[2]; unsigned gC[2];
#pragma unroll
    for (int i = 0; i < 2; ++i) { int R, C; stage_rc(tid * 16 + i * 8192, R, C); const int Rb = Epi::PERM ? ((R & ~31) + perm32(R & 31)) : R;
        voffA[i] = (unsigned)(R * g.lda + C) * 2u; voffB[i] = (unsigned)(Rb * K + C) * 2u; gR[i] = R; gC[i] = (unsigned)C * 2u; }
    unsigned coff[2][2], noff[2][2], nnoff[2][2];
#define PG8_LOADOFF(dst, un) do { const unsigned* tb_ = S.offtab() + S.slotbase(un); _Pragma("unroll") for (int h_ = 0; h_ < 2; ++h_) _Pragma("unroll") for (int i_ = 0; i_ < 2; ++i_) dst[h_][i_] = tb_[h_ * 128 + gR[i_]] + gC[i_]; } while (0)
#define PG8_STAGE_A(bufoff, kb, h, nx) do { if constexpr (GATHER) { _Pragma("unroll") for (int _i = 0; _i < 2; ++_i) glds16_s(S.gbase() + (kb), (nx) ? noff[h][_i] : coff[h][_i], ldsb + (unsigned)((bufoff) + _i * 8192)); } \
        else { PG8_STAGE(bufoff, ((nx) ? nA : cA) + (kb) + (h) * hstepA, voffA); } } while (0)
    const size_t kstep = (size_t)(BK * 2);
    const size_t hstepA = (size_t)HALF * g.lda * 2, hstepB = (size_t)HALF * K * 2;
    const unsigned ldsb = (unsigned)(uintptr_t)lds + (unsigned)wid * 1024u;
    const int aoff = lds_byte(wr * 64 + fr, fq * 8), boff = lds_byte(wc * 32 + fr, fq * 8);
#define PG8_SA(b, h) (((b) * 2 + (h)) * HTB)
#define PG8_SB(b, h) ((4 + (b) * 2 + (h)) * HTB)
#define PG8_STAGE(bufoff, gbase, voff) do { _Pragma("unroll") for (int _i = 0; _i < 2; ++_i) glds16_s((gbase), (voff)[_i], ldsb + (unsigned)((bufoff) + _i * 8192)); } while (0)
#define PG8_LD32(p) __builtin_shufflevector(*(const LAS i32x4a*)(p), *(const LAS i32x4a*)((p) + 1024), 0, 1, 2, 3, 4, 5, 6, 7)
#define PG8_LDA(dst, b, h) do { if constexpr (FP8) { _Pragma("unroll") for (int m = 0; m < 4; ++m) dst##8[m] = PG8_LD32(lds + PG8_SA(b, h) + aoff + m * 2048); } \
        else { _Pragma("unroll") for (int m = 0; m < 4; ++m) _Pragma("unroll") for (int k = 0; k < 2; ++k) dst[m][k] = *(const LAS bf16x8*)(lds + PG8_SA(b, h) + aoff + m * 2048 + k * 1024); } } while (0)
#define PG8_LDB(dst, b, h) do { if constexpr (FP8) { _Pragma("unroll") for (int n = 0; n < 2; ++n) dst##8[n] = PG8_LD32(lds + PG8_SB(b, h) + boff + n * 2048); } \
        else { _Pragma("unroll") for (int n = 0; n < 2; ++n) _Pragma("unroll") for (int k = 0; k < 2; ++k) dst[n][k] = *(const LAS bf16x8*)(lds + PG8_SB(b, h) + boff + n * 2048 + k * 1024); } } while (0)
#define PG8_MMA(ai, bj, At, Bt) do { __builtin_amdgcn_s_setprio(1); _Pragma("unroll") for (int m = 0; m < 4; ++m) _Pragma("unroll") for (int n = 0; n < 2; ++n) { \
        f32x16& av_ = accv[ai][bj][m >> 1]; constexpr int dummy_ = 0; (void)dummy_; const int g_ = ((m & 1) * 2 + n) * 4; f32x4 c_ = (f32x4){av_[g_], av_[g_ + 1], av_[g_ + 2], av_[g_ + 3]}; \
        if constexpr (FP8) c_ = __builtin_amdgcn_mfma_scale_f32_16x16x128_f8f6f4(Bt##8[n], At##8[m], c_, 0, 0, 0, 127, 0, 127); \
        else { _Pragma("unroll") for (int k = 0; k < 2; ++k) c_ = __builtin_amdgcn_mfma_f32_16x16x32_bf16(Bt[n][k], At[m][k], c_, 0, 0, 0); } \
        av_[g_] = c_[0]; av_[g_ + 1] = c_[1]; av_[g_ + 2] = c_[2]; av_[g_ + 3] = c_[3]; } __builtin_amdgcn_s_setprio(0); } while (0)
#define PG8_WAIT_V(n) asm volatile("s_waitcnt vmcnt(" #n ")" ::: "memory")
#define PG8_WAIT_L(n) asm volatile("s_waitcnt lgkmcnt(" #n ")" ::: "memory")
#define PG8_BAR __builtin_amdgcn_s_barrier()
#define PG8_SCHED __builtin_amdgcn_sched_barrier(0)
    Unit cur, nxt; int ui = 0;
    if (!S.next(0, cur)) return;
    f32x16 accv[2][2][2];
#pragma unroll
    for (int a = 0; a < 2; ++a)
#pragma unroll
        for (int b = 0; b < 2; ++b)
#pragma unroll
            for (int m = 0; m < 2; ++m)
#pragma unroll
                for (int j = 0; j < 16; ++j) accv[a][b][m][j] = 0.f;
    bf16x8 At[4][2], B0[2][2], B1[2][2]; i32x8 At8[4], B08[2], B18[2];
    const char* cA = S.abase(cur); const char* cB = S.bbase(cur); const char* nA = cA;
    if constexpr (GATHER) { PG8_LOADOFF(coff, cur); Unit n1; if (S.next(1, n1)) PG8_LOADOFF(noff, n1); else PG8_LOADOFF(noff, cur); }
    PG8_STAGE(PG8_SB(0, 0), cB, voffB); PG8_STAGE_A(PG8_SA(0, 0), 0, 0, false); PG8_STAGE(PG8_SB(0, 1), cB + hstepB, voffB); PG8_STAGE_A(PG8_SA(0, 1), 0, 1, false);
    if (wr == 1) PG8_BAR;
    PG8_WAIT_V(4); PG8_BAR;
    PG8_STAGE(PG8_SB(1, 0), cB + kstep, voffB); PG8_STAGE_A(PG8_SA(1, 0), kstep, 0, false); PG8_STAGE(PG8_SB(1, 1), cB + hstepB + kstep, voffB);
    PG8_WAIT_V(6); PG8_BAR;
    for (;;) {
        const bool has_next = S.next(ui + 1, nxt);
        nA = has_next ? S.abase(nxt) : cA; const char* nB = has_next ? S.bbase(nxt) : cB;
        bool has_nn = false;
        if constexpr (GATHER) { Unit nn; has_nn = S.next(ui + 2, nn);
            if (has_nn) { const unsigned* tb_ = S.offtab() + S.slotbase(nn); _Pragma("unroll") for (int h_ = 0; h_ < 2; ++h_) _Pragma("unroll") for (int i_ = 0; i_ < 2; ++i_) nnoff[h_][i_] = tb_[h_ * 128 + gR[i_]]; } }
        for (int t = 0; t < nt; t += 2) {
            const bool last = (t == nt - 2);
            const size_t k1 = (size_t)(t + 1) * kstep, k2 = last ? 0 : (size_t)(t + 2) * kstep, k3 = k2 + kstep;
            const char* b2 = last ? nB : cB + (size_t)(t + 2) * kstep; const char* b3 = b2 + kstep;
            PG8_LDB(B0, 0, 0); PG8_SCHED; PG8_LDA(At, 0, 0); PG8_STAGE_A(PG8_SA(1, 1), k1, 1, false);
            PG8_WAIT_L(8); PG8_BAR; PG8_WAIT_L(0); PG8_MMA(0, 0, At, B0); PG8_BAR; PG8_SCHED;
            PG8_LDB(B1, 0, 1); PG8_STAGE(PG8_SB(0, 0), b2, voffB);
            PG8_BAR; PG8_WAIT_L(0); PG8_MMA(0, 1, At, B1); PG8_BAR;
            PG8_LDA(At, 0, 1); PG8_STAGE_A(PG8_SA(0, 0), k2, 0, last);
            PG8_BAR; PG8_WAIT_L(0); PG8_MMA(1, 0, At, B0); PG8_BAR; PG8_SCHED;
            PG8_STAGE(PG8_SB(0, 1), b2 + hstepB, voffB);
            PG8_WAIT_V(6); PG8_BAR; PG8_MMA(1, 1, At, B1); PG8_BAR;
            PG8_LDB(B0, 1, 0); PG8_SCHED; PG8_LDA(At, 1, 0); PG8_STAGE_A(PG8_SA(0, 1), k2, 1, last);
            PG8_WAIT_L(8); PG8_BAR; PG8_WAIT_L(0); PG8_MMA(0, 0, At, B0); PG8_BAR; PG8_SCHED;
            PG8_LDB(B1, 1, 1); PG8_STAGE(PG8_SB(1, 0), b3, voffB);
            PG8_BAR; PG8_WAIT_L(0); PG8_MMA(0, 1, At, B1); PG8_BAR;
            PG8_LDA(At, 1, 1); PG8_STAGE_A(PG8_SA(1, 0), k3, 0, last);
            PG8_BAR; PG8_WAIT_L(0); PG8_MMA(1, 0, At, B0); PG8_BAR; PG8_SCHED;
            PG8_STAGE(PG8_SB(1, 1), b3 + hstepB, voffB);
            PG8_WAIT_V(6); PG8_BAR; PG8_MMA(1, 1, At, B1); PG8_BAR;
        }
        { f32x4 acc[2][2][4][2];
#pragma unroll
          for (int a = 0; a < 2; ++a)
#pragma unroll
            for (int b = 0; b < 2; ++b)
#pragma unroll
              for (int m = 0; m < 4; ++m)
#pragma unroll
                for (int n = 0; n < 2; ++n) { const int g_ = ((m & 1) * 2 + n) * 4; acc[a][b][m][n] = (f32x4){accv[a][b][m >> 1][g_], accv[a][b][m >> 1][g_ + 1], accv[a][b][m >> 1][g_ + 2], accv[a][b][m >> 1][g_ + 3]}; }
          const int le_ = lane_fresh(); E(acc, cur, wr, wc, le_ & 15, le_ >> 4); }
        if (!has_next) break;
#pragma unroll
        for (int a = 0; a < 2; ++a)
#pragma unroll
            for (int b = 0; b < 2; ++b)
#pragma unroll
                for (int m = 0; m < 2; ++m)
#pragma unroll
                    for (int j = 0; j < 16; ++j) accv[a][b][m][j] = 0.f;
        cur = nxt; cA = nA; cB = nB; ++ui;
        if constexpr (GATHER) {
#pragma unroll
            for (int h_ = 0; h_ < 2; ++h_)
#pragma unroll
                for (int i_ = 0; i_ < 2; ++i_) { coff[h_][i_] = noff[h_][i_]; if (has_nn) noff[h_][i_] = nnoff[h_][i_] + gC[i_]; } }
    }
    PG8_WAIT_V(0);
    if (wr == 0) PG8_BAR;
    PG8_BAR;
#undef PG8_SA
#undef PG8_SB
#undef PG8_STAGE
#undef PG8_STAGE_A
#undef PG8_LOADOFF
#undef PG8_LDA
#undef PG8_LD32
#undef PG8_LDB
#undef PG8_MMA
#undef PG8_WAIT_V
#undef PG8_WAIT_L
#undef PG8_BAR
#undef PG8_SCHED
}
}
using pg8::Unit;

struct SchedDense {
    __device__ __forceinline__ const unsigned* offtab() const { return nullptr; }
    __device__ __forceinline__ int slotbase(const Unit&) const { return 0; }
    __device__ __forceinline__ const char* gbase() const { return nullptr; }
    const char* A; const char* Bt; int nM, nN, G, c, lda, K, lat_only;
    __device__ __forceinline__ bool next(int i, Unit& u) const {
        const int nwg = nM * nN; const int L = i * G + c; if (L >= nwg) return false;
        const int w = xcd_remap(L, nwg);
        const int nig = 8 * nN, gid = w / nig, fm = gid * 8, gsz = (nM - fm) < 8 ? (nM - fm) : 8;
        const int lm = fm + ((w % nig) % gsz); u.pn = (w % nig) / gsz; u.pm = lat_only ? (lm + (lm >> 4) + 1) : lm; u.e = 0; return true;
    }
    __device__ __forceinline__ const char* abase(const Unit& u) const { return A + (size_t)u.pm * 256 * lda * 2; }
    __device__ __forceinline__ const char* bbase(const Unit& u) const { return Bt + (size_t)u.pn * 256 * K * 2; }
};
struct SchedOdIn {
    __device__ __forceinline__ const unsigned* offtab() const { return nullptr; }
    __device__ __forceinline__ int slotbase(const Unit&) const { return 0; }
    __device__ __forceinline__ const char* gbase() const { return nullptr; }
    const char* A; const char* Bt; int G, c;
    __device__ __forceinline__ bool next(int i, Unit& u) const {
        const int L = i * G + c; if (L >= 1320) return false;
        if (L < 1280) { const int w = xcd_remap(L, 1280); const int nig = 8 * 20, gid = w / nig, fm = gid * 8; const int lm = fm + ((w % nig) % 8); u.pn = (w % nig) / 8; u.pm = lm + (lm >> 4) + 1; }
        else { const int q = L - 1280; u.pm = 17 * (q & 3); u.pn = q >> 2; }
        u.e = 0; return true;
    }
    __device__ __forceinline__ const char* abase(const Unit& u) const { return A + (size_t)u.pm * 256 * DM * 2; }
    __device__ __forceinline__ const char* bbase(const Unit& u) const { return Bt + (size_t)u.pn * 256 * DM * 2; }
};
struct SchedLru {
    __device__ __forceinline__ const unsigned* offtab() const { return nullptr; }
    __device__ __forceinline__ int slotbase(const Unit&) const { return 0; }
    __device__ __forceinline__ const char* gbase() const { return nullptr; }
    const char* A; const char* Bt; int G, c;
    __device__ __forceinline__ bool next(int i, Unit& u) const {
        const int L = i * G + c; if (L >= NMT * 40) return false;
        const int w = xcd_remap(L, NMT * 40); const int q = w % 40; u.pm = w / 40; u.e = q >> 1; u.pn = q & 1; return true;
    }
    __device__ __forceinline__ const char* abase(const Unit& u) const { return A + ((size_t)u.pm * 256 * LRUW + (u.e % 10) * 256) * 2; }
    __device__ __forceinline__ const char* bbase(const Unit& u) const { return Bt + ((size_t)u.e * 512 + u.pn * 256) * 256 * 2; }
};
struct SchedMoe {
    const char* A; const char* Bt; int nMe, nN, estr, brows, G, c; const unsigned* otab;
    __device__ __forceinline__ const unsigned* offtab() const { return otab; }
    __device__ __forceinline__ int slotbase(const Unit& u) const { return u.e * estr + u.pm * 256; }
    __device__ __forceinline__ const char* gbase() const { return A; }
    __device__ __forceinline__ bool next(int i, Unit& u) const {
        const int per = nMe * nN, nwg = NEXP * per; const int L = i * G + c; if (L >= nwg) return false;
        const int w = xcd_remap(L, nwg); u.e = w / per; const int r = w % per; u.pm = r % nMe; u.pn = r / nMe; return true;
    }
    __device__ __forceinline__ const char* abase(const Unit& u) const { return A + ((size_t)u.e * estr + u.pm * 256) * DM; }
    __device__ __forceinline__ const char* bbase(const Unit& u) const { return Bt + ((size_t)u.e * brows + u.pn * 256) * DM; }
};

struct EpiPlainBf16 {
    static constexpr bool PERM = true;
    bf16_t* O; int ldc; int gelu_from;
    __device__ __forceinline__ void operator()(const f32x4 (&acc)[2][2][4][2], const Unit& u, int wr, int wc, int fr, int fq) const {
        const int row0 = u.pm * 256 + wr * 64 + fr, col0 = u.pn * 256 + wc * 32 + 8 * fq; const bool gl = u.pn >= gelu_from;
#pragma unroll
        for (int ai = 0; ai < 2; ++ai)
#pragma unroll
            for (int m = 0; m < 4; ++m) { bf16_t* rowp = O + (size_t)(row0 + ai * 128 + m * 16) * ldc + col0;
#pragma unroll
                for (int bj = 0; bj < 2; ++bj) { f32x4 v0 = acc[ai][bj][m][0], v1 = acc[ai][bj][m][1];
                    if (gl) {
#pragma unroll
                        for (int j = 0; j < 4; ++j) { v0[j] = gelu_tanh(v0[j]); v1[j] = gelu_tanh(v1[j]); } }
                    u32x4 w; w.x = cvt_pk_bf16(v0[0], v0[1]); w.y = cvt_pk_bf16(v0[2], v0[3]); w.z = cvt_pk_bf16(v1[0], v1[1]); w.w = cvt_pk_bf16(v1[2], v1[3]);
                    *(u32x4*)(rowp + bj * 128) = w; } }
    }
};
struct EpiEvIn {
    static constexpr bool PERM = true;
    bf16_t* O; int ldc;
    __device__ __forceinline__ void operator()(const f32x4 (&acc)[2][2][4][2], const Unit& u, int wr, int wc, int fr, int fq) const {
        const int row0 = u.pm * 256 + wr * 64 + fr;
        if (u.pn < 10) { const int col0 = u.pn * 256 + wc * 32 + 8 * fq;
#pragma unroll
            for (int ai = 0; ai < 2; ++ai)
#pragma unroll
                for (int m = 0; m < 4; ++m) { bf16_t* rowp = O + (size_t)(row0 + ai * 128 + m * 16) * ldc + col0;
#pragma unroll
                    for (int bj = 0; bj < 2; ++bj) { const f32x4 v0 = acc[ai][bj][m][0], v1 = acc[ai][bj][m][1];
                        u32x4 w; w.x = cvt_pk_bf16(v0[0], v0[1]); w.y = cvt_pk_bf16(v0[2], v0[3]); w.z = cvt_pk_bf16(v1[0], v1[1]); w.w = cvt_pk_bf16(v1[2], v1[3]);
                        *(u32x4*)(rowp + bj * 128) = w; } }
        } else { const int col0 = 2560 + (u.pn - 10) * 128 + wc * 32 + 8 * fq;
#pragma unroll
            for (int ai = 0; ai < 2; ++ai)
#pragma unroll
                for (int m = 0; m < 4; ++m) { const f32x4 v0 = acc[ai][0][m][0] * acc[ai][1][m][0], v1 = acc[ai][0][m][1] * acc[ai][1][m][1];
                    u32x4 w; w.x = cvt_pk_bf16(v0[0], v0[1]); w.y = cvt_pk_bf16(v0[2], v0[3]); w.z = cvt_pk_bf16(v1[0], v1[1]); w.w = cvt_pk_bf16(v1[2], v1[3]);
                    *(u32x4*)(O + (size_t)(row0 + ai * 128 + m * 16) * ldc + col0) = w; }
        }
    }
};
struct EpiResid {
    static constexpr bool PERM = true;
    const float* x; const float* ctx; bf16_t* h; const float* mod; int layer0;
    __device__ __forceinline__ void operator()(const f32x4 (&acc)[2][2][4][2], const Unit& u, int wr, int wc, int fr, int fq) const {
        const int b = u.pm / 17, pt = u.pm - b * 17;
        const float* hold = pt == 0 ? ctx + (size_t)b * CTXL * DM : x + ((size_t)b * SEQ + (pt - 1) * 256) * DM;
        bf16_t* ho = h + (size_t)u.pm * 256 * DM;
        const float* gate = mod + (size_t)(pt == 0 ? 4 : b) * MODN + 4096;
        const int r0 = wr * 64 + fr, col0 = u.pn * 256 + wc * 32 + 8 * fq;
        f32x4 gv[2][2];
#pragma unroll
        for (int bj = 0; bj < 2; ++bj)
#pragma unroll
            for (int n = 0; n < 2; ++n) gv[bj][n] = *(const f32x4*)(gate + col0 + bj * 128 + n * 4);
#pragma unroll
        for (int ai = 0; ai < 2; ++ai) {
            if (layer0) { f32x4 hv[4][2][2];
#pragma unroll
                for (int m = 0; m < 4; ++m) { const size_t off = (size_t)(r0 + ai * 128 + m * 16) * DM + col0;
#pragma unroll
                    for (int bj = 0; bj < 2; ++bj)
#pragma unroll
                        for (int n = 0; n < 2; ++n) hv[m][bj][n] = *(const f32x4*)(hold + off + bj * 128 + n * 4); }
#pragma unroll
                for (int m = 0; m < 4; ++m) { const size_t off = (size_t)(r0 + ai * 128 + m * 16) * DM + col0;
#pragma unroll
                    for (int bj = 0; bj < 2; ++bj) { const f32x4 v0 = hv[m][bj][0] + gv[bj][0] * acc[ai][bj][m][0], v1 = hv[m][bj][1] + gv[bj][1] * acc[ai][bj][m][1];
                        u32x4 w; w.x = cvt_pk_bf16(v0[0], v0[1]); w.y = cvt_pk_bf16(v0[2], v0[3]); w.z = cvt_pk_bf16(v1[0], v1[1]); w.w = cvt_pk_bf16(v1[2], v1[3]); *(u32x4*)(ho + off + bj * 128) = w; } }
            } else { u32x4 hw[4][2];
#pragma unroll
                for (int m = 0; m < 4; ++m) { const size_t off = (size_t)(r0 + ai * 128 + m * 16) * DM + col0;
#pragma unroll
                    for (int bj = 0; bj < 2; ++bj) hw[m][bj] = *(const u32x4*)(ho + off + bj * 128); }
#pragma unroll
                for (int m = 0; m < 4; ++m) { const size_t off = (size_t)(r0 + ai * 128 + m * 16) * DM + col0;
#pragma unroll
                    for (int bj = 0; bj < 2; ++bj) { const u32x4 q = hw[m][bj];
                        const f32x4 v0 = (f32x4){bf_lo(q.x), bf_hi(q.x), bf_lo(q.y), bf_hi(q.y)} + gv[bj][0] * acc[ai][bj][m][0], v1 = (f32x4){bf_lo(q.z), bf_hi(q.z), bf_lo(q.w), bf_hi(q.w)} + gv[bj][1] * acc[ai][bj][m][1];
                        u32x4 w; w.x = cvt_pk_bf16(v0[0], v0[1]); w.y = cvt_pk_bf16(v0[2], v0[3]); w.z = cvt_pk_bf16(v1[0], v1[1]); w.w = cvt_pk_bf16(v1[2], v1[3]); *(u32x4*)(ho + off + bj * 128) = w; } } }
        }
    }
};
struct EpiSwiglu {
    static constexpr bool PERM = true;
    unsigned char* O; int estr;
    __device__ __forceinline__ void operator()(const f32x4 (&acc)[2][2][4][2], const Unit& u, int wr, int wc, int fr, int fq) const {
        const unsigned row0 = (unsigned)(u.e * estr + u.pm * 256 + wr * 64 + fr); const unsigned col0 = (unsigned)(u.pn * 128 + wc * 32 + 8 * fq);
#pragma unroll
        for (int ai = 0; ai < 2; ++ai)
#pragma unroll
            for (int m = 0; m < 4; ++m) { float o[8];
#pragma unroll
                for (int n = 0; n < 2; ++n)
#pragma unroll
                    for (int jp = 0; jp < 2; ++jp) { const f32x2 a2 = {acc[ai][0][m][n][2 * jp], acc[ai][0][m][n][2 * jp + 1]}, b2 = {acc[ai][1][m][n][2 * jp], acc[ai][1][m][n][2 * jp + 1]};
                        const f32x2 t2 = a2 * (-1.4426950408889634f * W8_INV); f32x2 d2; d2.x = __builtin_amdgcn_exp2f(t2.x); d2.y = __builtin_amdgcn_exp2f(t2.y); d2 = d2 + 1.0f;
                        f32x2 r2; r2.x = __builtin_amdgcn_rcpf(d2.x); r2.y = __builtin_amdgcn_rcpf(d2.y);
                        const f32x2 o2 = ((a2 * b2) * (W8_INV * W8_INV)) * r2; o[n * 4 + 2 * jp] = o2.x; o[n * 4 + 2 * jp + 1] = o2.y; }
                u32x2 w; w.x = pk4_fp8(o[0], o[1], o[2], o[3]); w.y = pk4_fp8(o[4], o[5], o[6], o[7]);
                *(u32x2*)(O + (unsigned)((row0 + ai * 128 + m * 16) * DM + col0)) = w; __builtin_amdgcn_sched_barrier(0); }
    }
};
struct EpiDown {
    static constexpr bool PERM = true;
    unsigned char* O; const float* gval; int estr;
    __device__ __forceinline__ void operator()(const f32x4 (&acc)[2][2][4][2], const Unit& u, int wr, int wc, int fr, int fq) const {
        const unsigned row0 = (unsigned)(u.e * estr + u.pm * 256 + wr * 64 + fr); const unsigned col0 = (unsigned)(u.pn * 256 + wc * 32 + 8 * fq);
#pragma unroll
        for (int ai = 0; ai < 2; ++ai) { float gvv[4];
#pragma unroll
            for (int m = 0; m < 4; ++m) gvv[m] = gval[row0 + ai * 128 + m * 16] * W8_INV;
            __builtin_amdgcn_sched_barrier(0);
#pragma unroll
            for (int m = 0; m < 4; ++m) { const unsigned slot = row0 + ai * 128 + m * 16; const float gv = gvv[m];
#pragma unroll
                for (int bj = 0; bj < 2; ++bj) { const f32x4 v0 = acc[ai][bj][m][0] * gv, v1 = acc[ai][bj][m][1] * gv;
                    u32x2 w; w.x = pk4_fp8(v0[0], v0[1], v0[2], v0[3]); w.y = pk4_fp8(v1[0], v1[1], v1[2], v1[3]);
                    *(u32x2*)(O + (slot * DM + col0 + bj * 128)) = w; }
                __builtin_amdgcn_sched_barrier(0); } }
    }
};
struct EpiLru {
    static constexpr bool PERM = true;
    const bf16_t* U; unsigned* lagi; const float* ba; const float* bx; const float* lam;
    __device__ __forceinline__ void operator()(const f32x4 (&acc)[2][2][4][2], const Unit& u, int wr, int wc, int fr, int fq) const {
        const int d = u.e / 10, hb = u.e - d * 10; const int ch0 = hb * 256 + u.pn * 128 + wc * 32 + 8 * fq; const int row0 = u.pm * 256 + wr * 64 + fr;
        unsigned short* outp = (unsigned short*)lagi + (size_t)d * MROWS * LRUW;
        constexpr float NL2E = -1.4426950408889634f;
#pragma unroll
        for (int n = 0; n < 2; ++n) { const int chn = ch0 + 4 * n; f32x2 vba[2], vbx[2], sp[2], csp[2];
#pragma unroll
            for (int j = 0; j < 4; ++j) { const float lm = lam[d * LRUW + chn + j]; const float spl = fmaxf(-lm, 0.f) + __logf(1.0f + __expf(-fabsf(lm)));
                vba[j >> 1][j & 1] = NL2E * ba[d * LRUW + chn + j]; vbx[j >> 1][j & 1] = NL2E * bx[d * LRUW + chn + j]; sp[j >> 1][j & 1] = -8.0f * spl; csp[j >> 1][j & 1] = 4.0f * __builtin_amdgcn_sqrtf(spl); }
            u32x2 uws[2][4];
#pragma unroll
            for (int ai = 0; ai < 2; ++ai)
#pragma unroll
                for (int m = 0; m < 4; ++m) uws[ai][m] = *(const u32x2*)(U + (size_t)(row0 + ai * 128 + m * 16) * LRUW + chn);
#pragma unroll
            for (int ai = 0; ai < 2; ++ai)
#pragma unroll
                for (int m = 0; m < 4; ++m) { const size_t row = (size_t)(row0 + ai * 128 + m * 16); const u32x2 uw = uws[ai][m]; unsigned o[2];
#pragma unroll
                    for (int h = 0; h < 2; ++h) { const unsigned uwh = h ? uw.y : uw.x; const f32x2 uv = {bf_lo(uwh), bf_hi(uwh)};
                        f32x2 ta = (f32x2){acc[ai][0][m][n][2 * h], acc[ai][0][m][n][2 * h + 1]} * NL2E + vba[h], tx = (f32x2){acc[ai][1][m][n][2 * h], acc[ai][1][m][n][2 * h + 1]} * NL2E + vbx[h];
                        f32x2 ea, ex; ea.x = __builtin_amdgcn_exp2f(fminf(ta.x, 40.f)); ea.y = __builtin_amdgcn_exp2f(fminf(ta.y, 40.f)); ex.x = __builtin_amdgcn_exp2f(fminf(tx.x, 40.f)); ex.y = __builtin_amdgcn_exp2f(fminf(tx.y, 40.f));
                        ea = ea + 1.0f; ex = ex + 1.0f;
                        const f32x2 dd = (ea * ex) * ex; f32x2 g; g.x = __builtin_amdgcn_rsqf(dd.x); g.y = __builtin_amdgcn_rsqf(dd.y);
                        const f32x2 q = g * ex, r = q * q, la = r * sp[h], y = la + la;
                        f32x2 t = y * 0.041666668f + 0.16666667f; t = t * y + 0.5f; t = t * y;
                        f32x2 s1 = t * (-0.125f) + 0.5f; s1 = s1 * t + 1.0f;
                        const f32x2 bt = ((csp[h] * uv) * g) * s1;
                        (void)la; const f32x2 cq = q * 255.0f + 0.5f;
                        unsigned wd = (unsigned)__builtin_amdgcn_cvt_pk_fp8_f32(bt.x, bt.y, 0, true);
                        wd = __builtin_amdgcn_cvt_pk_u8_f32(cq.x, 0, wd); wd = __builtin_amdgcn_cvt_pk_u8_f32(cq.y, 1, wd);
                        o[h] = wd; }
                    *(u32x2*)(outp + row * LRUW + chn) = (u32x2){o[0], o[1]}; } }
    }
};

namespace att {
constexpr int D = 128, NW = 8, QBLK = 32, KVBLK = 64;
constexpr float SCALE = 0.088388347648318440f;
constexpr float THR = 8.f;
constexpr int LDQ = PRJ_LD, LDK = 128, LDO = YLD;
constexpr size_t SHM_V = KVBLK * D * 2, SHM_K = KVBLK * D * 2, SHM_ATTN = 2 * SHM_V + 2 * SHM_K + NW * 64 * 4;
#define KSWZ(row, colB) ((row) * 256 + ((colB) ^ (((row) & 7) << 4)))
#define SBAR() __builtin_amdgcn_sched_barrier(0)
__device__ __forceinline__ int crow(int r, int hi) { return (r & 3) + 8 * (r >> 2) + 4 * hi; }
__device__ __forceinline__ void partialSM(f32x16& p0, f32x16& p1, float& m_reg, float& mn, float& alpha) {
  constexpr float C = SCALE * 1.4426950408889634f;
  float pmax = p0[0]; for (int r = 1; r < 16; ++r) pmax = fmaxf(pmax, p0[r]); for (int r = 0; r < 16; ++r) pmax = fmaxf(pmax, p1[r]);
  { auto rr = __builtin_amdgcn_permlane32_swap(__float_as_uint(pmax), __float_as_uint(pmax), false, false);
    pmax = fmaxf(__uint_as_float(rr[0]), __uint_as_float(rr[1])); }
  if (__builtin_expect(__all(pmax - m_reg <= THR / SCALE), 1)) { mn = m_reg; alpha = 1.f; }
  else { mn = fmaxf(m_reg, pmax); alpha = __builtin_amdgcn_exp2f((m_reg - mn) * C); m_reg = mn; }
  float mnC = -mn * C;
  for (int r = 0; r < 16; ++r) p0[r] = fmaf(p0[r], C, mnC); for (int r = 0; r < 16; ++r) p1[r] = fmaf(p1[r], C, mnC);
  for (int r = 0; r < 16; ++r) p0[r] = __builtin_amdgcn_exp2f(p0[r]);
}
__device__ __forceinline__ void finishSM(f32x16& p0, f32x16& p1, float alpha, float& l_reg, bf16x8& pa0, bf16x8& pa1, bf16x8& pa2, bf16x8& pa3) {
  for (int r = 0; r < 16; ++r) p1[r] = __builtin_amdgcn_exp2f(p1[r]);
  float ps = 0; for (int r = 0; r < 16; ++r) ps += p0[r]; for (int r = 0; r < 16; ++r) ps += p1[r];
  { auto rr = __builtin_amdgcn_permlane32_swap(__float_as_uint(ps), __float_as_uint(ps), false, false);
    ps = __uint_as_float(rr[0]) + __uint_as_float(rr[1]); }
  l_reg = l_reg * alpha + ps;
#define PK4(P, BASE, OUT) do { unsigned a0 = cvt_pk_bf16(P[BASE + 0], P[BASE + 1]), a1 = cvt_pk_bf16(P[BASE + 2], P[BASE + 3]);   \
    unsigned b0 = cvt_pk_bf16(P[BASE + 4], P[BASE + 5]), b1 = cvt_pk_bf16(P[BASE + 6], P[BASE + 7]);                              \
    auto r0 = __builtin_amdgcn_permlane32_swap(a0, b0, false, false); auto r1 = __builtin_amdgcn_permlane32_swap(a1, b1, false, false); \
    u32x4 w = {r0[0], r1[0], r0[1], r1[1]}; OUT = *reinterpret_cast<bf16x8*>(&w); } while (0)
  PK4(p0, 0, pa0); PK4(p0, 8, pa1); PK4(p1, 0, pa2); PK4(p1, 8, pa3);
#undef PK4
}
__device__ __forceinline__ void qkt(f32x16& p0, f32x16& p1, const bf16_t* Ks, const bf16x8* qr, int r32, int hi) {
  p0 = f32x16{}; p1 = f32x16{};
  for (int d0 = 0; d0 < 8; ++d0) { int cb = (d0 * 16 + hi * 8) * 2;
    bf16x8 b0 = *reinterpret_cast<const bf16x8*>((const char*)Ks + KSWZ(r32, cb));
    bf16x8 b1 = *reinterpret_cast<const bf16x8*>((const char*)Ks + KSWZ(32 + r32, cb));
    p0 = __builtin_amdgcn_mfma_f32_32x32x16_bf16(b0, qr[d0], p0, 0, 0, 0);
    p1 = __builtin_amdgcn_mfma_f32_32x32x16_bf16(b1, qr[d0], p1, 0, 0, 0); }
}
__device__ __forceinline__ int v_st(int k, int c) { const int kk = (k & ~0xC) | ((k & 4) << 1) | ((k & 8) >> 1); return ((kk >> 3) * 4 + (c >> 5)) * 512 + ((kk & 7) * 32 + (c & 31)) * 2; }
__device__ __forceinline__ int v_rd_base(int lane) { return ((lane & 3) << 3) | (((lane >> 2) & 3) << 6) | (((lane >> 4) & 1) << 5) | (((lane >> 5) & 1) << 8); }
constexpr int v_rd_off(int d0, int ks, int half) { return d0 * 512 + ks * 4096 + half * 2048; }
template <int OFF> __device__ __forceinline__ s16x4 tr_read(int vb) {
  s16x4 r; asm volatile("ds_read_b64_tr_b16 %0, %1 offset:%2" : "=&v"(r) : "v"(vb), "i"(OFF) : "memory"); return r;
}
template <int D0> __device__ __forceinline__ void pv_one(f32x16& od, int vb, bf16x8 pa0, bf16x8 pa1, bf16x8 pa2, bf16x8 pa3) {
  const s16x4 l0 = tr_read<v_rd_off(D0, 0, 0)>(vb), h0 = tr_read<v_rd_off(D0, 0, 1)>(vb), l1 = tr_read<v_rd_off(D0, 1, 0)>(vb), h1 = tr_read<v_rd_off(D0, 1, 1)>(vb);
  const s16x4 l2 = tr_read<v_rd_off(D0, 2, 0)>(vb), h2 = tr_read<v_rd_off(D0, 2, 1)>(vb), l3 = tr_read<v_rd_off(D0, 3, 0)>(vb), h3 = tr_read<v_rd_off(D0, 3, 1)>(vb);
  asm volatile("s_waitcnt lgkmcnt(0)" ::: "memory"); SBAR();
#define PK(L, H) (bf16x8){L[0], L[1], L[2], L[3], H[0], H[1], H[2], H[3]}
  od = __builtin_amdgcn_mfma_f32_32x32x16_bf16(pa0, PK(l0, h0), od, 0, 0, 0);
  od = __builtin_amdgcn_mfma_f32_32x32x16_bf16(pa1, PK(l1, h1), od, 0, 0, 0);
  od = __builtin_amdgcn_mfma_f32_32x32x16_bf16(pa2, PK(l2, h2), od, 0, 0, 0);
  od = __builtin_amdgcn_mfma_f32_32x32x16_bf16(pa3, PK(l3, h3), od, 0, 0, 0);
#undef PK
}
__device__ __forceinline__ void pv_d0(f32x16* o, int vb, bf16x8 pa0, bf16x8 pa1, bf16x8 pa2, bf16x8 pa3) {
  pv_one<0>(o[0], vb, pa0, pa1, pa2, pa3); pv_one<1>(o[1], vb, pa0, pa1, pa2, pa3); pv_one<2>(o[2], vb, pa0, pa1, pa2, pa3); pv_one<3>(o[3], vb, pa0, pa1, pa2, pa3);
}
__device__ __forceinline__ void attn_dense_body(const bf16_t* __restrict__ Qb, const bf16_t* __restrict__ Kh, const bf16_t* __restrict__ Vh, bf16_t* __restrict__ Ob, int seq, char* lds, int wid_in) {
  const int lane = lane_fresh();
  const int wid = wid_in, tid = wid * 64 + lane, r32 = lane & 31, hi = lane >> 5;
  bf16_t* V_lds = (bf16_t*)lds; bf16_t* K_lds = (bf16_t*)(lds + 2 * SHM_V);
  float* ws = (float*)(lds + 2 * SHM_V + 2 * SHM_K) + wid * 64; float* li_l = ws; float* al_l = ws + 32;
  float m_reg = -1e30f, l_reg = 0; f32x16 o[4] = {}; bf16x8 qr[8];
  const bf16_t* Qw = Qb + (long)(wid * QBLK + r32) * LDQ + hi * 8;
#pragma unroll
  for (int d0 = 0; d0 < 8; ++d0) qr[d0] = *reinterpret_cast<const bf16x8*>(Qw + d0 * 16);
  const int sr = tid >> 4, sc = (tid & 15) * 8, vst0 = v_st(sr, sc), vst1 = v_st(32 + sr, sc);
  const int vb0 = (int)(uintptr_t)V_lds + v_rd_base(lane);
  const unsigned toff = (unsigned)(sr * LDK + sc) * 2u;
  struct { bf16x8 vs0, vs1, ks0, ks1; } sr_[2];
#define SLOAD(i, k0) do { const char* vp_ = (const char*)(Vh + (long)(k0) * LDK); const char* kp_ = (const char*)(Kh + (long)(k0) * LDK); \
    sr_[i].vs0 = *reinterpret_cast<const bf16x8*>(vp_ + toff); sr_[i].vs1 = *reinterpret_cast<const bf16x8*>(vp_ + 32 * LDK * 2 + toff); \
    sr_[i].ks0 = *reinterpret_cast<const bf16x8*>(kp_ + toff); sr_[i].ks1 = *reinterpret_cast<const bf16x8*>(kp_ + 32 * LDK * 2 + toff); } while (0)
#define SWRITE(b, i) do { *(bf16x8*)((char*)V_lds + (b) * SHM_V + vst0) = sr_[i].vs0;          \
    *(bf16x8*)((char*)V_lds + (b) * SHM_V + vst1) = sr_[i].vs1; int kc = sc * 2;               \
    *(bf16x8*)((char*)K_lds + (b) * SHM_K + KSWZ(sr, kc)) = sr_[i].ks0;                       \
    *(bf16x8*)((char*)K_lds + (b) * SHM_K + KSWZ(32 + sr, kc)) = sr_[i].ks1; } while (0)
#define SWAIT() asm volatile("s_waitcnt vmcnt(4)" ::: "memory")
#define RESC(a) do { if (__any((a) < 1.f)) { if (hi == 0) al_l[r32] = (a); asm volatile("s_waitcnt lgkmcnt(0)" ::: "memory"); \
    for (int d = 0; d < 4; ++d) for (int r = 0; r < 16; ++r) o[d][r] *= al_l[crow(r, hi)]; } } while (0)
  f32x16 pA0, pA1, pB0, pB1; float mnA, mnB, alA, alB; bf16x8 pa0, pa1, pa2, pa3; const int NT = seq / KVBLK;
  constexpr int SE = 0, SO = 1;
  SLOAD(SE, 0); asm volatile("s_waitcnt vmcnt(0)" ::: "memory"); SWRITE(0, SE); __syncthreads();
  qkt(pA0, pA1, K_lds, qr, r32, hi); partialSM(pA0, pA1, m_reg, mnA, alA);
  SLOAD(SO, KVBLK); if (2 < NT) SLOAD(SE, 2 * KVBLK);
  SWAIT(); SWRITE(1, SO); __syncthreads();
  for (int j = 1; j + 1 < NT; j += 2) {
    SBAR(); qkt(pB0, pB1, (bf16_t*)((char*)K_lds + SHM_K), qr, r32, hi);
    finishSM(pA0, pA1, alA, l_reg, pa0, pa1, pa2, pa3); SBAR();
    SLOAD(SO, (j + 2) * KVBLK); SBAR();
    pv_d0(o, vb0, pa0, pa1, pa2, pa3); partialSM(pB0, pB1, m_reg, mnB, alB);
    __syncthreads(); SWAIT(); SWRITE(0, SE);
    RESC(alB); __syncthreads();
    SBAR(); qkt(pA0, pA1, K_lds, qr, r32, hi);
    finishSM(pB0, pB1, alB, l_reg, pa0, pa1, pa2, pa3); SBAR();
    if (j + 3 < NT) SLOAD(SE, (j + 3) * KVBLK); SBAR();
    pv_d0(o, vb0 + (int)SHM_V, pa0, pa1, pa2, pa3); partialSM(pA0, pA1, m_reg, mnA, alA);
    __syncthreads(); SWAIT(); SWRITE(1, SO);
    RESC(alA); __syncthreads();
  }
  SBAR(); qkt(pB0, pB1, (bf16_t*)((char*)K_lds + SHM_K), qr, r32, hi);
  finishSM(pA0, pA1, alA, l_reg, pa0, pa1, pa2, pa3); SBAR();
  pv_d0(o, vb0, pa0, pa1, pa2, pa3); partialSM(pB0, pB1, m_reg, mnB, alB);
  __syncthreads(); RESC(alB);
  finishSM(pB0, pB1, alB, l_reg, pa0, pa1, pa2, pa3); SBAR();
  pv_d0(o, vb0 + (int)SHM_V, pa0, pa1, pa2, pa3);
  if (hi == 0) li_l[r32] = l_reg; asm volatile("s_waitcnt lgkmcnt(0)" ::: "memory");
  float rli[16];
#pragma unroll
  for (int r = 0; r < 16; ++r) rli[r] = __builtin_amdgcn_rcpf(li_l[crow(r, hi)]);
  bf16_t* Ow = Ob + (long)(wid * QBLK) * LDO;
#pragma unroll
  for (int r = 0; r < 16; ++r) { int orow = crow(r, hi);
    for (int d0 = 0; d0 < 4; ++d0) Ow[(long)orow * LDO + d0 * 32 + r32] = (bf16_t)(cvt_pk_bf16(o[d0][r] * rli[r], 0.f) & 0xffffu); }
  __syncthreads();
#undef SLOAD
#undef SWRITE
#undef SWAIT
#undef RESC
}
}

struct Ctx {
    Params P; unsigned char* ws; int wid, G, c;
    LAS unsigned char* lds; char* ldsg;
};

constexpr int N_MOD_UNITS = 192;
constexpr int CV_A = 576, CV_B = CV_A + 256, CV_C = CV_B + 640, CV_D = CV_C + 320, CV_E = CV_D + 160, CV_F = CV_E + 424 + 2 * 3 * 16 * 128 - 11424  ;
__device__ __noinline__ void cvt_tile(const float* __restrict__ src, int ld, bf16_t* __restrict__ dst, int ldd, int tid) {
    const int c4 = ((tid >> 6) & 3) * 8 + (tid & 7), kq = (tid >> 8) * 8 + ((tid >> 3) & 7);
    const float* s = src + (size_t)(kq * 8) * ld + c4 * 4;
    f32x4 v[8];
#pragma unroll
    for (int i = 0; i < 8; ++i) v[i] = ld_nt(s + (size_t)i * ld);
#pragma unroll
    for (int j = 0; j < 4; ++j) { u32x4 w; w.x = cvt_pk_bf16(v[0][j], v[1][j]); w.y = cvt_pk_bf16(v[2][j], v[3][j]); w.z = cvt_pk_bf16(v[4][j], v[5][j]); w.w = cvt_pk_bf16(v[6][j], v[7][j]);
        __builtin_nontemporal_store(w, (GAS u32x4*)(GAS bf16_t*)(dst + (size_t)(c4 * 4 + j) * ldd + kq * 8)); }
}
__device__ __noinline__ void cvt_tile8(const float* __restrict__ src, int ld, unsigned char* __restrict__ dst, int ldd, int split, int tid) {
    const int c4 = (tid >> 6) * 8 + (tid & 7), kq = (tid >> 3) & 7;
    const float* s = src + (size_t)(kq * 16) * ld + c4 * 4;
    f32x4 v[16];
#pragma unroll
    for (int i = 0; i < 16; ++i) v[i] = ld_nt(s + (size_t)i * ld);
    const int rbase = split ? ((c4 >> 5) * 256 + (c4 & 31) * 4) : c4 * 4;
#pragma unroll
    for (int j = 0; j < 4; ++j) { u32x4 w;
        w.x = pk4_fp8(v[0][j] * W8_SCALE, v[1][j] * W8_SCALE, v[2][j] * W8_SCALE, v[3][j] * W8_SCALE); w.y = pk4_fp8(v[4][j] * W8_SCALE, v[5][j] * W8_SCALE, v[6][j] * W8_SCALE, v[7][j] * W8_SCALE);
        w.z = pk4_fp8(v[8][j] * W8_SCALE, v[9][j] * W8_SCALE, v[10][j] * W8_SCALE, v[11][j] * W8_SCALE); w.w = pk4_fp8(v[12][j] * W8_SCALE, v[13][j] * W8_SCALE, v[14][j] * W8_SCALE, v[15][j] * W8_SCALE);
        __builtin_nontemporal_store(w, (GAS u32x4*)(GAS unsigned char*)(dst + (size_t)(rbase + j) * ldd + kq * 16)); }
}
constexpr int MOE_TILES = 3 * 16 * 128;
__device__ __forceinline__ void moe_cvt_tile(const Ctx& F, int layer, int q, int tid) {
    const Params& P = F.P; const int m = q / 2048, r = q % 2048, le = layer * 16 + (r >> 7), kt = (r >> 3) & 15, nt = r & 7;
    const size_t so = (size_t)le * DM * DM + (size_t)kt * 128 * DM + nt * 256;
    if (m == 0)      cvt_tile8(P.in[I_WGATE] + so, DM, F.ws + WS_WGU + ((size_t)le * 4096 + nt * 512) * DM + kt * 128, DM, 1, tid);
    else if (m == 1) cvt_tile8(P.in[I_WUP]   + so, DM, F.ws + WS_WGU + ((size_t)le * 4096 + nt * 512 + 128) * DM + kt * 128, DM, 1, tid);
    else             cvt_tile8(P.in[I_WDOWN] + so, DM, F.ws + WS_WDN + ((size_t)le * DM + nt * 256) * DM + kt * 128, DM, 0, tid);
}
struct CvtJob { const float* src; unsigned char* dst; int split; };
__device__ __forceinline__ CvtJob moe_job(const Ctx& F, int g) {
    const Params& P = F.P; const int layer = g / MOE_TILES, q = g - layer * MOE_TILES, m = q >> 11, r = q & 2047, le = layer * 16 + (r >> 7), kt = (r >> 3) & 15, nt = r & 7;
    const float* pg = P.in[I_WGATE]; const float* pu = P.in[I_WUP]; const float* pd = P.in[I_WDOWN];
    asm volatile("" : "+s"(pg), "+s"(pu), "+s"(pd));
    const size_t so = (size_t)le * DM * DM + (size_t)kt * 128 * DM + nt * 256;
    CvtJob j; j.src = (m == 0 ? pg : (m == 1 ? pu : pd)) + so; j.split = m < 2 ? 1 : 0;
    j.dst = m < 2 ? F.ws + WS_WGU + ((size_t)le * 4096 + nt * 512 + (m == 1 ? 128 : 0)) * DM + kt * 128 : F.ws + WS_WDN + ((size_t)le * DM + nt * 256) * DM + kt * 128;
    return j;
}
__device__ __forceinline__ void conv_range(const Ctx& F, int g0, int g1, int first_cu) {
    const int tid = F.wid * 64 + lane_fresh(); const int c4 = (tid >> 6) * 8 + (tid & 7), kq = (tid >> 3) & 7; constexpr int n = 1;
    const int cnt = (g1 - g0 + (F.G - first_cu) - 1) / (F.G - first_cu);
    int g = g0 + (F.c - first_cu) * cnt; g1 = g + cnt < g1 ? g + cnt : g1; if (g >= g1) return;
#define CV8_LOAD(v_, src_) { const GAS float* s_ = (const GAS float*)(src_) + (size_t)(kq * 16) * DM + c4 * 4; _Pragma("unroll") for (int i = 0; i < 16; ++i) v_[i] = __builtin_nontemporal_load((const GAS f32x4*)(s_ + (size_t)i * DM)); }
#define CV8_STORE(v_, job_) { const int rbase = (job_).split ? ((c4 >> 5) * 256 + (c4 & 31) * 4) : c4 * 4; \
        _Pragma("unroll") for (int j = 0; j < 4; ++j) { u32x4 w; \
            w.x = pk4_fp8(v_[0][j] * W8_SCALE, v_[1][j] * W8_SCALE, v_[2][j] * W8_SCALE, v_[3][j] * W8_SCALE); w.y = pk4_fp8(v_[4][j] * W8_SCALE, v_[5][j] * W8_SCALE, v_[6][j] * W8_SCALE, v_[7][j] * W8_SCALE); \
            w.z = pk4_fp8(v_[8][j] * W8_SCALE, v_[9][j] * W8_SCALE, v_[10][j] * W8_SCALE, v_[11][j] * W8_SCALE); w.w = pk4_fp8(v_[12][j] * W8_SCALE, v_[13][j] * W8_SCALE, v_[14][j] * W8_SCALE, v_[15][j] * W8_SCALE); \
            __builtin_nontemporal_store(w, (GAS u32x4*)(GAS unsigned char*)((job_).dst + (size_t)(rbase + j) * DM + kq * 16)); } }
    f32x4 va[16], vb[16]; CvtJob ja = moe_job(F, g), jb = ja; CV8_LOAD(va, ja.src)
    for (;;) {
        if (g + n >= g1) { CV8_STORE(va, ja) break; }
        jb = moe_job(F, g + n); CV8_LOAD(vb, jb.src)
        CV8_STORE(va, ja)
        g += n;
        if (g + n >= g1) { CV8_STORE(vb, jb) break; }
        ja = moe_job(F, g + n); CV8_LOAD(va, ja.src)
        CV8_STORE(vb, jb)
        g += n;
    }
#undef CV8_STORE
#undef CV8_LOAD
}
constexpr int NCV2 = 48, NCV5 = 72, NCV9 = 64, NCV11 = 32, NCV13 = 8;
constexpr int GT0 = 424, GT2 = 3694, GT5 = 6144, GT9 = 9024, GT11 = 11204, GT13 = 11424;
static_assert(GT5 >= MOE_TILES, "layer 0's expert weights must be complete before P8");
__device__ __forceinline__ void p0_prologue(const Ctx& F) {
    const Params& P = F.P; const int tid = F.wid * 64 + lane_fresh();
    LAS float* sil = (LAS float*)F.lds;
    LAS float* red = (LAS float*)(F.lds + 40960);
    for (int u = F.c; u < N_MOD_UNITS + CV_F; u += F.G) {
        if (u < N_MOD_UNITS) {
            const int l = u / 96, j0 = (u % 96) * 128;
            for (int i = tid; i < 5 * DM; i += 512) { const int v = i >> 11, k = i & 2047; const float cv = v < 4 ? P.in[I_C][v * DM + k] : P.in[I_CCTX][k]; sil[i] = cv * fast_sigmoid(cv); }
            __syncthreads();
            const int hw = tid >> 5, l32 = tid & 31;
            f32x4 a0 = {0, 0, 0, 0}, a1 = a0, a2 = a0, a3 = a0, a4 = a0;
            const float* wp = P.in[I_MODW] + ((size_t)(l * DM + hw * 128)) * MODN + j0 + l32 * 4;
#pragma unroll 8
            for (int kk = 0; kk < 128; ++kk) { const f32x4 w = ld_nt(wp + (size_t)kk * MODN); const int k = hw * 128 + kk;
                a0 += sil[k] * w; a1 += sil[DM + k] * w; a2 += sil[2 * DM + k] * w; a3 += sil[3 * DM + k] * w; a4 += sil[4 * DM + k] * w; }
            *(LAS f32x4*)(red + (hw * 5 + 0) * 128 + l32 * 4) = a0; *(LAS f32x4*)(red + (hw * 5 + 1) * 128 + l32 * 4) = a1; *(LAS f32x4*)(red + (hw * 5 + 2) * 128 + l32 * 4) = a2;
            *(LAS f32x4*)(red + (hw * 5 + 3) * 128 + l32 * 4) = a3; *(LAS f32x4*)(red + (hw * 5 + 4) * 128 + l32 * 4) = a4;
            __syncthreads();
            float* mod = (float*)(F.ws + WS_MOD);
            for (int o = tid; o < 640; o += 512) { const int v = o >> 7, col = o & 127; float s = 0.f;
#pragma unroll
                for (int h = 0; h < 16; ++h) s += red[(h * 5 + v) * 128 + col];
                mod[(size_t)(l * 5 + v) * MODN + j0 + col] = s + P.in[I_MODB][l * MODN + j0 + col]; }
            __syncthreads();
        } else {
            const int t = u - N_MOD_UNITS;
            if (t < CV_A)      { const int q = t;        const int kt = q / 36, nt = q % 36; const int drow = nt < 20 ? nt * 128 : (nt < 28 ? 2560 + (nt - 20) * 256 : 2560 + (nt - 28) * 256 + 128);
                cvt_tile(P.in[I_EVWIN]  + (size_t)kt * 128 * EV_IN + nt * 128, EV_IN, (bf16_t*)(F.ws + WS_WEVIN)  + (size_t)drow * DM + kt * 128, DM, tid); }
            else if (t < CV_B) { const int q = t - CV_A; const int kt = q / 16, nt = q % 16; cvt_tile(P.in[I_EVWOUT] + (size_t)kt * 128 * DM + nt * 128, DM, (bf16_t*)(F.ws + WS_WEVOUT) + (size_t)nt * 128 * DM + kt * 128, DM, tid); }
            else if (t < CV_C) { const int q = t - CV_B; const int kt = q / 40, nt = q % 40; cvt_tile(P.in[I_ODWIN]  + (size_t)kt * 128 * OD_IN + nt * 128, OD_IN, (bf16_t*)(F.ws + WS_WODIN)  + (size_t)nt * 128 * DM + kt * 128, DM, tid); }
            else if (t < CV_D) { const int q = t - CV_C; const int kt = q / 16, nt = q % 16; cvt_tile(P.in[I_ODWOUT] + (size_t)kt * 128 * DM + nt * 128, DM, (bf16_t*)(F.ws + WS_WODOUT) + (size_t)nt * 128 * LRUW + kt * 128, LRUW, tid); }
            else if (t < CV_E) { const int q = t - CV_D; const int m = q / 80, r = q % 80, dh = r >> 2, kt = (r >> 1) & 1, nt = r & 1;
                bf16_t* dst = (bf16_t*)(F.ws + WS_WLRU) + ((size_t)dh * 512 + nt * 256 + m * 128) * 256 + kt * 128; const size_t so = (size_t)dh * 65536 + (size_t)kt * 128 * 256 + nt * 128;
                if (m == 0) cvt_tile(P.in[I_ODWA] + so, 256, dst, 256, tid); else cvt_tile(P.in[I_ODWX] + so, 256, dst, 256, tid); }
            else { const int q = t - CV_E; const int g = q < GT0 ? q : GT13 + (q - GT0); moe_cvt_tile(F, g / MOE_TILES, g % MOE_TILES, tid); }
        }
    }
}

template <int MODE> __device__ __forceinline__ void norm_pair(const Ctx& F, const LAS float* lm, int lane, int row, const f32x4 (&nx)[2][8], const u32x2 (&nw)[2][8], int sm0, int sm1) {
    const Params& P = F.P; bf16_t* h = (bf16_t*)(F.ws + WS_H); bf16_t* act = (bf16_t*)(F.ws + WS_ACT); const unsigned char* eo = F.ws + WS_EO;
    const int b = row / TPB, p = row - b * TPB; const bool isctx = p < CTXL; const int mv = isctx ? 4 : b;
    f32x4 v[2][8];
#pragma unroll
    for (int q = 0; q < 2; ++q)
#pragma unroll
        for (int i = 0; i < 8; ++i) v[q][i] = MODE == 0 ? nx[q][i] : (f32x4){bf_lo(nw[q][i].x), bf_hi(nw[q][i].x), bf_lo(nw[q][i].y), bf_hi(nw[q][i].y)};
    if (MODE >= 1) {
        f32x4 a[2][8];
#pragma unroll
        for (int q = 0; q < 2; ++q)
#pragma unroll
            for (int i = 0; i < 8; ++i) a[q][i] = (f32x4){0.f, 0.f, 0.f, 0.f};
        unsigned sel0 = (unsigned)__ballot(sm0 >= 0) & 0xffffu, sel1 = (unsigned)__ballot(sm1 >= 0) & 0xffffu;
        while (sel0 | sel1) {
            int sl[4]; bool on[4];
            { on[0] = sel0 != 0u; const int e = on[0] ? __builtin_ctz(sel0) : 0; if (on[0]) sel0 &= sel0 - 1u; sl[0] = on[0] ? __builtin_amdgcn_readlane(sm0, e) : 0; }
            { on[1] = sel0 != 0u; const int e = on[1] ? __builtin_ctz(sel0) : 0; if (on[1]) sel0 &= sel0 - 1u; sl[1] = on[1] ? __builtin_amdgcn_readlane(sm0, e) : sl[0]; }
            { on[2] = sel1 != 0u; const int e = on[2] ? __builtin_ctz(sel1) : 0; if (on[2]) sel1 &= sel1 - 1u; sl[2] = on[2] ? __builtin_amdgcn_readlane(sm1, e) : 0; }
            { on[3] = sel1 != 0u; const int e = on[3] ? __builtin_ctz(sel1) : 0; if (on[3]) sel1 &= sel1 - 1u; sl[3] = on[3] ? __builtin_amdgcn_readlane(sm1, e) : sl[2]; }
            unsigned w[4][8];
#pragma unroll
            for (int t = 0; t < 4; ++t)
#pragma unroll
                for (int i = 0; i < 8; ++i) w[t][i] = *(const unsigned*)(eo + (size_t)sl[t] * DM + lane * 4 + 256 * i);
#pragma unroll
            for (int t = 0; t < 4; ++t) { if (on[t]) {
#pragma unroll
                for (int i = 0; i < 8; ++i) a[t >> 1][i] += (f32x4){__builtin_amdgcn_cvt_f32_fp8((int)w[t][i], 0), __builtin_amdgcn_cvt_f32_fp8((int)w[t][i], 1), __builtin_amdgcn_cvt_f32_fp8((int)w[t][i], 2), __builtin_amdgcn_cvt_f32_fp8((int)w[t][i], 3)}; } }
        }
        const LAS float* g2 = lm + 10 * DM + mv * DM + lane * 4;
#pragma unroll
        for (int i = 0; i < 8; ++i) { const f32x4 gv = *(const LAS f32x4*)(g2 + 256 * i); v[0][i] += gv * a[0][i]; v[1][i] += gv * a[1][i]; }
        if (MODE == 1) {
#pragma unroll
            for (int q = 0; q < 2; ++q)
#pragma unroll
                for (int i = 0; i < 8; ++i) { u32x2 w2; w2.x = cvt_pk_bf16(v[q][i][0], v[q][i][1]); w2.y = cvt_pk_bf16(v[q][i][2], v[q][i][3]); *(u32x2*)(h + (size_t)(row + q) * DM + lane * 4 + 256 * i) = w2; } }
    }
    float rinv[2];
#pragma unroll
    for (int q = 0; q < 2; ++q) { float ss = 0.f;
#pragma unroll
        for (int i = 0; i < 8; ++i) ss += v[q][i][0] * v[q][i][0] + v[q][i][1] * v[q][i][1] + v[q][i][2] * v[q][i][2] + v[q][i][3] * v[q][i][3];
        ss = wave_sum(ss); rinv[q] = __builtin_amdgcn_rsqf(ss * (1.0f / DM) + EPS); }
    if (MODE == 2) {
        float* op = P.out + ((size_t)b * SEQ + (p - CTXL)) * DM + lane * 4; const LAS float* gf = lm + lane * 4;
#pragma unroll
        for (int i = 0; i < 8; ++i) { const f32x4 gv = *(const LAS f32x4*)(gf + 256 * i); st_nt(op + 256 * i, v[0][i] * rinv[0] * gv); st_nt(op + DM + 256 * i, v[1][i] * rinv[1] * gv); }
    } else {
        const LAS float* gsp = lm + mv * DM + lane * 4;
#pragma unroll
        for (int i = 0; i < 8; ++i) { const f32x4 gs = *(const LAS f32x4*)(gsp + 256 * i), sv = *(const LAS f32x4*)(gsp + 5 * DM + 256 * i);
#pragma unroll
            for (int q = 0; q < 2; ++q) { const f32x4 y = v[q][i] * rinv[q] * gs + sv;
                u32x2 w2; w2.x = cvt_pk_bf16(y[0], y[1]); w2.y = cvt_pk_bf16(y[2], y[3]); *(u32x2*)(act + (size_t)(row + q) * DM + lane * 4 + 256 * i) = w2; } }
    }
}
template <int MODE> __device__ __forceinline__ void phase_norm(const Ctx& F) {
    const Params& P = F.P; const int lane = lane_fresh();
    const float* mod = (const float*)(F.ws + WS_MOD); const bf16_t* h = (const bf16_t*)(F.ws + WS_H); const int* slotmap = (const int*)(F.ws + WS_SLOT);
    const int lprev = MODE == 2 ? 1 : 0, lnext = MODE == 0 ? 0 : 1;
    LAS float* lm = (LAS float*)F.lds;
    { const int tid = F.wid * 64 + lane;
      for (int i = tid; i < 5 * DM; i += 512) { const int mvv = i >> 11, k = i & 2047;
          if (MODE != 2) { const float* sh_ = mod + (size_t)(lnext * 5 + mvv) * MODN; lm[i] = P.in[I_N1G][lnext * DM + k] * (1.0f + sh_[2048 + k]); lm[5 * DM + i] = sh_[k]; }
          if (MODE >= 1) lm[10 * DM + i] = mod[(size_t)(lprev * 5 + mvv) * MODN + 10240 + k]; }
      if (MODE == 2) for (int i = tid; i < DM; i += 512) lm[i] = P.in[I_FNG][i];
      __syncthreads(); }
    const int npair = MODE == 2 ? NB * SEQ / 2 : MROWS / 2; const int pstep = F.G * 8;
#define NM_ROW(j) (MODE == 2 ? ((j) / (SEQ / 2)) * TPB + CTXL + ((j) % (SEQ / 2)) * 2 : (j) * 2)
#define NM_LOAD(j, nx, nw, nsm0, nsm1) { const int r_ = NM_ROW(j); \
        if (MODE == 0) { const int b_ = r_ / TPB, p_ = r_ - b_ * TPB; const float* src = p_ < CTXL ? P.in[I_CTX] + ((size_t)b_ * CTXL + p_) * DM : P.in[I_X] + ((size_t)b_ * SEQ + (p_ - CTXL)) * DM; \
            _Pragma("unroll") for (int q = 0; q < 2; ++q) _Pragma("unroll") for (int i = 0; i < 8; ++i) nx[q][i] = ld_nt(src + (size_t)q * DM + lane * 4 + 256 * i); \
        } else { \
            _Pragma("unroll") for (int q = 0; q < 2; ++q) _Pragma("unroll") for (int i = 0; i < 8; ++i) nw[q][i] = *(const u32x2*)(h + (size_t)(r_ + q) * DM + lane * 4 + 256 * i); \
            nsm0 = lane < 16 ? slotmap[(size_t)r_ * 16 + lane] : -1; nsm1 = lane < 16 ? slotmap[(size_t)(r_ + 1) * 16 + lane] : -1; } }
    f32x4 ax[2][8], bx[2][8]; u32x2 aw[2][8], bw[2][8]; int as0 = -1, as1 = -1, bs0 = -1, bs1 = -1; int jp = F.c * 8 + F.wid;
    if (jp < npair) {
        NM_LOAD(jp, ax, aw, as0, as1)
        for (;;) {
            if (jp + pstep >= npair) { norm_pair<MODE>(F, lm, lane, NM_ROW(jp), ax, aw, as0, as1); break; }
            NM_LOAD(jp + pstep, bx, bw, bs0, bs1)
            norm_pair<MODE>(F, lm, lane, NM_ROW(jp), ax, aw, as0, as1);
            jp += pstep;
            if (jp + pstep >= npair) { norm_pair<MODE>(F, lm, lane, NM_ROW(jp), bx, bw, bs0, bs1); break; }
            NM_LOAD(jp + pstep, ax, aw, as0, as1)
            norm_pair<MODE>(F, lm, lane, NM_ROW(jp), bx, bw, bs0, bs1);
            jp += pstep;
        }
    }
#undef NM_LOAD
#undef NM_ROW
}

__device__ __forceinline__ void phase_router(const Ctx& F, int layer) {
    const Params& P = F.P; const int lane = lane_fresh(), tid = F.wid * 64 + lane;
    const float* mod = (const float*)(F.ws + WS_MOD); const bf16_t* h = (const bf16_t*)(F.ws + WS_H); unsigned char* act8 = F.ws + WS_ACT; float* aff = (float*)(F.ws + WS_AFF);
    LAS float* Wt = (LAS float*)F.lds;
    const float* wr = P.in[I_ROUTER] + (size_t)layer * DM * 16;
    for (int i = tid; i < DM * 16; i += 512) Wt[(i & 15) * DM + (i >> 4)] = wr[i];
    __syncthreads();
    const int npair = layer == 0 ? MROWS / 2 : NB * SEQ / 2; const int pstep = F.G * 8;
#define RT_ROW(j) (layer == 0 ? (j) * 2 : ((j) / (SEQ / 2)) * TPB + CTXL + ((j) % (SEQ / 2)) * 2)
    u32x2 nw[2][8]; int jp = F.c * 8 + F.wid;
    if (jp < npair) { const int r_ = RT_ROW(jp);
#pragma unroll
        for (int q = 0; q < 2; ++q)
#pragma unroll
            for (int i = 0; i < 8; ++i) nw[q][i] = *(const u32x2*)(h + (size_t)(r_ + q) * DM + lane * 4 + 256 * i); }
    for (; jp < npair; jp += pstep) {
        const int row = RT_ROW(jp); const int b = row / TPB, p = row - b * TPB; const bool isctx = p < CTXL; const int mv = isctx ? 4 : b;
        f32x2 pv[8][4];
#pragma unroll
        for (int i = 0; i < 8; ++i) { pv[i][0] = (f32x2){bf_lo(nw[0][i].x), bf_lo(nw[1][i].x)}; pv[i][1] = (f32x2){bf_hi(nw[0][i].x), bf_hi(nw[1][i].x)};
                                       pv[i][2] = (f32x2){bf_lo(nw[0][i].y), bf_lo(nw[1][i].y)}; pv[i][3] = (f32x2){bf_hi(nw[0][i].y), bf_hi(nw[1][i].y)}; }
        if (jp + pstep < npair) { const int r_ = RT_ROW(jp + pstep);
#pragma unroll
            for (int q = 0; q < 2; ++q)
#pragma unroll
                for (int i = 0; i < 8; ++i) nw[q][i] = *(const u32x2*)(h + (size_t)(r_ + q) * DM + lane * 4 + 256 * i); }
        f32x2 ss2 = {0.f, 0.f};
#pragma unroll
        for (int i = 0; i < 8; ++i)
#pragma unroll
            for (int k = 0; k < 4; ++k) ss2 += pv[i][k] * pv[i][k];
        f32x2 rinv2; rinv2.x = __builtin_amdgcn_rsqf(wave_sum(ss2.x) * (1.0f / DM) + EPS); rinv2.y = __builtin_amdgcn_rsqf(wave_sum(ss2.y) * (1.0f / DM) + EPS);
        const float* g = P.in[I_N2G] + layer * DM + lane * 4; const float* sh = mod + (size_t)(layer * 5 + mv) * MODN + 6144 + lane * 4; const float* sc = sh + 2048;
#pragma unroll
        for (int i = 0; i < 8; ++i) { const f32x4 gs = *(const f32x4*)(g + 256 * i) * (1.0f + *(const f32x4*)(sc + 256 * i)), sv = *(const f32x4*)(sh + 256 * i);
#pragma unroll
            for (int k = 0; k < 4; ++k) pv[i][k] = (pv[i][k] * rinv2) * (f32x2){gs[k], gs[k]} + (f32x2){sv[k], sv[k]};
            *(unsigned*)(act8 + (size_t)row * DM + lane * 4 + 256 * i) = pk4_fp8(pv[i][0].x, pv[i][1].x, pv[i][2].x, pv[i][3].x);
            *(unsigned*)(act8 + (size_t)(row + 1) * DM + lane * 4 + 256 * i) = pk4_fp8(pv[i][0].y, pv[i][1].y, pv[i][2].y, pv[i][3].y); }
        f32x2 lg2[16];
#pragma unroll
        for (int e = 0; e < 16; ++e) { f32x2 acc[4] = {{0.f, 0.f}, {0.f, 0.f}, {0.f, 0.f}, {0.f, 0.f}};
#pragma unroll
            for (int i = 0; i < 8; ++i) { const f32x4 w = *(const LAS f32x4*)(Wt + e * DM + lane * 4 + 256 * i);
#pragma unroll
                for (int k = 0; k < 4; ++k) acc[k] += pv[i][k] * (f32x2){w[k], w[k]}; }
            lg2[e] = (acc[0] + acc[1]) + (acc[2] + acc[3]); __builtin_amdgcn_sched_barrier(0); }
        const bool b0 = (lane & 1) != 0, b1 = (lane & 2) != 0, b2 = (lane & 4) != 0, b3 = (lane & 8) != 0, b4 = (lane & 16) != 0;
        float u16[16], u8[8], u4[4], u2[2];
#pragma unroll
        for (int j = 0; j < 16; ++j) { const float send = b0 ? lg2[j].x : lg2[j].y, keep = b0 ? lg2[j].y : lg2[j].x;
            u16[j] = keep + __int_as_float(__builtin_amdgcn_update_dpp(0, __float_as_int(send), 0xB1, 0xf, 0xf, true)); }
#pragma unroll
        for (int j = 0; j < 8; ++j) { const float send = b1 ? u16[j] : u16[8 + j], keep = b1 ? u16[8 + j] : u16[j];
            u8[j] = keep + __int_as_float(__builtin_amdgcn_update_dpp(0, __float_as_int(send), 0x4E, 0xf, 0xf, true)); }
#pragma unroll
        for (int j = 0; j < 4; ++j) { const float send = b2 ? u8[j] : u8[4 + j], keep = b2 ? u8[4 + j] : u8[j]; u4[j] = keep + __shfl_xor(send, 4); }
#pragma unroll
        for (int j = 0; j < 2; ++j) { const float send = b3 ? u4[j] : u4[2 + j], keep = b3 ? u4[2 + j] : u4[j]; u2[j] = keep + __shfl_xor(send, 8); }
        float lgt; { const float send = b4 ? u2[0] : u2[1], keep = b4 ? u2[1] : u2[0]; lgt = keep + __shfl_xor(send, 16); }
        lgt += __shfl_xor(lgt, 32);
        float mx = lgt;
#pragma unroll
        for (int o = 2; o <= 16; o <<= 1) mx = fmaxf(mx, __shfl_xor(mx, o));
        const float pe = __expf(lgt - mx); float sum = pe;
#pragma unroll
        for (int o = 2; o <= 16; o <<= 1) sum += __shfl_xor(sum, o);
        if (lane < 32) { const int e = (b1 ? 8 : 0) + (b2 ? 4 : 0) + (b3 ? 2 : 0) + (b4 ? 1 : 0); aff[(size_t)(row + (b0 ? 1 : 0)) * 16 + e] = pe / sum; }
    }
#undef RT_ROW
    __syncthreads();
}

__device__ __forceinline__ unsigned block_excl_scan(unsigned x, LAS unsigned* wsum, int lane, int wid) {
    unsigned s = x;
#pragma unroll
    for (int o = 1; o < 64; o <<= 1) { const unsigned t = __shfl_up(s, o); if (lane >= o) s += t; }
    if (lane == 63) wsum[wid] = s;
    __syncthreads();
    unsigned below = 0;
#pragma unroll
    for (int w = 0; w < 8; ++w) below += (w < wid) ? wsum[w] : 0u;
    __syncthreads();
    return below + s - x;
}
__device__ __forceinline__ void phase_topk(const Ctx& F, int layer) {
    const int lane = lane_fresh(), tid = F.wid * 64 + lane; const int estr = layer == 0 ? 2304 : 2048;
    const float* aff = (const float*)(F.ws + WS_AFF); int* slotmap = (int*)(F.ws + WS_SLOT); float* gval = (float*)(F.ws + WS_GVAL);
    unsigned* offt = (unsigned*)(F.ws + WS_OFFT);
    LAS unsigned* key = (LAS unsigned*)F.lds;
    LAS unsigned* hist = key + 4096;
    LAS unsigned* wsum = hist + 256;
    LAS unsigned* bc = wsum + 16;
    LAS unsigned* list = bc + 16;
    const int nunits = layer == 0 ? 320 : 256;
    for (int u = F.c; u < nunits; u += F.G) {
        const bool lat = u < 256; const int be = lat ? (u >> 2) : (u - 256), q = lat ? (u & 3) : 0; const int b = be >> 4, e = be & 15;
        const int n = lat ? SEQ : CTXL, cap = n >> 3, row0 = b * TPB + (lat ? CTXL : 0);
        for (int i = tid; i < n; i += 512) key[i] = __float_as_uint(aff[(size_t)(row0 + i) * 16 + e]);
        unsigned prefix = 0u, mask = 0u, krem = (unsigned)cap;
#pragma unroll 1
        for (int pass = 0; pass < 4; ++pass) { const int shift = 24 - 8 * pass;
            if (tid < 256) hist[tid] = 0u;
            __syncthreads();
            for (int i = tid; i < n; i += 512) { const unsigned k = key[i]; if ((k & mask) == prefix) __hip_atomic_fetch_add(hist + ((k >> shift) & 255u), 1u, __ATOMIC_RELAXED, __HIP_MEMORY_SCOPE_WORKGROUP); }
            __syncthreads();
            unsigned sfx = 0u;
            if (tid < 256) { sfx = hist[tid];
#pragma unroll
                for (int o = 1; o < 64; o <<= 1) { const unsigned t = __shfl_down(sfx, o); if (lane + o < 64) sfx += t; }
                if (lane == 0) wsum[F.wid] = sfx; }
            __syncthreads();
            if (tid < 256) { unsigned above = 0u;
#pragma unroll
                for (int w = 1; w < 4; ++w) above += (w > F.wid) ? wsum[w] : 0u;
                const unsigned ge = sfx + above; unsigned gt = __shfl_down(sfx, 1); gt = (lane == 63) ? above : gt + above;
                if (ge >= krem && gt < krem) { bc[0] = (unsigned)tid; bc[1] = krem - gt; } }
            __syncthreads();
            prefix |= bc[0] << shift; mask |= 255u << shift; krem = bc[1];
        }
        const int per = lat ? 8 : 1; const bool own = tid * per < n; const int i0 = tid * per;
        unsigned eqc = 0u;
        if (own) for (int j = 0; j < per; ++j) eqc += (key[i0 + j] == prefix) ? 1u : 0u;
        unsigned eqb = block_excl_scan(eqc, wsum, lane, F.wid);
        unsigned selm = 0u, selc = 0u;
        if (own) for (int j = 0; j < per; ++j) { const unsigned k = key[i0 + j]; bool sl = k > prefix; if (k == prefix) { sl = eqb < krem; ++eqb; } if (sl) { selm |= 1u << j; ++selc; } }
        unsigned sb = block_excl_scan(selc, wsum, lane, F.wid);
        const int slot0 = e * estr + (lat ? b * 512 : 2048 + b * 32);
        const bool mine = lat ? ((tid >> 7) == q) : true;
        if (own) for (int j = 0; j < per; ++j) { const bool sl = (selm >> j) & 1u; if (sl) list[sb] = (unsigned)(i0 + j);
            if (mine) slotmap[(size_t)(row0 + i0 + j) * 16 + e] = sl ? slot0 + (int)sb : -1; if (sl) ++sb; }
        __syncthreads();
        const int r_lo = lat ? q * 128 : 0, r_hi = lat ? r_lo + 128 : 32;
        for (int r = r_lo + tid; r < r_hi; r += 512) { const unsigned t = list[r]; gval[slot0 + r] = __uint_as_float(key[t]); offt[slot0 + r] = (unsigned)(row0 + t) * (unsigned)DM; }
        if (layer == 0 && !lat && b == 0 && tid < 128) offt[e * estr + 2176 + tid] = 0u;
        __syncthreads();
    }
}

__device__ __forceinline__ void unpack8(const u32x4 v, float (&o)[8]) { o[0] = bf_lo(v.x); o[1] = bf_hi(v.x); o[2] = bf_lo(v.y); o[3] = bf_hi(v.y); o[4] = bf_lo(v.z); o[5] = bf_hi(v.z); o[6] = bf_lo(v.w); o[7] = bf_hi(v.w); }
__device__ __forceinline__ void load_cu(const bf16_t* prj, int row, int ch, float (&o)[8]) {
    const u32x4 cv = *(const u32x4*)(prj + (size_t)row * PRJ_LD + 2560 + ch), uv = *(const u32x4*)(prj + (size_t)row * PRJ_LD + 3584 + ch);
    o[0] = bf_lo(cv.x) * bf_lo(uv.x); o[1] = bf_hi(cv.x) * bf_hi(uv.x); o[2] = bf_lo(cv.y) * bf_lo(uv.y); o[3] = bf_hi(cv.y) * bf_hi(uv.y);
    o[4] = bf_lo(cv.z) * bf_lo(uv.z); o[5] = bf_hi(cv.z) * bf_hi(uv.z); o[6] = bf_lo(cv.w) * bf_lo(uv.w); o[7] = bf_hi(cv.w) * bf_hi(uv.w);
}
__device__ __forceinline__ void load_x8(const bf16_t* prj, int row, int ch, int seg_lo, int seg_hi, float (&o)[8]) {
    if (row < seg_lo || row >= seg_hi) {
#pragma unroll
        for (int j = 0; j < 8; ++j) o[j] = 0.f; }
    else { const u32x4 v = *(const u32x4*)(prj + (size_t)row * PRJ_LD + ch); o[0] = bf_lo(v.x); o[1] = bf_hi(v.x); o[2] = bf_lo(v.y); o[3] = bf_hi(v.y); o[4] = bf_lo(v.z); o[5] = bf_hi(v.z); o[6] = bf_lo(v.w); o[7] = bf_hi(v.w); }
}
__device__ __forceinline__ int rope_unit(int c, int k, int G) {
    constexpr int NROPE = MROWS / 16;
    if (G != 256) { const int u = c + k * G; return u < NROPE ? u : -1; }
    if (k < 3) return k * 256 + c;
    if (k == 3) return c >= 32 ? 768 + (c - 32) : -1;
    if (k == 4) return (c >= 32 && c < 128) ? 992 + (c - 32) : -1;
    return -1;
}
__device__ __forceinline__ void phase_rope_conv(const Ctx& F) {
    const Params& P = F.P; const int tid = F.wid * 64 + lane_fresh();
    bf16_t* prj = (bf16_t*)(F.ws + WS_PRJ); bf16_t* yin = (bf16_t*)(F.ws + WS_YIN);
    constexpr int NCONV = MROWS / 32, NROPE = MROWS / 16;
    {
        const int ch = (tid & 127) * 8;
        const float* cw = P.in[I_EVCW]; float w0[8], w1[8], w2[8], cb[8];
#pragma unroll
        for (int j = 0; j < 8; ++j) { w0[j] = cw[ch + j]; w1[j] = cw[1024 + ch + j]; w2[j] = cw[2048 + ch + j]; cb[j] = P.in[I_EVCB][ch + j]; }
        u32x4 ncin[10], nbin[8];
#define RC_LOAD(un) { const int r0_ = (un) * 32 + (tid >> 7) * 8; const int b_ = r0_ / TPB, p_ = r0_ - b_ * TPB; const int lo_ = b_ * TPB + (p_ < CTXL ? 0 : CTXL), hi_ = b_ * TPB + (p_ < CTXL ? CTXL : TPB); \
            _Pragma("unroll") for (int k = 0; k < 10; ++k) { const int row = r0_ - 1 + k; const int rc = row < lo_ ? lo_ : (row >= hi_ ? hi_ - 1 : row); \
                ncin[k] = *(const u32x4*)((const char*)prj + (unsigned)(rc * PRJ_LD + 2560 + ch) * 2u); if (row < lo_ || row >= hi_) ncin[k] = (u32x4){0u, 0u, 0u, 0u}; }         \
            _Pragma("unroll") for (int k = 0; k < 8; ++k) nbin[k] = *(const u32x4*)((const char*)prj + (unsigned)((r0_ + k) * PRJ_LD + 1536 + ch) * 2u); }
        int u = F.c; if (u < NCONV) RC_LOAD(u)
        for (; u < NCONV; u += F.G) {
            const int r0 = u * 32 + (tid >> 7) * 8;
            u32x4 cin[10], bin[8];
#pragma unroll
            for (int k = 0; k < 10; ++k) cin[k] = ncin[k];
#pragma unroll
            for (int k = 0; k < 8; ++k) bin[k] = nbin[k];
            if (u + F.G < NCONV) RC_LOAD(u + F.G)
            const unsigned so0 = (unsigned)(r0 * YLD + 1024 + ch) * 2u; __builtin_amdgcn_sched_barrier(0);
            float prev[8], cur[8], nxt[8];
            unpack8(cin[0], prev); unpack8(cin[1], cur);
#pragma unroll
            for (int rr = 0; rr < 8; ++rr) { float bb[8]; unpack8(cin[rr + 2], nxt); unpack8(bin[rr], bb);
                float o[8];
#pragma unroll
                for (int j = 0; j < 8; ++j) { o[j] = bb[j] * (w0[j] * prev[j] + w1[j] * cur[j] + w2[j] * nxt[j] + cb[j]); prev[j] = cur[j]; cur[j] = nxt[j]; }
                u32x4 w; w.x = cvt_pk_bf16(o[0], o[1]); w.y = cvt_pk_bf16(o[2], o[3]); w.z = cvt_pk_bf16(o[4], o[5]); w.w = cvt_pk_bf16(o[6], o[7]);
                *(u32x4*)((char*)yin + (so0 + (unsigned)(rr * YLD * 2))) = w; __builtin_amdgcn_sched_barrier(0); }
        }
#undef RC_LOAD
    }
    {
        const int i = tid & 31; const bool second = ((i >> 3) & 1) != 0;
        float gq[4], gk[4], fr[4];
#pragma unroll
        for (int j = 0; j < 4; ++j) { gq[j] = P.in[I_EVQN][4 * i + j]; gk[j] = P.in[I_EVKN][4 * i + j]; const int fi = 4 * (i & 7) + j; fr[j] = __powf(10000.0f, -(float)(2 * fi) * (1.0f / 64.0f)); }
        u32x2 nwv[10], nv0, nv1;
#define RR_LOAD(un) { const bf16_t* rp_ = prj + (size_t)((un) * 16 + (tid >> 5)) * PRJ_LD + 4 * i; \
            _Pragma("unroll") for (int hh = 0; hh < 10; ++hh) nwv[hh] = *(const u32x2*)(rp_ + hh * 128); nv0 = *(const u32x2*)(rp_ + 1280); nv1 = *(const u32x2*)(rp_ + 1408); }
        int k = 0, u = rope_unit(F.c, 0, F.G); if (u >= 0) RR_LOAD(u)
        for (; u >= 0; ++k) {
            const int un = rope_unit(F.c, k + 1, F.G);
            const int row = u * 16 + (tid >> 5);
            const int b = row / TPB, p = row - b * TPB; const bool lat = p >= CTXL; const int t = p - CTXL;
            u32x2 wv[10];
#pragma unroll
            for (int hh = 0; hh < 10; ++hh) wv[hh] = nwv[hh];
            const u32x2 vv0 = nv0, vv1 = nv1;
            if (un >= 0) RR_LOAD(un)
            float cs[4], sn[4];
            { const int blk = i >> 4; const float pos = lat ? (float)(blk == 0 ? (t >> 6) : (t & 63)) : 0.f;
#pragma unroll
              for (int j = 0; j < 4; ++j) { float s_, c_; sincosf(pos * fr[j], &s_, &c_); cs[j] = c_; sn[j] = s_; } }
            bf16_t* rowp = prj + (size_t)row * PRJ_LD + 4 * i;
#pragma unroll
            for (int hh = 0; hh < 10; ++hh) {
                const u32x2 w = wv[hh]; float x[4] = {bf_lo(w.x), bf_hi(w.x), bf_lo(w.y), bf_hi(w.y)};
                float ss = x[0] * x[0] + x[1] * x[1] + x[2] * x[2] + x[3] * x[3];
#pragma unroll
                for (int o = 16; o >= 1; o >>= 1) ss += __shfl_xor(ss, o);
                const float rinv = __builtin_amdgcn_rsqf(ss * (1.0f / 128.0f) + EPS);
                float y[4];
#pragma unroll
                for (int j = 0; j < 4; ++j) y[j] = x[j] * rinv * (hh < 8 ? gq[j] : gk[j]);
                float o4[4];
#pragma unroll
                for (int j = 0; j < 4; ++j) { const float pr = __shfl_xor(y[j], 8); o4[j] = second ? (pr * sn[j] + y[j] * cs[j]) : (y[j] * cs[j] - pr * sn[j]); }
                wv[hh].x = cvt_pk_bf16(o4[0], o4[1]); wv[hh].y = cvt_pk_bf16(o4[2], o4[3]);
            }
#pragma unroll
            for (int hh = 0; hh < 8; ++hh) *(u32x2*)(rowp + hh * 128) = wv[hh];
            bf16_t* kc = (bf16_t*)(F.ws + WS_KC) + ((size_t)(b * 2) * TPB + p) * 128 + 4 * i; bf16_t* vc = (bf16_t*)(F.ws + WS_VC) + ((size_t)(b * 2) * TPB + p) * 128 + 4 * i;
            *(u32x2*)kc = wv[8]; *(u32x2*)(kc + (size_t)TPB * 128) = wv[9]; *(u32x2*)vc = vv0; *(u32x2*)(vc + (size_t)TPB * 128) = vv1;
            u = un;
        }
#undef RR_LOAD
    }
}

__device__ __forceinline__ void phase_attn(const Ctx& F) {
    const bf16_t* prj = (const bf16_t*)(F.ws + WS_PRJ); bf16_t* yin = (bf16_t*)(F.ws + WS_YIN);
    const int combo = F.c & 7, b = combo >> 1, kvh = combo & 1;
    const bf16_t* Kh = (const bf16_t*)(F.ws + WS_KC) + (size_t)(b * 2 + kvh) * TPB * 128; const bf16_t* Vh = (const bf16_t*)(F.ws + WS_VC) + (size_t)(b * 2 + kvh) * TPB * 128;
#define ATT_UNIT(i) do { const int w = (F.c >> 3) + 32 * (i); const int hq = kvh * 4 + ((i) < 2 ? (w >> 4) : (F.c >> 3)), qb = w & 15; \
        const size_t qrow = (size_t)b * TPB + ((i) < 2 ? CTXL + qb * 256 : 0); \
        att::attn_dense_body(prj + qrow * PRJ_LD + hq * 128, Kh, Vh, yin + qrow * YLD + hq * 128, (i) < 2 ? TPB : CTXL, F.ldsg, F.wid); } while (0)
    ATT_UNIT(0);
    ATT_UNIT(1);
    if (F.c < 32) ATT_UNIT(2);
#undef ATT_UNIT
}

__device__ __forceinline__ void phase_lru_conv(const Ctx& F) {
    const Params& P = F.P; const int tid = F.wid * 64 + lane_fresh();
    const bf16_t* prj = (const bf16_t*)(F.ws + WS_PRJ); bf16_t* U = (bf16_t*)(F.ws + WS_U);
    constexpr int RG = 8, NRG = MROWS / RG;
    const int gt = F.c * 512 + tid, nth = (F.G * 512) / 320;
    if (gt < nth * 320) {
        const int ch = (gt % 320) * 8; int rg = gt / 320;
        const float* cw = P.in[I_ODCW]; float w0[8], w1[8], w2[8], w3[8], cb[8];
#pragma unroll
        for (int j = 0; j < 8; ++j) { w0[j] = cw[ch + j]; w1[j] = cw[LRUW + ch + j]; w2[j] = cw[2 * LRUW + ch + j]; w3[j] = cw[3 * LRUW + ch + j]; cb[j] = P.in[I_ODCB][ch + j]; }
        u32x4 nin[RG + 3];
#define LC_LOAD(g) { const int r0_ = (g) * RG; const int b_ = r0_ / TPB, p_ = r0_ - b_ * TPB; const int lo_ = b_ * TPB + (p_ < CTXL ? 0 : CTXL), hi_ = b_ * TPB + (p_ < CTXL ? CTXL : TPB); \
            _Pragma("unroll") for (int k = 0; k < RG + 3; ++k) { const int row = r0_ - 1 + k; const int rc = row < lo_ ? lo_ : (row >= hi_ ? hi_ - 1 : row); \
                nin[k] = *(const u32x4*)((const char*)prj + (unsigned)(rc * PRJ_LD + ch) * 2u); if (row < lo_ || row >= hi_) nin[k] = (u32x4){0u, 0u, 0u, 0u}; } }
        if (rg < NRG) LC_LOAD(rg)
        for (; rg < NRG; rg += nth) {
            u32x4 xin[RG + 3];
#pragma unroll
            for (int k = 0; k < RG + 3; ++k) xin[k] = nin[k];
            if (rg + nth < NRG) LC_LOAD(rg + nth)
            const unsigned so0 = (unsigned)(rg * RG * LRUW + ch) * 2u; __builtin_amdgcn_sched_barrier(0);
#pragma unroll
            for (int rr = 0; rr < RG; ++rr) { float xm[8], x0[8], x1[8], x2[8]; unpack8(xin[rr], xm); unpack8(xin[rr + 1], x0); unpack8(xin[rr + 2], x1); unpack8(xin[rr + 3], x2);
                float o[8];
#pragma unroll
                for (int j = 0; j < 8; ++j) o[j] = w0[j] * xm[j] + w1[j] * x0[j] + w2[j] * x1[j] + w3[j] * x2[j] + cb[j];
                u32x4 w; w.x = cvt_pk_bf16(o[0], o[1]); w.y = cvt_pk_bf16(o[2], o[3]); w.z = cvt_pk_bf16(o[4], o[5]); w.w = cvt_pk_bf16(o[6], o[7]);
                *(u32x4*)((char*)U + (so0 + (unsigned)(rr * LRUW * 2))) = w; __builtin_amdgcn_sched_barrier(0); }
        }
#undef LC_LOAD
    }
}

__device__ __forceinline__ int scan_chunk_at(int d, int k) { return d == 0 ? k : (k < 4 ? 3 - k : 71 - k); }
__device__ __forceinline__ int scan_order_of(int d, int c) { return d == 0 ? c : (c < 4 ? 3 - c : 71 - c); }
__device__ __forceinline__ void scan_dec(unsigned w, float sp0, float sp1, float& a0, float& b0, float& a1, float& b1) {
    const float q0 = (float)(w & 0xffu) * (1.0f / 255.0f), q1 = (float)((w >> 8) & 0xffu) * (1.0f / 255.0f);
    a0 = __expf(q0 * q0 * sp0); a1 = __expf(q1 * q1 * sp1); b0 = __builtin_amdgcn_cvt_f32_fp8((int)w, 2); b1 = __builtin_amdgcn_cvt_f32_fp8((int)w, 3);
}
__device__ __forceinline__ float lru_sp(const float* lam, int d, int ch) { const float lm = lam[d * LRUW + ch]; return -8.0f * (fmaxf(-lm, 0.f) + __logf(1.0f + __expf(-fabsf(lm)))); }
__device__ __forceinline__ void phase_scan1(const Ctx& F) {
    const unsigned short* lav = (const unsigned short*)(F.ws + WS_LAGI); float* agg = (float*)(F.ws + WS_AGG); const int lane = lane_fresh(); const float* lam = F.P.in[I_ODLAM];
    float* carry = (float*)(F.ws + WS_CARRY); unsigned* scnt = (unsigned*)(F.ws + WS_SCNT);
    constexpr int NU = 2 * NB * 68 * 10;
    const int half = lane >> 5, sub = lane & 31;
    for (int u = F.c * 8 + F.wid; u < NU; u += F.G * 8) {
        const int cg = u % 10, c = (u / 10) % 68, b = (u / (10 * 68)) % NB, d = u / (10 * 68 * NB);
        const int ch = cg * 256 + sub * 8;
        const int r0 = d == 0 ? half * 32 : 63 - half * 32; const int rstep = d == 0 ? LRUW * 2 : -LRUW * 2;
        unsigned off = (unsigned)((((size_t)d * MROWS + (size_t)b * TPB + c * 64 + r0) * LRUW + ch) * 2);
        float hh[8], ss[8], sp[8];
#pragma unroll
        for (int j = 0; j < 8; ++j) { hh[j] = 0.f; ss[j] = 0.f; sp[j] = lru_sp(lam, d, ch + j); asm volatile("" : "+v"(sp[j])); }
#pragma unroll
        for (int blk = 0; blk < 2; ++blk) { u32x4 w[16];
#pragma unroll
            for (int kk = 0; kk < 16; ++kk) { w[kk] = *(const u32x4*)((const char*)lav + off); off += (unsigned)rstep; }
#pragma unroll
            for (int kk = 0; kk < 16; ++kk) {
#pragma unroll
                for (int p = 0; p < 4; ++p) { const unsigned x = p == 0 ? w[kk].x : (p == 1 ? w[kk].y : (p == 2 ? w[kk].z : w[kk].w));
                    const float q0 = (float)(x & 0xffu) * (1.0f / 255.0f), q1 = (float)((x >> 8) & 0xffu) * (1.0f / 255.0f); const float la0 = q0 * q0 * sp[2 * p], la1 = q1 * q1 * sp[2 * p + 1];
                    hh[2 * p] = __expf(la0) * hh[2 * p] + __builtin_amdgcn_cvt_f32_fp8((int)x, 2); hh[2 * p + 1] = __expf(la1) * hh[2 * p + 1] + __builtin_amdgcn_cvt_f32_fp8((int)x, 3); ss[2 * p] += la0; ss[2 * p + 1] += la1;
                    asm volatile("" : "+v"(hh[2 * p]), "+v"(hh[2 * p + 1]), "+v"(ss[2 * p]), "+v"(ss[2 * p + 1])); }
                __builtin_amdgcn_sched_barrier(0); }
        }
        float so[8], ho[8];
#pragma unroll
        for (int j = 0; j < 8; ++j) { so[j] = __shfl_xor(ss[j], 32); ho[j] = __shfl_xor(hh[j], 32); }
        if (half == 1) { float* ap = agg + ((((size_t)d * NB + b) * 68 + c) * LRUW + ch) * 2;
#pragma unroll
            for (int p = 0; p < 4; ++p) { const float h0 = __expf(ss[2 * p]) * ho[2 * p] + hh[2 * p], h1 = __expf(ss[2 * p + 1]) * ho[2 * p + 1] + hh[2 * p + 1];
                st_wt16(ap + 4 * p, (f32x4){ss[2 * p] + so[2 * p], h0, ss[2 * p + 1] + so[2 * p + 1], h1}); } }
        asm volatile("s_waitcnt vmcnt(0)" ::: "memory");
        unsigned old_ = 0u;
        if (lane == 0) old_ = __hip_atomic_fetch_add(scnt + (((d * NB + b) * 10 + cg) * 16), 1u, __ATOMIC_RELAXED, __HIP_MEMORY_SCOPE_AGENT);
        old_ = (unsigned)__builtin_amdgcn_readfirstlane((int)old_);
        if (old_ == 67u) {
            __builtin_amdgcn_fence(__ATOMIC_ACQUIRE, "agent");
            const int pch = cg * 256 + lane * 4; float st[4] = {0.f, 0.f, 0.f, 0.f};
            const float* ab = agg + (((size_t)d * NB + b) * 68 * LRUW + pch) * 2; float* cb = carry + ((size_t)d * NB + b) * 68 * LRUW + pch;
#pragma unroll 1
            for (int k0 = 0; k0 < 68; k0 += 17) { f32x4 a0[17], a1[17];
#pragma unroll
                for (int j = 0; j < 17; ++j) { const int cc = scan_chunk_at(d, k0 + j); a0[j] = *(const f32x4*)(ab + (size_t)cc * LRUW * 2); a1[j] = *(const f32x4*)(ab + (size_t)cc * LRUW * 2 + 4); }
#pragma unroll
                for (int j = 0; j < 17; ++j) { const int cc = scan_chunk_at(d, k0 + j);
                    *(f32x4*)(cb + (size_t)cc * LRUW) = (f32x4){st[0], st[1], st[2], st[3]};
                    st[0] = __expf(a0[j][0]) * st[0] + a0[j][1]; st[1] = __expf(a0[j][2]) * st[1] + a0[j][3]; st[2] = __expf(a1[j][0]) * st[2] + a1[j][1]; st[3] = __expf(a1[j][2]) * st[3] + a1[j][3]; } }
        }
    }
}
__device__ __forceinline__ void scan_carry(const float* agg, int d, int b, int c, int ch, float& h0, float& h1) {
    h0 = 0.f; h1 = 0.f; const int ord = scan_order_of(d, c);
    for (int k0 = 0; k0 < ord; k0 += 16) { f32x4 a[16];
#pragma unroll
        for (int j = 0; j < 16; ++j) { const int cc = scan_chunk_at(d, (k0 + j < ord) ? k0 + j : 0); a[j] = *(const f32x4*)(agg + ((((size_t)d * NB + b) * 68 + cc) * LRUW + ch) * 2);
            if (k0 + j >= ord) a[j] = (f32x4){0.f, 0.f, 0.f, 0.f}; }
#pragma unroll
        for (int j = 0; j < 16; ++j) { h0 = __expf(a[j][0]) * h0 + a[j][1]; h1 = __expf(a[j][2]) * h1 + a[j][3]; } }
}
__device__ __forceinline__ void phase_scan2(const Ctx& F) {
    const unsigned short* lav = (const unsigned short*)(F.ws + WS_LAGI); const float* carry = (const float*)(F.ws + WS_CARRY); const float* lam = F.P.in[I_ODLAM];
    const bf16_t* prj = (const bf16_t*)(F.ws + WS_PRJ); bf16_t* yin = (bf16_t*)(F.ws + WS_YIN); const int lane = lane_fresh();
    constexpr int NU = NB * 64 * 20;
    for (int u = F.c * 8 + F.wid; u < NU; u += F.G * 8) {
        const int cg = u % 20, c = 4 + (u / 20) % 64, b = u / (20 * 64);
        const int ch = cg * 128 + lane * 2; const size_t row0 = (size_t)b * TPB + c * 64;
        unsigned yf[64]; float h0, h1;
        { const f32x2 cv = *(const f32x2*)(carry + (((size_t)0 * NB + b) * 68 + c) * LRUW + ch); h0 = cv.x; h1 = cv.y; }
        { const size_t base = row0 * LRUW + ch;
          const float sp0 = lru_sp(lam, 0, ch), sp1 = lru_sp(lam, 0, ch + 1);
#pragma unroll
          for (int blk = 0; blk < 4; ++blk) { unsigned w[16];
#pragma unroll
            for (int r = 0; r < 16; ++r) w[r] = *(const unsigned*)(lav + base + (size_t)(blk * 16 + r) * LRUW);
#pragma unroll
            for (int r = 0; r < 16; ++r) { float a0, b0, a1, b1; scan_dec(w[r], sp0, sp1, a0, b0, a1, b1); h0 = a0 * h0 + b0; h1 = a1 * h1 + b1; yf[blk * 16 + r] = cvt_pk_bf16(h0, h1); } } }
        { const f32x2 cv = *(const f32x2*)(carry + (((size_t)1 * NB + b) * 68 + c) * LRUW + ch); h0 = cv.x; h1 = cv.y; }
        { const size_t base = (size_t)MROWS * LRUW + row0 * LRUW + ch;
          const float sp0 = lru_sp(lam, 1, ch), sp1 = lru_sp(lam, 1, ch + 1);
#pragma unroll
          for (int blk = 3; blk >= 0; --blk) { unsigned w[16]; unsigned gw[16];
#pragma unroll
            for (int r = 0; r < 16; ++r) { w[r] = *(const unsigned*)(lav + base + (size_t)(blk * 16 + r) * LRUW); gw[r] = *(const unsigned*)(prj + (row0 + blk * 16 + r) * PRJ_LD + LRUW + ch); }
#pragma unroll
            for (int r = 15; r >= 0; --r) { float a0, b0, a1, b1; scan_dec(w[r], sp0, sp1, a0, b0, a1, b1); h0 = a0 * h0 + b0; h1 = a1 * h1 + b1;
                const unsigned f = yf[blk * 16 + r]; gw[r] = cvt_pk_bf16((h0 + bf_lo(f)) * bf_lo(gw[r]), (h1 + bf_hi(f)) * bf_hi(gw[r])); }
#pragma unroll
            for (int r = 0; r < 16; ++r) *(unsigned*)(yin + (row0 + blk * 16 + r) * YLD + ch) = gw[r]; } }
    }
}

constexpr int NPHASE = 22;
constexpr int LDS_BYTES = 147456;
constexpr int LDS_MISC = 135168;
__global__ void __launch_bounds__(512, 2) mk_fwd(Params prm) {
    extern __shared__ __attribute__((aligned(16))) unsigned char lds_raw[];
    Ctx F; F.P = prm; F.ws = prm.ws; F.wid = __builtin_amdgcn_readfirstlane((int)threadIdx.x >> 6); F.G = gridDim.x; F.c = blockIdx.x;
    F.lds = (LAS unsigned char*)lds_raw; F.ldsg = (char*)lds_raw;
    volatile LAS unsigned* misc = (volatile LAS unsigned*)(F.lds + LDS_MISC);
    if (threadIdx.x < 4) misc[threadIdx.x] = 0u;
    __syncthreads();
    XcdBarrier bar; bar.bar = (unsigned*)(F.ws + WS_CTL); bar.x = 0; bar.st = misc; bar.wid = F.wid;
    const int lo = prm.ph_lo, hi = prm.ph_hi;
    if (hi - lo > 1) bar = xcd_barrier_post((unsigned*)(F.ws + WS_CTL), misc, F.wid);
#ifndef PH_MASK
#define PH_MASK 0xffffffffu
#endif
#define IN(k) ((((unsigned)PH_MASK >> (k)) & 1u) && lo <= (k) && (k) < hi)
#define SEAM(k) do { if (IN((k) + 1)) xcd_barrier(bar); } while (0)
#ifndef REP_MASK
#define REP_MASK 0u
#endif
#define NREP(k) ((((unsigned)REP_MASK >> (k)) & 1u) ? 2 : 1)
#define PHASE(k, ...) if (IN(k)) { for (int rep_ = 0; rep_ < NREP(k); ++rep_) { __VA_ARGS__ if (rep_ + 1 < NREP(k)) xcd_barrier(bar); } SEAM(k); }
    const float* mod = (const float*)(F.ws + WS_MOD);
    PHASE(0, p0_prologue(F);)
    PHASE(1, phase_norm<0>(F);)
    PHASE(2, if (F.c < F.G - NCV2) { SchedDense S{(const char*)(F.ws + WS_ACT), (const char*)(F.ws + WS_WEVIN), NMT, EV_IN / 256, F.G - NCV2, F.c, DM, DM, 0};
        EpiEvIn E{(bf16_t*)(F.ws + WS_PRJ), PRJ_LD}; pg8::gemm_phase<false, false>(F.lds, F.wid, pg8::Shape{DM, DM}, S, E); } else conv_range(F, GT0, GT2, F.G - NCV2);)
    PHASE(3, phase_rope_conv(F);)
    PHASE(4, phase_attn(F);)
    PHASE(5, if (F.c < F.G - NCV5) { SchedDense S{(const char*)(F.ws + WS_YIN), (const char*)(F.ws + WS_WEVOUT), NMT, DM / 256, F.G - NCV5, F.c, YLD, DM, 0};
        EpiResid E{prm.in[I_X], prm.in[I_CTX], (bf16_t*)(F.ws + WS_H), mod, 1}; pg8::gemm_phase<false, false>(F.lds, F.wid, pg8::Shape{DM, YLD}, S, E); } else conv_range(F, GT2, GT5, F.G - NCV5);)
    PHASE(6, phase_router(F, 0);)
    PHASE(7, phase_topk(F, 0);)
    PHASE(8, SchedMoe S{(const char*)(F.ws + WS_ACT), (const char*)(F.ws + WS_WGU), 9, 16, 2304, 4096, F.G, F.c, (const unsigned*)(F.ws + WS_OFFT)};
        EpiSwiglu E{F.ws + WS_HID, 2304}; pg8::gemm_phase<true, true>(F.lds, F.wid, pg8::Shape{DM / 2, DM / 2}, S, E);)
    PHASE(9, if (F.c < F.G - NCV9) { SchedMoe S{(const char*)(F.ws + WS_HID), (const char*)(F.ws + WS_WDN), 9, 8, 2304, 2048, F.G - NCV9, F.c, nullptr};
        EpiDown E{F.ws + WS_EO, (const float*)(F.ws + WS_GVAL), 2304}; pg8::gemm_phase<true, false>(F.lds, F.wid, pg8::Shape{DM / 2, DM / 2}, S, E); } else conv_range(F, GT5, GT9, F.G - NCV9);)
    PHASE(10, phase_norm<1>(F);)
    PHASE(11, if (F.c < F.G - NCV11) { SchedOdIn S{(const char*)(F.ws + WS_ACT), (const char*)(F.ws + WS_WODIN), F.G - NCV11, F.c};
        EpiPlainBf16 E{(bf16_t*)(F.ws + WS_PRJ), PRJ_LD, 10}; pg8::gemm_phase<false, false>(F.lds, F.wid, pg8::Shape{DM, DM}, S, E); } else conv_range(F, GT9, GT11, F.G - NCV11);)
    PHASE(12, phase_lru_conv(F);)
    PHASE(13, if (F.c < F.G - NCV13) { SchedLru S{(const char*)(F.ws + WS_U), (const char*)(F.ws + WS_WLRU), F.G - NCV13, F.c};
        EpiLru E{(const bf16_t*)(F.ws + WS_U), (unsigned*)(F.ws + WS_LAGI), prm.in[I_ODBA], prm.in[I_ODBX], prm.in[I_ODLAM]}; pg8::gemm_phase<false, false>(F.lds, F.wid, pg8::Shape{256, LRUW}, S, E); } else conv_range(F, GT11, GT13, F.G - NCV13);)
    PHASE(14, phase_scan1(F);)
    PHASE(15, phase_scan2(F);)
    PHASE(16, SchedDense S{(const char*)(F.ws + WS_YIN), (const char*)(F.ws + WS_WODOUT), 64, DM / 256, F.G, F.c, YLD, LRUW, 1};
        EpiResid E{prm.in[I_X], prm.in[I_CTX], (bf16_t*)(F.ws + WS_H), mod + 5 * MODN, 0}; pg8::gemm_phase<false, false>(F.lds, F.wid, pg8::Shape{LRUW, YLD}, S, E);)
    PHASE(17, phase_router(F, 1);)
    PHASE(18, phase_topk(F, 1);)
    PHASE(19, SchedMoe S{(const char*)(F.ws + WS_ACT), (const char*)(F.ws + WS_WGU) + (size_t)NEXP * 4096 * DM, 8, 16, 2048, 4096, F.G, F.c, (const unsigned*)(F.ws + WS_OFFT)};
        EpiSwiglu E{F.ws + WS_HID, 2048}; pg8::gemm_phase<true, true>(F.lds, F.wid, pg8::Shape{DM / 2, DM / 2}, S, E);)
    PHASE(20, SchedMoe S{(const char*)(F.ws + WS_HID), (const char*)(F.ws + WS_WDN) + (size_t)NEXP * DM * DM, 8, 8, 2048, 2048, F.G, F.c, nullptr};
        EpiDown E{F.ws + WS_EO, (const float*)(F.ws + WS_GVAL), 2048}; pg8::gemm_phase<true, false>(F.lds, F.wid, pg8::Shape{DM / 2, DM / 2}, S, E);)
    PHASE(21, phase_norm<2>(F);)
#undef IN
#undef SEAM
}

extern "C" void kernel_launch(void* const* d_in, const int* in_sizes, int n_in, void* d_out, int out_size, void* d_ws, size_t ws_size, hipStream_t stream) {
    static int grid = 0;
    if (grid == 0) {
        if (n_in != 28 || out_size != NB * SEQ * DM || ws_size < WS_END) { fprintf(stderr, "kernel_launch: bad shapes: n_in %d out %d ws %zu (need %zu)\n", n_in, out_size, ws_size, (size_t)WS_END); grid = -1; return; }
        int dev = 0, cus = 0, per_cu = 0;
        if (hipGetDevice(&dev) != hipSuccess || hipDeviceGetAttribute(&cus, hipDeviceAttributeMultiprocessorCount, dev) != hipSuccess) { grid = -1; return; }
        if (hipFuncSetAttribute((const void*)mk_fwd, hipFuncAttributeMaxDynamicSharedMemorySize, LDS_BYTES) != hipSuccess) { fprintf(stderr, "kernel_launch: hipFuncSetAttribute failed\n"); grid = -1; return; }
        if (hipOccupancyMaxActiveBlocksPerMultiprocessor(&per_cu, (const void*)mk_fwd, 512, LDS_BYTES) != hipSuccess || per_cu < 1) fprintf(stderr, "kernel_launch: occupancy query says %d\n", per_cu);
        (void)hipGetLastError();
        grid = cus;
    }
    if (grid < 0) return;
    (void)in_sizes;
    (void)hipMemsetAsync((char*)d_ws + WS_CTL, 0, 65536, stream);
    Params p{};
    for (int i = 0; i < 28; ++i) p.in[i] = (const float*)d_in[i];
    p.out = (float*)d_out; p.ws = (unsigned char*)d_ws;
#if MK_PER_PHASE
    for (int ph = 0; ph < NPHASE; ++ph) { p.ph_lo = ph; p.ph_hi = ph + 1; hipLaunchKernelGGL(mk_fwd, dim3(grid), dim3(512), LDS_BYTES, stream, p); }
#else
    p.ph_lo = 0; p.ph_hi = NPHASE; hipLaunchKernelGGL(mk_fwd, dim3(grid), dim3(512), LDS_BYTES, stream, p);
#endif
    const hipError_t le = hipPeekAtLastError();
    if (le != hipSuccess) fprintf(stderr, "kernel_launch: launch failed: %s\n", hipGetErrorName(le));
}
```

```cpp
#include <hip/hip_runtime.h>
#include <cstdio>
#include <cstdint>

#ifndef MK_PER_PHASE
#define MK_PER_PHASE 0
#endif

#define LAS __attribute__((address_space(3)))
typedef unsigned short bf16_t;
typedef short bf16x8 __attribute__((ext_vector_type(8)));
typedef short s16x4 __attribute__((ext_vector_type(4)));
typedef float f32x4 __attribute__((ext_vector_type(4)));
typedef float f32x2 __attribute__((ext_vector_type(2)));
typedef float f32x16 __attribute__((ext_vector_type(16)));
typedef unsigned u32x4 __attribute__((ext_vector_type(4)));
typedef unsigned u32x2 __attribute__((ext_vector_type(2)));
typedef int i32x8 __attribute__((ext_vector_type(8)));
typedef int i32x8a __attribute__((ext_vector_type(8), aligned(16)));
typedef int i32x4a __attribute__((ext_vector_type(4), aligned(16)));

#define XB_TMO      128
#define XB_XCNT(j)  (256  + 64 * (j))
#define XB_XSUB(j)  (1280 + 64 * (j))
#define XB_XGEN(j)  (2304 + 64 * (j))
#define XB_TOP      3328
#define XB_TOPGEN   3392
#define XCD_BAR_WORDS 3456
#define XB_SPIN_CAP (1u << 18)

__device__ __forceinline__ unsigned xb_ld(unsigned* p)              { return __hip_atomic_load(p, __ATOMIC_RELAXED, __HIP_MEMORY_SCOPE_AGENT); }
__device__ __forceinline__ unsigned xb_add(unsigned* p, unsigned v) { return __hip_atomic_fetch_add(p, v, __ATOMIC_RELAXED, __HIP_MEMORY_SCOPE_AGENT); }
__device__ __forceinline__ unsigned xb_xcc_id() { return (unsigned)__builtin_amdgcn_s_getreg((3 << 11) | 20) & 0xFu; }
#define XB_SPIN(cond, bar) do { unsigned _sp = 0; while (cond) { __builtin_amdgcn_s_sleep(1); \
    if ((++_sp & 255u) == 0u) { if (xb_ld(&(bar)[XB_TMO])) break; if (_sp > XB_SPIN_CAP) { atomicAdd(&(bar)[XB_TMO], 1u); break; } } } } while (0)

struct XcdBarrier { unsigned* bar; unsigned x; volatile LAS unsigned* st; int wid; };

__device__ __forceinline__ int xb_lane() { int l; asm volatile("v_mbcnt_lo_u32_b32 %0, -1, 0\n\tv_mbcnt_hi_u32_b32 %0, -1, %0" : "=v"(l)); return l; }
__device__ __forceinline__ XcdBarrier xcd_barrier_post(unsigned* bar, volatile LAS unsigned* st, int wid) {
    XcdBarrier b; b.bar = bar; b.x = xb_xcc_id(); b.st = st; b.wid = wid;
    if (wid == 0 && xb_lane() == 0) (void)xb_add(&bar[XB_XCNT(b.x)], 1u);
    return b;
}
__device__ __forceinline__ void xcd_barrier_complete(unsigned* bar, unsigned x, unsigned& nloc, unsigned& nx) {
    const unsigned G = gridDim.x * gridDim.y * gridDim.z;
    unsigned sum, cnt, mine, sp = 0u;
    for (;;) {
        sum = 0u; cnt = 0u; mine = 0u;
#pragma unroll
        for (unsigned j = 0; j < 16; ++j) { const unsigned c = xb_ld(&bar[XB_XCNT(j)]); sum += c; cnt += (c > 0u) ? 1u : 0u; mine = (j == x) ? c : mine; }
        if (sum == G) break;
        __builtin_amdgcn_s_sleep(1);
        if ((++sp & 255u) == 0u) { if (xb_ld(&bar[XB_TMO])) break; if (sp > XB_SPIN_CAP) { atomicAdd(&bar[XB_TMO], 1u); break; } }
    }
    nloc = mine > 0u ? mine : 1u; nx = cnt > 0u ? cnt : 1u;
}
__device__ __forceinline__ void xcd_barrier(const XcdBarrier& b) {
    asm volatile("s_waitcnt vmcnt(0)" ::: "memory");
    __syncthreads();
    if (b.wid == 0 && xb_lane() == 0) {
        unsigned* bar = b.bar;
        __builtin_amdgcn_s_waitcnt(0);
        unsigned nloc = b.st[0], nx = b.st[1];
        if (nloc == 0u) { xcd_barrier_complete(bar, b.x, nloc, nx); b.st[0] = nloc; b.st[1] = nx; }
        const unsigned old = xb_add(&bar[XB_XSUB(b.x)], 1u);
        const unsigned gen = old / nloc;
        if (old + 1u == (gen + 1u) * nloc) {
            __builtin_amdgcn_fence(__ATOMIC_RELEASE, "agent");
            asm volatile("s_waitcnt vmcnt(0)" ::: "memory");
            const unsigned og = xb_add(&bar[XB_TOP], 1u);
            const unsigned tg = og / nx;
            if (og + 1u == (tg + 1u) * nx) xb_add(&bar[XB_TOPGEN], 1u);
            else XB_SPIN(xb_ld(&bar[XB_TOPGEN]) == tg, bar);
            __builtin_amdgcn_fence(__ATOMIC_ACQUIRE, "agent");
            xb_add(&bar[XB_XGEN(b.x)], 1u);
            asm volatile("s_waitcnt vmcnt(0)" ::: "memory");
        } else {
            XB_SPIN(xb_ld(&bar[XB_XGEN(b.x)]) == gen, bar);
            __builtin_amdgcn_fence(__ATOMIC_ACQUIRE, "agent");
            asm volatile("s_waitcnt vmcnt(0)" ::: "memory");
        }
    }
    __syncthreads();
}

constexpr int DM = 2048, NB = 4, SEQ = 4096, CTXL = 256, TPB = SEQ + CTXL  , MROWS = NB * TPB  ;
constexpr int NMT = MROWS / 256;
constexpr int EV_IN = 4608, OD_IN = 5120, LRUW = 2560, PRJ_LD = 5120, YLD = 2560, MODN = 12288;
constexpr int NEXP = 16, FF = 2048;
constexpr float EPS = 1e-6f;
constexpr float W8_SCALE = 32.0f, W8_INV = 1.0f / 32.0f;

constexpr size_t al256(size_t x) { return (x + 255) / 256 * 256; }
constexpr size_t WS_CTL   = 0;
constexpr size_t WS_MOD   = 65536;
constexpr size_t WS_WEVIN = WS_MOD   + al256((size_t)2 * 5 * MODN * 4);
constexpr size_t WS_WEVOUT= WS_WEVIN + (size_t)EV_IN * DM * 2;
constexpr size_t WS_WODIN = WS_WEVOUT+ (size_t)DM * DM * 2;
constexpr size_t WS_WLRU  = WS_WODIN + (size_t)OD_IN * DM * 2;
constexpr size_t WS_WODOUT= WS_WLRU  + (size_t)2 * 10 * 512 * 256 * 2;
constexpr size_t WS_WGU   = WS_WODOUT+ (size_t)DM * LRUW * 2;
constexpr size_t WS_WDN   = WS_WGU   + (size_t)2 * NEXP * 4096 * DM;
constexpr size_t WS_H     = WS_WDN   + (size_t)2 * NEXP * DM * DM;
constexpr size_t WS_ACT   = WS_H     + (size_t)MROWS * DM * 4;
constexpr size_t WS_PRJ   = WS_ACT   + (size_t)MROWS * DM * 2;
constexpr size_t WS_U     = WS_PRJ   + (size_t)MROWS * PRJ_LD * 2;
constexpr size_t WS_YIN   = WS_U     + (size_t)MROWS * LRUW * 2;
constexpr size_t WS_AFF   = WS_YIN   + (size_t)MROWS * YLD * 2;
constexpr size_t WS_SLOT  = WS_AFF   + (size_t)MROWS * 16 * 4;
constexpr size_t WS_GVAL  = WS_SLOT  + (size_t)MROWS * 16 * 4;
constexpr size_t WS_OFFT  = WS_GVAL  + al256((size_t)NEXP * 2304 * 4);
constexpr size_t WS_AGG   = WS_OFFT  + al256((size_t)NEXP * 2304 * 4);
constexpr size_t WS_XS    = WS_AGG   + (size_t)2 * NB * 68 * LRUW * 8;
constexpr size_t WS_HID   = WS_XS    + (size_t)NEXP * 2304 * DM * 2;
constexpr size_t WS_EO    = WS_HID   + (size_t)NEXP * 2304 * DM * 2;
constexpr size_t WS_KC    = WS_EO    + (size_t)NEXP * 2304 * DM * 2;
constexpr size_t WS_VC    = WS_KC    + (size_t)NB * 2 * TPB * 128 * 2;
constexpr size_t WS_CARRY = WS_VC    + (size_t)NB * 2 * TPB * 128 * 2;
constexpr size_t WS_END   = WS_CARRY + (size_t)2 * NB * 68 * LRUW * 4;
constexpr size_t WS_SCNT  = WS_CTL + 16384;
constexpr size_t WS_LAGI  = WS_XS;
static_assert((size_t)2 * MROWS * LRUW * 4 <= WS_KC - WS_XS, "LAGI alias");

struct Params { const float* in[28]; float* out; unsigned char* ws; int ph_lo, ph_hi; };
enum { I_X = 0, I_C, I_CTX, I_CCTX, I_MODW, I_MODB, I_N1G, I_N2G, I_EVWIN, I_EVQN, I_EVKN, I_EVCW, I_EVCB, I_EVWOUT, I_ODWIN, I_ODCW, I_ODCB, I_ODWA, I_ODBA, I_ODWX, I_ODBX,
       I_ODLAM, I_ODWOUT, I_ROUTER, I_WGATE, I_WUP, I_WDOWN, I_FNG };

__device__ __forceinline__ unsigned cvt_pk_bf16(float lo, float hi) { unsigned r; asm volatile("v_cvt_pk_bf16_f32 %0, %1, %2" : "=v"(r) : "v"(lo), "v"(hi)); return r; }
__device__ __forceinline__ unsigned pk4_fp8(float a, float b, float c, float d) { int w = 0; w = __builtin_amdgcn_cvt_pk_fp8_f32(a, b, w, false); w = __builtin_amdgcn_cvt_pk_fp8_f32(c, d, w, true); return (unsigned)w; }
#define GAS __attribute__((address_space(1)))
__device__ __forceinline__ f32x4 ld_nt(const float* p) { return __builtin_nontemporal_load((const GAS f32x4*)(const GAS float*)p); }
__device__ __forceinline__ void st_nt(float* p, f32x4 v) { __builtin_nontemporal_store(v, (GAS f32x4*)(GAS float*)p); }
__device__ __forceinline__ void st_wt16(float* p, f32x4 v) { asm volatile("global_store_dwordx4 %0, %1, off sc1\n\ts_nop 1" :: "v"(p), "v"(v) : "memory"); }
__device__ __forceinline__ float bf_lo(unsigned w) { return __uint_as_float(w << 16); }
__device__ __forceinline__ float bf_hi(unsigned w) { return __uint_as_float(w & 0xffff0000u); }
__device__ __forceinline__ int lane_fresh() { int l; asm volatile("v_mbcnt_lo_u32_b32 %0, -1, 0\n\tv_mbcnt_hi_u32_b32 %0, -1, %0" : "=v"(l)); return l; }
__device__ __forceinline__ float wave_sum(float v) {
#pragma unroll
    for (int o = 32; o >= 1; o >>= 1) v += __shfl_xor(v, o);
    return v;
}
__device__ __forceinline__ float fast_sigmoid(float x) { return __builtin_amdgcn_rcpf(1.0f + __builtin_amdgcn_exp2f(-1.4426950408889634f * x)); }
__device__ __forceinline__ float gelu_tanh(float x) { const float t = 0.7978845608028654f * (x + 0.044715f * x * x * x); return x * fast_sigmoid(2.0f * t); }
__device__ __forceinline__ int xcd_remap(int L, int nwg) { const int q = nwg >> 3, r = nwg & 7, xcd = L & 7, off = L >> 3; return (xcd < r ? xcd * (q + 1) : r * (q + 1) + (xcd - r) * q) + off; }

namespace pg8 {
constexpr int BM = 256, BK = 64, HALF = 128, HTB = HALF * BK * 2, STAGE_BYTES = 8 * HTB;
__device__ __forceinline__ int lds_byte(int r, int c) { const int st = (r >> 4) * 2 + (c >> 5), rr = r & 15, cc = c & 31, ob = rr * 64 + cc * 2; return st * 1024 + (ob ^ (((ob >> 9) & 1) << 5)); }
__device__ __forceinline__ void stage_rc(int b, int& R, int& C) { const int st = b / 1024, sb = b % 1024, swz = sb ^ (((sb >> 9) & 1) << 5); R = (st >> 1) * 16 + swz / 64; C = (st & 1) * 32 + (swz % 64) / 2; }
__device__ __forceinline__ int perm32(int rho) { const int n = rho >> 4, i = rho & 15; return 8 * (i >> 2) + 4 * n + (i & 3); }
struct Unit { int pm, pn, e; };
__device__ __forceinline__ void glds16_s(const void* base_uniform, unsigned voff, unsigned lds_dst) {
    unsigned keep;
    asm volatile("s_mov_b32 %0, m0\n\ts_mov_b32 m0, %3\n\ts_nop 0\n\tglobal_load_lds_dwordx4 %1, %2\n\ts_mov_b32 m0, %0" : "=&s"(keep) : "v"(voff), "s"(base_uniform), "s"(lds_dst) : "memory");
}
struct Shape { int K, lda; };

template <bool FP8, bool GATHER, class Epi, class Sched>
__device__ __forceinline__ void gemm_phase(LAS unsigned char* lds, int wid_in, const Shape g, const Sched& S, const Epi& E) {
    const int lane = lane_fresh(), wid = wid_in, tid = wid * 64 + lane, wr = wid >> 2, wc = wid & 3, fr = lane & 15, fq = lane >> 4;
    const int K = g.K, nt = K / BK;
    unsigned voffA[2], voffB[2]; int gR[2]; unsigned gC[2];
#pragma unroll
    for (int i = 0; i < 2; ++i) { int R, C; stage_rc(tid * 16 + i * 8192, R, C); const int Rb = Epi::PERM ? ((R & ~31) + perm32(R & 31)) : R;
        voffA[i] = (unsigned)(R * g.lda + C) * 2u; voffB[i] = (unsigned)(Rb * K + C) * 2u; gR[i] = R; gC[i] = (unsigned)C * 2u; }
    unsigned coff[2][2], noff[2][2], nnoff[2][2];
#define PG8_LOADOFF(dst, un) do { const unsigned* tb_ = S.offtab() + S.slotbase(un); _Pragma("unroll") for (int h_ = 0; h_ < 2; ++h_) _Pragma("unroll") for (int i_ = 0; i_ < 2; ++i_) dst[h_][i_] = tb_[h_ * 128 + gR[i_]] + gC[i_]; } while (0)
#define PG8_STAGE_A(bufoff, kb, h, nx) do { if constexpr (GATHER) { _Pragma("unroll") for (int _i = 0; _i < 2; ++_i) glds16_s(S.gbase() + (kb), (nx) ? noff[h][_i] : coff[h][_i], ldsb + (unsigned)((bufoff) + _i * 8192)); } \
        else { PG8_STAGE(bufoff, ((nx) ? nA : cA) + (kb) + (h) * hstepA, voffA); } } while (0)
    const size_t kstep = (size_t)(BK * 2);
    const size_t hstepA = (size_t)HALF * g.lda * 2, hstepB = (size_t)HALF * K * 2;
    const unsigned ldsb = (unsigned)(uintptr_t)lds + (unsigned)wid * 1024u;
    const int aoff = lds_byte(wr * 64 + fr, fq * 8), boff = lds_byte(wc * 32 + fr, fq * 8);
#define PG8_SA(b, h) (((b) * 2 + (h)) * HTB)
#define PG8_SB(b, h) ((4 + (b) * 2 + (h)) * HTB)
#define PG8_STAGE(bufoff, gbase, voff) do { _Pragma("unroll") for (int _i = 0; _i < 2; ++_i) glds16_s((gbase), (voff)[_i], ldsb + (unsigned)((bufoff) + _i * 8192)); } while (0)
#define PG8_LD32(p) __builtin_shufflevector(*(const LAS i32x4a*)(p), *(const LAS i32x4a*)((p) + 1024), 0, 1, 2, 3, 4, 5, 6, 7)
#define PG8_LDA(dst, b, h) do { if constexpr (FP8) { _Pragma("unroll") for (int m = 0; m < 4; ++m) dst##8[m] = PG8_LD32(lds + PG8_SA(b, h) + aoff + m * 2048); } \
        else { _Pragma("unroll") for (int m = 0; m < 4; ++m) _Pragma("unroll") for (int k = 0; k < 2; ++k) dst[m][k] = *(const LAS bf16x8*)(lds + PG8_SA(b, h) + aoff + m * 2048 + k * 1024); } } while (0)
#define PG8_LDB(dst, b, h) do { if constexpr (FP8) { _Pragma("unroll") for (int n = 0; n < 2; ++n) dst##8[n] = PG8_LD32(lds + PG8_SB(b, h) + boff + n * 2048); } \
        else { _Pragma("unroll") for (int n = 0; n < 2; ++n) _Pragma("unroll") for (int k = 0; k < 2; ++k) dst[n][k] = *(const LAS bf16x8*)(lds + PG8_SB(b, h) + boff + n * 2048 + k * 1024); } } while (0)
#define PG8_MMA(ai, bj, At, Bt) do { __builtin_amdgcn_s_setprio(1); _Pragma("unroll") for (int m = 0; m < 4; ++m) _Pragma("unroll") for (int n = 0; n < 2; ++n) { \
        f32x16& av_ = accv[ai][bj][m >> 1]; constexpr int dummy_ = 0; (void)dummy_; const int g_ = ((m & 1) * 2 + n) * 4; f32x4 c_ = (f32x4){av_[g_], av_[g_ + 1], av_[g_ + 2], av_[g_ + 3]}; \
        if constexpr (FP8) c_ = __builtin_amdgcn_mfma_scale_f32_16x16x128_f8f6f4(Bt##8[n], At##8[m], c_, 0, 0, 0, 127, 0, 127); \
        else { _Pragma("unroll") for (int k = 0; k < 2; ++k) c_ = __builtin_amdgcn_mfma_f32_16x16x32_bf16(Bt[n][k], At[m][k], c_, 0, 0, 0); } \
        av_[g_] = c_[0]; av_[g_ + 1] = c_[1]; av_[g_ + 2] = c_[2]; av_[g_ + 3] = c_[3]; } __builtin_amdgcn_s_setprio(0); } while (0)
#define PG8_WAIT_V(n) asm volatile("s_waitcnt vmcnt(" #n ")" ::: "memory")
#define PG8_WAIT_L(n) asm volatile("s_waitcnt lgkmcnt(" #n ")" ::: "memory")
#define PG8_BAR __builtin_amdgcn_s_barrier()
#define PG8_SCHED __builtin_amdgcn_sched_barrier(0)
    Unit cur, nxt; int ui = 0;
    if (!S.next(0, cur)) return;
    f32x16 accv[2][2][2];
#pragma unroll
    for (int a = 0; a < 2; ++a)
#pragma unroll
        for (int b = 0; b < 2; ++b)
#pragma unroll
            for (int m = 0; m < 2; ++m)
#pragma unroll
                for (int j = 0; j < 16; ++j) accv[a][b][m][j] = 0.f;
    bf16x8 At[4][2], B0[2][2], B1[2][2]; i32x8 At8[4], B08[2], B18[2];
    const char* cA = S.abase(cur); const char* cB = S.bbase(cur); const char* nA = cA;
    if constexpr (GATHER) { PG8_LOADOFF(coff, cur); Unit n1; if (S.next(1, n1)) PG8_LOADOFF(noff, n1); else PG8_LOADOFF(noff, cur); }
    PG8_STAGE(PG8_SB(0, 0), cB, voffB); PG8_STAGE_A(PG8_SA(0, 0), 0, 0, false); PG8_STAGE(PG8_SB(0, 1), cB + hstepB, voffB); PG8_STAGE_A(PG8_SA(0, 1), 0, 1, false);
    if (wr == 1) PG8_BAR;
    PG8_WAIT_V(4); PG8_BAR;
    PG8_STAGE(PG8_SB(1, 0), cB + kstep, voffB); PG8_STAGE_A(PG8_SA(1, 0), kstep, 0, false); PG8_STAGE(PG8_SB(1, 1), cB + hstepB + kstep, voffB);
    PG8_WAIT_V(6); PG8_BAR;
    for (;;) {
        const bool has_next = S.next(ui + 1, nxt);
        nA = has_next ? S.abase(nxt) : cA; const char* nB = has_next ? S.bbase(nxt) : cB;
        bool has_nn = false;
        if constexpr (GATHER) { Unit nn; has_nn = S.next(ui + 2, nn);
            if (has_nn) { const unsigned* tb_ = S.offtab() + S.slotbase(nn); _Pragma("unroll") for (int h_ = 0; h_ < 2; ++h_) _Pragma("unroll") for (int i_ = 0; i_ < 2; ++i_) nnoff[h_][i_] = tb_[h_ * 128 + gR[i_]]; } }
        for (int t = 0; t < nt; t += 2) {
            const bool last = (t == nt - 2);
            const size_t k1 = (size_t)(t + 1) * kstep, k2 = last ? 0 : (size_t)(t + 2) * kstep, k3 = k2 + kstep;
            const char* b2 = last ? nB : cB + (size_t)(t + 2) * kstep; const char* b3 = b2 + kstep;
            PG8_LDB(B0, 0, 0); PG8_SCHED; PG8_LDA(At, 0, 0); PG8_STAGE_A(PG8_SA(1, 1), k1, 1, false);
            PG8_WAIT_L(8); PG8_BAR; PG8_WAIT_L(0); PG8_MMA(0, 0, At, B0); PG8_BAR; PG8_SCHED;
            PG8_LDB(B1, 0, 1); PG8_STAGE(PG8_SB(0, 0), b2, voffB);
            PG8_BAR; PG8_WAIT_L(0); PG8_MMA(0, 1, At, B1); PG8_BAR;
            PG8_LDA(At, 0, 1); PG8_STAGE_A(PG8_SA(0, 0), k2, 0, last);
            PG8_BAR; PG8_WAIT_L(0); PG8_MMA(1, 0, At, B0); PG8_BAR; PG8_SCHED;
            PG8_STAGE(PG8_SB(0, 1), b2 + hstepB, voffB);
            PG8_WAIT_V(6); PG8_BAR; PG8_MMA(1, 1, At, B1); PG8_BAR;
            PG8_LDB(B0, 1, 0); PG8_SCHED; PG8_LDA(At, 1, 0); PG8_STAGE_A(PG8_SA(0, 1), k2, 1, last);
            PG8_WAIT_L(8); PG8_BAR; PG8_WAIT_L(0); PG8_MMA(0, 0, At, B0); PG8_BAR; PG8_SCHED;
            PG8_LDB(B1, 1, 1); PG8_STAGE(PG8_SB(1, 0), b3, voffB);
            PG8_BAR; PG8_WAIT_L(0); PG8_MMA(0, 1, At, B1); PG8_BAR;
            PG8_LDA(At, 1, 1); PG8_STAGE_A(PG8_SA(1, 0), k3, 0, last);
            PG8_BAR; PG8_WAIT_L(0); PG8_MMA(1, 0, At, B0); PG8_BAR; PG8_SCHED;
            PG8_STAGE(PG8_SB(1, 1), b3 + hstepB, voffB);
            PG8_WAIT_V(6); PG8_BAR; PG8_MMA(1, 1, At, B1); PG8_BAR;
        }
        { f32x4 acc[2][2][4][2];
#pragma unroll
          for (int a = 0; a < 2; ++a)
#pragma unroll
            for (int b = 0; b < 2; ++b)
#pragma unroll
              for (int m = 0; m < 4; ++m)
#pragma unroll
                for (int n = 0; n < 2; ++n) { const int g_ = ((m & 1) * 2 + n) * 4; acc[a][b][m][n] = (f32x4){accv[a][b][m >> 1][g_], accv[a][b][m >> 1][g_ + 1], accv[a][b][m >> 1][g_ + 2], accv[a][b][m >> 1][g_ + 3]}; }
          const int le_ = lane_fresh(); E(acc, cur, wr, wc, le_ & 15, le_ >> 4); }
        if (!has_next) break;
#pragma unroll
        for (int a = 0; a < 2; ++a)
#pragma unroll
            for (int b = 0; b < 2; ++b)
#pragma unroll
                for (int m = 0; m < 2; ++m)
#pragma unroll
                    for (int j = 0; j < 16; ++j) accv[a][b][m][j] = 0.f;
        cur = nxt; cA = nA; cB = nB; ++ui;
        if constexpr (GATHER) {
#pragma unroll
            for (int h_ = 0; h_ < 2; ++h_)
#pragma unroll
                for (int i_ = 0; i_ < 2; ++i_) { coff[h_][i_] = noff[h_][i_]; if (has_nn) noff[h_][i_] = nnoff[h_][i_] + gC[i_]; } }
    }
    PG8_WAIT_V(0);
    if (wr == 0) PG8_BAR;
    PG8_BAR;
#undef PG8_SA
#undef PG8_SB
#undef PG8_STAGE
#undef PG8_STAGE_A
#undef PG8_LOADOFF
#undef PG8_LDA
#undef PG8_LD32
#undef PG8_LDB
#undef PG8_MMA
#undef PG8_WAIT_V
#undef PG8_WAIT_L
#undef PG8_BAR
#undef PG8_SCHED
}
}
using pg8::Unit;

struct SchedDense {
    __device__ __forceinline__ const unsigned* offtab() const { return nullptr; }
    __device__ __forceinline__ int slotbase(const Unit&) const { return 0; }
    __device__ __forceinline__ const char* gbase() const { return nullptr; }
    const char* A; const char* Bt; int nM, nN, G, c, lda, K, lat_only;
    __device__ __forceinline__ bool next(int i, Unit& u) const {
        const int nwg = nM * nN; const int L = i * G + c; if (L >= nwg) return false;
        const int w = xcd_remap(L, nwg);
        const int nig = 8 * nN, gid = w / nig, fm = gid * 8, gsz = (nM - fm) < 8 ? (nM - fm) : 8;
        const int lm = fm + ((w % nig) % gsz); u.pn = (w % nig) / gsz; u.pm = lat_only ? (lm + (lm >> 4) + 1) : lm; u.e = 0; return true;
    }
    __device__ __forceinline__ const char* abase(const Unit& u) const { return A + (size_t)u.pm * 256 * lda * 2; }
    __device__ __forceinline__ const char* bbase(const Unit& u) const { return Bt + (size_t)u.pn * 256 * K * 2; }
};
struct SchedOdIn {
    __device__ __forceinline__ const unsigned* offtab() const { return nullptr; }
    __device__ __forceinline__ int slotbase(const Unit&) const { return 0; }
    __device__ __forceinline__ const char* gbase() const { return nullptr; }
    const char* A; const char* Bt; int G, c;
    __device__ __forceinline__ bool next(int i, Unit& u) const {
        const int L = i * G + c; if (L >= 1320) return false;
        if (L < 1280) { const int w = xcd_remap(L, 1280); const int nig = 8 * 20, gid = w / nig, fm = gid * 8; const int lm = fm + ((w % nig) % 8); u.pn = (w % nig) / 8; u.pm = lm + (lm >> 4) + 1; }
        else { const int q = L - 1280; u.pm = 17 * (q & 3); u.pn = q >> 2; }
        u.e = 0; return true;
    }
    __device__ __forceinline__ const char* abase(const Unit& u) const { return A + (size_t)u.pm * 256 * DM * 2; }
    __device__ __forceinline__ const char* bbase(const Unit& u) const { return Bt + (size_t)u.pn * 256 * DM * 2; }
};
struct SchedLru {
    __device__ __forceinline__ const unsigned* offtab() const { return nullptr; }
    __device__ __forceinline__ int slotbase(const Unit&) const { return 0; }
    __device__ __forceinline__ const char* gbase() const { return nullptr; }
    const char* A; const char* Bt; int G, c;
    __device__ __forceinline__ bool next(int i, Unit& u) const {
        const int L = i * G + c; if (L >= NMT * 40) return false;
        const int w = xcd_remap(L, NMT * 40); const int q = w % 40; u.pm = w / 40; u.e = q >> 1; u.pn = q & 1; return true;
    }
    __device__ __forceinline__ const char* abase(const Unit& u) const { return A + ((size_t)u.pm * 256 * LRUW + (u.e % 10) * 256) * 2; }
    __device__ __forceinline__ const char* bbase(const Unit& u) const { return Bt + ((size_t)u.e * 512 + u.pn * 256) * 256 * 2; }
};
struct SchedMoe {
    const char* A; const char* Bt; int nMe, nN, estr, brows, G, c; const unsigned* otab;
    __device__ __forceinline__ const unsigned* offtab() const { return otab; }
    __device__ __forceinline__ int slotbase(const Unit& u) const { return u.e * estr + u.pm * 256; }
    __device__ __forceinline__ const char* gbase() const { return A; }
    __device__ __forceinline__ bool next(int i, Unit& u) const {
        const int per = nMe * nN, nwg = NEXP * per; const int L = i * G + c; if (L >= nwg) return false;
        const int w = xcd_remap(L, nwg); u.e = w / per; const int r = w % per; u.pm = r % nMe; u.pn = r / nMe; return true;
    }
    __device__ __forceinline__ const char* abase(const Unit& u) const { return A + ((size_t)u.e * estr + u.pm * 256) * DM; }
    __device__ __forceinline__ const char* bbase(const Unit& u) const { return Bt + ((size_t)u.e * brows + u.pn * 256) * DM; }
};

struct EpiPlainBf16 {
    static constexpr bool PERM = true;
    bf16_t* O; int ldc; int gelu_from;
    __device__ __forceinline__ void operator()(const f32x4 (&acc)[2][2][4][2], const Unit& u, int wr, int wc, int fr, int fq) const {
        const int row0 = u.pm * 256 + wr * 64 + fr, col0 = u.pn * 256 + wc * 32 + 8 * fq; const bool gl = u.pn >= gelu_from;
#pragma unroll
        for (int ai = 0; ai < 2; ++ai)
#pragma unroll
            for (int m = 0; m < 4; ++m) { bf16_t* rowp = O + (size_t)(row0 + ai * 128 + m * 16) * ldc + col0;
#pragma unroll
                for (int bj = 0; bj < 2; ++bj) { f32x4 v0 = acc[ai][bj][m][0], v1 = acc[ai][bj][m][1];
                    if (gl) {
#pragma unroll
                        for (int jp = 0; jp < 2; ++jp) { f32x2 x0 = {v0[2 * jp], v0[2 * jp + 1]}, x1 = {v1[2 * jp], v1[2 * jp + 1]};
                            const f32x2 p0 = (x0 * x0) * (-0.10294324f) + (-2.3022082f), p1 = (x1 * x1) * (-0.10294324f) + (-2.3022082f); const f32x2 t0 = x0 * p0, t1 = x1 * p1;
                            f32x2 d0, d1; d0.x = __builtin_amdgcn_exp2f(t0.x); d0.y = __builtin_amdgcn_exp2f(t0.y); d1.x = __builtin_amdgcn_exp2f(t1.x); d1.y = __builtin_amdgcn_exp2f(t1.y); d0 = d0 + 1.0f; d1 = d1 + 1.0f;
                            f32x2 r0, r1; r0.x = __builtin_amdgcn_rcpf(d0.x); r0.y = __builtin_amdgcn_rcpf(d0.y); r1.x = __builtin_amdgcn_rcpf(d1.x); r1.y = __builtin_amdgcn_rcpf(d1.y);
                            x0 = x0 * r0; x1 = x1 * r1; v0[2 * jp] = x0.x; v0[2 * jp + 1] = x0.y; v1[2 * jp] = x1.x; v1[2 * jp + 1] = x1.y; } }
                    u32x4 w; w.x = cvt_pk_bf16(v0[0], v0[1]); w.y = cvt_pk_bf16(v0[2], v0[3]); w.z = cvt_pk_bf16(v1[0], v1[1]); w.w = cvt_pk_bf16(v1[2], v1[3]);
                    *(u32x4*)(rowp + bj * 128) = w; } }
    }
};
struct EpiEvIn {
    static constexpr bool PERM = true;
    bf16_t* O; int ldc;
    __device__ __forceinline__ void operator()(const f32x4 (&acc)[2][2][4][2], const Unit& u, int wr, int wc, int fr, int fq) const {
        const int row0 = u.pm * 256 + wr * 64 + fr;
        if (u.pn < 10) { const int col0 = u.pn * 256 + wc * 32 + 8 * fq;
#pragma unroll
            for (int ai = 0; ai < 2; ++ai)
#pragma unroll
                for (int m = 0; m < 4; ++m) { bf16_t* rowp = O + (size_t)(row0 + ai * 128 + m * 16) * ldc + col0;
#pragma unroll
                    for (int bj = 0; bj < 2; ++bj) { const f32x4 v0 = acc[ai][bj][m][0], v1 = acc[ai][bj][m][1];
                        u32x4 w; w.x = cvt_pk_bf16(v0[0], v0[1]); w.y = cvt_pk_bf16(v0[2], v0[3]); w.z = cvt_pk_bf16(v1[0], v1[1]); w.w = cvt_pk_bf16(v1[2], v1[3]);
                        *(u32x4*)(rowp + bj * 128) = w; } }
        } else { const int col0 = 2560 + (u.pn - 10) * 128 + wc * 32 + 8 * fq;
#pragma unroll
            for (int ai = 0; ai < 2; ++ai)
#pragma unroll
                for (int m = 0; m < 4; ++m) { const f32x4 v0 = acc[ai][0][m][0] * acc[ai][1][m][0], v1 = acc[ai][0][m][1] * acc[ai][1][m][1];
                    u32x4 w; w.x = cvt_pk_bf16(v0[0], v0[1]); w.y = cvt_pk_bf16(v0[2], v0[3]); w.z = cvt_pk_bf16(v1[0], v1[1]); w.w = cvt_pk_bf16(v1[2], v1[3]);
                    *(u32x4*)(O + (size_t)(row0 + ai * 128 + m * 16) * ldc + col0) = w; }
        }
    }
};
struct EpiResid {
    static constexpr bool PERM = true;
    const float* x; const float* ctx; bf16_t* h; const float* mod; int layer0;
    __device__ __forceinline__ void operator()(const f32x4 (&acc)[2][2][4][2], const Unit& u, int wr, int wc, int fr, int fq) const {
        const int b = u.pm / 17, pt = u.pm - b * 17;
        const float* hold = pt == 0 ? ctx + (size_t)b * CTXL * DM : x + ((size_t)b * SEQ + (pt - 1) * 256) * DM;
        bf16_t* ho = h + (size_t)u.pm * 256 * DM;
        const float* gate = mod + (size_t)(pt == 0 ? 4 : b) * MODN + 4096;
        const int r0 = wr * 64 + fr, col0 = u.pn * 256 + wc * 32 + 8 * fq;
        f32x4 gv[2][2];
#pragma unroll
        for (int bj = 0; bj < 2; ++bj)
#pragma unroll
            for (int n = 0; n < 2; ++n) gv[bj][n] = *(const f32x4*)(gate + col0 + bj * 128 + n * 4);
#pragma unroll
        for (int ai = 0; ai < 2; ++ai) {
            if (layer0) { f32x4 hv[4][2][2];
#pragma unroll
                for (int m = 0; m < 4; ++m) { const size_t off = (size_t)(r0 + ai * 128 + m * 16) * DM + col0;
#pragma unroll
                    for (int bj = 0; bj < 2; ++bj)
#pragma unroll
                        for (int n = 0; n < 2; ++n) hv[m][bj][n] = *(const f32x4*)(hold + off + bj * 128 + n * 4); }
#pragma unroll
                for (int m = 0; m < 4; ++m) { const size_t off = (size_t)(r0 + ai * 128 + m * 16) * DM + col0;
#pragma unroll
                    for (int bj = 0; bj < 2; ++bj) { const f32x4 v0 = hv[m][bj][0] + gv[bj][0] * acc[ai][bj][m][0], v1 = hv[m][bj][1] + gv[bj][1] * acc[ai][bj][m][1];
                        u32x4 w; w.x = cvt_pk_bf16(v0[0], v0[1]); w.y = cvt_pk_bf16(v0[2], v0[3]); w.z = cvt_pk_bf16(v1[0], v1[1]); w.w = cvt_pk_bf16(v1[2], v1[3]); *(u32x4*)(ho + off + bj * 128) = w; } }
            } else { u32x4 hw[4][2];
#pragma unroll
                for (int m = 0; m < 4; ++m) { const size_t off = (size_t)(r0 + ai * 128 + m * 16) * DM + col0;
#pragma unroll
                    for (int bj = 0; bj < 2; ++bj) hw[m][bj] = *(const u32x4*)(ho + off + bj * 128); }
#pragma unroll
                for (int m = 0; m < 4; ++m) { const size_t off = (size_t)(r0 + ai * 128 + m * 16) * DM + col0;
#pragma unroll
                    for (int bj = 0; bj < 2; ++bj) { const u32x4 q = hw[m][bj];
                        const f32x4 v0 = (f32x4){bf_lo(q.x), bf_hi(q.x), bf_lo(q.y), bf_hi(q.y)} + gv[bj][0] * acc[ai][bj][m][0], v1 = (f32x4){bf_lo(q.z), bf_hi(q.z), bf_lo(q.w), bf_hi(q.w)} + gv[bj][1] * acc[ai][bj][m][1];
                        u32x4 w; w.x = cvt_pk_bf16(v0[0], v0[1]); w.y = cvt_pk_bf16(v0[2], v0[3]); w.z = cvt_pk_bf16(v1[0], v1[1]); w.w = cvt_pk_bf16(v1[2], v1[3]); *(u32x4*)(ho + off + bj * 128) = w; } } }
        }
    }
};
struct EpiSwiglu {
    static constexpr bool PERM = true;
    unsigned char* O; int estr;
    __device__ __forceinline__ void operator()(const f32x4 (&acc)[2][2][4][2], const Unit& u, int wr, int wc, int fr, int fq) const {
        const unsigned row0 = (unsigned)(u.e * estr + u.pm * 256 + wr * 64 + fr); const unsigned col0 = (unsigned)(u.pn * 128 + wc * 32 + 8 * fq);
#pragma unroll
        for (int ai = 0; ai < 2; ++ai)
#pragma unroll
            for (int m = 0; m < 4; ++m) { float o[8];
#pragma unroll
                for (int n = 0; n < 2; ++n)
#pragma unroll
                    for (int jp = 0; jp < 2; ++jp) { const f32x2 a2 = {acc[ai][0][m][n][2 * jp], acc[ai][0][m][n][2 * jp + 1]}, b2 = {acc[ai][1][m][n][2 * jp], acc[ai][1][m][n][2 * jp + 1]};
                        const f32x2 t2 = a2 * (-1.4426950408889634f * W8_INV); f32x2 d2; d2.x = __builtin_amdgcn_exp2f(t2.x); d2.y = __builtin_amdgcn_exp2f(t2.y); d2 = d2 + 1.0f;
                        f32x2 r2; r2.x = __builtin_amdgcn_rcpf(d2.x); r2.y = __builtin_amdgcn_rcpf(d2.y);
                        const f32x2 o2 = ((a2 * b2) * (W8_INV * W8_INV)) * r2; o[n * 4 + 2 * jp] = o2.x; o[n * 4 + 2 * jp + 1] = o2.y; }
                u32x2 w; w.x = pk4_fp8(o[0], o[1], o[2], o[3]); w.y = pk4_fp8(o[4], o[5], o[6], o[7]);
                *(u32x2*)(O + (unsigned)((row0 + ai * 128 + m * 16) * DM + col0)) = w; __builtin_amdgcn_sched_barrier(0); }
    }
};
struct EpiDown {
    static constexpr bool PERM = true;
    unsigned char* O; const float* gval; int estr;
    __device__ __forceinline__ void operator()(const f32x4 (&acc)[2][2][4][2], const Unit& u, int wr, int wc, int fr, int fq) const {
        const unsigned row0 = (unsigned)(u.e * estr + u.pm * 256 + wr * 64 + fr); const unsigned col0 = (unsigned)(u.pn * 256 + wc * 32 + 8 * fq);
#pragma unroll
        for (int ai = 0; ai < 2; ++ai) { float gvv[4];
#pragma unroll
            for (int m = 0; m < 4; ++m) gvv[m] = gval[row0 + ai * 128 + m * 16] * W8_INV;
            __builtin_amdgcn_sched_barrier(0);
#pragma unroll
            for (int m = 0; m < 4; ++m) { const unsigned slot = row0 + ai * 128 + m * 16; const float gv = gvv[m];
#pragma unroll
                for (int bj = 0; bj < 2; ++bj) { const f32x4 v0 = acc[ai][bj][m][0] * gv, v1 = acc[ai][bj][m][1] * gv;
                    u32x2 w; w.x = pk4_fp8(v0[0], v0[1], v0[2], v0[3]); w.y = pk4_fp8(v1[0], v1[1], v1[2], v1[3]);
                    *(u32x2*)(O + (slot * DM + col0 + bj * 128)) = w; }
                __builtin_amdgcn_sched_barrier(0); } }
    }
};
struct EpiLru {
    static constexpr bool PERM = true;
    const bf16_t* U; unsigned* lagi; const float* ba; const float* bx; const float* lam;
    __device__ __forceinline__ void operator()(const f32x4 (&acc)[2][2][4][2], const Unit& u, int wr, int wc, int fr, int fq) const {
        const int d = u.e / 10, hb = u.e - d * 10; const int ch0 = hb * 256 + u.pn * 128 + wc * 32 + 8 * fq; const int row0 = u.pm * 256 + wr * 64 + fr;
        unsigned short* outp = (unsigned short*)lagi + (size_t)d * MROWS * LRUW;
        constexpr float NL2E = -1.4426950408889634f;
#pragma unroll
        for (int n = 0; n < 2; ++n) { const int chn = ch0 + 4 * n; f32x2 vba[2], vbx[2], sp[2], csp[2];
#pragma unroll
            for (int j = 0; j < 4; ++j) { const float lm = lam[d * LRUW + chn + j]; const float spl = fmaxf(-lm, 0.f) + __logf(1.0f + __expf(-fabsf(lm)));
                vba[j >> 1][j & 1] = NL2E * ba[d * LRUW + chn + j]; vbx[j >> 1][j & 1] = NL2E * bx[d * LRUW + chn + j]; sp[j >> 1][j & 1] = -8.0f * spl; csp[j >> 1][j & 1] = 4.0f * __builtin_amdgcn_sqrtf(spl); }
            u32x2 uws[2][4];
#pragma unroll
            for (int ai = 0; ai < 2; ++ai)
#pragma unroll
                for (int m = 0; m < 4; ++m) uws[ai][m] = *(const u32x2*)(U + (size_t)(row0 + ai * 128 + m * 16) * LRUW + chn);
#pragma unroll
            for (int ai = 0; ai < 2; ++ai)
#pragma unroll
                for (int m = 0; m < 4; ++m) { const size_t row = (size_t)(row0 + ai * 128 + m * 16); const u32x2 uw = uws[ai][m]; unsigned o[2];
#pragma unroll
                    for (int h = 0; h < 2; ++h) { const unsigned uwh = h ? uw.y : uw.x; const f32x2 uv = {bf_lo(uwh), bf_hi(uwh)};
                        f32x2 ta = (f32x2){acc[ai][0][m][n][2 * h], acc[ai][0][m][n][2 * h + 1]} * NL2E + vba[h], tx = (f32x2){acc[ai][1][m][n][2 * h], acc[ai][1][m][n][2 * h + 1]} * NL2E + vbx[h];
                        f32x2 ea, ex; ea.x = __builtin_amdgcn_exp2f(ta.x); ea.y = __builtin_amdgcn_exp2f(ta.y); ex.x = __builtin_amdgcn_exp2f(fminf(tx.x, 40.f)); ex.y = __builtin_amdgcn_exp2f(fminf(tx.y, 40.f));
                        ea = ea + 1.0f; ex = ex + 1.0f;
                        const f32x2 dd = (ea * ex) * ex; f32x2 g; g.x = __builtin_amdgcn_rsqf(dd.x); g.y = __builtin_amdgcn_rsqf(dd.y);
                        const f32x2 q = g * ex, r = q * q, la = r * sp[h], y = la + la;
                        f32x2 t = y * 0.041666668f + 0.16666667f; t = t * y + 0.5f; t = t * y;
                        f32x2 s1 = t * (-0.125f) + 0.5f; s1 = s1 * t + 1.0f;
                        const f32x2 bt = ((csp[h] * uv) * g) * s1;
                        (void)la; const f32x2 cq = q * 255.0f + 0.5f;
                        unsigned wd = (unsigned)__builtin_amdgcn_cvt_pk_fp8_f32(bt.x, bt.y, 0, true);
                        wd = __builtin_amdgcn_cvt_pk_u8_f32(cq.x, 0, wd); wd = __builtin_amdgcn_cvt_pk_u8_f32(cq.y, 1, wd);
                        o[h] = wd; }
                    *(u32x2*)(outp + row * LRUW + chn) = (u32x2){o[0], o[1]}; } }
    }
};

namespace att {
constexpr int D = 128, NW = 8, QBLK = 32, KVBLK = 64;
constexpr float SCALE = 0.088388347648318440f;
constexpr float THR = 8.f;
constexpr int LDQ = PRJ_LD, LDK = 128, LDO = YLD;
constexpr size_t SHM_V = KVBLK * D * 2, SHM_K = KVBLK * D * 2, SHM_ATTN = 2 * SHM_V + 2 * SHM_K + NW * 64 * 4;
#define KSWZ(row, colB) ((row) * 256 + ((colB) ^ (((row) & 7) << 4)))
#define SBAR() __builtin_amdgcn_sched_barrier(0)
__device__ __forceinline__ int crow(int r, int hi) { return (r & 3) + 8 * (r >> 2) + 4 * hi; }
__device__ __forceinline__ void partialSM(f32x16& p0, f32x16& p1, float& m_reg, float& mn, float& alpha) {
  constexpr float C = SCALE * 1.4426950408889634f;
  float pmax = p0[0]; for (int r = 1; r < 16; ++r) pmax = fmaxf(pmax, p0[r]); for (int r = 0; r < 16; ++r) pmax = fmaxf(pmax, p1[r]);
  { auto rr = __builtin_amdgcn_permlane32_swap(__float_as_uint(pmax), __float_as_uint(pmax), false, false);
    pmax = fmaxf(__uint_as_float(rr[0]), __uint_as_float(rr[1])); }
  if (__builtin_expect(__all(pmax - m_reg <= THR / SCALE), 1)) { mn = m_reg; alpha = 1.f; }
  else { mn = fmaxf(m_reg, pmax); alpha = __builtin_amdgcn_exp2f((m_reg - mn) * C); m_reg = mn; }
  float mnC = -mn * C;
  for (int r = 0; r < 16; ++r) p0[r] = fmaf(p0[r], C, mnC); for (int r = 0; r < 16; ++r) p1[r] = fmaf(p1[r], C, mnC);
  for (int r = 0; r < 16; ++r) p0[r] = __builtin_amdgcn_exp2f(p0[r]);
}
__device__ __forceinline__ void finishSM(f32x16& p0, f32x16& p1, float alpha, float& l_reg, bf16x8& pa0, bf16x8& pa1, bf16x8& pa2, bf16x8& pa3) {
  for (int r = 0; r < 16; ++r) p1[r] = __builtin_amdgcn_exp2f(p1[r]);
  float ps = 0; for (int r = 0; r < 16; ++r) ps += p0[r]; for (int r = 0; r < 16; ++r) ps += p1[r];
  { auto rr = __builtin_amdgcn_permlane32_swap(__float_as_uint(ps), __float_as_uint(ps), false, false);
    ps = __uint_as_float(rr[0]) + __uint_as_float(rr[1]); }
  l_reg = l_reg * alpha + ps;
#define PK4(P, BASE, OUT) do { unsigned a0 = cvt_pk_bf16(P[BASE + 0], P[BASE + 1]), a1 = cvt_pk_bf16(P[BASE + 2], P[BASE + 3]);   \
    unsigned b0 = cvt_pk_bf16(P[BASE + 4], P[BASE + 5]), b1 = cvt_pk_bf16(P[BASE + 6], P[BASE + 7]);                              \
    auto r0 = __builtin_amdgcn_permlane32_swap(a0, b0, false, false); auto r1 = __builtin_amdgcn_permlane32_swap(a1, b1, false, false); \
    u32x4 w = {r0[0], r1[0], r0[1], r1[1]}; OUT = *reinterpret_cast<bf16x8*>(&w); } while (0)
  PK4(p0, 0, pa0); PK4(p0, 8, pa1); PK4(p1, 0, pa2); PK4(p1, 8, pa3);
#undef PK4
}
__device__ __forceinline__ void qkt(f32x16& p0, f32x16& p1, const bf16_t* Ks, const bf16x8* qr, int r32, int hi) {
  p0 = f32x16{}; p1 = f32x16{};
  for (int d0 = 0; d0 < 8; ++d0) { int cb = (d0 * 16 + hi * 8) * 2;
    bf16x8 b0 = *reinterpret_cast<const bf16x8*>((const char*)Ks + KSWZ(r32, cb));
    bf16x8 b1 = *reinterpret_cast<const bf16x8*>((const char*)Ks + KSWZ(32 + r32, cb));
    p0 = __builtin_amdgcn_mfma_f32_32x32x16_bf16(b0, qr[d0], p0, 0, 0, 0);
    p1 = __builtin_amdgcn_mfma_f32_32x32x16_bf16(b1, qr[d0], p1, 0, 0, 0); }
}
__device__ __forceinline__ int v_st(int k, int c) { const int kk = (k & ~0xC) | ((k & 4) << 1) | ((k & 8) >> 1); return ((kk >> 3) * 4 + (c >> 5)) * 512 + ((kk & 7) * 32 + (c & 31)) * 2; }
__device__ __forceinline__ int v_rd_base(int lane) { return ((lane & 3) << 3) | (((lane >> 2) & 3) << 6) | (((lane >> 4) & 1) << 5) | (((lane >> 5) & 1) << 8); }
constexpr int v_rd_off(int d0, int ks, int half) { return d0 * 512 + ks * 4096 + half * 2048; }
template <int OFF> __device__ __forceinline__ s16x4 tr_read(int vb) {
  s16x4 r; asm volatile("ds_read_b64_tr_b16 %0, %1 offset:%2" : "=&v"(r) : "v"(vb), "i"(OFF) : "memory"); return r;
}
template <int D0> __device__ __forceinline__ void pv_one(f32x16& od, int vb, bf16x8 pa0, bf16x8 pa1, bf16x8 pa2, bf16x8 pa3) {
  const s16x4 l0 = tr_read<v_rd_off(D0, 0, 0)>(vb), h0 = tr_read<v_rd_off(D0, 0, 1)>(vb), l1 = tr_read<v_rd_off(D0, 1, 0)>(vb), h1 = tr_read<v_rd_off(D0, 1, 1)>(vb);
  const s16x4 l2 = tr_read<v_rd_off(D0, 2, 0)>(vb), h2 = tr_read<v_rd_off(D0, 2, 1)>(vb), l3 = tr_read<v_rd_off(D0, 3, 0)>(vb), h3 = tr_read<v_rd_off(D0, 3, 1)>(vb);
  asm volatile("s_waitcnt lgkmcnt(0)" ::: "memory"); SBAR();
#define PK(L, H) (bf16x8){L[0], L[1], L[2], L[3], H[0], H[1], H[2], H[3]}
  od = __builtin_amdgcn_mfma_f32_32x32x16_bf16(pa0, PK(l0, h0), od, 0, 0, 0);
  od = __builtin_amdgcn_mfma_f32_32x32x16_bf16(pa1, PK(l1, h1), od, 0, 0, 0);
  od = __builtin_amdgcn_mfma_f32_32x32x16_bf16(pa2, PK(l2, h2), od, 0, 0, 0);
  od = __builtin_amdgcn_mfma_f32_32x32x16_bf16(pa3, PK(l3, h3), od, 0, 0, 0);
#undef PK
}
__device__ __forceinline__ void pv_d0(f32x16* o, int vb, bf16x8 pa0, bf16x8 pa1, bf16x8 pa2, bf16x8 pa3) {
  pv_one<0>(o[0], vb, pa0, pa1, pa2, pa3); pv_one<1>(o[1], vb, pa0, pa1, pa2, pa3); pv_one<2>(o[2], vb, pa0, pa1, pa2, pa3); pv_one<3>(o[3], vb, pa0, pa1, pa2, pa3);
}
__device__ __forceinline__ void attn_dense_body(const bf16_t* __restrict__ Qb, const bf16_t* __restrict__ Kh, const bf16_t* __restrict__ Vh, bf16_t* __restrict__ Ob, int seq, char* lds, int wid_in) {
  const int lane = lane_fresh();
  const int wid = wid_in, tid = wid * 64 + lane, r32 = lane & 31, hi = lane >> 5;
  bf16_t* V_lds = (bf16_t*)lds; bf16_t* K_lds = (bf16_t*)(lds + 2 * SHM_V);
  float* ws = (float*)(lds + 2 * SHM_V + 2 * SHM_K) + wid * 64; float* li_l = ws; float* al_l = ws + 32;
  float m_reg = -1e30f, l_reg = 0; f32x16 o[4] = {}; bf16x8 qr[8];
  const bf16_t* Qw = Qb + (long)(wid * QBLK + r32) * LDQ + hi * 8;
#pragma unroll
  for (int d0 = 0; d0 < 8; ++d0) qr[d0] = *reinterpret_cast<const bf16x8*>(Qw + d0 * 16);
  const int sr = tid >> 4, sc = (tid & 15) * 8, vst0 = v_st(sr, sc), vst1 = v_st(32 + sr, sc);
  const int vb0 = (int)(uintptr_t)V_lds + v_rd_base(lane);
  const unsigned toff = (unsigned)(sr * LDK + sc) * 2u;
  struct { bf16x8 vs0, vs1, ks0, ks1; } sr_[2];
#define SLOAD(i, k0) do { const char* vp_ = (const char*)(Vh + (long)(k0) * LDK); const char* kp_ = (const char*)(Kh + (long)(k0) * LDK); \
    sr_[i].vs0 = *reinterpret_cast<const bf16x8*>(vp_ + toff); sr_[i].vs1 = *reinterpret_cast<const bf16x8*>(vp_ + 32 * LDK * 2 + toff); \
    sr_[i].ks0 = *reinterpret_cast<const bf16x8*>(kp_ + toff); sr_[i].ks1 = *reinterpret_cast<const bf16x8*>(kp_ + 32 * LDK * 2 + toff); } while (0)
#define SWRITE(b, i) do { *(bf16x8*)((char*)V_lds + (b) * SHM_V + vst0) = sr_[i].vs0;          \
    *(bf16x8*)((char*)V_lds + (b) * SHM_V + vst1) = sr_[i].vs1; int kc = sc * 2;               \
    *(bf16x8*)((char*)K_lds + (b) * SHM_K + KSWZ(sr, kc)) = sr_[i].ks0;                       \
    *(bf16x8*)((char*)K_lds + (b) * SHM_K + KSWZ(32 + sr, kc)) = sr_[i].ks1; } while (0)
#define SWAIT() asm volatile("s_waitcnt vmcnt(4)" ::: "memory")
#define RESC(a) do { if (__any((a) < 1.f)) { if (hi == 0) al_l[r32] = (a); asm volatile("s_waitcnt lgkmcnt(0)" ::: "memory"); \
    for (int d = 0; d < 4; ++d) for (int r = 0; r < 16; ++r) o[d][r] *= al_l[crow(r, hi)]; } } while (0)
  f32x16 pA0, pA1, pB0, pB1; float mnA, mnB, alA, alB; bf16x8 pa0, pa1, pa2, pa3; const int NT = seq / KVBLK;
  constexpr int SE = 0, SO = 1;
  SLOAD(SE, 0); asm volatile("s_waitcnt vmcnt(0)" ::: "memory"); SWRITE(0, SE); __syncthreads();
  qkt(pA0, pA1, K_lds, qr, r32, hi); partialSM(pA0, pA1, m_reg, mnA, alA);
  SLOAD(SO, KVBLK); if (2 < NT) SLOAD(SE, 2 * KVBLK);
  SWAIT(); SWRITE(1, SO); __syncthreads();
  for (int j = 1; j + 1 < NT; j += 2) {
    SBAR(); qkt(pB0, pB1, (bf16_t*)((char*)K_lds + SHM_K), qr, r32, hi);
    finishSM(pA0, pA1, alA, l_reg, pa0, pa1, pa2, pa3); SBAR();
    SLOAD(SO, (j + 2) * KVBLK); SBAR();
    pv_d0(o, vb0, pa0, pa1, pa2, pa3); partialSM(pB0, pB1, m_reg, mnB, alB);
    __syncthreads(); SWAIT(); SWRITE(0, SE);
    RESC(alB); __syncthreads();
    SBAR(); qkt(pA0, pA1, K_lds, qr, r32, hi);
    finishSM(pB0, pB1, alB, l_reg, pa0, pa1, pa2, pa3); SBAR();
    if (j + 3 < NT) SLOAD(SE, (j + 3) * KVBLK); SBAR();
    pv_d0(o, vb0 + (int)SHM_V, pa0, pa1, pa2, pa3); partialSM(pA0, pA1, m_reg, mnA, alA);
    __syncthreads(); SWAIT(); SWRITE(1, SO);
    RESC(alA); __syncthreads();
  }
  SBAR(); qkt(pB0, pB1, (bf16_t*)((char*)K_lds + SHM_K), qr, r32, hi);
  finishSM(pA0, pA1, alA, l_reg, pa0, pa1, pa2, pa3); SBAR();
  pv_d0(o, vb0, pa0, pa1, pa2, pa3); partialSM(pB0, pB1, m_reg, mnB, alB);
  __syncthreads(); RESC(alB);
  finishSM(pB0, pB1, alB, l_reg, pa0, pa1, pa2, pa3); SBAR();
  pv_d0(o, vb0 + (int)SHM_V, pa0, pa1, pa2, pa3);
  if (hi == 0) li_l[r32] = l_reg; asm volatile("s_waitcnt lgkmcnt(0)" ::: "memory");
  float rli[16];
#pragma unroll
  for (int r = 0; r < 16; ++r) rli[r] = __builtin_amdgcn_rcpf(li_l[crow(r, hi)]);
  bf16_t* Ow = Ob + (long)(wid * QBLK) * LDO;
#pragma unroll
  for (int r = 0; r < 16; ++r) { int orow = crow(r, hi);
    for (int d0 = 0; d0 < 4; ++d0) Ow[(long)orow * LDO + d0 * 32 + r32] = (bf16_t)(cvt_pk_bf16(o[d0][r] * rli[r], 0.f) & 0xffffu); }
  __syncthreads();
#undef SLOAD
#undef SWRITE
#undef SWAIT
#undef RESC
}
}

struct Ctx {
    Params P; unsigned char* ws; int wid, G, c;
    LAS unsigned char* lds; char* ldsg;
};

constexpr int N_MOD_UNITS = 192;
constexpr int CV_A = 576, CV_B = CV_A + 256, CV_C = CV_B + 640, CV_D = CV_C + 320, CV_E = CV_D + 160, CV_F = CV_E + 424 + 2 * 3 * 16 * 128 - 11424  ;
__device__ __noinline__ void cvt_tile(const float* __restrict__ src, int ld, bf16_t* __restrict__ dst, int ldd, int tid) {
    const int c4 = ((tid >> 6) & 3) * 8 + (tid & 7), kq = (tid >> 8) * 8 + ((tid >> 3) & 7);
    const float* s = src + (size_t)(kq * 8) * ld + c4 * 4;
    f32x4 v[8];
#pragma unroll
    for (int i = 0; i < 8; ++i) v[i] = ld_nt(s + (size_t)i * ld);
#pragma unroll
    for (int j = 0; j < 4; ++j) { u32x4 w; w.x = cvt_pk_bf16(v[0][j], v[1][j]); w.y = cvt_pk_bf16(v[2][j], v[3][j]); w.z = cvt_pk_bf16(v[4][j], v[5][j]); w.w = cvt_pk_bf16(v[6][j], v[7][j]);
        __builtin_nontemporal_store(w, (GAS u32x4*)(GAS bf16_t*)(dst + (size_t)(c4 * 4 + j) * ldd + kq * 8)); }
}
__device__ __noinline__ void cvt_tile8(const float* __restrict__ src, int ld, unsigned char* __restrict__ dst, int ldd, int split, int tid) {
    const int c4 = (tid >> 6) * 8 + (tid & 7), kq = (tid >> 3) & 7;
    const float* s = src + (size_t)(kq * 16) * ld + c4 * 4;
    f32x4 v[16];
#pragma unroll
    for (int i = 0; i < 16; ++i) v[i] = ld_nt(s + (size_t)i * ld);
    const int rbase = split ? ((c4 >> 5) * 256 + (c4 & 31) * 4) : c4 * 4;
#pragma unroll
    for (int j = 0; j < 4; ++j) { u32x4 w;
        w.x = pk4_fp8(v[0][j] * W8_SCALE, v[1][j] * W8_SCALE, v[2][j] * W8_SCALE, v[3][j] * W8_SCALE); w.y = pk4_fp8(v[4][j] * W8_SCALE, v[5][j] * W8_SCALE, v[6][j] * W8_SCALE, v[7][j] * W8_SCALE);
        w.z = pk4_fp8(v[8][j] * W8_SCALE, v[9][j] * W8_SCALE, v[10][j] * W8_SCALE, v[11][j] * W8_SCALE); w.w = pk4_fp8(v[12][j] * W8_SCALE, v[13][j] * W8_SCALE, v[14][j] * W8_SCALE, v[15][j] * W8_SCALE);
        __builtin_nontemporal_store(w, (GAS u32x4*)(GAS unsigned char*)(dst + (size_t)(rbase + j) * ldd + kq * 16)); }
}
constexpr int MOE_TILES = 3 * 16 * 128;
__device__ __forceinline__ void moe_cvt_tile(const Ctx& F, int layer, int q, int tid) {
    const Params& P = F.P; const int m = q / 2048, r = q % 2048, le = layer * 16 + (r >> 7), kt = (r >> 3) & 15, nt = r & 7;
    const size_t so = (size_t)le * DM * DM + (size_t)kt * 128 * DM + nt * 256;
    if (m == 0)      cvt_tile8(P.in[I_WGATE] + so, DM, F.ws + WS_WGU + ((size_t)le * 4096 + nt * 512) * DM + kt * 128, DM, 1, tid);
    else if (m == 1) cvt_tile8(P.in[I_WUP]   + so, DM, F.ws + WS_WGU + ((size_t)le * 4096 + nt * 512 + 128) * DM + kt * 128, DM, 1, tid);
    else             cvt_tile8(P.in[I_WDOWN] + so, DM, F.ws + WS_WDN + ((size_t)le * DM + nt * 256) * DM + kt * 128, DM, 0, tid);
}
struct CvtJob { const float* src; unsigned char* dst; int split; };
__device__ __forceinline__ CvtJob moe_job(const Ctx& F, int g) {
    const Params& P = F.P; const int layer = g / MOE_TILES, q = g - layer * MOE_TILES, m = q >> 11, r = q & 2047, le = layer * 16 + (r >> 7), kt = (r >> 3) & 15, nt = r & 7;
    const float* pg = P.in[I_WGATE]; const float* pu = P.in[I_WUP]; const float* pd = P.in[I_WDOWN];
    asm volatile("" : "+s"(pg), "+s"(pu), "+s"(pd));
    const size_t so = (size_t)le * DM * DM + (size_t)kt * 128 * DM + nt * 256;
    CvtJob j; j.src = (m == 0 ? pg : (m == 1 ? pu : pd)) + so; j.split = m < 2 ? 1 : 0;
    j.dst = m < 2 ? F.ws + WS_WGU + ((size_t)le * 4096 + nt * 512 + (m == 1 ? 128 : 0)) * DM + kt * 128 : F.ws + WS_WDN + ((size_t)le * DM + nt * 256) * DM + kt * 128;
    return j;
}
__device__ __forceinline__ void conv_range(const Ctx& F, int g0, int g1, int first_cu) {
    const int tid = F.wid * 64 + lane_fresh(); const int c4 = (tid >> 6) * 8 + (tid & 7), kq = (tid >> 3) & 7; constexpr int n = 1;
    const int cnt = (g1 - g0 + (F.G - first_cu) - 1) / (F.G - first_cu);
    int g = g0 + (F.c - first_cu) * cnt; g1 = g + cnt < g1 ? g + cnt : g1; if (g >= g1) return;
#define CV8_LOAD(v_, src_) { const GAS float* s_ = (const GAS float*)(src_) + (size_t)(kq * 16) * DM + c4 * 4; _Pragma("unroll") for (int i = 0; i < 16; ++i) v_[i] = __builtin_nontemporal_load((const GAS f32x4*)(s_ + (size_t)i * DM)); }
#define CV8_STORE(v_, job_) { const int rbase = (job_).split ? ((c4 >> 5) * 256 + (c4 & 31) * 4) : c4 * 4; \
        _Pragma("unroll") for (int j = 0; j < 4; ++j) { u32x4 w; \
            w.x = pk4_fp8(v_[0][j] * W8_SCALE, v_[1][j] * W8_SCALE, v_[2][j] * W8_SCALE, v_[3][j] * W8_SCALE); w.y = pk4_fp8(v_[4][j] * W8_SCALE, v_[5][j] * W8_SCALE, v_[6][j] * W8_SCALE, v_[7][j] * W8_SCALE); \
            w.z = pk4_fp8(v_[8][j] * W8_SCALE, v_[9][j] * W8_SCALE, v_[10][j] * W8_SCALE, v_[11][j] * W8_SCALE); w.w = pk4_fp8(v_[12][j] * W8_SCALE, v_[13][j] * W8_SCALE, v_[14][j] * W8_SCALE, v_[15][j] * W8_SCALE); \
            __builtin_nontemporal_store(w, (GAS u32x4*)(GAS unsigned char*)((job_).dst + (size_t)(rbase + j) * DM + kq * 16)); } }
    f32x4 va[16], vb[16]; CvtJob ja = moe_job(F, g), jb = ja; CV8_LOAD(va, ja.src)
    for (;;) {
        if (g + n >= g1) { CV8_STORE(va, ja) break; }
        jb = moe_job(F, g + n); CV8_LOAD(vb, jb.src)
        CV8_STORE(va, ja)
        g += n;
        if (g + n >= g1) { CV8_STORE(vb, jb) break; }
        ja = moe_job(F, g + n); CV8_LOAD(va, ja.src)
        CV8_STORE(vb, jb)
        g += n;
    }
#undef CV8_STORE
#undef CV8_LOAD
}
constexpr int NCV2 = 48, NCV5 = 72, NCV9 = 64, NCV11 = 32, NCV13 = 8;
constexpr int GT0 = 424, GT2 = 3694, GT5 = 6144, GT9 = 9024, GT11 = 11204, GT13 = 11424;
static_assert(GT5 >= MOE_TILES, "layer 0's expert weights must be complete before P8");
__device__ __forceinline__ void p0_prologue(const Ctx& F) {
    const Params& P = F.P; const int tid = F.wid * 64 + lane_fresh();
    LAS float* sil = (LAS float*)F.lds;
    LAS float* red = (LAS float*)(F.lds + 40960);
    for (int u = F.c; u < N_MOD_UNITS + CV_F; u += F.G) {
        if (u < N_MOD_UNITS) {
            const int l = u / 96, j0 = (u % 96) * 128;
            for (int i = tid; i < 5 * DM; i += 512) { const int v = i >> 11, k = i & 2047; const float cv = v < 4 ? P.in[I_C][v * DM + k] : P.in[I_CCTX][k]; sil[i] = cv * fast_sigmoid(cv); }
            __syncthreads();
            const int hw = tid >> 5, l32 = tid & 31;
            f32x4 a0 = {0, 0, 0, 0}, a1 = a0, a2 = a0, a3 = a0, a4 = a0;
            const float* wp = P.in[I_MODW] + ((size_t)(l * DM + hw * 128)) * MODN + j0 + l32 * 4;
#pragma unroll 8
            for (int kk = 0; kk < 128; ++kk) { const f32x4 w = ld_nt(wp + (size_t)kk * MODN); const int k = hw * 128 + kk;
                a0 += sil[k] * w; a1 += sil[DM + k] * w; a2 += sil[2 * DM + k] * w; a3 += sil[3 * DM + k] * w; a4 += sil[4 * DM + k] * w; }
            *(LAS f32x4*)(red + (hw * 5 + 0) * 128 + l32 * 4) = a0; *(LAS f32x4*)(red + (hw * 5 + 1) * 128 + l32 * 4) = a1; *(LAS f32x4*)(red + (hw * 5 + 2) * 128 + l32 * 4) = a2;
            *(LAS f32x4*)(red + (hw * 5 + 3) * 128 + l32 * 4) = a3; *(LAS f32x4*)(red + (hw * 5 + 4) * 128 + l32 * 4) = a4;
            __syncthreads();
            float* mod = (float*)(F.ws + WS_MOD);
            for (int o = tid; o < 640; o += 512) { const int v = o >> 7, col = o & 127; float s = 0.f;
#pragma unroll
                for (int h = 0; h < 16; ++h) s += red[(h * 5 + v) * 128 + col];
                mod[(size_t)(l * 5 + v) * MODN + j0 + col] = s + P.in[I_MODB][l * MODN + j0 + col]; }
            __syncthreads();
        } else {
            const int t = u - N_MOD_UNITS;
            if (t < CV_A)      { const int q = t;        const int kt = q / 36, nt = q % 36; const int drow = nt < 20 ? nt * 128 : (nt < 28 ? 2560 + (nt - 20) * 256 : 2560 + (nt - 28) * 256 + 128);
                cvt_tile(P.in[I_EVWIN]  + (size_t)kt * 128 * EV_IN + nt * 128, EV_IN, (bf16_t*)(F.ws + WS_WEVIN)  + (size_t)drow * DM + kt * 128, DM, tid); }
            else if (t < CV_B) { const int q = t - CV_A; const int kt = q / 16, nt = q % 16; cvt_tile(P.in[I_EVWOUT] + (size_t)kt * 128 * DM + nt * 128, DM, (bf16_t*)(F.ws + WS_WEVOUT) + (size_t)nt * 128 * DM + kt * 128, DM, tid); }
            else if (t < CV_C) { const int q = t - CV_B; const int kt = q / 40, nt = q % 40; cvt_tile(P.in[I_ODWIN]  + (size_t)kt * 128 * OD_IN + nt * 128, OD_IN, (bf16_t*)(F.ws + WS_WODIN)  + (size_t)nt * 128 * DM + kt * 128, DM, tid); }
            else if (t < CV_D) { const int q = t - CV_C; const int kt = q / 16, nt = q % 16; cvt_tile(P.in[I_ODWOUT] + (size_t)kt * 128 * DM + nt * 128, DM, (bf16_t*)(F.ws + WS_WODOUT) + (size_t)nt * 128 * LRUW + kt * 128, LRUW, tid); }
            else if (t < CV_E) { const int q = t - CV_D; const int m = q / 80, r = q % 80, dh = r >> 2, kt = (r >> 1) & 1, nt = r & 1;
                bf16_t* dst = (bf16_t*)(F.ws + WS_WLRU) + ((size_t)dh * 512 + nt * 256 + m * 128) * 256 + kt * 128; const size_t so = (size_t)dh * 65536 + (size_t)kt * 128 * 256 + nt * 128;
                if (m == 0) cvt_tile(P.in[I_ODWA] + so, 256, dst, 256, tid); else cvt_tile(P.in[I_ODWX] + so, 256, dst, 256, tid); }
            else { const int q = t - CV_E; const int g = q < GT0 ? q : GT13 + (q - GT0); moe_cvt_tile(F, g / MOE_TILES, g % MOE_TILES, tid); }
        }
    }
}

template <int MODE> __device__ __forceinline__ void norm_pair(const Ctx& F, const LAS float* lm, int lane, int row, const f32x4 (&nx)[2][8], const u32x2 (&nw)[2][8], int sm0, int sm1) {
    const Params& P = F.P; bf16_t* h = (bf16_t*)(F.ws + WS_H); bf16_t* act = (bf16_t*)(F.ws + WS_ACT); const unsigned char* eo = F.ws + WS_EO;
    const int b = row / TPB, p = row - b * TPB; const bool isctx = p < CTXL; const int mv = isctx ? 4 : b;
    f32x4 v[2][8];
#pragma unroll
    for (int q = 0; q < 2; ++q)
#pragma unroll
        for (int i = 0; i < 8; ++i) v[q][i] = MODE == 0 ? nx[q][i] : (f32x4){bf_lo(nw[q][i].x), bf_hi(nw[q][i].x), bf_lo(nw[q][i].y), bf_hi(nw[q][i].y)};
    if (MODE >= 1) {
        f32x4 a[2][8];
#pragma unroll
        for (int q = 0; q < 2; ++q)
#pragma unroll
            for (int i = 0; i < 8; ++i) a[q][i] = (f32x4){0.f, 0.f, 0.f, 0.f};
        unsigned sel0 = (unsigned)__ballot(sm0 >= 0) & 0xffffu, sel1 = (unsigned)__ballot(sm1 >= 0) & 0xffffu;
        while (sel0 | sel1) {
            int sl[4]; bool on[4];
            { on[0] = sel0 != 0u; const int e = on[0] ? __builtin_ctz(sel0) : 0; if (on[0]) sel0 &= sel0 - 1u; sl[0] = on[0] ? __builtin_amdgcn_readlane(sm0, e) : 0; }
            { on[1] = sel0 != 0u; const int e = on[1] ? __builtin_ctz(sel0) : 0; if (on[1]) sel0 &= sel0 - 1u; sl[1] = on[1] ? __builtin_amdgcn_readlane(sm0, e) : sl[0]; }
            { on[2] = sel1 != 0u; const int e = on[2] ? __builtin_ctz(sel1) : 0; if (on[2]) sel1 &= sel1 - 1u; sl[2] = on[2] ? __builtin_amdgcn_readlane(sm1, e) : 0; }
            { on[3] = sel1 != 0u; const int e = on[3] ? __builtin_ctz(sel1) : 0; if (on[3]) sel1 &= sel1 - 1u; sl[3] = on[3] ? __builtin_amdgcn_readlane(sm1, e) : sl[2]; }
            unsigned w[4][8];
#pragma unroll
            for (int t = 0; t < 4; ++t)
#pragma unroll
                for (int i = 0; i < 8; ++i) w[t][i] = *(const unsigned*)(eo + (size_t)sl[t] * DM + lane * 4 + 256 * i);
#pragma unroll
            for (int t = 0; t < 4; ++t) { if (on[t]) {
#pragma unroll
                for (int i = 0; i < 8; ++i) a[t >> 1][i] += (f32x4){__builtin_amdgcn_cvt_f32_fp8((int)w[t][i], 0), __builtin_amdgcn_cvt_f32_fp8((int)w[t][i], 1), __builtin_amdgcn_cvt_f32_fp8((int)w[t][i], 2), __builtin_amdgcn_cvt_f32_fp8((int)w[t][i], 3)}; } }
        }
        const LAS float* g2 = lm + 10 * DM + mv * DM + lane * 4;
#pragma unroll
        for (int i = 0; i < 8; ++i) { const f32x4 gv = *(const LAS f32x4*)(g2 + 256 * i); v[0][i] += gv * a[0][i]; v[1][i] += gv * a[1][i]; }
        if (MODE == 1) {
#pragma unroll
            for (int q = 0; q < 2; ++q)
#pragma unroll
                for (int i = 0; i < 8; ++i) { u32x2 w2; w2.x = cvt_pk_bf16(v[q][i][0], v[q][i][1]); w2.y = cvt_pk_bf16(v[q][i][2], v[q][i][3]); *(u32x2*)(h + (size_t)(row + q) * DM + lane * 4 + 256 * i) = w2; } }
    }
    float rinv[2];
#pragma unroll
    for (int q = 0; q < 2; ++q) { float ss = 0.f;
#pragma unroll
        for (int i = 0; i < 8; ++i) ss += v[q][i][0] * v[q][i][0] + v[q][i][1] * v[q][i][1] + v[q][i][2] * v[q][i][2] + v[q][i][3] * v[q][i][3];
        ss = wave_sum(ss); rinv[q] = __builtin_amdgcn_rsqf(ss * (1.0f / DM) + EPS); }
    if (MODE == 2) {
        float* op = P.out + ((size_t)b * SEQ + (p - CTXL)) * DM + lane * 4; const LAS float* gf = lm + lane * 4;
#pragma unroll
        for (int i = 0; i < 8; ++i) { const f32x4 gv = *(const LAS f32x4*)(gf + 256 * i); st_nt(op + 256 * i, v[0][i] * rinv[0] * gv); st_nt(op + DM + 256 * i, v[1][i] * rinv[1] * gv); }
    } else {
        const LAS float* gsp = lm + mv * DM + lane * 4;
#pragma unroll
        for (int i = 0; i < 8; ++i) { const f32x4 gs = *(const LAS f32x4*)(gsp + 256 * i), sv = *(const LAS f32x4*)(gsp + 5 * DM + 256 * i);
#pragma unroll
            for (int q = 0; q < 2; ++q) { const f32x4 y = v[q][i] * rinv[q] * gs + sv;
                u32x2 w2; w2.x = cvt_pk_bf16(y[0], y[1]); w2.y = cvt_pk_bf16(y[2], y[3]); *(u32x2*)(act + (size_t)(row + q) * DM + lane * 4 + 256 * i) = w2; } }
    }
}
template <int MODE> __device__ __forceinline__ void phase_norm(const Ctx& F) {
    const Params& P = F.P; const int lane = lane_fresh();
    const float* mod = (const float*)(F.ws + WS_MOD); const bf16_t* h = (const bf16_t*)(F.ws + WS_H); const int* slotmap = (const int*)(F.ws + WS_SLOT);
    const int lprev = MODE == 2 ? 1 : 0, lnext = MODE == 0 ? 0 : 1;
    LAS float* lm = (LAS float*)F.lds;
    { const int tid = F.wid * 64 + lane;
      for (int i = tid; i < 5 * DM; i += 512) { const int mvv = i >> 11, k = i & 2047;
          if (MODE != 2) { const float* sh_ = mod + (size_t)(lnext * 5 + mvv) * MODN; lm[i] = P.in[I_N1G][lnext * DM + k] * (1.0f + sh_[2048 + k]); lm[5 * DM + i] = sh_[k]; }
          if (MODE >= 1) lm[10 * DM + i] = mod[(size_t)(lprev * 5 + mvv) * MODN + 10240 + k]; }
      if (MODE == 2) for (int i = tid; i < DM; i += 512) lm[i] = P.in[I_FNG][i];
      __syncthreads(); }
    const int npair = MODE == 2 ? NB * SEQ / 2 : MROWS / 2; const int pstep = F.G * 8;
#define NM_ROW(j) (MODE == 2 ? ((j) / (SEQ / 2)) * TPB + CTXL + ((j) % (SEQ / 2)) * 2 : (j) * 2)
#define NM_LOAD(j, nx, nw, nsm0, nsm1) { const int r_ = NM_ROW(j); \
        if (MODE == 0) { const int b_ = r_ / TPB, p_ = r_ - b_ * TPB; const float* src = p_ < CTXL ? P.in[I_CTX] + ((size_t)b_ * CTXL + p_) * DM : P.in[I_X] + ((size_t)b_ * SEQ + (p_ - CTXL)) * DM; \
            _Pragma("unroll") for (int q = 0; q < 2; ++q) _Pragma("unroll") for (int i = 0; i < 8; ++i) nx[q][i] = ld_nt(src + (size_t)q * DM + lane * 4 + 256 * i); \
        } else { \
            _Pragma("unroll") for (int q = 0; q < 2; ++q) _Pragma("unroll") for (int i = 0; i < 8; ++i) nw[q][i] = *(const u32x2*)(h + (size_t)(r_ + q) * DM + lane * 4 + 256 * i); \
            nsm0 = lane < 16 ? slotmap[(size_t)r_ * 16 + lane] : -1; nsm1 = lane < 16 ? slotmap[(size_t)(r_ + 1) * 16 + lane] : -1; } }
    f32x4 ax[2][8], bx[2][8]; u32x2 aw[2][8], bw[2][8]; int as0 = -1, as1 = -1, bs0 = -1, bs1 = -1; int jp = F.c * 8 + F.wid;
    if (jp < npair) {
        NM_LOAD(jp, ax, aw, as0, as1)
        for (;;) {
            if (jp + pstep >= npair) { norm_pair<MODE>(F, lm, lane, NM_ROW(jp), ax, aw, as0, as1); break; }
            NM_LOAD(jp + pstep, bx, bw, bs0, bs1)
            norm_pair<MODE>(F, lm, lane, NM_ROW(jp), ax, aw, as0, as1);
            jp += pstep;
            if (jp + pstep >= npair) { norm_pair<MODE>(F, lm, lane, NM_ROW(jp), bx, bw, bs0, bs1); break; }
            NM_LOAD(jp + pstep, ax, aw, as0, as1)
            norm_pair<MODE>(F, lm, lane, NM_ROW(jp), bx, bw, bs0, bs1);
            jp += pstep;
        }
    }
#undef NM_LOAD
#undef NM_ROW
}

__device__ __forceinline__ void phase_router(const Ctx& F, int layer) {
    const Params& P = F.P; const int lane = lane_fresh(), tid = F.wid * 64 + lane;
    const float* mod = (const float*)(F.ws + WS_MOD); const bf16_t* h = (const bf16_t*)(F.ws + WS_H); unsigned char* act8 = F.ws + WS_ACT; float* aff = (float*)(F.ws + WS_AFF);
    LAS float* Wt = (LAS float*)F.lds;
    const float* wr = P.in[I_ROUTER] + (size_t)layer * DM * 16;
    for (int i = tid; i < DM * 16; i += 512) Wt[(i & 15) * DM + (i >> 4)] = wr[i];
    __syncthreads();
    const int npair = layer == 0 ? MROWS / 2 : NB * SEQ / 2; const int pstep = F.G * 8;
#define RT_ROW(j) (layer == 0 ? (j) * 2 : ((j) / (SEQ / 2)) * TPB + CTXL + ((j) % (SEQ / 2)) * 2)
    u32x2 nw[2][8]; int jp = F.c * 8 + F.wid;
    if (jp < npair) { const int r_ = RT_ROW(jp);
#pragma unroll
        for (int q = 0; q < 2; ++q)
#pragma unroll
            for (int i = 0; i < 8; ++i) nw[q][i] = *(const u32x2*)(h + (size_t)(r_ + q) * DM + lane * 4 + 256 * i); }
    for (; jp < npair; jp += pstep) {
        const int row = RT_ROW(jp); const int b = row / TPB, p = row - b * TPB; const bool isctx = p < CTXL; const int mv = isctx ? 4 : b;
        f32x2 pv[8][4];
#pragma unroll
        for (int i = 0; i < 8; ++i) { pv[i][0] = (f32x2){bf_lo(nw[0][i].x), bf_lo(nw[1][i].x)}; pv[i][1] = (f32x2){bf_hi(nw[0][i].x), bf_hi(nw[1][i].x)};
                                       pv[i][2] = (f32x2){bf_lo(nw[0][i].y), bf_lo(nw[1][i].y)}; pv[i][3] = (f32x2){bf_hi(nw[0][i].y), bf_hi(nw[1][i].y)}; }
        if (jp + pstep < npair) { const int r_ = RT_ROW(jp + pstep);
#pragma unroll
            for (int q = 0; q < 2; ++q)
#pragma unroll
                for (int i = 0; i < 8; ++i) nw[q][i] = *(const u32x2*)(h + (size_t)(r_ + q) * DM + lane * 4 + 256 * i); }
        f32x2 ss2 = {0.f, 0.f};
#pragma unroll
        for (int i = 0; i < 8; ++i)
#pragma unroll
            for (int k = 0; k < 4; ++k) ss2 += pv[i][k] * pv[i][k];
        f32x2 rinv2; rinv2.x = __builtin_amdgcn_rsqf(wave_sum(ss2.x) * (1.0f / DM) + EPS); rinv2.y = __builtin_amdgcn_rsqf(wave_sum(ss2.y) * (1.0f / DM) + EPS);
        const float* g = P.in[I_N2G] + layer * DM + lane * 4; const float* sh = mod + (size_t)(layer * 5 + mv) * MODN + 6144 + lane * 4; const float* sc = sh + 2048;
#pragma unroll
        for (int i = 0; i < 8; ++i) { const f32x4 gs = *(const f32x4*)(g + 256 * i) * (1.0f + *(const f32x4*)(sc + 256 * i)), sv = *(const f32x4*)(sh + 256 * i);
#pragma unroll
            for (int k = 0; k < 4; ++k) pv[i][k] = (pv[i][k] * rinv2) * (f32x2){gs[k], gs[k]} + (f32x2){sv[k], sv[k]};
            *(unsigned*)(act8 + (size_t)row * DM + lane * 4 + 256 * i) = pk4_fp8(pv[i][0].x, pv[i][1].x, pv[i][2].x, pv[i][3].x);
            *(unsigned*)(act8 + (size_t)(row + 1) * DM + lane * 4 + 256 * i) = pk4_fp8(pv[i][0].y, pv[i][1].y, pv[i][2].y, pv[i][3].y); }
        f32x2 lg2[16];
#pragma unroll
        for (int e = 0; e < 16; ++e) { f32x2 acc[4] = {{0.f, 0.f}, {0.f, 0.f}, {0.f, 0.f}, {0.f, 0.f}};
#pragma unroll
            for (int i = 0; i < 8; ++i) { const f32x4 w = *(const LAS f32x4*)(Wt + e * DM + lane * 4 + 256 * i);
#pragma unroll
                for (int k = 0; k < 4; ++k) acc[k] += pv[i][k] * (f32x2){w[k], w[k]}; }
            lg2[e] = (acc[0] + acc[1]) + (acc[2] + acc[3]); __builtin_amdgcn_sched_barrier(0); }
        const bool b0 = (lane & 1) != 0, b1 = (lane & 2) != 0, b2 = (lane & 4) != 0, b3 = (lane & 8) != 0, b4 = (lane & 16) != 0;
        float u16[16], u8[8], u4[4], u2[2];
#pragma unroll
        for (int j = 0; j < 16; ++j) { const float send = b0 ? lg2[j].x : lg2[j].y, keep = b0 ? lg2[j].y : lg2[j].x;
            u16[j] = keep + __int_as_float(__builtin_amdgcn_update_dpp(0, __float_as_int(send), 0xB1, 0xf, 0xf, true)); }
#pragma unroll
        for (int j = 0; j < 8; ++j) { const float send = b1 ? u16[j] : u16[8 + j], keep = b1 ? u16[8 + j] : u16[j];
            u8[j] = keep + __int_as_float(__builtin_amdgcn_update_dpp(0, __float_as_int(send), 0x4E, 0xf, 0xf, true)); }
#pragma unroll
        for (int j = 0; j < 4; ++j) { const float send = b2 ? u8[j] : u8[4 + j], keep = b2 ? u8[4 + j] : u8[j]; u4[j] = keep + __shfl_xor(send, 4); }
#pragma unroll
        for (int j = 0; j < 2; ++j) { const float send = b3 ? u4[j] : u4[2 + j], keep = b3 ? u4[2 + j] : u4[j]; u2[j] = keep + __shfl_xor(send, 8); }
        float lgt; { const float send = b4 ? u2[0] : u2[1], keep = b4 ? u2[1] : u2[0]; lgt = keep + __shfl_xor(send, 16); }
        lgt += __shfl_xor(lgt, 32);
        float mx = lgt;
#pragma unroll
        for (int o = 2; o <= 16; o <<= 1) mx = fmaxf(mx, __shfl_xor(mx, o));
        const float pe = __expf(lgt - mx); float sum = pe;
#pragma unroll
        for (int o = 2; o <= 16; o <<= 1) sum += __shfl_xor(sum, o);
        if (lane < 32) { const int e = (b1 ? 8 : 0) + (b2 ? 4 : 0) + (b3 ? 2 : 0) + (b4 ? 1 : 0); aff[(size_t)(row + (b0 ? 1 : 0)) * 16 + e] = pe / sum; }
    }
#undef RT_ROW
    __syncthreads();
}

__device__ __forceinline__ unsigned block_excl_scan(unsigned x, LAS unsigned* wsum, int lane, int wid) {
    unsigned s = x;
#pragma unroll
    for (int o = 1; o < 64; o <<= 1) { const unsigned t = __shfl_up(s, o); if (lane >= o) s += t; }
    if (lane == 63) wsum[wid] = s;
    __syncthreads();
    unsigned below = 0;
#pragma unroll
    for (int w = 0; w < 8; ++w) below += (w < wid) ? wsum[w] : 0u;
    __syncthreads();
    return below + s - x;
}
__device__ __forceinline__ void phase_topk(const Ctx& F, int layer) {
    const int lane = lane_fresh(), tid = F.wid * 64 + lane; const int estr = layer == 0 ? 2304 : 2048;
    const float* aff = (const float*)(F.ws + WS_AFF); int* slotmap = (int*)(F.ws + WS_SLOT); float* gval = (float*)(F.ws + WS_GVAL);
    unsigned* offt = (unsigned*)(F.ws + WS_OFFT);
    LAS unsigned* key = (LAS unsigned*)F.lds;
    LAS unsigned* hist = key + 4096;
    LAS unsigned* wsum = hist + 256;
    LAS unsigned* bc = wsum + 16;
    LAS unsigned* list = bc + 16;
    const int nunits = layer == 0 ? 320 : 256;
    for (int u = F.c; u < nunits; u += F.G) {
        const bool lat = u < 256; const int be = lat ? (u >> 2) : (u - 256), q = lat ? (u & 3) : 0; const int b = be >> 4, e = be & 15;
        const int n = lat ? SEQ : CTXL, cap = n >> 3, row0 = b * TPB + (lat ? CTXL : 0);
        for (int i = tid; i < n; i += 512) key[i] = __float_as_uint(aff[(size_t)(row0 + i) * 16 + e]);
        unsigned prefix = 0u, mask = 0u, krem = (unsigned)cap;
#pragma unroll 1
        for (int pass = 0; pass < 4; ++pass) { const int shift = 24 - 8 * pass;
            if (tid < 256) hist[tid] = 0u;
            __syncthreads();
            for (int i = tid; i < n; i += 512) { const unsigned k = key[i]; if ((k & mask) == prefix) __hip_atomic_fetch_add(hist + ((k >> shift) & 255u), 1u, __ATOMIC_RELAXED, __HIP_MEMORY_SCOPE_WORKGROUP); }
            __syncthreads();
            unsigned sfx = 0u;
            if (tid < 256) { sfx = hist[tid];
#pragma unroll
                for (int o = 1; o < 64; o <<= 1) { const unsigned t = __shfl_down(sfx, o); if (lane + o < 64) sfx += t; }
                if (lane == 0) wsum[F.wid] = sfx; }
            __syncthreads();
            if (tid < 256) { unsigned above = 0u;
#pragma unroll
                for (int w = 1; w < 4; ++w) above += (w > F.wid) ? wsum[w] : 0u;
                const unsigned ge = sfx + above; unsigned gt = __shfl_down(sfx, 1); gt = (lane == 63) ? above : gt + above;
                if (ge >= krem && gt < krem) { bc[0] = (unsigned)tid; bc[1] = krem - gt; } }
            __syncthreads();
            prefix |= bc[0] << shift; mask |= 255u << shift; krem = bc[1];
        }
        const int per = lat ? 8 : 1; const bool own = tid * per < n; const int i0 = tid * per;
        unsigned eqc = 0u;
        if (own) for (int j = 0; j < per; ++j) eqc += (key[i0 + j] == prefix) ? 1u : 0u;
        unsigned eqb = block_excl_scan(eqc, wsum, lane, F.wid);
        unsigned selm = 0u, selc = 0u;
        if (own) for (int j = 0; j < per; ++j) { const unsigned k = key[i0 + j]; bool sl = k > prefix; if (k == prefix) { sl = eqb < krem; ++eqb; } if (sl) { selm |= 1u << j; ++selc; } }
        unsigned sb = block_excl_scan(selc, wsum, lane, F.wid);
        const int slot0 = e * estr + (lat ? b * 512 : 2048 + b * 32);
        const bool mine = lat ? ((tid >> 7) == q) : true;
        if (own) for (int j = 0; j < per; ++j) { const bool sl = (selm >> j) & 1u; if (sl) list[sb] = (unsigned)(i0 + j);
            if (mine) slotmap[(size_t)(row0 + i0 + j) * 16 + e] = sl ? slot0 + (int)sb : -1; if (sl) ++sb; }
        __syncthreads();
        const int r_lo = lat ? q * 128 : 0, r_hi = lat ? r_lo + 128 : 32;
        for (int r = r_lo + tid; r < r_hi; r += 512) { const unsigned t = list[r]; gval[slot0 + r] = __uint_as_float(key[t]); offt[slot0 + r] = (unsigned)(row0 + t) * (unsigned)DM; }
        if (layer == 0 && !lat && b == 0 && tid < 128) offt[e * estr + 2176 + tid] = 0u;
        __syncthreads();
    }
}

__device__ __forceinline__ void unpack8(const u32x4 v, float (&o)[8]) { o[0] = bf_lo(v.x); o[1] = bf_hi(v.x); o[2] = bf_lo(v.y); o[3] = bf_hi(v.y); o[4] = bf_lo(v.z); o[5] = bf_hi(v.z); o[6] = bf_lo(v.w); o[7] = bf_hi(v.w); }
__device__ __forceinline__ void load_cu(const bf16_t* prj, int row, int ch, float (&o)[8]) {
    const u32x4 cv = *(const u32x4*)(prj + (size_t)row * PRJ_LD + 2560 + ch), uv = *(const u32x4*)(prj + (size_t)row * PRJ_LD + 3584 + ch);
    o[0] = bf_lo(cv.x) * bf_lo(uv.x); o[1] = bf_hi(cv.x) * bf_hi(uv.x); o[2] = bf_lo(cv.y) * bf_lo(uv.y); o[3] = bf_hi(cv.y) * bf_hi(uv.y);
    o[4] = bf_lo(cv.z) * bf_lo(uv.z); o[5] = bf_hi(cv.z) * bf_hi(uv.z); o[6] = bf_lo(cv.w) * bf_lo(uv.w); o[7] = bf_hi(cv.w) * bf_hi(uv.w);
}
__device__ __forceinline__ void load_x8(const bf16_t* prj, int row, int ch, int seg_lo, int seg_hi, float (&o)[8]) {
    if (row < seg_lo || row >= seg_hi) {
#pragma unroll
        for (int j = 0; j < 8; ++j) o[j] = 0.f; }
    else { const u32x4 v = *(const u32x4*)(prj + (size_t)row * PRJ_LD + ch); o[0] = bf_lo(v.x); o[1] = bf_hi(v.x); o[2] = bf_lo(v.y); o[3] = bf_hi(v.y); o[4] = bf_lo(v.z); o[5] = bf_hi(v.z); o[6] = bf_lo(v.w); o[7] = bf_hi(v.w); }
}
__device__ __forceinline__ int rope_unit(int c, int k, int G) {
    constexpr int NROPE = MROWS / 16;
    if (G != 256) { const int u = c + k * G; return u < NROPE ? u : -1; }
    if (k < 3) return k * 256 + c;
    if (k == 3) return c >= 32 ? 768 + (c - 32) : -1;
    if (k == 4) return (c >= 32 && c < 128) ? 992 + (c - 32) : -1;
    return -1;
}
__device__ __forceinline__ void phase_rope_conv(const Ctx& F) {
    const Params& P = F.P; const int tid = F.wid * 64 + lane_fresh();
    bf16_t* prj = (bf16_t*)(F.ws + WS_PRJ); bf16_t* yin = (bf16_t*)(F.ws + WS_YIN);
    constexpr int NCONV = MROWS / 32, NROPE = MROWS / 16;
    {
        const int ch = (tid & 127) * 8;
        const float* cw = P.in[I_EVCW]; float w0[8], w1[8], w2[8], cb[8];
#pragma unroll
        for (int j = 0; j < 8; ++j) { w0[j] = cw[ch + j]; w1[j] = cw[1024 + ch + j]; w2[j] = cw[2048 + ch + j]; cb[j] = P.in[I_EVCB][ch + j]; }
        u32x4 ncin[10], nbin[8];
#define RC_LOAD(un) { const int r0_ = (un) * 32 + (tid >> 7) * 8; const int b_ = r0_ / TPB, p_ = r0_ - b_ * TPB; const int lo_ = b_ * TPB + (p_ < CTXL ? 0 : CTXL), hi_ = b_ * TPB + (p_ < CTXL ? CTXL : TPB); \
            _Pragma("unroll") for (int k = 0; k < 10; ++k) { const int row = r0_ - 1 + k; const int rc = row < lo_ ? lo_ : (row >= hi_ ? hi_ - 1 : row); \
                ncin[k] = *(const u32x4*)((const char*)prj + (unsigned)(rc * PRJ_LD + 2560 + ch) * 2u); if (row < lo_ || row >= hi_) ncin[k] = (u32x4){0u, 0u, 0u, 0u}; }         \
            _Pragma("unroll") for (int k = 0; k < 8; ++k) nbin[k] = *(const u32x4*)((const char*)prj + (unsigned)((r0_ + k) * PRJ_LD + 1536 + ch) * 2u); }
        int u = F.c; if (u < NCONV) RC_LOAD(u)
        for (; u < NCONV; u += F.G) {
            const int r0 = u * 32 + (tid >> 7) * 8;
            u32x4 cin[10], bin[8];
#pragma unroll
            for (int k = 0; k < 10; ++k) cin[k] = ncin[k];
#pragma unroll
            for (int k = 0; k < 8; ++k) bin[k] = nbin[k];
            if (u + F.G < NCONV) RC_LOAD(u + F.G)
            const unsigned so0 = (unsigned)(r0 * YLD + 1024 + ch) * 2u; __builtin_amdgcn_sched_barrier(0);
            float prev[8], cur[8], nxt[8];
            unpack8(cin[0], prev); unpack8(cin[1], cur);
#pragma unroll
            for (int rr = 0; rr < 8; ++rr) { float bb[8]; unpack8(cin[rr + 2], nxt); unpack8(bin[rr], bb);
                float o[8];
#pragma unroll
                for (int j = 0; j < 8; ++j) { o[j] = bb[j] * (w0[j] * prev[j] + w1[j] * cur[j] + w2[j] * nxt[j] + cb[j]); prev[j] = cur[j]; cur[j] = nxt[j]; }
                u32x4 w; w.x = cvt_pk_bf16(o[0], o[1]); w.y = cvt_pk_bf16(o[2], o[3]); w.z = cvt_pk_bf16(o[4], o[5]); w.w = cvt_pk_bf16(o[6], o[7]);
                *(u32x4*)((char*)yin + (so0 + (unsigned)(rr * YLD * 2))) = w; __builtin_amdgcn_sched_barrier(0); }
        }
#undef RC_LOAD
    }
    {
        const int i = tid & 31; const bool second = ((i >> 3) & 1) != 0;
        float gq[4], gk[4], fr[4];
#pragma unroll
        for (int j = 0; j < 4; ++j) { gq[j] = P.in[I_EVQN][4 * i + j]; gk[j] = P.in[I_EVKN][4 * i + j]; const int fi = 4 * (i & 7) + j; fr[j] = __powf(10000.0f, -(float)(2 * fi) * (1.0f / 64.0f)); }
        u32x2 nwv[10], nv0, nv1;
#define RR_LOAD(un) { const bf16_t* rp_ = prj + (size_t)((un) * 16 + (tid >> 5)) * PRJ_LD + 4 * i; \
            _Pragma("unroll") for (int hh = 0; hh < 10; ++hh) nwv[hh] = *(const u32x2*)(rp_ + hh * 128); nv0 = *(const u32x2*)(rp_ + 1280); nv1 = *(const u32x2*)(rp_ + 1408); }
        int k = 0, u = rope_unit(F.c, 0, F.G); if (u >= 0) RR_LOAD(u)
        for (; u >= 0; ++k) {
            const int un = rope_unit(F.c, k + 1, F.G);
            const int row = u * 16 + (tid >> 5);
            const int b = row / TPB, p = row - b * TPB; const bool lat = p >= CTXL; const int t = p - CTXL;
            u32x2 wv[10];
#pragma unroll
            for (int hh = 0; hh < 10; ++hh) wv[hh] = nwv[hh];
            const u32x2 vv0 = nv0, vv1 = nv1;
            if (un >= 0) RR_LOAD(un)
            float cs[4], sn[4];
            { const int blk = i >> 4; const float pos = lat ? (float)(blk == 0 ? (t >> 6) : (t & 63)) : 0.f;
#pragma unroll
              for (int j = 0; j < 4; ++j) { float s_, c_; sincosf(pos * fr[j], &s_, &c_); cs[j] = c_; sn[j] = s_; } }
            bf16_t* rowp = prj + (size_t)row * PRJ_LD + 4 * i;
#pragma unroll
            for (int hh = 0; hh < 10; ++hh) {
                const u32x2 w = wv[hh]; float x[4] = {bf_lo(w.x), bf_hi(w.x), bf_lo(w.y), bf_hi(w.y)};
                float ss = x[0] * x[0] + x[1] * x[1] + x[2] * x[2] + x[3] * x[3];
#pragma unroll
                for (int o = 16; o >= 1; o >>= 1) ss += __shfl_xor(ss, o);
                const float rinv = __builtin_amdgcn_rsqf(ss * (1.0f / 128.0f) + EPS);
                float y[4];
#pragma unroll
                for (int j = 0; j < 4; ++j) y[j] = x[j] * rinv * (hh < 8 ? gq[j] : gk[j]);
                float o4[4];
#pragma unroll
                for (int j = 0; j < 4; ++j) { const float pr = __shfl_xor(y[j], 8); o4[j] = second ? (pr * sn[j] + y[j] * cs[j]) : (y[j] * cs[j] - pr * sn[j]); }
                wv[hh].x = cvt_pk_bf16(o4[0], o4[1]); wv[hh].y = cvt_pk_bf16(o4[2], o4[3]);
            }
#pragma unroll
            for (int hh = 0; hh < 8; ++hh) *(u32x2*)(rowp + hh * 128) = wv[hh];
            bf16_t* kc = (bf16_t*)(F.ws + WS_KC) + ((size_t)(b * 2) * TPB + p) * 128 + 4 * i; bf16_t* vc = (bf16_t*)(F.ws + WS_VC) + ((size_t)(b * 2) * TPB + p) * 128 + 4 * i;
            *(u32x2*)kc = wv[8]; *(u32x2*)(kc + (size_t)TPB * 128) = wv[9]; *(u32x2*)vc = vv0; *(u32x2*)(vc + (size_t)TPB * 128) = vv1;
            u = un;
        }
#undef RR_LOAD
    }
}

__device__ __forceinline__ void phase_attn(const Ctx& F) {
    const bf16_t* prj = (const bf16_t*)(F.ws + WS_PRJ); bf16_t* yin = (bf16_t*)(F.ws + WS_YIN);
    const int combo = F.c & 7, b = combo >> 1, kvh = combo & 1;
    const bf16_t* Kh = (const bf16_t*)(F.ws + WS_KC) + (size_t)(b * 2 + kvh) * TPB * 128; const bf16_t* Vh = (const bf16_t*)(F.ws + WS_VC) + (size_t)(b * 2 + kvh) * TPB * 128;
#define ATT_UNIT(i) do { const int w = (F.c >> 3) + 32 * (i); const int hq = kvh * 4 + ((i) < 2 ? (w >> 4) : (F.c >> 3)), qb = w & 15; \
        const size_t qrow = (size_t)b * TPB + ((i) < 2 ? CTXL + qb * 256 : 0); \
        att::attn_dense_body(prj + qrow * PRJ_LD + hq * 128, Kh, Vh, yin + qrow * YLD + hq * 128, (i) < 2 ? TPB : CTXL, F.ldsg, F.wid); } while (0)
    ATT_UNIT(0);
    ATT_UNIT(1);
    if (F.c < 32) ATT_UNIT(2);
#undef ATT_UNIT
}

__device__ __forceinline__ void phase_lru_conv(const Ctx& F) {
    const Params& P = F.P; const int tid = F.wid * 64 + lane_fresh();
    const bf16_t* prj = (const bf16_t*)(F.ws + WS_PRJ); bf16_t* U = (bf16_t*)(F.ws + WS_U);
    constexpr int RG = 8, NRG = MROWS / RG;
    const int gt = F.c * 512 + tid, nth = (F.G * 512) / 320;
    if (gt < nth * 320) {
        const int ch = (gt % 320) * 8; int rg = gt / 320;
        const float* cw = P.in[I_ODCW]; float w0[8], w1[8], w2[8], w3[8], cb[8];
#pragma unroll
        for (int j = 0; j < 8; ++j) { w0[j] = cw[ch + j]; w1[j] = cw[LRUW + ch + j]; w2[j] = cw[2 * LRUW + ch + j]; w3[j] = cw[3 * LRUW + ch + j]; cb[j] = P.in[I_ODCB][ch + j]; }
        u32x4 nin[RG + 3];
#define LC_LOAD(g) { const int r0_ = (g) * RG; const int b_ = r0_ / TPB, p_ = r0_ - b_ * TPB; const int lo_ = b_ * TPB + (p_ < CTXL ? 0 : CTXL), hi_ = b_ * TPB + (p_ < CTXL ? CTXL : TPB); \
            _Pragma("unroll") for (int k = 0; k < RG + 3; ++k) { const int row = r0_ - 1 + k; const int rc = row < lo_ ? lo_ : (row >= hi_ ? hi_ - 1 : row); \
                nin[k] = *(const u32x4*)((const char*)prj + (unsigned)(rc * PRJ_LD + ch) * 2u); if (row < lo_ || row >= hi_) nin[k] = (u32x4){0u, 0u, 0u, 0u}; } }
        if (rg < NRG) LC_LOAD(rg)
        for (; rg < NRG; rg += nth) {
            u32x4 xin[RG + 3];
#pragma unroll
            for (int k = 0; k < RG + 3; ++k) xin[k] = nin[k];
            if (rg + nth < NRG) LC_LOAD(rg + nth)
            const unsigned so0 = (unsigned)(rg * RG * LRUW + ch) * 2u; __builtin_amdgcn_sched_barrier(0);
#pragma unroll
            for (int rr = 0; rr < RG; ++rr) { float xm[8], x0[8], x1[8], x2[8]; unpack8(xin[rr], xm); unpack8(xin[rr + 1], x0); unpack8(xin[rr + 2], x1); unpack8(xin[rr + 3], x2);
                float o[8];
#pragma unroll
                for (int j = 0; j < 8; ++j) o[j] = w0[j] * xm[j] + w1[j] * x0[j] + w2[j] * x1[j] + w3[j] * x2[j] + cb[j];
                u32x4 w; w.x = cvt_pk_bf16(o[0], o[1]); w.y = cvt_pk_bf16(o[2], o[3]); w.z = cvt_pk_bf16(o[4], o[5]); w.w = cvt_pk_bf16(o[6], o[7]);
                *(u32x4*)((char*)U + (so0 + (unsigned)(rr * LRUW * 2))) = w; __builtin_amdgcn_sched_barrier(0); }
        }
#undef LC_LOAD
    }
}

__device__ __forceinline__ int scan_chunk_at(int d, int k) { return d == 0 ? k : (k < 4 ? 3 - k : 71 - k); }
__device__ __forceinline__ int scan_order_of(int d, int c) { return d == 0 ? c : (c < 4 ? 3 - c : 71 - c); }
__device__ __forceinline__ void scan_dec(unsigned w, float sp0, float sp1, float& a0, float& b0, float& a1, float& b1) {
    const float q0 = (float)(w & 0xffu) * (1.0f / 255.0f), q1 = (float)((w >> 8) & 0xffu) * (1.0f / 255.0f);
    a0 = __expf(q0 * q0 * sp0); a1 = __expf(q1 * q1 * sp1); b0 = __builtin_amdgcn_cvt_f32_fp8((int)w, 2); b1 = __builtin_amdgcn_cvt_f32_fp8((int)w, 3);
}
__device__ __forceinline__ float lru_sp(const float* lam, int d, int ch) { const float lm = lam[d * LRUW + ch]; return -8.0f * (fmaxf(-lm, 0.f) + __logf(1.0f + __expf(-fabsf(lm)))); }
__device__ __forceinline__ void phase_scan1(const Ctx& F) {
    const unsigned short* lav = (const unsigned short*)(F.ws + WS_LAGI); float* agg = (float*)(F.ws + WS_AGG); const int lane = lane_fresh(); const float* lam = F.P.in[I_ODLAM];
    float* carry = (float*)(F.ws + WS_CARRY); unsigned* scnt = (unsigned*)(F.ws + WS_SCNT);
    constexpr int NU = 2 * NB * 68 * 10;
    const int half = lane >> 5, sub = lane & 31;
    for (int u = F.c * 8 + F.wid; u < NU; u += F.G * 8) {
        const int cg = u % 10, c = (u / 10) % 68, b = (u / (10 * 68)) % NB, d = u / (10 * 68 * NB);
        const int ch = cg * 256 + sub * 8;
        const int r0 = d == 0 ? half * 32 : 63 - half * 32; const int rstep = d == 0 ? LRUW * 2 : -LRUW * 2;
        unsigned off = (unsigned)((((size_t)d * MROWS + (size_t)b * TPB + c * 64 + r0) * LRUW + ch) * 2);
        float hh[8], ss[8], sp[8];
#pragma unroll
        for (int j = 0; j < 8; ++j) { hh[j] = 0.f; ss[j] = 0.f; sp[j] = lru_sp(lam, d, ch + j); asm volatile("" : "+v"(sp[j])); }
#pragma unroll
        for (int blk = 0; blk < 2; ++blk) { u32x4 w[16];
#pragma unroll
            for (int kk = 0; kk < 16; ++kk) { w[kk] = *(const u32x4*)((const char*)lav + off); off += (unsigned)rstep; }
#pragma unroll
            for (int kk = 0; kk < 16; ++kk) {
#pragma unroll
                for (int p = 0; p < 4; ++p) { const unsigned x = p == 0 ? w[kk].x : (p == 1 ? w[kk].y : (p == 2 ? w[kk].z : w[kk].w));
                    const float q0 = (float)(x & 0xffu) * (1.0f / 255.0f), q1 = (float)((x >> 8) & 0xffu) * (1.0f / 255.0f); const float la0 = q0 * q0 * sp[2 * p], la1 = q1 * q1 * sp[2 * p + 1];
                    hh[2 * p] = __expf(la0) * hh[2 * p] + __builtin_amdgcn_cvt_f32_fp8((int)x, 2); hh[2 * p + 1] = __expf(la1) * hh[2 * p + 1] + __builtin_amdgcn_cvt_f32_fp8((int)x, 3); ss[2 * p] += la0; ss[2 * p + 1] += la1;
                    asm volatile("" : "+v"(hh[2 * p]), "+v"(hh[2 * p + 1]), "+v"(ss[2 * p]), "+v"(ss[2 * p + 1])); }
                __builtin_amdgcn_sched_barrier(0); }
        }
        float so[8], ho[8];
#pragma unroll
        for (int j = 0; j < 8; ++j) { so[j] = __shfl_xor(ss[j], 32); ho[j] = __shfl_xor(hh[j], 32); }
        if (half == 1) { float* ap = agg + ((((size_t)d * NB + b) * 68 + c) * LRUW + ch) * 2;
#pragma unroll
            for (int p = 0; p < 4; ++p) { const float h0 = __expf(ss[2 * p]) * ho[2 * p] + hh[2 * p], h1 = __expf(ss[2 * p + 1]) * ho[2 * p + 1] + hh[2 * p + 1];
                st_wt16(ap + 4 * p, (f32x4){ss[2 * p] + so[2 * p], h0, ss[2 * p + 1] + so[2 * p + 1], h1}); } }
        asm volatile("s_waitcnt vmcnt(0)" ::: "memory");
        unsigned old_ = 0u;
        if (lane == 0) old_ = __hip_atomic_fetch_add(scnt + (((d * NB + b) * 10 + cg) * 16), 1u, __ATOMIC_RELAXED, __HIP_MEMORY_SCOPE_AGENT);
        old_ = (unsigned)__builtin_amdgcn_readfirstlane((int)old_);
        if (old_ == 67u) {
            __builtin_amdgcn_fence(__ATOMIC_ACQUIRE, "agent");
            const int pch = cg * 256 + lane * 4; float st[4] = {0.f, 0.f, 0.f, 0.f};
            const float* ab = agg + (((size_t)d * NB + b) * 68 * LRUW + pch) * 2; float* cb = carry + ((size_t)d * NB + b) * 68 * LRUW + pch;
#pragma unroll 1
            for (int k0 = 0; k0 < 68; k0 += 17) { f32x4 a0[17], a1[17];
#pragma unroll
                for (int j = 0; j < 17; ++j) { const int cc = scan_chunk_at(d, k0 + j); a0[j] = *(const f32x4*)(ab + (size_t)cc * LRUW * 2); a1[j] = *(const f32x4*)(ab + (size_t)cc * LRUW * 2 + 4); }
#pragma unroll
                for (int j = 0; j < 17; ++j) { const int cc = scan_chunk_at(d, k0 + j);
                    *(f32x4*)(cb + (size_t)cc * LRUW) = (f32x4){st[0], st[1], st[2], st[3]};
                    st[0] = __expf(a0[j][0]) * st[0] + a0[j][1]; st[1] = __expf(a0[j][2]) * st[1] + a0[j][3]; st[2] = __expf(a1[j][0]) * st[2] + a1[j][1]; st[3] = __expf(a1[j][2]) * st[3] + a1[j][3]; } }
        }
    }
}
__device__ __forceinline__ void scan_carry(const float* agg, int d, int b, int c, int ch, float& h0, float& h1) {
    h0 = 0.f; h1 = 0.f; const int ord = scan_order_of(d, c);
    for (int k0 = 0; k0 < ord; k0 += 16) { f32x4 a[16];
#pragma unroll
        for (int j = 0; j < 16; ++j) { const int cc = scan_chunk_at(d, (k0 + j < ord) ? k0 + j : 0); a[j] = *(const f32x4*)(agg + ((((size_t)d * NB + b) * 68 + cc) * LRUW + ch) * 2);
            if (k0 + j >= ord) a[j] = (f32x4){0.f, 0.f, 0.f, 0.f}; }
#pragma unroll
        for (int j = 0; j < 16; ++j) { h0 = __expf(a[j][0]) * h0 + a[j][1]; h1 = __expf(a[j][2]) * h1 + a[j][3]; } }
}
__device__ __forceinline__ void phase_scan2(const Ctx& F) {
    const unsigned short* lav = (const unsigned short*)(F.ws + WS_LAGI); const float* carry = (const float*)(F.ws + WS_CARRY); const float* lam = F.P.in[I_ODLAM];
    const bf16_t* prj = (const bf16_t*)(F.ws + WS_PRJ); bf16_t* yin = (bf16_t*)(F.ws + WS_YIN); const int lane = lane_fresh();
    constexpr int NU = NB * 64 * 20;
    for (int u = F.c * 8 + F.wid; u < NU; u += F.G * 8) {
        const int cg = u % 20, c = 4 + (u / 20) % 64, b = u / (20 * 64);
        const int ch = cg * 128 + lane * 2; const size_t row0 = (size_t)b * TPB + c * 64;
        unsigned yf[64]; float h0, h1;
        { const f32x2 cv = *(const f32x2*)(carry + (((size_t)0 * NB + b) * 68 + c) * LRUW + ch); h0 = cv.x; h1 = cv.y; }
        { const size_t base = row0 * LRUW + ch;
          const float sp0 = lru_sp(lam, 0, ch), sp1 = lru_sp(lam, 0, ch + 1);
#pragma unroll
          for (int blk = 0; blk < 4; ++blk) { unsigned w[16];
#pragma unroll
            for (int r = 0; r < 16; ++r) w[r] = *(const unsigned*)(lav + base + (size_t)(blk * 16 + r) * LRUW);
#pragma unroll
            for (int r = 0; r < 16; ++r) { float a0, b0, a1, b1; scan_dec(w[r], sp0, sp1, a0, b0, a1, b1); h0 = a0 * h0 + b0; h1 = a1 * h1 + b1; yf[blk * 16 + r] = cvt_pk_bf16(h0, h1); } } }
        { const f32x2 cv = *(const f32x2*)(carry + (((size_t)1 * NB + b) * 68 + c) * LRUW + ch); h0 = cv.x; h1 = cv.y; }
        { const size_t base = (size_t)MROWS * LRUW + row0 * LRUW + ch;
          const float sp0 = lru_sp(lam, 1, ch), sp1 = lru_sp(lam, 1, ch + 1);
#pragma unroll
          for (int blk = 3; blk >= 0; --blk) { unsigned w[16]; unsigned gw[16];
#pragma unroll
            for (int r = 0; r < 16; ++r) { w[r] = *(const unsigned*)(lav + base + (size_t)(blk * 16 + r) * LRUW); gw[r] = *(const unsigned*)(prj + (row0 + blk * 16 + r) * PRJ_LD + LRUW + ch); }
#pragma unroll
            for (int r = 15; r >= 0; --r) { float a0, b0, a1, b1; scan_dec(w[r], sp0, sp1, a0, b0, a1, b1); h0 = a0 * h0 + b0; h1 = a1 * h1 + b1;
                const unsigned f = yf[blk * 16 + r]; gw[r] = cvt_pk_bf16((h0 + bf_lo(f)) * bf_lo(gw[r]), (h1 + bf_hi(f)) * bf_hi(gw[r])); }
#pragma unroll
            for (int r = 0; r < 16; ++r) *(unsigned*)(yin + (row0 + blk * 16 + r) * YLD + ch) = gw[r]; } }
    }
}

constexpr int NPHASE = 22;
constexpr int LDS_BYTES = 147456;
constexpr int LDS_MISC = 135168;
__global__ void __launch_bounds__(512, 2) mk_fwd(Params prm) {
    extern __shared__ __attribute__((aligned(16))) unsigned char lds_raw[];
    Ctx F; F.P = prm; F.ws = prm.ws; F.wid = __builtin_amdgcn_readfirstlane((int)threadIdx.x >> 6); F.G = gridDim.x; F.c = blockIdx.x;
    F.lds = (LAS unsigned char*)lds_raw; F.ldsg = (char*)lds_raw;
    volatile LAS unsigned* misc = (volatile LAS unsigned*)(F.lds + LDS_MISC);
    if (threadIdx.x < 4) misc[threadIdx.x] = 0u;
    __syncthreads();
    XcdBarrier bar; bar.bar = (unsigned*)(F.ws + WS_CTL); bar.x = 0; bar.st = misc; bar.wid = F.wid;
    const int lo = prm.ph_lo, hi = prm.ph_hi;
    if (hi - lo > 1) bar = xcd_barrier_post((unsigned*)(F.ws + WS_CTL), misc, F.wid);
#ifndef PH_MASK
#define PH_MASK 0xffffffffu
#endif
#define IN(k) ((((unsigned)PH_MASK >> (k)) & 1u) && lo <= (k) && (k) < hi)
#define SEAM(k) do { if (IN((k) + 1)) xcd_barrier(bar); } while (0)
#ifndef REP_MASK
#define REP_MASK 0u
#endif
#define NREP(k) ((((unsigned)REP_MASK >> (k)) & 1u) ? 2 : 1)
#define PHASE(k, ...) if (IN(k)) { for (int rep_ = 0; rep_ < NREP(k); ++rep_) { __VA_ARGS__ if (rep_ + 1 < NREP(k)) xcd_barrier(bar); } SEAM(k); }
    const float* mod = (const float*)(F.ws + WS_MOD);
    PHASE(0, p0_prologue(F);)
    PHASE(1, phase_norm<0>(F);)
    PHASE(2, if (F.c < F.G - NCV2) { SchedDense S{(const char*)(F.ws + WS_ACT), (const char*)(F.ws + WS_WEVIN), NMT, EV_IN / 256, F.G - NCV2, F.c, DM, DM, 0};
        EpiEvIn E{(bf16_t*)(F.ws + WS_PRJ), PRJ_LD}; pg8::gemm_phase<false, false>(F.lds, F.wid, pg8::Shape{DM, DM}, S, E); } else conv_range(F, GT0, GT2, F.G - NCV2);)
    PHASE(3, phase_rope_conv(F);)
    PHASE(4, phase_attn(F);)
    PHASE(5, if (F.c < F.G - NCV5) { SchedDense S{(const char*)(F.ws + WS_YIN), (const char*)(F.ws + WS_WEVOUT), NMT, DM / 256, F.G - NCV5, F.c, YLD, DM, 0};
        EpiResid E{prm.in[I_X], prm.in[I_CTX], (bf16_t*)(F.ws + WS_H), mod, 1}; pg8::gemm_phase<false, false>(F.lds, F.wid, pg8::Shape{DM, YLD}, S, E); } else conv_range(F, GT2, GT5, F.G - NCV5);)
    PHASE(6, phase_router(F, 0);)
    PHASE(7, phase_topk(F, 0);)
    PHASE(8, SchedMoe S{(const char*)(F.ws + WS_ACT), (const char*)(F.ws + WS_WGU), 9, 16, 2304, 4096, F.G, F.c, (const unsigned*)(F.ws + WS_OFFT)};
        EpiSwiglu E{F.ws + WS_HID, 2304}; pg8::gemm_phase<true, true>(F.lds, F.wid, pg8::Shape{DM / 2, DM / 2}, S, E);)
    PHASE(9, if (F.c < F.G - NCV9) { SchedMoe S{(const char*)(F.ws + WS_HID), (const char*)(F.ws + WS_WDN), 9, 8, 2304, 2048, F.G - NCV9, F.c, nullptr};
        EpiDown E{F.ws + WS_EO, (const float*)(F.ws + WS_GVAL), 2304}; pg8::gemm_phase<true, false>(F.lds, F.wid, pg8::Shape{DM / 2, DM / 2}, S, E); } else conv_range(F, GT5, GT9, F.G - NCV9);)
    PHASE(10, phase_norm<1>(F);)
    PHASE(11, if (F.c < F.G - NCV11) { SchedOdIn S{(const char*)(F.ws + WS_ACT), (const char*)(F.ws + WS_WODIN), F.G - NCV11, F.c};
        EpiPlainBf16 E{(bf16_t*)(F.ws + WS_PRJ), PRJ_LD, 10}; pg8::gemm_phase<false, false>(F.lds, F.wid, pg8::Shape{DM, DM}, S, E); } else conv_range(F, GT9, GT11, F.G - NCV11);)
    PHASE(12, phase_lru_conv(F);)
    PHASE(13, if (F.c < F.G - NCV13) { SchedLru S{(const char*)(F.ws + WS_U), (const char*)(F.ws + WS_WLRU), F.G - NCV13, F.c};
        EpiLru E{(const bf16_t*)(F.ws + WS_U), (unsigned*)(F.ws + WS_LAGI), prm.in[I_ODBA], prm.in[I_ODBX], prm.in[I_ODLAM]}; pg8::gemm_phase<false, false>(F.lds, F.wid, pg8::Shape{256, LRUW}, S, E); } else conv_range(F, GT11, GT13, F.G - NCV13);)
    PHASE(14, phase_scan1(F);)
    PHASE(15, phase_scan2(F);)
    PHASE(16, SchedDense S{(const char*)(F.ws + WS_YIN), (const char*)(F.ws + WS_WODOUT), 64, DM / 256, F.G, F.c, YLD, LRUW, 1};
        EpiResid E{prm.in[I_X], prm.in[I_CTX], (bf16_t*)(F.ws + WS_H), mod + 5 * MODN, 0}; pg8::gemm_phase<false, false>(F.lds, F.wid, pg8::Shape{LRUW, YLD}, S, E);)
    PHASE(17, phase_router(F, 1);)
    PHASE(18, phase_topk(F, 1);)
    PHASE(19, SchedMoe S{(const char*)(F.ws + WS_ACT), (const char*)(F.ws + WS_WGU) + (size_t)NEXP * 4096 * DM, 8, 16, 2048, 4096, F.G, F.c, (const unsigned*)(F.ws + WS_OFFT)};
        EpiSwiglu E{F.ws + WS_HID, 2048}; pg8::gemm_phase<true, true>(F.lds, F.wid, pg8::Shape{DM / 2, DM / 2}, S, E);)
    PHASE(20, SchedMoe S{(const char*)(F.ws + WS_HID), (const char*)(F.ws + WS_WDN) + (size_t)NEXP * DM * DM, 8, 8, 2048, 2048, F.G, F.c, nullptr};
        EpiDown E{F.ws + WS_EO, (const float*)(F.ws + WS_GVAL), 2048}; pg8::gemm_phase<true, false>(F.lds, F.wid, pg8::Shape{DM / 2, DM / 2}, S, E);)
    PHASE(21, phase_norm<2>(F);)
#undef IN
#undef SEAM
}

extern "C" void kernel_launch(void* const* d_in, const int* in_sizes, int n_in, void* d_out, int out_size, void* d_ws, size_t ws_size, hipStream_t stream) {
    static int grid = 0;
    if (grid == 0) {
        if (n_in != 28 || out_size != NB * SEQ * DM || ws_size < WS_END) { fprintf(stderr, "kernel_launch: bad shapes: n_in %d out %d ws %zu (need %zu)\n", n_in, out_size, ws_size, (size_t)WS_END); grid = -1; return; }
        int dev = 0, cus = 0, per_cu = 0;
        if (hipGetDevice(&dev) != hipSuccess || hipDeviceGetAttribute(&cus, hipDeviceAttributeMultiprocessorCount, dev) != hipSuccess) { grid = -1; return; }
        if (hipFuncSetAttribute((const void*)mk_fwd, hipFuncAttributeMaxDynamicSharedMemorySize, LDS_BYTES) != hipSuccess) { fprintf(stderr, "kernel_launch: hipFuncSetAttribute failed\n"); grid = -1; return; }
        if (hipOccupancyMaxActiveBlocksPerMultiprocessor(&per_cu, (const void*)mk_fwd, 512, LDS_BYTES) != hipSuccess || per_cu < 1) fprintf(stderr, "kernel_launch: occupancy query says %d\n", per_cu);
        (void)hipGetLastError();
        grid = cus;
    }
    if (grid < 0) return;
    (void)in_sizes;
    (void)hipMemsetAsync((char*)d_ws + WS_CTL, 0, 65536, stream);
    Params p{};
    for (int i = 0; i < 28; ++i) p.in[i] = (const float*)d_in[i];
    p.out = (float*)d_out; p.ws = (unsigned char*)d_ws;
#if MK_PER_PHASE
    for (int ph = 0; ph < NPHASE; ++ph) { p.ph_lo = ph; p.ph_hi = ph + 1; hipLaunchKernelGGL(mk_fwd, dim3(grid), dim3(512), LDS_BYTES, stream, p); }
#else
    p.ph_lo = 0; p.ph_hi = NPHASE; hipLaunchKernelGGL(mk_fwd, dim3(grid), dim3(512), LDS_BYTES, stream, p);
#endif
    const hipError_t le = hipPeekAtLastError();
    if (le != hipSuccess) fprintf(stderr, "kernel_launch: launch failed: %s\n", hipGetErrorName(le));
}
```

```cpp
#include <hip/hip_runtime.h>
#include <cstdio>
#include <cstdint>

#ifndef MK_PER_PHASE
#define MK_PER_PHASE 0
#endif

#define LAS __attribute__((address_space(3)))
typedef unsigned short bf16_t;
typedef short bf16x8 __attribute__((ext_vector_type(8)));
typedef short s16x4 __attribute__((ext_vector_type(4)));
typedef float f32x4 __attribute__((ext_vector_type(4)));
typedef float f32x2 __attribute__((ext_vector_type(2)));
typedef float f32x16 __attribute__((ext_vector_type(16)));
typedef unsigned u32x4 __attribute__((ext_vector_type(4)));
typedef unsigned u32x2 __attribute__((ext_vector_type(2)));
typedef int i32x8 __attribute__((ext_vector_type(8)));
typedef int i32x8a __attribute__((ext_vector_type(8), aligned(16)));
typedef int i32x4a __attribute__((ext_vector_type(4), aligned(16)));

#define XB_TMO      128
#define XB_XCNT(j)  (256  + 64 * (j))
#define XB_XSUB(j)  (1280 + 64 * (j))
#define XB_XGEN(j)  (2304 + 64 * (j))
#define XB_TOP      3328
#define XB_TOPGEN   3392
#define XCD_BAR_WORDS 3456
#define XB_SPIN_CAP (1u << 18)

__device__ __forceinline__ unsigned xb_ld(unsigned* p)              { return __hip_atomic_load(p, __ATOMIC_RELAXED, __HIP_MEMORY_SCOPE_AGENT); }
__device__ __forceinline__ unsigned xb_add(unsigned* p, unsigned v) { return __hip_atomic_fetch_add(p, v, __ATOMIC_RELAXED, __HIP_MEMORY_SCOPE_AGENT); }
__device__ __forceinline__ unsigned xb_xcc_id() { return (unsigned)__builtin_amdgcn_s_getreg((3 << 11) | 20) & 0xFu; }
#define XB_SPIN(cond, bar) do { unsigned _sp = 0; while (cond) { __builtin_amdgcn_s_sleep(1); \
    if ((++_sp & 255u) == 0u) { if (xb_ld(&(bar)[XB_TMO])) break; if (_sp > XB_SPIN_CAP) { atomicAdd(&(bar)[XB_TMO], 1u); break; } } } } while (0)

struct XcdBarrier { unsigned* bar; unsigned x; volatile LAS unsigned* st; int wid; };

__device__ __forceinline__ int xb_lane() { int l; asm volatile("v_mbcnt_lo_u32_b32 %0, -1, 0\n\tv_mbcnt_hi_u32_b32 %0, -1, %0" : "=v"(l)); return l; }
__device__ __forceinline__ XcdBarrier xcd_barrier_post(unsigned* bar, volatile LAS unsigned* st, int wid) {
    XcdBarrier b; b.bar = bar; b.x = xb_xcc_id(); b.st = st; b.wid = wid;
    if (wid == 0 && xb_lane() == 0) (void)xb_add(&bar[XB_XCNT(b.x)], 1u);
    return b;
}
__device__ __forceinline__ void xcd_barrier_complete(unsigned* bar, unsigned x, unsigned& nloc, unsigned& nx) {
    const unsigned G = gridDim.x * gridDim.y * gridDim.z;
    unsigned sum, cnt, mine, sp = 0u;
    for (;;) {
        sum = 0u; cnt = 0u; mine = 0u;
#pragma unroll
        for (unsigned j = 0; j < 16; ++j) { const unsigned c = xb_ld(&bar[XB_XCNT(j)]); sum += c; cnt += (c > 0u) ? 1u : 0u; mine = (j == x) ? c : mine; }
        if (sum == G) break;
        __builtin_amdgcn_s_sleep(1);
        if ((++sp & 255u) == 0u) { if (xb_ld(&bar[XB_TMO])) break; if (sp > XB_SPIN_CAP) { atomicAdd(&bar[XB_TMO], 1u); break; } }
    }
    nloc = mine > 0u ? mine : 1u; nx = cnt > 0u ? cnt : 1u;
}
__device__ __forceinline__ void xcd_barrier(const XcdBarrier& b) {
    asm volatile("s_waitcnt vmcnt(0)" ::: "memory");
    __syncthreads();
    if (b.wid == 0 && xb_lane() == 0) {
        unsigned* bar = b.bar;
        __builtin_amdgcn_s_waitcnt(0);
        unsigned nloc = b.st[0], nx = b.st[1];
        if (nloc == 0u) { xcd_barrier_complete(bar, b.x, nloc, nx); b.st[0] = nloc; b.st[1] = nx; }
        const unsigned old = xb_add(&bar[XB_XSUB(b.x)], 1u);
        const unsigned gen = old / nloc;
        if (old + 1u == (gen + 1u) * nloc) {
            __builtin_amdgcn_fence(__ATOMIC_RELEASE, "agent");
            asm volatile("s_waitcnt vmcnt(0)" ::: "memory");
            const unsigned og = xb_add(&bar[XB_TOP], 1u);
            const unsigned tg = og / nx;
            if (og + 1u == (tg + 1u) * nx) xb_add(&bar[XB_TOPGEN], 1u);
            else XB_SPIN(xb_ld(&bar[XB_TOPGEN]) == tg, bar);
            __builtin_amdgcn_fence(__ATOMIC_ACQUIRE, "agent");
            xb_add(&bar[XB_XGEN(b.x)], 1u);
            asm volatile("s_waitcnt vmcnt(0)" ::: "memory");
        } else {
            XB_SPIN(xb_ld(&bar[XB_XGEN(b.x)]) == gen, bar);
            __builtin_amdgcn_fence(__ATOMIC_ACQUIRE, "agent");
            asm volatile("s_waitcnt vmcnt(0)" ::: "memory");
        }
    }
    __syncthreads();
}

constexpr int DM = 2048, NB = 4, SEQ = 4096, CTXL = 256, TPB = SEQ + CTXL  , MROWS = NB * TPB  ;
constexpr int NMT = MROWS / 256;
constexpr int EV_IN = 4608, OD_IN = 5120, LRUW = 2560, PRJ_LD = 5120, YLD = 2560, MODN = 12288;
constexpr int NEXP = 16, FF = 2048;
constexpr float EPS = 1e-6f;
constexpr float W8_SCALE = 32.0f, W8_INV = 1.0f / 32.0f;

constexpr size_t al256(size_t x) { return (x + 255) / 256 * 256; }
constexpr size_t WS_CTL   = 0;
constexpr size_t WS_MOD   = 65536;
constexpr size_t WS_WEVIN = WS_MOD   + al256((size_t)2 * 5 * MODN * 4);
constexpr size_t WS_WEVOUT= WS_WEVIN + (size_t)EV_IN * DM * 2;
constexpr size_t WS_WODIN = WS_WEVOUT+ (size_t)DM * DM * 2;
constexpr size_t WS_WLRU  = WS_WODIN + (size_t)OD_IN * DM * 2;
constexpr size_t WS_WODOUT= WS_WLRU  + (size_t)2 * 10 * 512 * 256 * 2;
constexpr size_t WS_WGU   = WS_WODOUT+ (size_t)DM * LRUW * 2;
constexpr size_t WS_WDN   = WS_WGU   + (size_t)2 * NEXP * 4096 * DM;
constexpr size_t WS_H     = WS_WDN   + (size_t)2 * NEXP * DM * DM;
constexpr size_t WS_ACT   = WS_H     + (size_t)MROWS * DM * 4;
constexpr size_t WS_PRJ   = WS_ACT   + (size_t)MROWS * DM * 2;
constexpr size_t WS_U     = WS_PRJ   + (size_t)MROWS * PRJ_LD * 2;
constexpr size_t WS_YIN   = WS_U     + (size_t)MROWS * LRUW * 2;
constexpr size_t WS_AFF   = WS_YIN   + (size_t)MROWS * YLD * 2;
constexpr size_t WS_SLOT  = WS_AFF   + (size_t)MROWS * 16 * 4;
constexpr size_t WS_GVAL  = WS_SLOT  + (size_t)MROWS * 16 * 4;
constexpr size_t WS_OFFT  = WS_GVAL  + al256((size_t)NEXP * 2304 * 4);
constexpr size_t WS_AGG   = WS_OFFT  + al256((size_t)NEXP * 2304 * 4);
constexpr size_t WS_XS    = WS_AGG   + (size_t)2 * NB * 68 * LRUW * 8;
constexpr size_t WS_HID   = WS_XS    + (size_t)NEXP * 2304 * DM * 2;
constexpr size_t WS_EO    = WS_HID   + (size_t)NEXP * 2304 * DM * 2;
constexpr size_t WS_KC    = WS_EO    + (size_t)NEXP * 2304 * DM * 2;
constexpr size_t WS_VC    = WS_KC    + (size_t)NB * 2 * TPB * 128 * 2;
constexpr size_t WS_CARRY = WS_VC    + (size_t)NB * 2 * TPB * 128 * 2;
constexpr size_t WS_END   = WS_CARRY + (size_t)2 * NB * 68 * LRUW * 4;
constexpr size_t WS_SCNT  = WS_CTL + 16384;
constexpr size_t WS_LAGI  = WS_XS;
static_assert((size_t)2 * MROWS * LRUW * 4 <= WS_KC - WS_XS, "LAGI alias");

struct Params { const float* in[28]; float* out; unsigned char* ws; int ph_lo, ph_hi; };
enum { I_X = 0, I_C, I_CTX, I_CCTX, I_MODW, I_MODB, I_N1G, I_N2G, I_EVWIN, I_EVQN, I_EVKN, I_EVCW, I_EVCB, I_EVWOUT, I_ODWIN, I_ODCW, I_ODCB, I_ODWA, I_ODBA, I_ODWX, I_ODBX,
       I_ODLAM, I_ODWOUT, I_ROUTER, I_WGATE, I_WUP, I_WDOWN, I_FNG };

__device__ __forceinline__ unsigned cvt_pk_bf16(float lo, float hi) { unsigned r; asm volatile("v_cvt_pk_bf16_f32 %0, %1, %2" : "=v"(r) : "v"(lo), "v"(hi)); return r; }
__device__ __forceinline__ unsigned pk4_fp8(float a, float b, float c, float d) { int w = 0; w = __builtin_amdgcn_cvt_pk_fp8_f32(a, b, w, false); w = __builtin_amdgcn_cvt_pk_fp8_f32(c, d, w, true); return (unsigned)w; }
#define GAS __attribute__((address_space(1)))
__device__ __forceinline__ f32x4 ld_nt(const float* p) { return __builtin_nontemporal_load((const GAS f32x4*)(const GAS float*)p); }
__device__ __forceinline__ void st_nt(float* p, f32x4 v) { __builtin_nontemporal_store(v, (GAS f32x4*)(GAS float*)p); }
__device__ __forceinline__ void st_wt16(float* p, f32x4 v) { asm volatile("global_store_dwordx4 %0, %1, off sc1\n\ts_nop 1" :: "v"(p), "v"(v) : "memory"); }
__device__ __forceinline__ float bf_lo(unsigned w) { return __uint_as_float(w << 16); }
__device__ __forceinline__ float bf_hi(unsigned w) { return __uint_as_float(w & 0xffff0000u); }
__device__ __forceinline__ int lane_fresh() { int l; asm volatile("v_mbcnt_lo_u32_b32 %0, -1, 0\n\tv_mbcnt_hi_u32_b32 %0, -1, %0" : "=v"(l)); return l; }
__device__ __forceinline__ float wave_sum(float v) {
#pragma unroll
    for (int o = 32; o >= 1; o >>= 1) v += __shfl_xor(v, o);
    return v;
}
__device__ __forceinline__ float fast_sigmoid(float x) { return __builtin_amdgcn_rcpf(1.0f + __builtin_amdgcn_exp2f(-1.4426950408889634f * x)); }
__device__ __forceinline__ float gelu_tanh(float x) { const float t = 0.7978845608028654f * (x + 0.044715f * x * x * x); return x * fast_sigmoid(2.0f * t); }
__device__ __forceinline__ int xcd_remap(int L, int nwg) { const int q = nwg >> 3, r = nwg & 7, xcd = L & 7, off = L >> 3; return (xcd < r ? xcd * (q + 1) : r * (q + 1) + (xcd - r) * q) + off; }

namespace pg8 {
constexpr int BM = 256, BK = 64, HALF = 128, HTB = HALF * BK * 2, STAGE_BYTES = 8 * HTB;
__device__ __forceinline__ int lds_byte(int r, int c) { const int st = (r >> 4) * 2 + (c >> 5), rr = r & 15, cc = c & 31, ob = rr * 64 + cc * 2; return st * 1024 + (ob ^ (((ob >> 9) & 1) << 5)); }
__device__ __forceinline__ void stage_rc(int b, int& R, int& C) { const int st = b / 1024, sb = b % 1024, swz = sb ^ (((sb >> 9) & 1) << 5); R = (st >> 1) * 16 + swz / 64; C = (st & 1) * 32 + (swz % 64) / 2; }
__device__ __forceinline__ int perm32(int rho) { const int n = rho >> 4, i = rho & 15; return 8 * (i >> 2) + 4 * n + (i & 3); }
struct Unit { int pm, pn, e; };
__device__ __forceinline__ void glds16_s(const void* base_uniform, unsigned voff, unsigned lds_dst) {
    unsigned keep;
    asm volatile("s_mov_b32 %0, m0\n\ts_mov_b32 m0, %3\n\ts_nop 0\n\tglobal_load_lds_dwordx4 %1, %2\n\ts_mov_b32 m0, %0" : "=&s"(keep) : "v"(voff), "s"(base_uniform), "s"(lds_dst) : "memory");
}
struct Shape { int K, lda; };

template <bool FP8, bool GATHER, class Epi, class Sched>
__device__ __forceinline__ void gemm_phase(LAS unsigned char* lds, int wid_in, const Shape g, const Sched& S, const Epi& E) {
    const int lane = lane_fresh(), wid = wid_in, tid = wid * 64 + lane, wr = wid >> 2, wc = wid & 3, fr = lane & 15, fq = lane >> 4;
    const int K = g.K, nt = K / BK;
    unsigned voffA[2], voffB[2]; int gR[2]; unsigned gC[2];
#pragma unroll
    for (int i = 0; i < 2; ++i) { int R, C; stage_rc(tid * 16 + i * 8192, R, C); const int Rb = Epi::PERM ? ((R & ~31) + perm32(R & 31)) : R;
        voffA[i] = (unsigned)(R * g.lda + C) * 2u; voffB[i] = (unsigned)(Rb * K + C) * 2u; gR[i] = R; gC[i] = (unsigned)C * 2u; }
    unsigned coff[2][2], noff[2][2], nnoff[2][2];
#define PG8_LOADOFF(dst, un) do { const unsigned* tb_ = S.offtab() + S.slotbase(un); _Pragma("unroll") for (int h_ = 0; h_ < 2; ++h_) _Pragma("unroll") for (int i_ = 0; i_ < 2; ++i_) dst[h_][i_] = tb_[h_ * 128 + gR[i_]] + gC[i_]; } while (0)
#define PG8_STAGE_A(bufoff, kb, h, nx) do { if constexpr (GATHER) { _Pragma("unroll") for (int _i = 0; _i < 2; ++_i) glds16_s(S.gbase() + (kb), (nx) ? noff[h][_i] : coff[h][_i], ldsb + (unsigned)((bufoff) + _i * 8192)); } \
        else { PG8_STAGE(bufoff, ((nx) ? nA : cA) + (kb) + (h) * hstepA, voffA); } } while (0)
    const size_t kstep = (size_t)(BK * 2);
    const size_t hstepA = (size_t)HALF * g.lda * 2, hstepB = (size_t)HALF * K * 2;
    const unsigned ldsb = (unsigned)(uintptr_t)lds + (unsigned)wid * 1024u;
    const int aoff = lds_byte(wr * 64 + fr, fq * 8), boff = lds_byte(wc * 32 + fr, fq * 8);
#define PG8_SA(b, h) (((b) * 2 + (h)) * HTB)
#define PG8_SB(b, h) ((4 + (b) * 2 + (h)) * HTB)
#define PG8_STAGE(bufoff, gbase, voff) do { _Pragma("unroll") for (int _i = 0; _i < 2; ++_i) glds16_s((gbase), (voff)[_i], ldsb + (unsigned)((bufoff) + _i * 8192)); } while (0)
#define PG8_LD32(p) __builtin_shufflevector(*(const LAS i32x4a*)(p), *(const LAS i32x4a*)((p) + 1024), 0, 1, 2, 3, 4, 5, 6, 7)
#define PG8_LDA(dst, b, h) do { if constexpr (FP8) { _Pragma("unroll") for (int m = 0; m < 4; ++m) dst##8[m] = PG8_LD32(lds + PG8_SA(b, h) + aoff + m * 2048); } \
        else { _Pragma("unroll") for (int m = 0; m < 4; ++m) _Pragma("unroll") for (int k = 0; k < 2; ++k) dst[m][k] = *(const LAS bf16x8*)(lds + PG8_SA(b, h) + aoff + m * 2048 + k * 1024); } } while (0)
#define PG8_LDB(dst, b, h) do { if constexpr (FP8) { _Pragma("unroll") for (int n = 0; n < 2; ++n) dst##8[n] = PG8_LD32(lds + PG8_SB(b, h) + boff + n * 2048); } \
        else { _Pragma("unroll") for (int n = 0; n < 2; ++n) _Pragma("unroll") for (int k = 0; k < 2; ++k) dst[n][k] = *(const LAS bf16x8*)(lds + PG8_SB(b, h) + boff + n * 2048 + k * 1024); } } while (0)
#define PG8_MMA(ai, bj, At, Bt) do { __builtin_amdgcn_s_setprio(1); _Pragma("unroll") for (int m = 0; m < 4; ++m) _Pragma("unroll") for (int n = 0; n < 2; ++n) { \
        f32x16& av_ = accv[ai][bj][m >> 1]; constexpr int dummy_ = 0; (void)dummy_; const int g_ = ((m & 1) * 2 + n) * 4; f32x4 c_ = (f32x4){av_[g_], av_[g_ + 1], av_[g_ + 2], av_[g_ + 3]}; \
        if constexpr (FP8) c_ = __builtin_amdgcn_mfma_scale_f32_16x16x128_f8f6f4(Bt##8[n], At##8[m], c_, 0, 0, 0, 127, 0, 127); \
        else { _Pragma("unroll") for (int k = 0; k < 2; ++k) c_ = __builtin_amdgcn_mfma_f32_16x16x32_bf16(Bt[n][k], At[m][k], c_, 0, 0, 0); } \
        av_[g_] = c_[0]; av_[g_ + 1] = c_[1]; av_[g_ + 2] = c_[2]; av_[g_ + 3] = c_[3]; } __builtin_amdgcn_s_setprio(0); } while (0)
#define PG8_WAIT_V(n) asm volatile("s_waitcnt vmcnt(" #n ")" ::: "memory")
#define PG8_WAIT_L(n) asm volatile("s_waitcnt lgkmcnt(" #n ")" ::: "memory")
#define PG8_BAR __builtin_amdgcn_s_barrier()
#define PG8_SCHED __builtin_amdgcn_sched_barrier(0)
    Unit cur, nxt; int ui = 0;
    if (!S.next(0, cur)) return;
    f32x16 accv[2][2][2];
#pragma unroll
    for (int a = 0; a < 2; ++a)
#pragma unroll
        for (int b = 0; b < 2; ++b)
#pragma unroll
            for (int m = 0; m < 2; ++m)
#pragma unroll
                for (int j = 0; j < 16; ++j) accv[a][b][m][j] = 0.f;
    bf16x8 At[4][2], B0[2][2], B1[2][2]; i32x8 At8[4], B08[2], B18[2];
    const char* cA = S.abase(cur); const char* cB = S.bbase(cur); const char* nA = cA;
    if constexpr (GATHER) { PG8_LOADOFF(coff, cur); Unit n1; if (S.next(1, n1)) PG8_LOADOFF(noff, n1); else PG8_LOADOFF(noff, cur); }
    PG8_STAGE(PG8_SB(0, 0), cB, voffB); PG8_STAGE_A(PG8_SA(0, 0), 0, 0, false); PG8_STAGE(PG8_SB(0, 1), cB + hstepB, voffB); PG8_STAGE_A(PG8_SA(0, 1), 0, 1, false);
    if (wr == 1) PG8_BAR;
    PG8_WAIT_V(4); PG8_BAR;
    PG8_STAGE(PG8_SB(1, 0), cB + kstep, voffB); PG8_STAGE_A(PG8_SA(1, 0), kstep, 0, false); PG8_STAGE(PG8_SB(1, 1), cB + hstepB + kstep, voffB);
    PG8_WAIT_V(6); PG8_BAR;
    for (;;) {
        const bool has_next = S.next(ui + 1, nxt);
        nA = has_next ? S.abase(nxt) : cA; const char* nB = has_next ? S.bbase(nxt) : cB;
        bool has_nn = false;
        if constexpr (GATHER) { Unit nn; has_nn = S.next(ui + 2, nn);
            if (has_nn) { const unsigned* tb_ = S.offtab() + S.slotbase(nn); _Pragma("unroll") for (int h_ = 0; h_ < 2; ++h_) _Pragma("unroll") for (int i_ = 0; i_ < 2; ++i_) nnoff[h_][i_] = tb_[h_ * 128 + gR[i_]]; } }
        for (int t = 0; t < nt; t += 2) {
            const bool last = (t == nt - 2);
            const size_t k1 = (size_t)(t + 1) * kstep, k2 = last ? 0 : (size_t)(t + 2) * kstep, k3 = k2 + kstep;
            const char* b2 = last ? nB : cB + (size_t)(t + 2) * kstep; const char* b3 = b2 + kstep;
            PG8_LDB(B0, 0, 0); PG8_SCHED; PG8_LDA(At, 0, 0); PG8_STAGE_A(PG8_SA(1, 1), k1, 1, false);
            PG8_WAIT_L(8); PG8_BAR; PG8_WAIT_L(0); PG8_MMA(0, 0, At, B0); PG8_BAR; PG8_SCHED;
            PG8_LDB(B1, 0, 1); PG8_STAGE(PG8_SB(0, 0), b2, voffB);
            PG8_BAR; PG8_WAIT_L(0); PG8_MMA(0, 1, At, B1); PG8_BAR;
            PG8_LDA(At, 0, 1); PG8_STAGE_A(PG8_SA(0, 0), k2, 0, last);
            PG8_BAR; PG8_WAIT_L(0); PG8_MMA(1, 0, At, B0); PG8_BAR; PG8_SCHED;
            PG8_STAGE(PG8_SB(0, 1), b2 + hstepB, voffB);
            PG8_WAIT_V(6); PG8_BAR; PG8_MMA(1, 1, At, B1); PG8_BAR;
            PG8_LDB(B0, 1, 0); PG8_SCHED; PG8_LDA(At, 1, 0); PG8_STAGE_A(PG8_SA(0, 1), k2, 1, last);
            PG8_WAIT_L(8); PG8_BAR; PG8_WAIT_L(0); PG8_MMA(0, 0, At, B0); PG8_BAR; PG8_SCHED;
            PG8_LDB(B1, 1, 1); PG8_STAGE(PG8_SB(1, 0), b3, voffB);
            PG8_BAR; PG8_WAIT_L(0); PG8_MMA(0, 1, At, B1); PG8_BAR;
            PG8_LDA(At, 1, 1); PG8_STAGE_A(PG8_SA(1, 0), k3, 0, last);
            PG8_BAR; PG8_WAIT_L(0); PG8_MMA(1, 0, At, B0); PG8_BAR; PG8_SCHED;
            PG8_STAGE(PG8_SB(1, 1), b3 + hstepB, voffB);
            PG8_WAIT_V(6); PG8_BAR; PG8_MMA(1, 1, At, B1); PG8_BAR;
        }
        { f32x4 acc[2][2][4][2];
#pragma unroll
          for (int a = 0; a < 2; ++a)
#pragma unroll
            for (int b = 0; b < 2; ++b)
#pragma unroll
              for (int m = 0; m < 4; ++m)
#pragma unroll
                for (int n = 0; n < 2; ++n) { const int g_ = ((m & 1) * 2 + n) * 4; acc[a][b][m][n] = (f32x4){accv[a][b][m >> 1][g_], accv[a][b][m >> 1][g_ + 1], accv[a][b][m >> 1][g_ + 2], accv[a][b][m >> 1][g_ + 3]}; }
          const int le_ = lane_fresh(); E(acc, cur, wr, wc, le_ & 15, le_ >> 4); }
        if (!has_next) break;
#pragma unroll
        for (int a = 0; a < 2; ++a)
#pragma unroll
            for (int b = 0; b < 2; ++b)
#pragma unroll
                for (int m = 0; m < 2; ++m)
#pragma unroll
                    for (int j = 0; j < 16; ++j) accv[a][b][m][j] = 0.f;
        cur = nxt; cA = nA; cB = nB; ++ui;
        if constexpr (GATHER) {
#pragma unroll
            for (int h_ = 0; h_ < 2; ++h_)
#pragma unroll
                for (int i_ = 0; i_ < 2; ++i_) { coff[h_][i_] = noff[h_][i_]; if (has_nn) noff[h_][i_] = nnoff[h_][i_] + gC[i_]; } }
    }
    PG8_WAIT_V(0);
    if (wr == 0) PG8_BAR;
    PG8_BAR;
#undef PG8_SA
#undef PG8_SB
#undef PG8_STAGE
#undef PG8_STAGE_A
#undef PG8_LOADOFF
#undef PG8_LDA
#undef PG8_LD32
#undef PG8_LDB
#undef PG8_MMA
#undef PG8_WAIT_V
#undef PG8_WAIT_L
#undef PG8_BAR
#undef PG8_SCHED
}
}
using pg8::Unit;

struct SchedDense {
    __device__ __forceinline__ const unsigned* offtab() const { return nullptr; }
    __device__ __forceinline__ int slotbase(const Unit&) const { return 0; }
    __device__ __forceinline__ const char* gbase() const { return nullptr; }
    const char* A; const char* Bt; int nM, nN, G, c, lda, K, lat_only;
    __device__ __forceinline__ bool next(int i, Unit& u) const {
        const int nwg = nM * nN; const int L = i * G + c; if (L >= nwg) return false;
        const int w = xcd_remap(L, nwg);
        const int nig = 8 * nN, gid = w / nig, fm = gid * 8, gsz = (nM - fm) < 8 ? (nM - fm) : 8;
        const int lm = fm + ((w % nig) % gsz); u.pn = (w % nig) / gsz; u.pm = lat_only ? (lm + (lm >> 4) + 1) : lm; u.e = 0; return true;
    }
    __device__ __forceinline__ const char* abase(const Unit& u) const { return A + (size_t)u.pm * 256 * lda * 2; }
    __device__ __forceinline__ const char* bbase(const Unit& u) const { return Bt + (size_t)u.pn * 256 * K * 2; }
};
struct SchedOdIn {
    __device__ __forceinline__ const unsigned* offtab() const { return nullptr; }
    __device__ __forceinline__ int slotbase(const Unit&) const { return 0; }
    __device__ __forceinline__ const char* gbase() const { return nullptr; }
    const char* A; const char* Bt; int G, c;
    __device__ __forceinline__ bool next(int i, Unit& u) const {
        const int L = i * G + c; if (L >= 1320) return false;
        if (L < 1280) { const int w = xcd_remap(L, 1280); const int nig = 8 * 20, gid = w / nig, fm = gid * 8; const int lm = fm + ((w % nig) % 8); u.pn = (w % nig) / 8; u.pm = lm + (lm >> 4) + 1; }
        else { const int q = L - 1280; u.pm = 17 * (q & 3); u.pn = q >> 2; }
        u.e = 0; return true;
    }
    __device__ __forceinline__ const char* abase(const Unit& u) const { return A + (size_t)u.pm * 256 * DM * 2; }
    __device__ __forceinline__ const char* bbase(const Unit& u) const { return Bt + (size_t)u.pn * 256 * DM * 2; }
};
struct SchedLru {
    __device__ __forceinline__ const unsigned* offtab() const { return nullptr; }
    __device__ __forceinline__ int slotbase(const Unit&) const { return 0; }
    __device__ __forceinline__ const char* gbase() const { return nullptr; }
    const char* A; const char* Bt; int G, c;
    __device__ __forceinline__ bool next(int i, Unit& u) const {
        const int L = i * G + c; if (L >= NMT * 40) return false;
        const int w = xcd_remap(L, NMT * 40); const int q = w % 40; u.pm = w / 40; u.e = q >> 1; u.pn = q & 1; return true;
    }
    __device__ __forceinline__ const char* abase(const Unit& u) const { return A + ((size_t)u.pm * 256 * LRUW + (u.e % 10) * 256) * 2; }
    __device__ __forceinline__ const char* bbase(const Unit& u) const { return Bt + ((size_t)u.e * 512 + u.pn * 256) * 256 * 2; }
};
struct SchedMoe {
    const char* A; const char* Bt; int nMe, nN, estr, brows, G, c; const unsigned* otab;
    __device__ __forceinline__ const unsigned* offtab() const { return otab; }
    __device__ __forceinline__ int slotbase(const Unit& u) const { return u.e * estr + u.pm * 256; }
    __device__ __forceinline__ const char* gbase() const { return A; }
    __device__ __forceinline__ bool next(int i, Unit& u) const {
        const int per = nMe * nN, nwg = NEXP * per; const int L = i * G + c; if (L >= nwg) return false;
        const int w = xcd_remap(L, nwg); u.e = w / per; const int r = w % per; u.pm = r % nMe; u.pn = r / nMe; return true;
    }
    __device__ __forceinline__ const char* abase(const Unit& u) const { return A + ((size_t)u.e * estr + u.pm * 256) * DM; }
    __device__ __forceinline__ const char* bbase(const Unit& u) const { return Bt + ((size_t)u.e * brows + u.pn * 256) * DM; }
};

struct EpiPlainBf16 {
    static constexpr bool PERM = true;
    bf16_t* O; int ldc; int gelu_from;
    __device__ __forceinline__ void operator()(const f32x4 (&acc)[2][2][4][2], const Unit& u, int wr, int wc, int fr, int fq) const {
        const int row0 = u.pm * 256 + wr * 64 + fr, col0 = u.pn * 256 + wc * 32 + 8 * fq; const bool gl = u.pn >= gelu_from;
#pragma unroll
        for (int ai = 0; ai < 2; ++ai)
#pragma unroll
            for (int m = 0; m < 4; ++m) { bf16_t* rowp = O + (size_t)(row0 + ai * 128 + m * 16) * ldc + col0;
#pragma unroll
                for (int bj = 0; bj < 2; ++bj) { f32x4 v0 = acc[ai][bj][m][0], v1 = acc[ai][bj][m][1];
                    if (gl) {
#pragma unroll
                        for (int jp = 0; jp < 2; ++jp) { f32x2 x0 = {v0[2 * jp], v0[2 * jp + 1]}, x1 = {v1[2 * jp], v1[2 * jp + 1]};
                            const f32x2 p0 = (x0 * x0) * (-0.10294324f) + (-2.3022082f), p1 = (x1 * x1) * (-0.10294324f) + (-2.3022082f); const f32x2 t0 = x0 * p0, t1 = x1 * p1;
                            f32x2 d0, d1; d0.x = __builtin_amdgcn_exp2f(t0.x); d0.y = __builtin_amdgcn_exp2f(t0.y); d1.x = __builtin_amdgcn_exp2f(t1.x); d1.y = __builtin_amdgcn_exp2f(t1.y); d0 = d0 + 1.0f; d1 = d1 + 1.0f;
                            f32x2 r0, r1; r0.x = __builtin_amdgcn_rcpf(d0.x); r0.y = __builtin_amdgcn_rcpf(d0.y); r1.x = __builtin_amdgcn_rcpf(d1.x); r1.y = __builtin_amdgcn_rcpf(d1.y);
                            x0 = x0 * r0; x1 = x1 * r1; v0[2 * jp] = x0.x; v0[2 * jp + 1] = x0.y; v1[2 * jp] = x1.x; v1[2 * jp + 1] = x1.y; } }
                    u32x4 w; w.x = cvt_pk_bf16(v0[0], v0[1]); w.y = cvt_pk_bf16(v0[2], v0[3]); w.z = cvt_pk_bf16(v1[0], v1[1]); w.w = cvt_pk_bf16(v1[2], v1[3]);
                    *(u32x4*)(rowp + bj * 128) = w; } }
    }
};
struct EpiEvIn {
    static constexpr bool PERM = true;
    bf16_t* O; int ldc;
    __device__ __forceinline__ void operator()(const f32x4 (&acc)[2][2][4][2], const Unit& u, int wr, int wc, int fr, int fq) const {
        const int row0 = u.pm * 256 + wr * 64 + fr;
        if (u.pn < 10) { const int col0 = u.pn * 256 + wc * 32 + 8 * fq;
#pragma unroll
            for (int ai = 0; ai < 2; ++ai)
#pragma unroll
                for (int m = 0; m < 4; ++m) { bf16_t* rowp = O + (size_t)(row0 + ai * 128 + m * 16) * ldc + col0;
#pragma unroll
                    for (int bj = 0; bj < 2; ++bj) { const f32x4 v0 = acc[ai][bj][m][0], v1 = acc[ai][bj][m][1];
                        u32x4 w; w.x = cvt_pk_bf16(v0[0], v0[1]); w.y = cvt_pk_bf16(v0[2], v0[3]); w.z = cvt_pk_bf16(v1[0], v1[1]); w.w = cvt_pk_bf16(v1[2], v1[3]);
                        *(u32x4*)(rowp + bj * 128) = w; } }
        } else { const int col0 = 2560 + (u.pn - 10) * 128 + wc * 32 + 8 * fq;
#pragma unroll
            for (int ai = 0; ai < 2; ++ai)
#pragma unroll
                for (int m = 0; m < 4; ++m) { const f32x4 v0 = acc[ai][0][m][0] * acc[ai][1][m][0], v1 = acc[ai][0][m][1] * acc[ai][1][m][1];
                    u32x4 w; w.x = cvt_pk_bf16(v0[0], v0[1]); w.y = cvt_pk_bf16(v0[2], v0[3]); w.z = cvt_pk_bf16(v1[0], v1[1]); w.w = cvt_pk_bf16(v1[2], v1[3]);
                    *(u32x4*)(O + (size_t)(row0 + ai * 128 + m * 16) * ldc + col0) = w; }
        }
    }
};
struct EpiResid {
    static constexpr bool PERM = true;
    const float* x; const float* ctx; bf16_t* h; const float* mod; int layer0;
    __device__ __forceinline__ void operator()(const f32x4 (&acc)[2][2][4][2], const Unit& u, int wr, int wc, int fr, int fq) const {
        const int b = u.pm / 17, pt = u.pm - b * 17;
        const float* hold = pt == 0 ? ctx + (size_t)b * CTXL * DM : x + ((size_t)b * SEQ + (pt - 1) * 256) * DM;
        bf16_t* ho = h + (size_t)u.pm * 256 * DM;
        const float* gate = mod + (size_t)(pt == 0 ? 4 : b) * MODN + 4096;
        const int r0 = wr * 64 + fr, col0 = u.pn * 256 + wc * 32 + 8 * fq;
        f32x4 gv[2][2];
#pragma unroll
        for (int bj = 0; bj < 2; ++bj)
#pragma unroll
            for (int n = 0; n < 2; ++n) gv[bj][n] = *(const f32x4*)(gate + col0 + bj * 128 + n * 4);
#pragma unroll
        for (int ai = 0; ai < 2; ++ai) {
            if (layer0) { f32x4 hv[4][2][2];
#pragma unroll
                for (int m = 0; m < 4; ++m) { const size_t off = (size_t)(r0 + ai * 128 + m * 16) * DM + col0;
#pragma unroll
                    for (int bj = 0; bj < 2; ++bj)
#pragma unroll
                        for (int n = 0; n < 2; ++n) hv[m][bj][n] = *(const f32x4*)(hold + off + bj * 128 + n * 4); }
#pragma unroll
                for (int m = 0; m < 4; ++m) { const size_t off = (size_t)(r0 + ai * 128 + m * 16) * DM + col0;
#pragma unroll
                    for (int bj = 0; bj < 2; ++bj) { const f32x4 v0 = hv[m][bj][0] + gv[bj][0] * acc[ai][bj][m][0], v1 = hv[m][bj][1] + gv[bj][1] * acc[ai][bj][m][1];
                        u32x4 w; w.x = cvt_pk_bf16(v0[0], v0[1]); w.y = cvt_pk_bf16(v0[2], v0[3]); w.z = cvt_pk_bf16(v1[0], v1[1]); w.w = cvt_pk_bf16(v1[2], v1[3]); *(u32x4*)(ho + off + bj * 128) = w; } }
            } else { u32x4 hw[4][2];
#pragma unroll
                for (int m = 0; m < 4; ++m) { const size_t off = (size_t)(r0 + ai * 128 + m * 16) * DM + col0;
#pragma unroll
                    for (int bj = 0; bj < 2; ++bj) hw[m][bj] = *(const u32x4*)(ho + off + bj * 128); }
#pragma unroll
                for (int m = 0; m < 4; ++m) { const size_t off = (size_t)(r0 + ai * 128 + m * 16) * DM + col0;
#pragma unroll
                    for (int bj = 0; bj < 2; ++bj) { const u32x4 q = hw[m][bj];
                        const f32x4 v0 = (f32x4){bf_lo(q.x), bf_hi(q.x), bf_lo(q.y), bf_hi(q.y)} + gv[bj][0] * acc[ai][bj][m][0], v1 = (f32x4){bf_lo(q.z), bf_hi(q.z), bf_lo(q.w), bf_hi(q.w)} + gv[bj][1] * acc[ai][bj][m][1];
                        u32x4 w; w.x = cvt_pk_bf16(v0[0], v0[1]); w.y = cvt_pk_bf16(v0[2], v0[3]); w.z = cvt_pk_bf16(v1[0], v1[1]); w.w = cvt_pk_bf16(v1[2], v1[3]); *(u32x4*)(ho + off + bj * 128) = w; } } }
        }
    }
};
struct EpiSwiglu {
    static constexpr bool PERM = true;
    unsigned char* O; int estr;
    __device__ __forceinline__ void operator()(const f32x4 (&acc)[2][2][4][2], const Unit& u, int wr, int wc, int fr, int fq) const {
        const unsigned row0 = (unsigned)(u.e * estr + u.pm * 256 + wr * 64 + fr); const unsigned col0 = (unsigned)(u.pn * 128 + wc * 32 + 8 * fq);
#pragma unroll
        for (int ai = 0; ai < 2; ++ai)
#pragma unroll
            for (int m = 0; m < 4; ++m) { float o[8];
#pragma unroll
                for (int n = 0; n < 2; ++n)
#pragma unroll
                    for (int jp = 0; jp < 2; ++jp) { const f32x2 a2 = {acc[ai][0][m][n][2 * jp], acc[ai][0][m][n][2 * jp + 1]}, b2 = {acc[ai][1][m][n][2 * jp], acc[ai][1][m][n][2 * jp + 1]};
                        const f32x2 t2 = a2 * (-1.4426950408889634f * W8_INV); f32x2 d2; d2.x = __builtin_amdgcn_exp2f(t2.x); d2.y = __builtin_amdgcn_exp2f(t2.y); d2 = d2 + 1.0f;
                        f32x2 r2; r2.x = __builtin_amdgcn_rcpf(d2.x); r2.y = __builtin_amdgcn_rcpf(d2.y);
                        const f32x2 o2 = ((a2 * b2) * (W8_INV * W8_INV)) * r2; o[n * 4 + 2 * jp] = o2.x; o[n * 4 + 2 * jp + 1] = o2.y; }
                u32x2 w; w.x = pk4_fp8(o[0], o[1], o[2], o[3]); w.y = pk4_fp8(o[4], o[5], o[6], o[7]);
                *(u32x2*)(O + (unsigned)((row0 + ai * 128 + m * 16) * DM + col0)) = w; __builtin_amdgcn_sched_barrier(0); }
    }
};
struct EpiDown {
    static constexpr bool PERM = true;
    unsigned char* O; const float* gval; int estr;
    __device__ __forceinline__ void operator()(const f32x4 (&acc)[2][2][4][2], const Unit& u, int wr, int wc, int fr, int fq) const {
        const unsigned row0 = (unsigned)(u.e * estr + u.pm * 256 + wr * 64 + fr); const unsigned col0 = (unsigned)(u.pn * 256 + wc * 32 + 8 * fq);
#pragma unroll
        for (int ai = 0; ai < 2; ++ai) { float gvv[4];
#pragma unroll
            for (int m = 0; m < 4; ++m) gvv[m] = gval[row0 + ai * 128 + m * 16] * W8_INV;
            __builtin_amdgcn_sched_barrier(0);
#pragma unroll
            for (int m = 0; m < 4; ++m) { const unsigned slot = row0 + ai * 128 + m * 16; const float gv = gvv[m];
#pragma unroll
                for (int bj = 0; bj < 2; ++bj) { const f32x4 v0 = acc[ai][bj][m][0] * gv, v1 = acc[ai][bj][m][1] * gv;
                    u32x2 w; w.x = pk4_fp8(v0[0], v0[1], v0[2], v0[3]); w.y = pk4_fp8(v1[0], v1[1], v1[2], v1[3]);
                    *(u32x2*)(O + (slot * DM + col0 + bj * 128)) = w; }
                __builtin_amdgcn_sched_barrier(0); } }
    }
};
struct EpiLru {
    static constexpr bool PERM = true;
    const bf16_t* U; unsigned* lagi; const float* ba; const float* bx; const float* lam;
    __device__ __forceinline__ void operator()(const f32x4 (&acc)[2][2][4][2], const Unit& u, int wr, int wc, int fr, int fq) const {
        const int d = u.e / 10, hb = u.e - d * 10; const int ch0 = hb * 256 + u.pn * 128 + wc * 32 + 8 * fq; const int row0 = u.pm * 256 + wr * 64 + fr;
        unsigned short* outp = (unsigned short*)lagi + (size_t)d * MROWS * LRUW;
        constexpr float NL2E = -1.4426950408889634f;
#pragma unroll
        for (int n = 0; n < 2; ++n) { const int chn = ch0 + 4 * n; f32x2 vba[2], vbx[2], sp[2], csp[2];
#pragma unroll
            for (int j = 0; j < 4; ++j) { const float lm = lam[d * LRUW + chn + j]; const float spl = fmaxf(-lm, 0.f) + __logf(1.0f + __expf(-fabsf(lm)));
                vba[j >> 1][j & 1] = NL2E * ba[d * LRUW + chn + j]; vbx[j >> 1][j & 1] = NL2E * bx[d * LRUW + chn + j]; sp[j >> 1][j & 1] = -8.0f * spl; csp[j >> 1][j & 1] = 4.0f * __builtin_amdgcn_sqrtf(spl); }
            u32x2 uws[2][4];
#pragma unroll
            for (int ai = 0; ai < 2; ++ai)
#pragma unroll
                for (int m = 0; m < 4; ++m) uws[ai][m] = *(const u32x2*)(U + (size_t)(row0 + ai * 128 + m * 16) * LRUW + chn);
#pragma unroll
            for (int ai = 0; ai < 2; ++ai)
#pragma unroll
                for (int m = 0; m < 4; ++m) { const size_t row = (size_t)(row0 + ai * 128 + m * 16); const u32x2 uw = uws[ai][m]; unsigned o[2];
#pragma unroll
                    for (int h = 0; h < 2; ++h) { const unsigned uwh = h ? uw.y : uw.x; const f32x2 uv = {bf_lo(uwh), bf_hi(uwh)};
                        f32x2 ta = (f32x2){acc[ai][0][m][n][2 * h], acc[ai][0][m][n][2 * h + 1]} * NL2E + vba[h], tx = (f32x2){acc[ai][1][m][n][2 * h], acc[ai][1][m][n][2 * h + 1]} * NL2E + vbx[h];
                        f32x2 ea, ex; ea.x = __builtin_amdgcn_exp2f(ta.x); ea.y = __builtin_amdgcn_exp2f(ta.y); ex.x = __builtin_amdgcn_exp2f(fminf(tx.x, 40.f)); ex.y = __builtin_amdgcn_exp2f(fminf(tx.y, 40.f));
                        ea = ea + 1.0f; ex = ex + 1.0f;
                        const f32x2 dd = (ea * ex) * ex; f32x2 g; g.x = __builtin_amdgcn_rsqf(dd.x); g.y = __builtin_amdgcn_rsqf(dd.y);
                        const f32x2 q = g * ex, r = q * q, la = r * sp[h], y = la + la;
                        f32x2 t = y * 0.041666668f + 0.16666667f; t = t * y + 0.5f; t = t * y;
                        f32x2 s1 = t * (-0.125f) + 0.5f; s1 = s1 * t + 1.0f;
                        const f32x2 bt = ((csp[h] * uv) * g) * s1;
                        (void)la; const f32x2 cq = q * 255.0f + 0.5f;
                        unsigned wd = (unsigned)__builtin_amdgcn_cvt_pk_fp8_f32(bt.x, bt.y, 0, true);
                        wd = __builtin_amdgcn_cvt_pk_u8_f32(cq.x, 0, wd); wd = __builtin_amdgcn_cvt_pk_u8_f32(cq.y, 1, wd);
                        o[h] = wd; }
                    *(u32x2*)(outp + row * LRUW + chn) = (u32x2){o[0], o[1]}; } }
    }
};

namespace att {
constexpr int D = 128, NW = 8, QBLK = 32, KVBLK = 64;
constexpr float SCALE = 0.088388347648318440f;
constexpr float THR = 8.f;
constexpr int LDQ = PRJ_LD, LDK = 128, LDO = YLD;
constexpr size_t SHM_V = KVBLK * D * 2, SHM_K = KVBLK * D * 2, SHM_ATTN = 2 * SHM_V + 2 * SHM_K + NW * 64 * 4;
#define KSWZ(row, colB) ((row) * 256 + ((colB) ^ (((row) & 7) << 4)))
#define SBAR() __builtin_amdgcn_sched_barrier(0)
__device__ __forceinline__ int crow(int r, int hi) { return (r & 3) + 8 * (r >> 2) + 4 * hi; }
__device__ __forceinline__ void partialSM(f32x16& p0, f32x16& p1, float& m_reg, float& mn, float& alpha) {
  constexpr float C = SCALE * 1.4426950408889634f;
  float pmax = p0[0]; for (int r = 1; r < 16; ++r) pmax = fmaxf(pmax, p0[r]); for (int r = 0; r < 16; ++r) pmax = fmaxf(pmax, p1[r]);
  { auto rr = __builtin_amdgcn_permlane32_swap(__float_as_uint(pmax), __float_as_uint(pmax), false, false);
    pmax = fmaxf(__uint_as_float(rr[0]), __uint_as_float(rr[1])); }
  if (__builtin_expect(__all(pmax - m_reg <= THR / SCALE), 1)) { mn = m_reg; alpha = 1.f; }
  else { mn = fmaxf(m_reg, pmax); alpha = __builtin_amdgcn_exp2f((m_reg - mn) * C); m_reg = mn; }
  float mnC = -mn * C;
  for (int r = 0; r < 16; ++r) p0[r] = fmaf(p0[r], C, mnC); for (int r = 0; r < 16; ++r) p1[r] = fmaf(p1[r], C, mnC);
  for (int r = 0; r < 16; ++r) p0[r] = __builtin_amdgcn_exp2f(p0[r]);
}
__device__ __forceinline__ void finishSM(f32x16& p0, f32x16& p1, float alpha, float& l_reg, bf16x8& pa0, bf16x8& pa1, bf16x8& pa2, bf16x8& pa3) {
  for (int r = 0; r < 16; ++r) p1[r] = __builtin_amdgcn_exp2f(p1[r]);
  float ps = 0; for (int r = 0; r < 16; ++r) ps += p0[r]; for (int r = 0; r < 16; ++r) ps += p1[r];
  { auto rr = __builtin_amdgcn_permlane32_swap(__float_as_uint(ps), __float_as_uint(ps), false, false);
    ps = __uint_as_float(rr[0]) + __uint_as_float(rr[1]); }
  l_reg = l_reg * alpha + ps;
#define PK4(P, BASE, OUT) do { unsigned a0 = cvt_pk_bf16(P[BASE + 0], P[BASE + 1]), a1 = cvt_pk_bf16(P[BASE + 2], P[BASE + 3]);   \
    unsigned b0 = cvt_pk_bf16(P[BASE + 4], P[BASE + 5]), b1 = cvt_pk_bf16(P[BASE + 6], P[BASE + 7]);                              \
    auto r0 = __builtin_amdgcn_permlane32_swap(a0, b0, false, false); auto r1 = __builtin_amdgcn_permlane32_swap(a1, b1, false, false); \
    u32x4 w = {r0[0], r1[0], r0[1], r1[1]}; OUT = *reinterpret_cast<bf16x8*>(&w); } while (0)
  PK4(p0, 0, pa0); PK4(p0, 8, pa1); PK4(p1, 0, pa2); PK4(p1, 8, pa3);
#undef PK4
}
__device__ __forceinline__ void qkt(f32x16& p0, f32x16& p1, const bf16_t* Ks, const bf16x8* qr, int r32, int hi) {
  p0 = f32x16{}; p1 = f32x16{};
  for (int d0 = 0; d0 < 8; ++d0) { int cb = (d0 * 16 + hi * 8) * 2;
    bf16x8 b0 = *reinterpret_cast<const bf16x8*>((const char*)Ks + KSWZ(r32, cb));
    bf16x8 b1 = *reinterpret_cast<const bf16x8*>((const char*)Ks + KSWZ(32 + r32, cb));
    p0 = __builtin_amdgcn_mfma_f32_32x32x16_bf16(b0, qr[d0], p0, 0, 0, 0);
    p1 = __builtin_amdgcn_mfma_f32_32x32x16_bf16(b1, qr[d0], p1, 0, 0, 0); }
}
__device__ __forceinline__ int v_st(int k, int c) { const int kk = (k & ~0xC) | ((k & 4) << 1) | ((k & 8) >> 1); return ((kk >> 3) * 4 + (c >> 5)) * 512 + ((kk & 7) * 32 + (c & 31)) * 2; }
__device__ __forceinline__ int v_rd_base(int lane) { return ((lane & 3) << 3) | (((lane >> 2) & 3) << 6) | (((lane >> 4) & 1) << 5) | (((lane >> 5) & 1) << 8); }
constexpr int v_rd_off(int d0, int ks, int half) { return d0 * 512 + ks * 4096 + half * 2048; }
template <int OFF> __device__ __forceinline__ s16x4 tr_read(int vb) {
  s16x4 r; asm volatile("ds_read_b64_tr_b16 %0, %1 offset:%2" : "=&v"(r) : "v"(vb), "i"(OFF) : "memory"); return r;
}
template <int D0> __device__ __forceinline__ void pv_one(f32x16& od, int vb, bf16x8 pa0, bf16x8 pa1, bf16x8 pa2, bf16x8 pa3) {
  const s16x4 l0 = tr_read<v_rd_off(D0, 0, 0)>(vb), h0 = tr_read<v_rd_off(D0, 0, 1)>(vb), l1 = tr_read<v_rd_off(D0, 1, 0)>(vb), h1 = tr_read<v_rd_off(D0, 1, 1)>(vb);
  const s16x4 l2 = tr_read<v_rd_off(D0, 2, 0)>(vb), h2 = tr_read<v_rd_off(D0, 2, 1)>(vb), l3 = tr_read<v_rd_off(D0, 3, 0)>(vb), h3 = tr_read<v_rd_off(D0, 3, 1)>(vb);
  asm volatile("s_waitcnt lgkmcnt(0)" ::: "memory"); SBAR();
#define PK(L, H) (bf16x8){L[0], L[1], L[2], L[3], H[0], H[1], H[2], H[3]}
  od = __builtin_amdgcn_mfma_f32_32x32x16_bf16(pa0, PK(l0, h0), od, 0, 0, 0);
  od = __builtin_amdgcn_mfma_f32_32x32x16_bf16(pa1, PK(l1, h1), od, 0, 0, 0);
  od = __builtin_amdgcn_mfma_f32_32x32x16_bf16(pa2, PK(l2, h2), od, 0, 0, 0);
  od = __builtin_amdgcn_mfma_f32_32x32x16_bf16(pa3, PK(l3, h3), od, 0, 0, 0);
#undef PK
}
__device__ __forceinline__ void pv_d0(f32x16* o, int vb, bf16x8 pa0, bf16x8 pa1, bf16x8 pa2, bf16x8 pa3) {
  pv_one<0>(o[0], vb, pa0, pa1, pa2, pa3); pv_one<1>(o[1], vb, pa0, pa1, pa2, pa3); pv_one<2>(o[2], vb, pa0, pa1, pa2, pa3); pv_one<3>(o[3], vb, pa0, pa1, pa2, pa3);
}
__device__ __forceinline__ void attn_dense_body(const bf16_t* __restrict__ Qb, const bf16_t* __restrict__ Kh, const bf16_t* __restrict__ Vh, bf16_t* __restrict__ Ob, int seq, char* lds, int wid_in) {
  const int lane = lane_fresh();
  const int wid = wid_in, tid = wid * 64 + lane, r32 = lane & 31, hi = lane >> 5;
  bf16_t* V_lds = (bf16_t*)lds; bf16_t* K_lds = (bf16_t*)(lds + 2 * SHM_V);
  float* ws = (float*)(lds + 2 * SHM_V + 2 * SHM_K) + wid * 64; float* li_l = ws; float* al_l = ws + 32;
  float m_reg = -1e30f, l_reg = 0; f32x16 o[4] = {}; bf16x8 qr[8];
  const bf16_t* Qw = Qb + (long)(wid * QBLK + r32) * LDQ + hi * 8;
#pragma unroll
  for (int d0 = 0; d0 < 8; ++d0) qr[d0] = *reinterpret_cast<const bf16x8*>(Qw + d0 * 16);
  const int sr = tid >> 4, sc = (tid & 15) * 8, vst0 = v_st(sr, sc), vst1 = v_st(32 + sr, sc);
  const int vb0 = (int)(uintptr_t)V_lds + v_rd_base(lane);
  const unsigned toff = (unsigned)(sr * LDK + sc) * 2u;
  struct { bf16x8 vs0, vs1, ks0, ks1; } sr_[2];
#define SLOAD(i, k0) do { const char* vp_ = (const char*)(Vh + (long)(k0) * LDK); const char* kp_ = (const char*)(Kh + (long)(k0) * LDK); \
    sr_[i].vs0 = *reinterpret_cast<const bf16x8*>(vp_ + toff); sr_[i].vs1 = *reinterpret_cast<const bf16x8*>(vp_ + 32 * LDK * 2 + toff); \
    sr_[i].ks0 = *reinterpret_cast<const bf16x8*>(kp_ + toff); sr_[i].ks1 = *reinterpret_cast<const bf16x8*>(kp_ + 32 * LDK * 2 + toff); } while (0)
#define SWRITE(b, i) do { *(bf16x8*)((char*)V_lds + (b) * SHM_V + vst0) = sr_[i].vs0;          \
    *(bf16x8*)((char*)V_lds + (b) * SHM_V + vst1) = sr_[i].vs1; int kc = sc * 2;               \
    *(bf16x8*)((char*)K_lds + (b) * SHM_K + KSWZ(sr, kc)) = sr_[i].ks0;                       \
    *(bf16x8*)((char*)K_lds + (b) * SHM_K + KSWZ(32 + sr, kc)) = sr_[i].ks1; } while (0)
#define SWAIT() asm volatile("s_waitcnt vmcnt(4)" ::: "memory")
#define RESC(a) do { if (__any((a) < 1.f)) { if (hi == 0) al_l[r32] = (a); asm volatile("s_waitcnt lgkmcnt(0)" ::: "memory"); \
    for (int d = 0; d < 4; ++d) for (int r = 0; r < 16; ++r) o[d][r] *= al_l[crow(r, hi)]; } } while (0)
  f32x16 pA0, pA1, pB0, pB1; float mnA, mnB, alA, alB; bf16x8 pa0, pa1, pa2, pa3; const int NT = seq / KVBLK;
  constexpr int SE = 0, SO = 1;
  SLOAD(SE, 0); asm volatile("s_waitcnt vmcnt(0)" ::: "memory"); SWRITE(0, SE); __syncthreads();
  qkt(pA0, pA1, K_lds, qr, r32, hi); partialSM(pA0, pA1, m_reg, mnA, alA);
  SLOAD(SO, KVBLK); if (2 < NT) SLOAD(SE, 2 * KVBLK);
  SWAIT(); SWRITE(1, SO); __syncthreads();
  for (int j = 1; j + 1 < NT; j += 2) {
    SBAR(); qkt(pB0, pB1, (bf16_t*)((char*)K_lds + SHM_K), qr, r32, hi);
    finishSM(pA0, pA1, alA, l_reg, pa0, pa1, pa2, pa3); SBAR();
    SLOAD(SO, (j + 2) * KVBLK); SBAR();
    pv_d0(o, vb0, pa0, pa1, pa2, pa3); partialSM(pB0, pB1, m_reg, mnB, alB);
    __syncthreads(); SWAIT(); SWRITE(0, SE);
    RESC(alB); __syncthreads();
    SBAR(); qkt(pA0, pA1, K_lds, qr, r32, hi);
    finishSM(pB0, pB1, alB, l_reg, pa0, pa1, pa2, pa3); SBAR();
    if (j + 3 < NT) SLOAD(SE, (j + 3) * KVBLK); SBAR();
    pv_d0(o, vb0 + (int)SHM_V, pa0, pa1, pa2, pa3); partialSM(pA0, pA1, m_reg, mnA, alA);
    __syncthreads(); SWAIT(); SWRITE(1, SO);
    RESC(alA); __syncthreads();
  }
  SBAR(); qkt(pB0, pB1, (bf16_t*)((char*)K_lds + SHM_K), qr, r32, hi);
  finishSM(pA0, pA1, alA, l_reg, pa0, pa1, pa2, pa3); SBAR();
  pv_d0(o, vb0, pa0, pa1, pa2, pa3); partialSM(pB0, pB1, m_reg, mnB, alB);
  __syncthreads(); RESC(alB);
  finishSM(pB0, pB1, alB, l_reg, pa0, pa1, pa2, pa3); SBAR();
  pv_d0(o, vb0 + (int)SHM_V, pa0, pa1, pa2, pa3);
  if (hi == 0) li_l[r32] = l_reg; asm volatile("s_waitcnt lgkmcnt(0)" ::: "memory");
  float rli[16];
#pragma unroll
  for (int r = 0; r < 16; ++r) rli[r] = __builtin_amdgcn_rcpf(li_l[crow(r, hi)]);
  bf16_t* Ow = Ob + (long)(wid * QBLK) * LDO;
#pragma unroll
  for (int r = 0; r < 16; ++r) { int orow = crow(r, hi);
    for (int d0 = 0; d0 < 4; ++d0) Ow[(long)orow * LDO + d0 * 32 + r32] = (bf16_t)(cvt_pk_bf16(o[d0][r] * rli[r], 0.f) & 0xffffu); }
  __syncthreads();
#undef SLOAD
#undef SWRITE
#undef SWAIT
#undef RESC
}
}

struct Ctx {
    Params P; unsigned char* ws; int wid, G, c;
    LAS unsigned char* lds; char* ldsg;
};

constexpr int N_MOD_UNITS = 192;
constexpr int CV_A = 576, CV_B = CV_A + 256, CV_C = CV_B + 640, CV_D = CV_C + 320, CV_E = CV_D + 160, CV_F = CV_E + 424 + 2 * 3 * 16 * 128 - 11424  ;
__device__ __noinline__ void cvt_tile(const float* __restrict__ src, int ld, bf16_t* __restrict__ dst, int ldd, int tid) {
    const int c4 = ((tid >> 6) & 3) * 8 + (tid & 7), kq = (tid >> 8) * 8 + ((tid >> 3) & 7);
    const float* s = src + (size_t)(kq * 8) * ld + c4 * 4;
    f32x4 v[8];
#pragma unroll
    for (int i = 0; i < 8; ++i) v[i] = ld_nt(s + (size_t)i * ld);
#pragma unroll
    for (int j = 0; j < 4; ++j) { u32x4 w; w.x = cvt_pk_bf16(v[0][j], v[1][j]); w.y = cvt_pk_bf16(v[2][j], v[3][j]); w.z = cvt_pk_bf16(v[4][j], v[5][j]); w.w = cvt_pk_bf16(v[6][j], v[7][j]);
        __builtin_nontemporal_store(w, (GAS u32x4*)(GAS bf16_t*)(dst + (size_t)(c4 * 4 + j) * ldd + kq * 8)); }
}
__device__ __noinline__ void cvt_tile8(const float* __restrict__ src, int ld, unsigned char* __restrict__ dst, int ldd, int split, int tid) {
    const int c4 = (tid >> 6) * 8 + (tid & 7), kq = (tid >> 3) & 7;
    const float* s = src + (size_t)(kq * 16) * ld + c4 * 4;
    f32x4 v[16];
#pragma unroll
    for (int i = 0; i < 16; ++i) v[i] = ld_nt(s + (size_t)i * ld);
    const int rbase = split ? ((c4 >> 5) * 256 + (c4 & 31) * 4) : c4 * 4;
#pragma unroll
    for (int j = 0; j < 4; ++j) { u32x4 w;
        w.x = pk4_fp8(v[0][j] * W8_SCALE, v[1][j] * W8_SCALE, v[2][j] * W8_SCALE, v[3][j] * W8_SCALE); w.y = pk4_fp8(v[4][j] * W8_SCALE, v[5][j] * W8_SCALE, v[6][j] * W8_SCALE, v[7][j] * W8_SCALE);
        w.z = pk4_fp8(v[8][j] * W8_SCALE, v[9][j] * W8_SCALE, v[10][j] * W8_SCALE, v[11][j] * W8_SCALE); w.w = pk4_fp8(v[12][j] * W8_SCALE, v[13][j] * W8_SCALE, v[14][j] * W8_SCALE, v[15][j] * W8_SCALE);
        __builtin_nontemporal_store(w, (GAS u32x4*)(GAS unsigned char*)(dst + (size_t)(rbase + j) * ldd + kq * 16)); }
}
constexpr int MOE_TILES = 3 * 16 * 128;
__device__ __forceinline__ void moe_cvt_tile(const Ctx& F, int layer, int q, int tid) {
    const Params& P = F.P; const int m = q / 2048, r = q % 2048, le = layer * 16 + (r >> 7), kt = (r >> 3) & 15, nt = r & 7;
    const size_t so = (size_t)le * DM * DM + (size_t)kt * 128 * DM + nt * 256;
    if (m == 0)      cvt_tile8(P.in[I_WGATE] + so, DM, F.ws + WS_WGU + ((size_t)le * 4096 + nt * 512) * DM + kt * 128, DM, 1, tid);
    else if (m == 1) cvt_tile8(P.in[I_WUP]   + so, DM, F.ws + WS_WGU + ((size_t)le * 4096 + nt * 512 + 128) * DM + kt * 128, DM, 1, tid);
    else             cvt_tile8(P.in[I_WDOWN] + so, DM, F.ws + WS_WDN + ((size_t)le * DM + nt * 256) * DM + kt * 128, DM, 0, tid);
}
struct CvtJob { const float* src; unsigned char* dst; int split; };
__device__ __forceinline__ CvtJob moe_job(const Ctx& F, int g) {
    const Params& P = F.P; const int layer = g / MOE_TILES, q = g - layer * MOE_TILES, m = q >> 11, r = q & 2047, le = layer * 16 + (r >> 7), kt = (r >> 3) & 15, nt = r & 7;
    const float* pg = P.in[I_WGATE]; const float* pu = P.in[I_WUP]; const float* pd = P.in[I_WDOWN];
    asm volatile("" : "+s"(pg), "+s"(pu), "+s"(pd));
    const size_t so = (size_t)le * DM * DM + (size_t)kt * 128 * DM + nt * 256;
    CvtJob j; j.src = (m == 0 ? pg : (m == 1 ? pu : pd)) + so; j.split = m < 2 ? 1 : 0;
    j.dst = m < 2 ? F.ws + WS_WGU + ((size_t)le * 4096 + nt * 512 + (m == 1 ? 128 : 0)) * DM + kt * 128 : F.ws + WS_WDN + ((size_t)le * DM + nt * 256) * DM + kt * 128;
    return j;
}
__device__ __forceinline__ void conv_range(const Ctx& F, int g0, int g1, int first_cu) {
    const int tid = F.wid * 64 + lane_fresh(); const int c4 = (tid >> 6) * 8 + (tid & 7), kq = (tid >> 3) & 7; constexpr int n = 1;
    const int cnt = (g1 - g0 + (F.G - first_cu) - 1) / (F.G - first_cu);
    int g = g0 + (F.c - first_cu) * cnt; g1 = g + cnt < g1 ? g + cnt : g1; if (g >= g1) return;
#define CV8_LOAD(v_, src_) { const GAS float* s_ = (const GAS float*)(src_) + (size_t)(kq * 16) * DM + c4 * 4; _Pragma("unroll") for (int i = 0; i < 16; ++i) v_[i] = __builtin_nontemporal_load((const GAS f32x4*)(s_ + (size_t)i * DM)); }
#define CV8_STORE(v_, job_) { const int rbase = (job_).split ? ((c4 >> 5) * 256 + (c4 & 31) * 4) : c4 * 4; \
        _Pragma("unroll") for (int j = 0; j < 4; ++j) { u32x4 w; \
            w.x = pk4_fp8(v_[0][j] * W8_SCALE, v_[1][j] * W8_SCALE, v_[2][j] * W8_SCALE, v_[3][j] * W8_SCALE); w.y = pk4_fp8(v_[4][j] * W8_SCALE, v_[5][j] * W8_SCALE, v_[6][j] * W8_SCALE, v_[7][j] * W8_SCALE); \
            w.z = pk4_fp8(v_[8][j] * W8_SCALE, v_[9][j] * W8_SCALE, v_[10][j] * W8_SCALE, v_[11][j] * W8_SCALE); w.w = pk4_fp8(v_[12][j] * W8_SCALE, v_[13][j] * W8_SCALE, v_[14][j] * W8_SCALE, v_[15][j] * W8_SCALE); \
            __builtin_nontemporal_store(w, (GAS u32x4*)(GAS unsigned char*)((job_).dst + (size_t)(rbase + j) * DM + kq * 16)); } }
    f32x4 va[16], vb[16]; CvtJob ja = moe_job(F, g), jb = ja; CV8_LOAD(va, ja.src)
    for (;;) {
        if (g + n >= g1) { CV8_STORE(va, ja) break; }
        jb = moe_job(F, g + n); CV8_LOAD(vb, jb.src)
        CV8_STORE(va, ja)
        g += n;
        if (g + n >= g1) { CV8_STORE(vb, jb) break; }
        ja = moe_job(F, g + n); CV8_LOAD(va, ja.src)
        CV8_STORE(vb, jb)
        g += n;
    }
#undef CV8_STORE
#undef CV8_LOAD
}
constexpr int NCV2 = 48, NCV5 = 72, NCV9 = 64, NCV11 = 32, NCV13 = 8;
constexpr int GT0 = 424, GT2 = 3694, GT5 = 6144, GT9 = 9024, GT11 = 11204, GT13 = 11424;
static_assert(GT5 >= MOE_TILES, "layer 0's expert weights must be complete before P8");
__device__ __forceinline__ void p0_prologue(const Ctx& F) {
    const Params& P = F.P; const int tid = F.wid * 64 + lane_fresh();
    LAS float* sil = (LAS float*)F.lds;
    LAS float* red = (LAS float*)(F.lds + 40960);
    for (int u = F.c; u < N_MOD_UNITS + CV_F; u += F.G) {
        if (u < N_MOD_UNITS) {
            const int l = u / 96, j0 = (u % 96) * 128;
            for (int i = tid; i < 5 * DM; i += 512) { const int v = i >> 11, k = i & 2047; const float cv = v < 4 ? P.in[I_C][v * DM + k] : P.in[I_CCTX][k]; sil[i] = cv * fast_sigmoid(cv); }
            __syncthreads();
            const int hw = tid >> 5, l32 = tid & 31;
            f32x4 a0 = {0, 0, 0, 0}, a1 = a0, a2 = a0, a3 = a0, a4 = a0;
            const float* wp = P.in[I_MODW] + ((size_t)(l * DM + hw * 128)) * MODN + j0 + l32 * 4;
#pragma unroll 8
            for (int kk = 0; kk < 128; ++kk) { const f32x4 w = ld_nt(wp + (size_t)kk * MODN); const int k = hw * 128 + kk;
                a0 += sil[k] * w; a1 += sil[DM + k] * w; a2 += sil[2 * DM + k] * w; a3 += sil[3 * DM + k] * w; a4 += sil[4 * DM + k] * w; }
            *(LAS f32x4*)(red + (hw * 5 + 0) * 128 + l32 * 4) = a0; *(LAS f32x4*)(red + (hw * 5 + 1) * 128 + l32 * 4) = a1; *(LAS f32x4*)(red + (hw * 5 + 2) * 128 + l32 * 4) = a2;
            *(LAS f32x4*)(red + (hw * 5 + 3) * 128 + l32 * 4) = a3; *(LAS f32x4*)(red + (hw * 5 + 4) * 128 + l32 * 4) = a4;
            __syncthreads();
            float* mod = (float*)(F.ws + WS_MOD);
            for (int o = tid; o < 640; o += 512) { const int v = o >> 7, col = o & 127; float s = 0.f;
#pragma unroll
                for (int h = 0; h < 16; ++h) s += red[(h * 5 + v) * 128 + col];
                mod[(size_t)(l * 5 + v) * MODN + j0 + col] = s + P.in[I_MODB][l * MODN + j0 + col]; }
            __syncthreads();
        } else {
            const int t = u - N_MOD_UNITS;
            if (t < CV_A)      { const int q = t;        const int kt = q / 36, nt = q % 36; const int drow = nt < 20 ? nt * 128 : (nt < 28 ? 2560 + (nt - 20) * 256 : 2560 + (nt - 28) * 256 + 128);
                cvt_tile(P.in[I_EVWIN]  + (size_t)kt * 128 * EV_IN + nt * 128, EV_IN, (bf16_t*)(F.ws + WS_WEVIN)  + (size_t)drow * DM + kt * 128, DM, tid); }
            else if (t < CV_B) { const int q = t - CV_A; const int kt = q / 16, nt = q % 16; cvt_tile(P.in[I_EVWOUT] + (size_t)kt * 128 * DM + nt * 128, DM, (bf16_t*)(F.ws + WS_WEVOUT) + (size_t)nt * 128 * DM + kt * 128, DM, tid); }
            else if (t < CV_C) { const int q = t - CV_B; const int kt = q / 40, nt = q % 40; cvt_tile(P.in[I_ODWIN]  + (size_t)kt * 128 * OD_IN + nt * 128, OD_IN, (bf16_t*)(F.ws + WS_WODIN)  + (size_t)nt * 128 * DM + kt * 128, DM, tid); }
            else if (t < CV_D) { const int q = t - CV_C; const int kt = q / 16, nt = q % 16; cvt_tile(P.in[I_ODWOUT] + (size_t)kt * 128 * DM + nt * 128, DM, (bf16_t*)(F.ws + WS_WODOUT) + (size_t)nt * 128 * LRUW + kt * 128, LRUW, tid); }
            else if (t < CV_E) { const int q = t - CV_D; const int m = q / 80, r = q % 80, dh = r >> 2, kt = (r >> 1) & 1, nt = r & 1;
                bf16_t* dst = (bf16_t*)(F.ws + WS_WLRU) + ((size_t)dh * 512 + nt * 256 + m * 128) * 256 + kt * 128; const size_t so = (size_t)dh * 65536 + (size_t)kt * 128 * 256 + nt * 128;
                if (m == 0) cvt_tile(P.in[I_ODWA] + so, 256, dst, 256, tid); else cvt_tile(P.in[I_ODWX] + so, 256, dst, 256, tid); }
            else { const int q = t - CV_E; const int g = q < GT0 ? q : GT13 + (q - GT0); moe_cvt_tile(F, g / MOE_TILES, g % MOE_TILES, tid); }
        }
    }
}

template <int MODE> __device__ __forceinline__ void norm_pair(const Ctx& F, const LAS float* lm, int lane, int row, const f32x4 (&nx)[2][8], const u32x2 (&nw)[2][8], int sm0, int sm1) {
    const Params& P = F.P; bf16_t* h = (bf16_t*)(F.ws + WS_H); bf16_t* act = (bf16_t*)(F.ws + WS_ACT); const unsigned char* eo = F.ws + WS_EO;
    const int b = row / TPB, p = row - b * TPB; const bool isctx = p < CTXL; const int mv = isctx ? 4 : b;
    f32x4 v[2][8];
#pragma unroll
    for (int q = 0; q < 2; ++q)
#pragma unroll
        for (int i = 0; i < 8; ++i) v[q][i] = MODE == 0 ? nx[q][i] : (f32x4){bf_lo(nw[q][i].x), bf_hi(nw[q][i].x), bf_lo(nw[q][i].y), bf_hi(nw[q][i].y)};
    if (MODE >= 1) {
        f32x4 a[2][8];
#pragma unroll
        for (int q = 0; q < 2; ++q)
#pragma unroll
            for (int i = 0; i < 8; ++i) a[q][i] = (f32x4){0.f, 0.f, 0.f, 0.f};
        unsigned sel0 = (unsigned)__ballot(sm0 >= 0) & 0xffffu, sel1 = (unsigned)__ballot(sm1 >= 0) & 0xffffu;
        while (sel0 | sel1) {
            int sl[4]; bool on[4];
            { on[0] = sel0 != 0u; const int e = on[0] ? __builtin_ctz(sel0) : 0; if (on[0]) sel0 &= sel0 - 1u; sl[0] = on[0] ? __builtin_amdgcn_readlane(sm0, e) : 0; }
            { on[1] = sel0 != 0u; const int e = on[1] ? __builtin_ctz(sel0) : 0; if (on[1]) sel0 &= sel0 - 1u; sl[1] = on[1] ? __builtin_amdgcn_readlane(sm0, e) : sl[0]; }
            { on[2] = sel1 != 0u; const int e = on[2] ? __builtin_ctz(sel1) : 0; if (on[2]) sel1 &= sel1 - 1u; sl[2] = on[2] ? __builtin_amdgcn_readlane(sm1, e) : 0; }
            { on[3] = sel1 != 0u; const int e = on[3] ? __builtin_ctz(sel1) : 0; if (on[3]) sel1 &= sel1 - 1u; sl[3] = on[3] ? __builtin_amdgcn_readlane(sm1, e) : sl[2]; }
            unsigned w[4][8];
#pragma unroll
            for (int t = 0; t < 4; ++t)
#pragma unroll
                for (int i = 0; i < 8; ++i) w[t][i] = *(const unsigned*)(eo + (size_t)sl[t] * DM + lane * 4 + 256 * i);
#pragma unroll
            for (int t = 0; t < 4; ++t) { if (on[t]) {
#pragma unroll
                for (int i = 0; i < 8; ++i) a[t >> 1][i] += (f32x4){__builtin_amdgcn_cvt_f32_fp8((int)w[t][i], 0), __builtin_amdgcn_cvt_f32_fp8((int)w[t][i], 1), __builtin_amdgcn_cvt_f32_fp8((int)w[t][i], 2), __builtin_amdgcn_cvt_f32_fp8((int)w[t][i], 3)}; } }
        }
        const LAS float* g2 = lm + 10 * DM + mv * DM + lane * 4;
#pragma unroll
        for (int i = 0; i < 8; ++i) { const f32x4 gv = *(const LAS f32x4*)(g2 + 256 * i); v[0][i] += gv * a[0][i]; v[1][i] += gv * a[1][i]; }
        if (MODE == 1) {
#pragma unroll
            for (int q = 0; q < 2; ++q)
#pragma unroll
                for (int i = 0; i < 8; ++i) { u32x2 w2; w2.x = cvt_pk_bf16(v[q][i][0], v[q][i][1]); w2.y = cvt_pk_bf16(v[q][i][2], v[q][i][3]); *(u32x2*)(h + (size_t)(row + q) * DM + lane * 4 + 256 * i) = w2; } }
    }
    float rinv[2];
#pragma unroll
    for (int q = 0; q < 2; ++q) { float ss = 0.f;
#pragma unroll
        for (int i = 0; i < 8; ++i) ss += v[q][i][0] * v[q][i][0] + v[q][i][1] * v[q][i][1] + v[q][i][2] * v[q][i][2] + v[q][i][3] * v[q][i][3];
        ss = wave_sum(ss); rinv[q] = __builtin_amdgcn_rsqf(ss * (1.0f / DM) + EPS); }
    if (MODE == 2) {
        float* op = P.out + ((size_t)b * SEQ + (p - CTXL)) * DM + lane * 4; const LAS float* gf = lm + lane * 4;
#pragma unroll
        for (int i = 0; i < 8; ++i) { const f32x4 gv = *(const LAS f32x4*)(gf + 256 * i); st_nt(op + 256 * i, v[0][i] * rinv[0] * gv); st_nt(op + DM + 256 * i, v[1][i] * rinv[1] * gv); }
    } else {
        const LAS float* gsp = lm + mv * DM + lane * 4;
#pragma unroll
        for (int i = 0; i < 8; ++i) { const f32x4 gs = *(const LAS f32x4*)(gsp + 256 * i), sv = *(const LAS f32x4*)(gsp + 5 * DM + 256 * i);
#pragma unroll
            for (int q = 0; q < 2; ++q) { const f32x4 y = v[q][i] * rinv[q] * gs + sv;
                u32x2 w2; w2.x = cvt_pk_bf16(y[0], y[1]); w2.y = cvt_pk_bf16(y[2], y[3]); *(u32x2*)(act + (size_t)(row + q) * DM + lane * 4 + 256 * i) = w2; } }
    }
}
template <int MODE> __device__ __forceinline__ void phase_norm(const Ctx& F) {
    const Params& P = F.P; const int lane = lane_fresh();
    const float* mod = (const float*)(F.ws + WS_MOD); const bf16_t* h = (const bf16_t*)(F.ws + WS_H); const int* slotmap = (const int*)(F.ws + WS_SLOT);
    const int lprev = MODE == 2 ? 1 : 0, lnext = MODE == 0 ? 0 : 1;
    LAS float* lm = (LAS float*)F.lds;
    { const int tid = F.wid * 64 + lane;
      for (int i = tid; i < 5 * DM; i += 512) { const int mvv = i >> 11, k = i & 2047;
          if (MODE != 2) { const float* sh_ = mod + (size_t)(lnext * 5 + mvv) * MODN; lm[i] = P.in[I_N1G][lnext * DM + k] * (1.0f + sh_[2048 + k]); lm[5 * DM + i] = sh_[k]; }
          if (MODE >= 1) lm[10 * DM + i] = mod[(size_t)(lprev * 5 + mvv) * MODN + 10240 + k]; }
      if (MODE == 2) for (int i = tid; i < DM; i += 512) lm[i] = P.in[I_FNG][i];
      __syncthreads(); }
    const int npair = MODE == 2 ? NB * SEQ / 2 : MROWS / 2; const int pstep = F.G * 8;
#define NM_ROW(j) (MODE == 2 ? ((j) / (SEQ / 2)) * TPB + CTXL + ((j) % (SEQ / 2)) * 2 : (j) * 2)
#define NM_LOAD(j, nx, nw, nsm0, nsm1) { const int r_ = NM_ROW(j); \
        if (MODE == 0) { const int b_ = r_ / TPB, p_ = r_ - b_ * TPB; const float* src = p_ < CTXL ? P.in[I_CTX] + ((size_t)b_ * CTXL + p_) * DM : P.in[I_X] + ((size_t)b_ * SEQ + (p_ - CTXL)) * DM; \
            _Pragma("unroll") for (int q = 0; q < 2; ++q) _Pragma("unroll") for (int i = 0; i < 8; ++i) nx[q][i] = ld_nt(src + (size_t)q * DM + lane * 4 + 256 * i); \
        } else { \
            _Pragma("unroll") for (int q = 0; q < 2; ++q) _Pragma("unroll") for (int i = 0; i < 8; ++i) nw[q][i] = *(const u32x2*)(h + (size_t)(r_ + q) * DM + lane * 4 + 256 * i); \
            nsm0 = lane < 16 ? slotmap[(size_t)r_ * 16 + lane] : -1; nsm1 = lane < 16 ? slotmap[(size_t)(r_ + 1) * 16 + lane] : -1; } }
    f32x4 ax[2][8], bx[2][8]; u32x2 aw[2][8], bw[2][8]; int as0 = -1, as1 = -1, bs0 = -1, bs1 = -1; int jp = F.c * 8 + F.wid;
    if (jp < npair) {
        NM_LOAD(jp, ax, aw, as0, as1)
        for (;;) {
            if (jp + pstep >= npair) { norm_pair<MODE>(F, lm, lane, NM_ROW(jp), ax, aw, as0, as1); break; }
            NM_LOAD(jp + pstep, bx, bw, bs0, bs1)
            norm_pair<MODE>(F, lm, lane, NM_ROW(jp), ax, aw, as0, as1);
            jp += pstep;
            if (jp + pstep >= npair) { norm_pair<MODE>(F, lm, lane, NM_ROW(jp), bx, bw, bs0, bs1); break; }
            NM_LOAD(jp + pstep, ax, aw, as0, as1)
            norm_pair<MODE>(F, lm, lane, NM_ROW(jp), bx, bw, bs0, bs1);
            jp += pstep;
        }
    }
#undef NM_LOAD
#undef NM_ROW
}

__device__ __forceinline__ void phase_router(const Ctx& F, int layer) {
    const Params& P = F.P; const int lane = lane_fresh(), tid = F.wid * 64 + lane;
    const float* mod = (const float*)(F.ws + WS_MOD); const bf16_t* h = (const bf16_t*)(F.ws + WS_H); unsigned char* act8 = F.ws + WS_ACT; float* aff = (float*)(F.ws + WS_AFF);
    LAS float* Wt = (LAS float*)F.lds;
    const float* wr = P.in[I_ROUTER] + (size_t)layer * DM * 16;
    for (int i = tid; i < DM * 16; i += 512) Wt[(i & 15) * DM + (i >> 4)] = wr[i];
    __syncthreads();
    const int npair = layer == 0 ? MROWS / 2 : NB * SEQ / 2; const int pstep = F.G * 8;
#define RT_ROW(j) (layer == 0 ? (j) * 2 : ((j) / (SEQ / 2)) * TPB + CTXL + ((j) % (SEQ / 2)) * 2)
    u32x2 nw[2][8]; int jp = F.c * 8 + F.wid;
    if (jp < npair) { const int r_ = RT_ROW(jp);
#pragma unroll
        for (int q = 0; q < 2; ++q)
#pragma unroll
            for (int i = 0; i < 8; ++i) nw[q][i] = *(const u32x2*)(h + (size_t)(r_ + q) * DM + lane * 4 + 256 * i); }
    for (; jp < npair; jp += pstep) {
        const int row = RT_ROW(jp); const int b = row / TPB, p = row - b * TPB; const bool isctx = p < CTXL; const int mv = isctx ? 4 : b;
        f32x2 pv[8][4];
#pragma unroll
        for (int i = 0; i < 8; ++i) { pv[i][0] = (f32x2){bf_lo(nw[0][i].x), bf_lo(nw[1][i].x)}; pv[i][1] = (f32x2){bf_hi(nw[0][i].x), bf_hi(nw[1][i].x)};
                                       pv[i][2] = (f32x2){bf_lo(nw[0][i].y), bf_lo(nw[1][i].y)}; pv[i][3] = (f32x2){bf_hi(nw[0][i].y), bf_hi(nw[1][i].y)}; }
        if (jp + pstep < npair) { const int r_ = RT_ROW(jp + pstep);
#pragma unroll
            for (int q = 0; q < 2; ++q)
#pragma unroll
                for (int i = 0; i < 8; ++i) nw[q][i] = *(const u32x2*)(h + (size_t)(r_ + q) * DM + lane * 4 + 256 * i); }
        f32x2 ss2 = {0.f, 0.f};
#pragma unroll
        for (int i = 0; i < 8; ++i)
#pragma unroll
            for (int k = 0; k < 4; ++k) ss2 += pv[i][k] * pv[i][k];
        f32x2 rinv2; rinv2.x = __builtin_amdgcn_rsqf(wave_sum(ss2.x) * (1.0f / DM) + EPS); rinv2.y = __builtin_amdgcn_rsqf(wave_sum(ss2.y) * (1.0f / DM) + EPS);
        const float* g = P.in[I_N2G] + layer * DM + lane * 4; const float* sh = mod + (size_t)(layer * 5 + mv) * MODN + 6144 + lane * 4; const float* sc = sh + 2048;
#pragma unroll
        for (int i = 0; i < 8; ++i) { const f32x4 gs = *(const f32x4*)(g + 256 * i) * (1.0f + *(const f32x4*)(sc + 256 * i)), sv = *(const f32x4*)(sh + 256 * i);
#pragma unroll
            for (int k = 0; k < 4; ++k) pv[i][k] = (pv[i][k] * rinv2) * (f32x2){gs[k], gs[k]} + (f32x2){sv[k], sv[k]};
            *(unsigned*)(act8 + (size_t)row * DM + lane * 4 + 256 * i) = pk4_fp8(pv[i][0].x, pv[i][1].x, pv[i][2].x, pv[i][3].x);
            *(unsigned*)(act8 + (size_t)(row + 1) * DM + lane * 4 + 256 * i) = pk4_fp8(pv[i][0].y, pv[i][1].y, pv[i][2].y, pv[i][3].y); }
        f32x2 lg2[16];
#pragma unroll
        for (int e = 0; e < 16; ++e) { f32x2 acc[4] = {{0.f, 0.f}, {0.f, 0.f}, {0.f, 0.f}, {0.f, 0.f}};
#pragma unroll
            for (int i = 0; i < 8; ++i) { const f32x4 w = *(const LAS f32x4*)(Wt + e * DM + lane * 4 + 256 * i);
#pragma unroll
                for (int k = 0; k < 4; ++k) acc[k] += pv[i][k] * (f32x2){w[k], w[k]}; }
            lg2[e] = (acc[0] + acc[1]) + (acc[2] + acc[3]); __builtin_amdgcn_sched_barrier(0); }
        const bool b0 = (lane & 1) != 0, b1 = (lane & 2) != 0, b2 = (lane & 4) != 0, b3 = (lane & 8) != 0, b4 = (lane & 16) != 0;
        float u16[16], u8[8], u4[4], u2[2];
#pragma unroll
        for (int j = 0; j < 16; ++j) { const float send = b0 ? lg2[j].x : lg2[j].y, keep = b0 ? lg2[j].y : lg2[j].x;
            u16[j] = keep + __int_as_float(__builtin_amdgcn_update_dpp(0, __float_as_int(send), 0xB1, 0xf, 0xf, true)); }
#pragma unroll
        for (int j = 0; j < 8; ++j) { const float send = b1 ? u16[j] : u16[8 + j], keep = b1 ? u16[8 + j] : u16[j];
            u8[j] = keep + __int_as_float(__builtin_amdgcn_update_dpp(0, __float_as_int(send), 0x4E, 0xf, 0xf, true)); }
#pragma unroll
        for (int j = 0; j < 4; ++j) { const float send = b2 ? u8[j] : u8[4 + j], keep = b2 ? u8[4 + j] : u8[j]; u4[j] = keep + __shfl_xor(send, 4); }
#pragma unroll
        for (int j = 0; j < 2; ++j) { const float send = b3 ? u4[j] : u4[2 + j], keep = b3 ? u4[2 + j] : u4[j]; u2[j] = keep + __shfl_xor(send, 8); }
        float lgt; { const float send = b4 ? u2[0] : u2[1], keep = b4 ? u2[1] : u2[0]; lgt = keep + __shfl_xor(send, 16); }
        lgt += __shfl_xor(lgt, 32);
        float mx = lgt;
#pragma unroll
        for (int o = 2; o <= 16; o <<= 1) mx = fmaxf(mx, __shfl_xor(mx, o));
        const float pe = __expf(lgt - mx); float sum = pe;
#pragma unroll
        for (int o = 2; o <= 16; o <<= 1) sum += __shfl_xor(sum, o);
        if (lane < 32) { const int e = (b1 ? 8 : 0) + (b2 ? 4 : 0) + (b3 ? 2 : 0) + (b4 ? 1 : 0); aff[(size_t)(row + (b0 ? 1 : 0)) * 16 + e] = pe / sum; }
    }
#undef RT_ROW
    __syncthreads();
}

__device__ __forceinline__ unsigned block_excl_scan(unsigned x, LAS unsigned* wsum, int lane, int wid) {
    unsigned s = x;
#pragma unroll
    for (int o = 1; o < 64; o <<= 1) { const unsigned t = __shfl_up(s, o); if (lane >= o) s += t; }
    if (lane == 63) wsum[wid] = s;
    __syncthreads();
    unsigned below = 0;
#pragma unroll
    for (int w = 0; w < 8; ++w) below += (w < wid) ? wsum[w] : 0u;
    __syncthreads();
    return below + s - x;
}
__device__ __forceinline__ void phase_topk(const Ctx& F, int layer) {
    const int lane = lane_fresh(), tid = F.wid * 64 + lane; const int estr = layer == 0 ? 2304 : 2048;
    const float* aff = (const float*)(F.ws + WS_AFF); int* slotmap = (int*)(F.ws + WS_SLOT); float* gval = (float*)(F.ws + WS_GVAL);
    unsigned* offt = (unsigned*)(F.ws + WS_OFFT);
    LAS unsigned* key = (LAS unsigned*)F.lds;
    LAS unsigned* hist = key + 4096;
    LAS unsigned* wsum = hist + 256;
    LAS unsigned* bc = wsum + 16;
    LAS unsigned* list = bc + 16;
    const int nunits = layer == 0 ? 320 : 256;
    for (int u = F.c; u < nunits; u += F.G) {
        const bool lat = u < 256; const int be = lat ? (u >> 2) : (u - 256), q = lat ? (u & 3) : 0; const int b = be >> 4, e = be & 15;
        const int n = lat ? SEQ : CTXL, cap = n >> 3, row0 = b * TPB + (lat ? CTXL : 0);
        for (int i = tid; i < n; i += 512) key[i] = __float_as_uint(aff[(size_t)(row0 + i) * 16 + e]);
        unsigned prefix = 0u, mask = 0u, krem = (unsigned)cap;
#pragma unroll 1
        for (int pass = 0; pass < 4; ++pass) { const int shift = 24 - 8 * pass;
            if (tid < 256) hist[tid] = 0u;
            __syncthreads();
            for (int i = tid; i < n; i += 512) { const unsigned k = key[i]; if ((k & mask) == prefix) __hip_atomic_fetch_add(hist + ((k >> shift) & 255u), 1u, __ATOMIC_RELAXED, __HIP_MEMORY_SCOPE_WORKGROUP); }
            __syncthreads();
            unsigned sfx = 0u;
            if (tid < 256) { sfx = hist[tid];
#pragma unroll
                for (int o = 1; o < 64; o <<= 1) { const unsigned t = __shfl_down(sfx, o); if (lane + o < 64) sfx += t; }
                if (lane == 0) wsum[F.wid] = sfx; }
            __syncthreads();
            if (tid < 256) { unsigned above = 0u;
#pragma unroll
                for (int w = 1; w < 4; ++w) above += (w > F.wid) ? wsum[w] : 0u;
                const unsigned ge = sfx + above; unsigned gt = __shfl_down(sfx, 1); gt = (lane == 63) ? above : gt + above;
                if (ge >= krem && gt < krem) { bc[0] = (unsigned)tid; bc[1] = krem - gt; } }
            __syncthreads();
            prefix |= bc[0] << shift; mask |= 255u << shift; krem = bc[1];
        }
        const int per = lat ? 8 : 1; const bool own = tid * per < n; const int i0 = tid * per;
        unsigned eqc = 0u;
        if (own) for (int j = 0; j < per; ++j) eqc += (key[i0 + j] == prefix) ? 1u : 0u;
        unsigned eqb = block_excl_scan(eqc, wsum, lane, F.wid);
        unsigned selm = 0u, selc = 0u;
        if (own) for (int j = 0; j < per; ++j) { const unsigned k = key[i0 + j]; bool sl = k > prefix; if (k == prefix) { sl = eqb < krem; ++eqb; } if (sl) { selm |= 1u << j; ++selc; } }
        unsigned sb = block_excl_scan(selc, wsum, lane, F.wid);
        const int slot0 = e * estr + (lat ? b * 512 : 2048 + b * 32);
        const bool mine = lat ? ((tid >> 7) == q) : true;
        if (own) for (int j = 0; j < per; ++j) { const bool sl = (selm >> j) & 1u; if (sl) list[sb] = (unsigned)(i0 + j);
            if (mine) slotmap[(size_t)(row0 + i0 + j) * 16 + e] = sl ? slot0 + (int)sb : -1; if (sl) ++sb; }
        __syncthreads();
        const int r_lo = lat ? q * 128 : 0, r_hi = lat ? r_lo + 128 : 32;
        for (int r = r_lo + tid; r < r_hi; r += 512) { const unsigned t = list[r]; gval[slot0 + r] = __uint_as_float(key[t]); offt[slot0 + r] = (unsigned)(row0 + t) * (unsigned)DM; }
        if (layer == 0 && !lat && b == 0 && tid < 128) offt[e * estr + 2176 + tid] = 0u;
        __syncthreads();
    }
}

__device__ __forceinline__ void unpack8(const u32x4 v, float (&o)[8]) { o[0] = bf_lo(v.x); o[1] = bf_hi(v.x); o[2] = bf_lo(v.y); o[3] = bf_hi(v.y); o[4] = bf_lo(v.z); o[5] = bf_hi(v.z); o[6] = bf_lo(v.w); o[7] = bf_hi(v.w); }
__device__ __forceinline__ void load_cu(const bf16_t* prj, int row, int ch, float (&o)[8]) {
    const u32x4 cv = *(const u32x4*)(prj + (size_t)row * PRJ_LD + 2560 + ch), uv = *(const u32x4*)(prj + (size_t)row * PRJ_LD + 3584 + ch);
    o[0] = bf_lo(cv.x) * bf_lo(uv.x); o[1] = bf_hi(cv.x) * bf_hi(uv.x); o[2] = bf_lo(cv.y) * bf_lo(uv.y); o[3] = bf_hi(cv.y) * bf_hi(uv.y);
    o[4] = bf_lo(cv.z) * bf_lo(uv.z); o[5] = bf_hi(cv.z) * bf_hi(uv.z); o[6] = bf_lo(cv.w) * bf_lo(uv.w); o[7] = bf_hi(cv.w) * bf_hi(uv.w);
}
__device__ __forceinline__ void load_x8(const bf16_t* prj, int row, int ch, int seg_lo, int seg_hi, float (&o)[8]) {
    if (row < seg_lo || row >= seg_hi) {
#pragma unroll
        for (int j = 0; j < 8; ++j) o[j] = 0.f; }
    else { const u32x4 v = *(const u32x4*)(prj + (size_t)row * PRJ_LD + ch); o[0] = bf_lo(v.x); o[1] = bf_hi(v.x); o[2] = bf_lo(v.y); o[3] = bf_hi(v.y); o[4] = bf_lo(v.z); o[5] = bf_hi(v.z); o[6] = bf_lo(v.w); o[7] = bf_hi(v.w); }
}
__device__ __forceinline__ int rope_unit(int c, int k, int G) {
    constexpr int NROPE = MROWS / 16;
    if (G != 256) { const int u = c + k * G; return u < NROPE ? u : -1; }
    if (k < 3) return k * 256 + c;
    if (k == 3) return c >= 32 ? 768 + (c - 32) : -1;
    if (k == 4) return (c >= 32 && c < 128) ? 992 + (c - 32) : -1;
    return -1;
}
__device__ __forceinline__ void phase_rope_conv(const Ctx& F) {
    const Params& P = F.P; const int tid = F.wid * 64 + lane_fresh();
    bf16_t* prj = (bf16_t*)(F.ws + WS_PRJ); bf16_t* yin = (bf16_t*)(F.ws + WS_YIN);
    constexpr int NCONV = MROWS / 32, NROPE = MROWS / 16;
    {
        const int ch = (tid & 127) * 8;
        const float* cw = P.in[I_EVCW]; float w0[8], w1[8], w2[8], cb[8];
#pragma unroll
        for (int j = 0; j < 8; ++j) { w0[j] = cw[ch + j]; w1[j] = cw[1024 + ch + j]; w2[j] = cw[2048 + ch + j]; cb[j] = P.in[I_EVCB][ch + j]; }
        u32x4 ncin[10], nbin[8];
#define RC_LOAD(un) { const int r0_ = (un) * 32 + (tid >> 7) * 8; const int b_ = r0_ / TPB, p_ = r0_ - b_ * TPB; const int lo_ = b_ * TPB + (p_ < CTXL ? 0 : CTXL), hi_ = b_ * TPB + (p_ < CTXL ? CTXL : TPB); \
            _Pragma("unroll") for (int k = 0; k < 10; ++k) { const int row = r0_ - 1 + k; const int rc = row < lo_ ? lo_ : (row >= hi_ ? hi_ - 1 : row); \
                ncin[k] = *(const u32x4*)((const char*)prj + (unsigned)(rc * PRJ_LD + 2560 + ch) * 2u); if (row < lo_ || row >= hi_) ncin[k] = (u32x4){0u, 0u, 0u, 0u}; }         \
            _Pragma("unroll") for (int k = 0; k < 8; ++k) nbin[k] = *(const u32x4*)((const char*)prj + (unsigned)((r0_ + k) * PRJ_LD + 1536 + ch) * 2u); }
        int u = F.c; if (u < NCONV) RC_LOAD(u)
        for (; u < NCONV; u += F.G) {
            const int r0 = u * 32 + (tid >> 7) * 8;
            u32x4 cin[10], bin[8];
#pragma unroll
            for (int k = 0; k < 10; ++k) cin[k] = ncin[k];
#pragma unroll
            for (int k = 0; k < 8; ++k) bin[k] = nbin[k];
            if (u + F.G < NCONV) RC_LOAD(u + F.G)
            const unsigned so0 = (unsigned)(r0 * YLD + 1024 + ch) * 2u; __builtin_amdgcn_sched_barrier(0);
            float prev[8], cur[8], nxt[8];
            unpack8(cin[0], prev); unpack8(cin[1], cur);
#pragma unroll
            for (int rr = 0; rr < 8; ++rr) { float bb[8]; unpack8(cin[rr + 2], nxt); unpack8(bin[rr], bb);
                float o[8];
#pragma unroll
                for (int j = 0; j < 8; ++j) { o[j] = bb[j] * (w0[j] * prev[j] + w1[j] * cur[j] + w2[j] * nxt[j] + cb[j]); prev[j] = cur[j]; cur[j] = nxt[j]; }
                u32x4 w; w.x = cvt_pk_bf16(o[0], o[1]); w.y = cvt_pk_bf16(o[2], o[3]); w.z = cvt_pk_bf16(o[4], o[5]); w.w = cvt_pk_bf16(o[6], o[7]);
                *(u32x4*)((char*)yin + (so0 + (unsigned)(rr * YLD * 2))) = w; __builtin_amdgcn_sched_barrier(0); }
        }
#undef RC_LOAD
    }
    {
        const int i = tid & 31; const bool second = ((i >> 3) & 1) != 0;
        float gq[4], gk[4], fr[4];
#pragma unroll
        for (int j = 0; j < 4; ++j) { gq[j] = P.in[I_EVQN][4 * i + j]; gk[j] = P.in[I_EVKN][4 * i + j]; const int fi = 4 * (i & 7) + j; fr[j] = __powf(10000.0f, -(float)(2 * fi) * (1.0f / 64.0f)); }
        u32x2 nwv[10], nv0, nv1;
#define RR_LOAD(un) { const bf16_t* rp_ = prj + (size_t)((un) * 16 + (tid >> 5)) * PRJ_LD + 4 * i; \
            _Pragma("unroll") for (int hh = 0; hh < 10; ++hh) nwv[hh] = *(const u32x2*)(rp_ + hh * 128); nv0 = *(const u32x2*)(rp_ + 1280); nv1 = *(const u32x2*)(rp_ + 1408); }
        int k = 0, u = rope_unit(F.c, 0, F.G); if (u >= 0) RR_LOAD(u)
        for (; u >= 0; ++k) {
            const int un = rope_unit(F.c, k + 1, F.G);
            const int row = u * 16 + (tid >> 5);
            const int b = row / TPB, p = row - b * TPB; const bool lat = p >= CTXL; const int t = p - CTXL;
            u32x2 wv[10];
#pragma unroll
            for (int hh = 0; hh < 10; ++hh) wv[hh] = nwv[hh];
            const u32x2 vv0 = nv0, vv1 = nv1;
            if (un >= 0) RR_LOAD(un)
            float cs[4], sn[4];
            { const int blk = i >> 4; const float pos = lat ? (float)(blk == 0 ? (t >> 6) : (t & 63)) : 0.f;
#pragma unroll
              for (int j = 0; j < 4; ++j) { float s_, c_; sincosf(pos * fr[j], &s_, &c_); cs[j] = c_; sn[j] = s_; } }
            bf16_t* rowp = prj + (size_t)row * PRJ_LD + 4 * i;
#pragma unroll
            for (int hh = 0; hh < 10; ++hh) {
                const u32x2 w = wv[hh]; float x[4] = {bf_lo(w.x), bf_hi(w.x), bf_lo(w.y), bf_hi(w.y)};
                float ss = x[0] * x[0] + x[1] * x[1] + x[2] * x[2] + x[3] * x[3];
#pragma unroll
                for (int o = 16; o >= 1; o >>= 1) ss += __shfl_xor(ss, o);
                const float rinv = __builtin_amdgcn_rsqf(ss * (1.0f / 128.0f) + EPS);
                float y[4];
#pragma unroll
                for (int j = 0; j < 4; ++j) y[j] = x[j] * rinv * (hh < 8 ? gq[j] : gk[j]);
                float o4[4];
#pragma unroll
                for (int j = 0; j < 4; ++j) { const float pr = __shfl_xor(y[j], 8); o4[j] = second ? (pr * sn[j] + y[j] * cs[j]) : (y[j] * cs[j] - pr * sn[j]); }
                wv[hh].x = cvt_pk_bf16(o4[0], o4[1]); wv[hh].y = cvt_pk_bf16(o4[2], o4[3]);
            }
#pragma unroll
            for (int hh = 0; hh < 8; ++hh) *(u32x2*)(rowp + hh * 128) = wv[hh];
            bf16_t* kc = (bf16_t*)(F.ws + WS_KC) + ((size_t)(b * 2) * TPB + p) * 128 + 4 * i; bf16_t* vc = (bf16_t*)(F.ws + WS_VC) + ((size_t)(b * 2) * TPB + p) * 128 + 4 * i;
            *(u32x2*)kc = wv[8]; *(u32x2*)(kc + (size_t)TPB * 128) = wv[9]; *(u32x2*)vc = vv0; *(u32x2*)(vc + (size_t)TPB * 128) = vv1;
            u = un;
        }
#undef RR_LOAD
    }
}

__device__ __forceinline__ void phase_attn(const Ctx& F) {
    const bf16_t* prj = (const bf16_t*)(F.ws + WS_PRJ); bf16_t* yin = (bf16_t*)(F.ws + WS_YIN);
    const int combo = F.c & 7, b = combo >> 1, kvh = combo & 1;
    const bf16_t* Kh = (const bf16_t*)(F.ws + WS_KC) + (size_t)(b * 2 + kvh) * TPB * 128; const bf16_t* Vh = (const bf16_t*)(F.ws + WS_VC) + (size_t)(b * 2 + kvh) * TPB * 128;
#define ATT_UNIT(i) do { const int w = (F.c >> 3) + 32 * (i); const int hq = kvh * 4 + ((i) < 2 ? (w >> 4) : (F.c >> 3)), qb = w & 15; \
        const size_t qrow = (size_t)b * TPB + ((i) < 2 ? CTXL + qb * 256 : 0); \
        att::attn_dense_body(prj + qrow * PRJ_LD + hq * 128, Kh, Vh, yin + qrow * YLD + hq * 128, (i) < 2 ? TPB : CTXL, F.ldsg, F.wid); } while (0)
    ATT_UNIT(0);
    ATT_UNIT(1);
    if (F.c < 32) ATT_UNIT(2);
#undef ATT_UNIT
}

__device__ __forceinline__ void phase_lru_conv(const Ctx& F) {
    const Params& P = F.P; const int tid = F.wid * 64 + lane_fresh();
    const bf16_t* prj = (const bf16_t*)(F.ws + WS_PRJ); bf16_t* U = (bf16_t*)(F.ws + WS_U);
    constexpr int RG = 8, NRG = MROWS / RG;
    const int gt = F.c * 512 + tid, nth = (F.G * 512) / 320;
    if (gt < nth * 320) {
        const int ch = (gt % 320) * 8; int rg = gt / 320;
        const float* cw = P.in[I_ODCW]; float w0[8], w1[8], w2[8], w3[8], cb[8];
#pragma unroll
        for (int j = 0; j < 8; ++j) { w0[j] = cw[ch + j]; w1[j] = cw[LRUW + ch + j]; w2[j] = cw[2 * LRUW + ch + j]; w3[j] = cw[3 * LRUW + ch + j]; cb[j] = P.in[I_ODCB][ch + j]; }
        u32x4 nin[RG + 3];
#define LC_LOAD(g) { const int r0_ = (g) * RG; const int b_ = r0_ / TPB, p_ = r0_ - b_ * TPB; const int lo_ = b_ * TPB + (p_ < CTXL ? 0 : CTXL), hi_ = b_ * TPB + (p_ < CTXL ? CTXL : TPB); \
            _Pragma("unroll") for (int k = 0; k < RG + 3; ++k) { const int row = r0_ - 1 + k; const int rc = row < lo_ ? lo_ : (row >= hi_ ? hi_ - 1 : row); \
                nin[k] = *(const u32x4*)((const char*)prj + (unsigned)(rc * PRJ_LD + ch) * 2u); if (row < lo_ || row >= hi_) nin[k] = (u32x4){0u, 0u, 0u, 0u}; } }
        if (rg < NRG) LC_LOAD(rg)
        for (; rg < NRG; rg += nth) {
            u32x4 xin[RG + 3];
#pragma unroll
            for (int k = 0; k < RG + 3; ++k) xin[k] = nin[k];
            if (rg + nth < NRG) LC_LOAD(rg + nth)
            const unsigned so0 = (unsigned)(rg * RG * LRUW + ch) * 2u; __builtin_amdgcn_sched_barrier(0);
#pragma unroll
            for (int rr = 0; rr < RG; ++rr) { float xm[8], x0[8], x1[8], x2[8]; unpack8(xin[rr], xm); unpack8(xin[rr + 1], x0); unpack8(xin[rr + 2], x1); unpack8(xin[rr + 3], x2);
                float o[8];
#pragma unroll
                for (int j = 0; j < 8; ++j) o[j] = w0[j] * xm[j] + w1[j] * x0[j] + w2[j] * x1[j] + w3[j] * x2[j] + cb[j];
                u32x4 w; w.x = cvt_pk_bf16(o[0], o[1]); w.y = cvt_pk_bf16(o[2], o[3]); w.z = cvt_pk_bf16(o[4], o[5]); w.w = cvt_pk_bf16(o[6], o[7]);
                *(u32x4*)((char*)U + (so0 + (unsigned)(rr * LRUW * 2))) = w; __builtin_amdgcn_sched_barrier(0); }
        }
#undef LC_LOAD
    }
}

__device__ __forceinline__ int scan_chunk_at(int d, int k) { return d == 0 ? k : (k < 4 ? 3 - k : 71 - k); }
__device__ __forceinline__ int scan_order_of(int d, int c) { return d == 0 ? c : (c < 4 ? 3 - c : 71 - c); }
__device__ __forceinline__ void scan_dec(unsigned w, f32x2 k2, f32x2& a2, f32x2& b2) {
    const f32x2 c2 = {(float)(w & 0xffu), (float)((w >> 8) & 0xffu)}; const f32x2 l2 = (c2 * c2) * k2;
    a2.x = __builtin_amdgcn_exp2f(l2.x); a2.y = __builtin_amdgcn_exp2f(l2.y); b2.x = __builtin_amdgcn_cvt_f32_fp8((int)w, 2); b2.y = __builtin_amdgcn_cvt_f32_fp8((int)w, 3);
}
__device__ __forceinline__ float lru_k2(const float* lam, int d, int ch);
__device__ __forceinline__ float lru_sp(const float* lam, int d, int ch) { const float lm = lam[d * LRUW + ch]; return -8.0f * (fmaxf(-lm, 0.f) + __logf(1.0f + __expf(-fabsf(lm)))); }
__device__ __forceinline__ float lru_k2(const float* lam, int d, int ch) { return lru_sp(lam, d, ch) * (1.4426950408889634f / 65025.0f); }
__device__ __forceinline__ void phase_scan1(const Ctx& F) {
    const unsigned short* lav = (const unsigned short*)(F.ws + WS_LAGI); float* agg = (float*)(F.ws + WS_AGG); const int lane = lane_fresh(); const float* lam = F.P.in[I_ODLAM];
    float* carry = (float*)(F.ws + WS_CARRY); unsigned* scnt = (unsigned*)(F.ws + WS_SCNT);
    constexpr int NU = 2 * NB * 68 * 10;
    const int half = lane >> 5, sub = lane & 31;
    for (int u = F.c * 8 + F.wid; u < NU; u += F.G * 8) {
        const int cg = u % 10, c = (u / 10) % 68, b = (u / (10 * 68)) % NB, d = u / (10 * 68 * NB);
        const int ch = cg * 256 + sub * 8;
        const int r0 = d == 0 ? half * 32 : 63 - half * 32; const int rstep = d == 0 ? LRUW * 2 : -LRUW * 2;
        unsigned off = (unsigned)((((size_t)d * MROWS + (size_t)b * TPB + c * 64 + r0) * LRUW + ch) * 2);
        float hh[8], ss[8], sp[8];
#pragma unroll
        for (int j = 0; j < 8; ++j) { hh[j] = 0.f; ss[j] = 0.f; sp[j] = lru_k2(lam, d, ch + j); asm volatile("" : "+v"(sp[j])); }
#pragma unroll
        for (int blk = 0; blk < 2; ++blk) { u32x4 w[16];
#pragma unroll
            for (int kk = 0; kk < 16; ++kk) { w[kk] = *(const u32x4*)((const char*)lav + off); off += (unsigned)rstep; }
#pragma unroll
            for (int kk = 0; kk < 16; ++kk) {
#pragma unroll
                for (int p = 0; p < 4; ++p) { const unsigned x = p == 0 ? w[kk].x : (p == 1 ? w[kk].y : (p == 2 ? w[kk].z : w[kk].w));
                    f32x2 a2, b2; scan_dec(x, (f32x2){sp[2 * p], sp[2 * p + 1]}, a2, b2); const f32x2 c2 = {(float)(x & 0xffu), (float)((x >> 8) & 0xffu)}; const f32x2 l2 = (c2 * c2) * (f32x2){sp[2 * p], sp[2 * p + 1]};
                    const f32x2 h2 = a2 * (f32x2){hh[2 * p], hh[2 * p + 1]} + b2; hh[2 * p] = h2.x; hh[2 * p + 1] = h2.y; ss[2 * p] += l2.x; ss[2 * p + 1] += l2.y;
                    asm volatile("" : "+v"(hh[2 * p]), "+v"(hh[2 * p + 1]), "+v"(ss[2 * p]), "+v"(ss[2 * p + 1])); }
                __builtin_amdgcn_sched_barrier(0); }
        }
        float so[8], ho[8];
#pragma unroll
        for (int j = 0; j < 8; ++j) { so[j] = __shfl_xor(ss[j], 32); ho[j] = __shfl_xor(hh[j], 32); }
        if (half == 1) { float* ap = agg + ((((size_t)d * NB + b) * 68 + c) * LRUW + ch) * 2;
#pragma unroll
            for (int p = 0; p < 4; ++p) { const float h0 = __builtin_amdgcn_exp2f(ss[2 * p]) * ho[2 * p] + hh[2 * p], h1 = __builtin_amdgcn_exp2f(ss[2 * p + 1]) * ho[2 * p + 1] + hh[2 * p + 1];
                st_wt16(ap + 4 * p, (f32x4){ss[2 * p] + so[2 * p], h0, ss[2 * p + 1] + so[2 * p + 1], h1}); } }
        asm volatile("s_waitcnt vmcnt(0)" ::: "memory");
        unsigned old_ = 0u;
        if (lane == 0) old_ = __hip_atomic_fetch_add(scnt + (((d * NB + b) * 10 + cg) * 16), 1u, __ATOMIC_RELAXED, __HIP_MEMORY_SCOPE_AGENT);
        old_ = (unsigned)__builtin_amdgcn_readfirstlane((int)old_);
        if (old_ == 67u) {
            __builtin_amdgcn_fence(__ATOMIC_ACQUIRE, "agent");
            const int pch = cg * 256 + lane * 4; float st[4] = {0.f, 0.f, 0.f, 0.f};
            const float* ab = agg + (((size_t)d * NB + b) * 68 * LRUW + pch) * 2; float* cb = carry + ((size_t)d * NB + b) * 68 * LRUW + pch;
#pragma unroll 1
            for (int k0 = 0; k0 < 68; k0 += 17) { f32x4 a0[17], a1[17];
#pragma unroll
                for (int j = 0; j < 17; ++j) { const int cc = scan_chunk_at(d, k0 + j); a0[j] = *(const f32x4*)(ab + (size_t)cc * LRUW * 2); a1[j] = *(const f32x4*)(ab + (size_t)cc * LRUW * 2 + 4); }
#pragma unroll
                for (int j = 0; j < 17; ++j) { const int cc = scan_chunk_at(d, k0 + j);
                    *(f32x4*)(cb + (size_t)cc * LRUW) = (f32x4){st[0], st[1], st[2], st[3]};
                    st[0] = __builtin_amdgcn_exp2f(a0[j][0]) * st[0] + a0[j][1]; st[1] = __builtin_amdgcn_exp2f(a0[j][2]) * st[1] + a0[j][3]; st[2] = __builtin_amdgcn_exp2f(a1[j][0]) * st[2] + a1[j][1]; st[3] = __builtin_amdgcn_exp2f(a1[j][2]) * st[3] + a1[j][3]; } }
        }
    }
}
__device__ __forceinline__ void phase_scan2(const Ctx& F) {
    const unsigned short* lav = (const unsigned short*)(F.ws + WS_LAGI); const float* carry = (const float*)(F.ws + WS_CARRY); const float* lam = F.P.in[I_ODLAM];
    const bf16_t* prj = (const bf16_t*)(F.ws + WS_PRJ); bf16_t* yin = (bf16_t*)(F.ws + WS_YIN); const int lane = lane_fresh();
    constexpr int NU = NB * 64 * 20;
    for (int u = F.c * 8 + F.wid; u < NU; u += F.G * 8) {
        const int cg = u % 20, c = 4 + (u / 20) % 64, b = u / (20 * 64);
        const int ch = cg * 128 + lane * 2; const size_t row0 = (size_t)b * TPB + c * 64;
        unsigned yf[64]; f32x2 h2;
        h2 = *(const f32x2*)(carry + (((size_t)0 * NB + b) * 68 + c) * LRUW + ch);
        { const size_t base = row0 * LRUW + ch;
          const f32x2 k2 = {lru_k2(lam, 0, ch), lru_k2(lam, 0, ch + 1)};
#pragma unroll
          for (int blk = 0; blk < 4; ++blk) { unsigned w[16];
#pragma unroll
            for (int r = 0; r < 16; ++r) w[r] = *(const unsigned*)(lav + base + (size_t)(blk * 16 + r) * LRUW);
#pragma unroll
            for (int r = 0; r < 16; ++r) { f32x2 a2, b2; scan_dec(w[r], k2, a2, b2); h2 = a2 * h2 + b2; yf[blk * 16 + r] = cvt_pk_bf16(h2.x, h2.y); } } }
        h2 = *(const f32x2*)(carry + (((size_t)1 * NB + b) * 68 + c) * LRUW + ch);
        { const size_t base = (size_t)MROWS * LRUW + row0 * LRUW + ch;
          const f32x2 k2 = {lru_k2(lam, 1, ch), lru_k2(lam, 1, ch + 1)};
#pragma unroll
          for (int blk = 3; blk >= 0; --blk) { unsigned w[16]; unsigned gw[16];
#pragma unroll
            for (int r = 0; r < 16; ++r) { w[r] = *(const unsigned*)(lav + base + (size_t)(blk * 16 + r) * LRUW); gw[r] = *(const unsigned*)(prj + (row0 + blk * 16 + r) * PRJ_LD + LRUW + ch); }
#pragma unroll
            for (int r = 15; r >= 0; --r) { f32x2 a2, b2; scan_dec(w[r], k2, a2, b2); h2 = a2 * h2 + b2;
                const unsigned f = yf[blk * 16 + r]; const f32x2 o2 = (h2 + (f32x2){bf_lo(f), bf_hi(f)}) * (f32x2){bf_lo(gw[r]), bf_hi(gw[r])}; gw[r] = cvt_pk_bf16(o2.x, o2.y); }
#pragma unroll
            for (int r = 0; r < 16; ++r) *(unsigned*)(yin + (row0 + blk * 16 + r) * YLD + ch) = gw[r]; } }
    }
}

constexpr int NPHASE = 22;
constexpr int LDS_BYTES = 147456;
constexpr int LDS_MISC = 135168;
__global__ void __launch_bounds__(512, 2) mk_fwd(Params prm) {
    extern __shared__ __attribute__((aligned(16))) unsigned char lds_raw[];
    Ctx F; F.P = prm; F.ws = prm.ws; F.wid = __builtin_amdgcn_readfirstlane((int)threadIdx.x >> 6); F.G = gridDim.x; F.c = blockIdx.x;
    F.lds = (LAS unsigned char*)lds_raw; F.ldsg = (char*)lds_raw;
    volatile LAS unsigned* misc = (volatile LAS unsigned*)(F.lds + LDS_MISC);
    if (threadIdx.x < 4) misc[threadIdx.x] = 0u;
    __syncthreads();
    XcdBarrier bar; bar.bar = (unsigned*)(F.ws + WS_CTL); bar.x = 0; bar.st = misc; bar.wid = F.wid;
    const int lo = prm.ph_lo, hi = prm.ph_hi;
    if (hi - lo > 1) bar = xcd_barrier_post((unsigned*)(F.ws + WS_CTL), misc, F.wid);
#ifndef PH_MASK
#define PH_MASK 0xffffffffu
#endif
#define IN(k) ((((unsigned)PH_MASK >> (k)) & 1u) && lo <= (k) && (k) < hi)
#define SEAM(k) do { if (IN((k) + 1)) xcd_barrier(bar); } while (0)
#ifndef REP_MASK
#define REP_MASK 0u
#endif
#define NREP(k) ((((unsigned)REP_MASK >> (k)) & 1u) ? 2 : 1)
#define PHASE(k, ...) if (IN(k)) { for (int rep_ = 0; rep_ < NREP(k); ++rep_) { __VA_ARGS__ if (rep_ + 1 < NREP(k)) xcd_barrier(bar); } SEAM(k); }
    const float* mod = (const float*)(F.ws + WS_MOD);
    PHASE(0, p0_prologue(F);)
    PHASE(1, phase_norm<0>(F);)
    PHASE(2, if (F.c < F.G - NCV2) { SchedDense S{(const char*)(F.ws + WS_ACT), (const char*)(F.ws + WS_WEVIN), NMT, EV_IN / 256, F.G - NCV2, F.c, DM, DM, 0};
        EpiEvIn E{(bf16_t*)(F.ws + WS_PRJ), PRJ_LD}; pg8::gemm_phase<false, false>(F.lds, F.wid, pg8::Shape{DM, DM}, S, E); } else conv_range(F, GT0, GT2, F.G - NCV2);)
    PHASE(3, phase_rope_conv(F);)
    PHASE(4, phase_attn(F);)
    PHASE(5, if (F.c < F.G - NCV5) { SchedDense S{(const char*)(F.ws + WS_YIN), (const char*)(F.ws + WS_WEVOUT), NMT, DM / 256, F.G - NCV5, F.c, YLD, DM, 0};
        EpiResid E{prm.in[I_X], prm.in[I_CTX], (bf16_t*)(F.ws + WS_H), mod, 1}; pg8::gemm_phase<false, false>(F.lds, F.wid, pg8::Shape{DM, YLD}, S, E); } else conv_range(F, GT2, GT5, F.G - NCV5);)
    PHASE(6, phase_router(F, 0);)
    PHASE(7, phase_topk(F, 0);)
    PHASE(8, SchedMoe S{(const char*)(F.ws + WS_ACT), (const char*)(F.ws + WS_WGU), 9, 16, 2304, 4096, F.G, F.c, (const unsigned*)(F.ws + WS_OFFT)};
        EpiSwiglu E{F.ws + WS_HID, 2304}; pg8::gemm_phase<true, true>(F.lds, F.wid, pg8::Shape{DM / 2, DM / 2}, S, E);)
    PHASE(9, if (F.c < F.G - NCV9) { SchedMoe S{(const char*)(F.ws + WS_HID), (const char*)(F.ws + WS_WDN), 9, 8, 2304, 2048, F.G - NCV9, F.c, nullptr};
        EpiDown E{F.ws + WS_EO, (const float*)(F.ws + WS_GVAL), 2304}; pg8::gemm_phase<true, false>(F.lds, F.wid, pg8::Shape{DM / 2, DM / 2}, S, E); } else conv_range(F, GT5, GT9, F.G - NCV9);)
    PHASE(10, phase_norm<1>(F);)
    PHASE(11, if (F.c < F.G - NCV11) { SchedOdIn S{(const char*)(F.ws + WS_ACT), (const char*)(F.ws + WS_WODIN), F.G - NCV11, F.c};
        EpiPlainBf16 E{(bf16_t*)(F.ws + WS_PRJ), PRJ_LD, 10}; pg8::gemm_phase<false, false>(F.lds, F.wid, pg8::Shape{DM, DM}, S, E); } else conv_range(F, GT9, GT11, F.G - NCV11);)
    PHASE(12, phase_lru_conv(F);)
    PHASE(13, if (F.c < F.G - NCV13) { SchedLru S{(const char*)(F.ws + WS_U), (const char*)(F.ws + WS_WLRU), F.G - NCV13, F.c};
        EpiLru E{(const bf16_t*)(F.ws + WS_U), (unsigned*)(F.ws + WS_LAGI), prm.in[I_ODBA], prm.in[I_ODBX], prm.in[I_ODLAM]}; pg8::gemm_phase<false, false>(F.lds, F.wid, pg8::Shape{256, LRUW}, S, E); } else conv_range(F, GT11, GT13, F.G - NCV13);)
    PHASE(14, phase_scan1(F);)
    PHASE(15, phase_scan2(F);)
    PHASE(16, SchedDense S{(const char*)(F.ws + WS_YIN), (const char*)(F.ws + WS_WODOUT), 64, DM / 256, F.G, F.c, YLD, LRUW, 1};
        EpiResid E{prm.in[I_X], prm.in[I_CTX], (bf16_t*)(F.ws + WS_H), mod + 5 * MODN, 0}; pg8::gemm_phase<false, false>(F.lds, F.wid, pg8::Shape{LRUW, YLD}, S, E);)
    PHASE(17, phase_router(F, 1);)
    PHASE(18, phase_topk(F, 1);)
    PHASE(19, SchedMoe S{(const char*)(F.ws + WS_ACT), (const char*)(F.ws + WS_WGU) + (size_t)NEXP * 4096 * DM, 8, 16, 2048, 4096, F.G, F.c, (const unsigned*)(F.ws + WS_OFFT)};
        EpiSwiglu E{F.ws + WS_HID, 2048}; pg8::gemm_phase<true, true>(F.lds, F.wid, pg8::Shape{DM / 2, DM / 2}, S, E);)
    PHASE(20, SchedMoe S{(const char*)(F.ws + WS_HID), (const char*)(F.ws + WS_WDN) + (size_t)NEXP * DM * DM, 8, 8, 2048, 2048, F.G, F.c, nullptr};
        EpiDown E{F.ws + WS_EO, (const float*)(F.ws + WS_GVAL), 2048}; pg8::gemm_phase<true, false>(F.lds, F.wid, pg8::Shape{DM / 2, DM / 2}, S, E);)
    PHASE(21, phase_norm<2>(F);)
#undef IN
#undef SEAM
}

extern "C" void kernel_launch(void* const* d_in, const int* in_sizes, int n_in, void* d_out, int out_size, void* d_ws, size_t ws_size, hipStream_t stream) {
    static int grid = 0;
    if (grid == 0) {
        if (n_in != 28 || out_size != NB * SEQ * DM || ws_size < WS_END) { fprintf(stderr, "kernel_launch: bad shapes: n_in %d out %d ws %zu (need %zu)\n", n_in, out_size, ws_size, (size_t)WS_END); grid = -1; return; }
        int dev = 0, cus = 0, per_cu = 0;
        if (hipGetDevice(&dev) != hipSuccess || hipDeviceGetAttribute(&cus, hipDeviceAttributeMultiprocessorCount, dev) != hipSuccess) { grid = -1; return; }
        if (hipFuncSetAttribute((const void*)mk_fwd, hipFuncAttributeMaxDynamicSharedMemorySize, LDS_BYTES) != hipSuccess) { fprintf(stderr, "kernel_launch: hipFuncSetAttribute failed\n"); grid = -1; return; }
        if (hipOccupancyMaxActiveBlocksPerMultiprocessor(&per_cu, (const void*)mk_fwd, 512, LDS_BYTES) != hipSuccess || per_cu < 1) fprintf(stderr, "kernel_launch: occupancy query says %d\n", per_cu);
        (void)hipGetLastError();
        grid = cus;
    }
    if (grid < 0) return;
    (void)in_sizes;
    (void)hipMemsetAsync((char*)d_ws + WS_CTL, 0, 65536, stream);
    Params p{};
    for (int i = 0; i < 28; ++i) p.in[i] = (const float*)d_in[i];
    p.out = (float*)d_out; p.ws = (unsigned char*)d_ws;
#if MK_PER_PHASE
    for (int ph = 0; ph < NPHASE; ++ph) { p.ph_lo = ph; p.ph_hi = ph + 1; hipLaunchKernelGGL(mk_fwd, dim3(grid), dim3(512), LDS_BYTES, stream, p); }
#else
    p.ph_lo = 0; p.ph_hi = NPHASE; hipLaunchKernelGGL(mk_fwd, dim3(grid), dim3(512), LDS_BYTES, stream, p);
#endif
    const hipError_t le = hipPeekAtLastError();
    if (le != hipSuccess) fprintf(stderr, "kernel_launch: launch failed: %s\n", hipGetErrorName(le));
}
```
